# Optimizing an MI355X kernel written in HIP

```python
import jax, jax.numpy as jnp
from jax import lax
import numpy as np

D_MODEL = 1024
BATCH = 2
SEQ = 8192
DEPTH = 1

CHUNK = 64
Q_BLOCK = 128
SB_HEADS = 8
SB_HD = 64
SB_DIM = SB_HEADS * SB_HD
ML_HEADS = 4
ML_HD = 128
ML_DIM = ML_HEADS * ML_HD
CONV_W = 4
MEM_LEN = 256
MEM_HEADS = 4
MEM_HD = 128
MEM_DIM = MEM_HEADS * MEM_HD
N_BRANCH = 3
N_KEYS = 128
N_EXPERTS = N_KEYS * N_KEYS
PEER_HEADS = 8
PEER_QDIM = 256
PEER_HALF = PEER_QDIM // 2
PEER_TOPK = 16
PEER_BLOCK = 128
EPS = 1e-6
IN_COLS = 3 * SB_DIM + 3 * ML_DIM + 2 * ML_HEADS + ML_DIM + MEM_DIM + N_BRANCH * D_MODEL

kernel_name = "hybrid_stickbreak_mlstm_memxattn_peer"


def _rmsnorm(x, g):
    xf = x.astype(jnp.float32)
    y = xf * lax.rsqrt(jnp.mean(xf * xf, axis=-1, keepdims=True) + EPS)
    return (y * g.astype(jnp.float32)).astype(x.dtype)


def _heads(t, n_heads, hd):
    b, s, _ = t.shape
    return t.reshape(b, s, n_heads, hd).transpose(0, 2, 1, 3)


def _merge(t):
    b, h, s, d = t.shape
    return t.transpose(0, 2, 1, 3).reshape(b, s, h * d)


def _split_points():
    sizes = [SB_DIM] * 3 + [ML_DIM] * 3 + [ML_HEADS, ML_HEADS, ML_DIM, MEM_DIM, N_BRANCH * D_MODEL]
    return [int(c) for c in np.cumsum(sizes)[:-1]]


def _causal_conv(x, w, b):
    s = x.shape[1]
    xp = jnp.pad(x, ((0, 0), (CONV_W - 1, 0), (0, 0)))
    y = b
    for k in range(CONV_W):
        y = y + w[k] * xp[:, k:k + s]
    return y


def _stick_breaking(q, k, v):
    b, h, s, d = q.shape
    nb = s // Q_BLOCK
    scale = d ** -0.5
    qb = q.astype(jnp.float32).reshape(b, h, nb, Q_BLOCK, d).transpose(2, 0, 1, 3, 4)
    starts = jnp.arange(nb, dtype=jnp.int32) * Q_BLOCK
    kf = k.astype(jnp.float32)
    vf = v.astype(jnp.float32)
    s_idx = jnp.arange(s, dtype=jnp.int32)

    def block(args):
        qi, start = args
        z = jnp.einsum('bhqd,bhkd->bhqk', qi, kf) * scale
        t_idx = start + jnp.arange(Q_BLOCK, dtype=jnp.int32)
        mask = s_idx[None, :] < t_idx[:, None]
        log_keep = jnp.where(mask, jax.nn.log_sigmoid(-z), 0.0)
        suffix = lax.cumsum(log_keep, axis=3, reverse=True) - log_keep
        a = jnp.where(mask, jnp.exp(jax.nn.log_sigmoid(z) + suffix), 0.0)
        return jnp.einsum('bhqk,bhkd->bhqd', a, vf)

    out = lax.map(block, (qb, starts))
    return out.transpose(1, 2, 0, 3, 4).reshape(b, h, s, d)


def _mlstm_step(carry, inp):
    c_st, n_st, m_st = carry
    q, k, v, ig, lf = inp
    l = q.shape[2]
    causal = jnp.tril(jnp.ones((l, l), dtype=bool))
    bcum = jnp.cumsum(lf, axis=-1)
    dmat = jnp.where(causal, bcum[..., :, None] - bcum[..., None, :] + ig[..., None, :], -jnp.inf)
    m_inter = bcum + m_st[..., None]
    m_t = jnp.maximum(m_inter, jnp.max(dmat, axis=-1))
    w = jnp.einsum('bhtd,bhsd->bhts', q, k) * jnp.exp(dmat - m_t[..., None])
    inter = jnp.exp(m_inter - m_t)
    num = jnp.einsum('bhts,bhse->bhte', w, v) + inter[..., None] * jnp.einsum('bhtd,bhde->bhte', q, c_st)
    den = jnp.sum(w, axis=-1) + inter * jnp.einsum('bhtd,bhd->bht', q, n_st)
    h = num / jnp.maximum(jnp.abs(den), jnp.exp(-m_t))[..., None]
    b_last = bcum[..., -1]
    g = b_last[..., None] - bcum + ig
    m_new = jnp.maximum(b_last + m_st, jnp.max(g, axis=-1))
    ws = jnp.exp(g - m_new[..., None])
    decay = jnp.exp(b_last + m_st - m_new)
    c_new = decay[..., None, None] * c_st + jnp.einsum('bhs,bhsd,bhse->bhde', ws, k, v)
    n_new = decay[..., None] * n_st + jnp.einsum('bhs,bhsd->bhd', ws, k)
    return (c_new, n_new, m_new), h


def _mlstm(q, k, v, ig, lf):
    b, h, s, d = q.shape
    nc = s // CHUNK

    def chunks(t):
        return jnp.moveaxis(t.reshape(b, h, nc, CHUNK, *t.shape[3:]), 2, 0)

    init = (jnp.zeros((b, h, d, d), jnp.float32), jnp.zeros((b, h, d), jnp.float32),
            jnp.zeros((b, h), jnp.float32))
    _, hs = lax.scan(_mlstm_step, init, (chunks(q), chunks(k), chunks(v), chunks(ig), chunks(lf)))
    return jnp.moveaxis(hs, 0, 2).reshape(b, h, s, d)


def _memory_attention(q, memn, w_kv, q_g, k_g):
    kv = memn @ w_kv
    km, vm = jnp.split(kv, 2, axis=-1)
    qh = _rmsnorm(_heads(q, MEM_HEADS, MEM_HD), q_g).astype(jnp.float32)
    kh = _rmsnorm(_heads(km, MEM_HEADS, MEM_HD), k_g).astype(jnp.float32)
    vh = _heads(vm, MEM_HEADS, MEM_HD).astype(jnp.float32)
    sc = jnp.einsum('bhqd,bhkd->bhqk', qh, kh) * (MEM_HD ** -0.5)
    p = jax.nn.softmax(sc, axis=-1)
    return _merge(jnp.einsum('bhqk,bhkd->bhqd', p, vh)).astype(q.dtype)


def _peer(xn, w_q, k1, k2, u_tab, v_tab):
    b, s, d = xn.shape
    t = b * s
    xf = xn.reshape(t, d)
    qry = (xf @ w_q).reshape(t, PEER_HEADS, 2, PEER_HALF).astype(jnp.float32)
    s1 = jnp.einsum('thd,hkd->thk', qry[:, :, 0], k1.astype(jnp.float32))
    s2 = jnp.einsum('thd,hkd->thk', qry[:, :, 1], k2.astype(jnp.float32))
    v1, i1 = lax.top_k(s1, PEER_TOPK)
    v2, i2 = lax.top_k(s2, PEER_TOPK)
    cand = (v1[..., :, None] + v2[..., None, :]).reshape(t, PEER_HEADS, PEER_TOPK * PEER_TOPK)
    top_v, top_c = lax.top_k(cand, PEER_TOPK)
    e1 = jnp.take_along_axis(i1, top_c // PEER_TOPK, axis=-1)
    e2 = jnp.take_along_axis(i2, top_c % PEER_TOPK, axis=-1)
    idx = e1 * N_KEYS + e2
    gates = jax.nn.softmax(top_v, axis=-1).astype(xn.dtype)
    nb = t // PEER_BLOCK

    def block(args):
        xb, ib, gb = args
        u = u_tab[ib]
        act = jax.nn.gelu(jnp.einsum('phkd,pd->phk', u, xb), approximate=False)
        return jnp.einsum('phk,phkd->pd', gb * act, v_tab[ib])

    out = lax.map(block, (xf.reshape(nb, PEER_BLOCK, d), idx.reshape(nb, PEER_BLOCK, PEER_HEADS, PEER_TOPK),
                          gates.reshape(nb, PEER_BLOCK, PEER_HEADS, PEER_TOPK)))
    return out.reshape(b, s, d)


def setup_inputs(seed: int = 0) -> dict:
    key = jax.random.key(seed)
    ks = jax.random.split(key, 26)

    def nrm(k, shape, scale):
        return jax.random.normal(k, shape, jnp.float32) * scale

    L = DEPTH
    return {
        "x": nrm(ks[0], (BATCH, SEQ, D_MODEL), 1.0),
        "mem": nrm(ks[1], (BATCH, MEM_LEN, D_MODEL), 1.0),
        "g_mix": 1.0 + nrm(ks[2], (L, D_MODEL), 0.1),
        "w_in": nrm(ks[3], (L, D_MODEL, IN_COLS), D_MODEL ** -0.5),
        "b_igate": nrm(ks[4], (L, ML_HEADS), 0.1),
        "b_fgate": 3.0 + nrm(ks[5], (L, ML_HEADS), 0.5),
        "conv_w": nrm(ks[6], (L, CONV_W, 2 * ML_DIM), 0.5),
        "conv_b": nrm(ks[7], (L, 2 * ML_DIM), 0.02),
        "ml_norm_g": 1.0 + nrm(ks[8], (L, ML_HD), 0.1),
        "mem_norm_g": 1.0 + nrm(ks[9], (L, D_MODEL), 0.1),
        "w_mem_kv": nrm(ks[10], (L, D_MODEL, 2 * MEM_DIM), D_MODEL ** -0.5),
        "q_norm_g": 1.0 + nrm(ks[11], (L, MEM_HD), 0.1),
        "k_norm_g": 1.0 + nrm(ks[12], (L, MEM_HD), 0.1),
        "w_sb_o": nrm(ks[13], (L, SB_DIM, D_MODEL), SB_DIM ** -0.5),
        "w_ml_o": nrm(ks[14], (L, ML_DIM, D_MODEL), ML_DIM ** -0.5),
        "w_mem_o": nrm(ks[15], (L, MEM_DIM, D_MODEL), MEM_DIM ** -0.5),
        "b_gate": nrm(ks[16], (L, N_BRANCH * D_MODEL), 0.1),
        "w_out": nrm(ks[17], (L, D_MODEL, D_MODEL), D_MODEL ** -0.5),
        "g_ffn": 1.0 + nrm(ks[18], (L, D_MODEL), 0.1),
        "w_peer_q": nrm(ks[19], (L, D_MODEL, PEER_HEADS * PEER_QDIM), D_MODEL ** -0.5),
        "peer_k1": nrm(ks[20], (L, PEER_HEADS, N_KEYS, PEER_HALF), PEER_HALF ** -0.5),
        "peer_k2": nrm(ks[21], (L, PEER_HEADS, N_KEYS, PEER_HALF), PEER_HALF ** -0.5),
        "peer_u": nrm(ks[22], (L, N_EXPERTS, D_MODEL), D_MODEL ** -0.5),
        "peer_v": nrm(ks[23], (L, N_EXPERTS, D_MODEL), 0.5),
    }


def reference(x, mem, g_mix, w_in, b_igate, b_fgate, conv_w, conv_b, ml_norm_g, mem_norm_g, w_mem_kv,
              q_norm_g, k_norm_g, w_sb_o, w_ml_o, w_mem_o, b_gate, w_out, g_ffn, w_peer_q, peer_k1,
              peer_k2, peer_u, peer_v):
    bsz, s, _ = x.shape
    h = x
    splits = _split_points()
    for l in range(DEPTH):
        xn = _rmsnorm(h, g_mix[l])
        proj = xn @ w_in[l]
        (sb_q, sb_k, sb_v, ml_q, ml_k, ml_v, ml_i, ml_f, ml_o, mem_q, gate_pre) = jnp.split(proj, splits, axis=-1)

        y_sb = _stick_breaking(_heads(sb_q, SB_HEADS, SB_HD), _heads(sb_k, SB_HEADS, SB_HD),
                               _heads(sb_v, SB_HEADS, SB_HD))
        y_sb = _merge(y_sb).astype(x.dtype)

        qk = jax.nn.silu(_causal_conv(jnp.concatenate([ml_q, ml_k], axis=-1), conv_w[l], conv_b[l]))
        mq, mk = jnp.split(qk, 2, axis=-1)
        qh = _heads(mq, ML_HEADS, ML_HD).astype(jnp.float32)
        kh = _heads(mk, ML_HEADS, ML_HD).astype(jnp.float32) * (ML_HD ** -0.5)
        vh = _heads(ml_v, ML_HEADS, ML_HD).astype(jnp.float32)
        ig = (ml_i + b_igate[l]).astype(jnp.float32).transpose(0, 2, 1)
        lf = jax.nn.log_sigmoid((ml_f + b_fgate[l]).astype(jnp.float32)).transpose(0, 2, 1)
        hm = _mlstm(qh, kh, vh, ig, lf)
        hm = _rmsnorm(hm, ml_norm_g[l])
        y_ml = (_merge(hm) * jax.nn.sigmoid(ml_o.astype(jnp.float32))).astype(x.dtype)

        memn = _rmsnorm(mem, mem_norm_g[l])
        y_mem = _memory_attention(mem_q, memn, w_mem_kv[l], q_norm_g[l], k_norm_g[l])

        gates = jax.nn.sigmoid(gate_pre + b_gate[l]).reshape(bsz, s, N_BRANCH, D_MODEL)
        merged = (gates[:, :, 0] * (y_sb @ w_sb_o[l]) + gates[:, :, 1] * (y_ml @ w_ml_o[l])
                  + gates[:, :, 2] * (y_mem @ w_mem_o[l]))
        h = h + merged @ w_out[l]

        hn = _rmsnorm(h, g_ffn[l])
        h = h + _peer(hn, w_peer_q[l], peer_k1[l], peer_k2[l], peer_u[l], peer_v[l])
    return h
```

```cpp
#include <hip/hip_runtime.h>
#include <cstdio>
#include <cstdint>

#ifndef MK_N_LAUNCHES
#define MK_N_LAUNCHES 1
#endif

namespace pg8 {
#define PG8_LAS __attribute__((address_space(3)))
typedef unsigned short bf16_t;
typedef short bf16x8 __attribute__((ext_vector_type(8)));
typedef float f32x4 __attribute__((ext_vector_type(4)));
typedef unsigned u32x4 __attribute__((ext_vector_type(4)));
constexpr int BM = 256, BK = 64, HALF = 128, HTB = HALF * BK * 2  , STAGE_BYTES = 8 * HTB, NXCD = 8, WGM = 8;

__host__ __device__ __forceinline__ int lds_byte(int r, int c) { const int st = (r >> 4) * 2 + (c >> 5), rr = r & 15, cc = c & 31, ob = rr * 64 + cc * 2; return st * 1024 + (ob ^ (((ob >> 9) & 1) << 5)); }
__host__ __device__ __forceinline__ void stage_rc(int b, int& R, int& C) { const int st = b / 1024, sb = b % 1024, swz = sb ^ (((sb >> 9) & 1) << 5); R = (st >> 1) * 16 + swz / 64; C = (st & 1) * 32 + (swz % 64) / 2; }
__host__ __device__ __forceinline__ int perm32(int rho) { const int n = rho >> 4, i = rho & 15; return 8 * (i >> 2) + 4 * n + (i & 3); }

struct Unit { int pm, pn, g; };
struct Gemm { const bf16_t* A; const bf16_t* Bt; int lda, ldb, K; };

struct StaticOrder {
    int nM, nN, nwg, G, c;
    __host__ __device__ void init(int M, int N, int G_, int c_) { nM = M / BM; nN = N / BM; nwg = nM * nN; G = G_; c = c_; }
    __host__ __device__ bool next(int i, Unit& u) const {
        const long L = (long)i * G + c; if (L >= nwg) return false;
        int wgid = (int)L; { const int q = nwg / NXCD, r = nwg % NXCD, xcd = wgid % NXCD, off = wgid / NXCD; wgid = (xcd < r ? xcd * (q + 1) : r * (q + 1) + (xcd - r) * q) + off; }
        const int nig = WGM * nN, gid = wgid / nig, fm = gid * WGM, gsz = (nM - fm) < WGM ? (nM - fm) : WGM;
        u.pm = fm + ((wgid % nig) % gsz); u.pn = (wgid % nig) / gsz; u.g = 0; return true;
    }
    __device__ __forceinline__ const char* aptr(const Gemm& g, const Unit& u) const { return (const char*)g.A + (size_t)u.pm * BM * g.lda * 2; }
    __device__ __forceinline__ const char* bptr(const Gemm& g, const Unit& u) const { return (const char*)g.Bt + (size_t)u.pn * BM * g.ldb * 2; }
    __device__ __forceinline__ void a_ready(const Unit&) const {}
    __device__ __forceinline__ void done(const Unit&) const {}
};
struct FewOrder {
    int nN, n, c;
    __device__ bool next(int i, Unit& u) const { if (i > 0 || c >= n) return false; u.pm = c / nN; u.pn = c % nN; u.g = 0; return true; }
    __device__ __forceinline__ const char* aptr(const Gemm& g, const Unit& u) const { return (const char*)g.A + (size_t)u.pm * BM * g.lda * 2; }
    __device__ __forceinline__ const char* bptr(const Gemm& g, const Unit& u) const { return (const char*)g.Bt + (size_t)u.pn * BM * g.ldb * 2; }
    __device__ __forceinline__ void a_ready(const Unit&) const {}
    __device__ __forceinline__ void done(const Unit&) const {}
};
struct GroupOrder {
    StaticOrder so; int ng; size_t a_gstride, b_gstride;
    __device__ bool next(int i, Unit& u) const { if (i >= ng) return false; if (!so.next(0, u)) return false; u.g = i; return true; }
    __device__ __forceinline__ const char* aptr(const Gemm& g, const Unit& u) const { return (const char*)g.A + (size_t)u.g * a_gstride + (size_t)u.pm * BM * g.lda * 2; }
    __device__ __forceinline__ const char* bptr(const Gemm& g, const Unit& u) const { return (const char*)g.Bt + (size_t)u.g * b_gstride + (size_t)u.pn * BM * g.ldb * 2; }
    __device__ __forceinline__ void a_ready(const Unit&) const {}
    __device__ __forceinline__ void done(const Unit&) const {}
};

__device__ __forceinline__ unsigned cvt_pk_bf16(float lo, float hi) { unsigned r; asm volatile("v_cvt_pk_bf16_f32 %0, %1, %2" : "=v"(r) : "v"(lo), "v"(hi)); return r; }
__device__ __forceinline__ float bf_lo(unsigned x) { return __uint_as_float(x << 16); }
__device__ __forceinline__ float bf_hi(unsigned x) { return __uint_as_float(x & 0xffff0000u); }
__device__ __forceinline__ float sigmoidf_(float x) { return 1.0f / (1.0f + __expf(-x)); }

struct EpiProj {
    static constexpr bool PERM = true, AFTER_DRAIN = false;
    bf16_t* O; int ldc; const float* bias; int split_cols; size_t split_stride; int n_sig_bias, sig_lo, sig_hi;
    __device__ __forceinline__ void operator()(const f32x4 (&acc)[2][2][4][2], const Unit& u, int wr, int wc, int fr, int fq) const {
        const int row0 = u.pm * BM + wr * 64 + fr; int colt = u.pn * BM; bf16_t* base = O;
        if (split_cols) { const int t = colt / split_cols; base += (size_t)t * split_stride; colt -= t * split_cols; }
        const int col0 = colt + wc * 32 + 8 * fq, bcol0 = u.pn * BM + wc * 32 + 8 * fq;
        const int mode = (u.pn < n_sig_bias) ? 1 : ((u.pn >= sig_lo && u.pn < sig_hi) ? 2 : 0);
        f32x4 bv[2][2];
#pragma unroll
        for (int bj = 0; bj < 2; ++bj)
#pragma unroll
            for (int n = 0; n < 2; ++n) bv[bj][n] = (mode == 1) ? *(const f32x4*)(bias + bcol0 + bj * HALF + 4 * n) : (f32x4){0.f, 0.f, 0.f, 0.f};
#pragma unroll
        for (int ai = 0; ai < 2; ++ai)
#pragma unroll
            for (int m = 0; m < 4; ++m) { bf16_t* rowp = base + (size_t)(row0 + ai * HALF + m * 16) * ldc + col0;
#pragma unroll
                for (int bj = 0; bj < 2; ++bj) { f32x4 v0 = acc[ai][bj][m][0] + bv[bj][0], v1 = acc[ai][bj][m][1] + bv[bj][1];
                    if (mode != 0) {
#pragma unroll
                        for (int e = 0; e < 4; ++e) { v0[e] = sigmoidf_(v0[e]); v1[e] = sigmoidf_(v1[e]); } }
                    u32x4 w; w.x = cvt_pk_bf16(v0[0], v0[1]); w.y = cvt_pk_bf16(v0[2], v0[3]); w.z = cvt_pk_bf16(v1[0], v1[1]); w.w = cvt_pk_bf16(v1[2], v1[3]);
                    *(u32x4*)(rowp + bj * HALF) = w; } }
    }
};

struct EpiBranch {
    static constexpr bool PERM = true, AFTER_DRAIN = false;
    const bf16_t* gates; size_t gate_stride; bf16_t* merged;
    __device__ __forceinline__ void operator()(const f32x4 (&acc)[2][2][4][2], const Unit& u, int wr, int wc, int fr, int fq) const {
        const int row0 = u.pm * BM + wr * 64 + fr; const int col0 = u.pn * BM + wc * 32 + 8 * fq;
#pragma unroll
        for (int ai = 0; ai < 2; ++ai)
#pragma unroll
            for (int m = 0; m < 4; ++m) { const size_t row = (size_t)(row0 + ai * HALF + m * 16);
#pragma unroll
                for (int bj = 0; bj < 2; ++bj) { const int c = col0 + bj * HALF; const int gc = u.g * 1024 + c;
                    const u32x4 gw = *(const u32x4*)(gates + (size_t)(gc >> 9) * gate_stride + row * 512 + (gc & 511));
                    bf16_t* mp = merged + row * 1024 + c;
                    f32x4 v0 = acc[ai][bj][m][0], v1 = acc[ai][bj][m][1];
                    v0[0] *= bf_lo(gw.x); v0[1] *= bf_hi(gw.x); v0[2] *= bf_lo(gw.y); v0[3] *= bf_hi(gw.y);
                    v1[0] *= bf_lo(gw.z); v1[1] *= bf_hi(gw.z); v1[2] *= bf_lo(gw.w); v1[3] *= bf_hi(gw.w);
                    if (u.g > 0) { const u32x4 pv = *(const u32x4*)mp;
                        v0[0] += bf_lo(pv.x); v0[1] += bf_hi(pv.x); v0[2] += bf_lo(pv.y); v0[3] += bf_hi(pv.y);
                        v1[0] += bf_lo(pv.z); v1[1] += bf_hi(pv.z); v1[2] += bf_lo(pv.w); v1[3] += bf_hi(pv.w); }
                    u32x4 w; w.x = cvt_pk_bf16(v0[0], v0[1]); w.y = cvt_pk_bf16(v0[2], v0[3]); w.z = cvt_pk_bf16(v1[0], v1[1]); w.w = cvt_pk_bf16(v1[2], v1[3]);
                    *(u32x4*)mp = w; } }
    }
};

struct EpiOut {
    static constexpr bool PERM = true, AFTER_DRAIN = false;
    const float* x; float* out; bf16_t* h1b; float* sumsq;
    __device__ __forceinline__ void operator()(const f32x4 (&acc)[2][2][4][2], const Unit& u, int wr, int wc, int fr, int fq) const {
        const int row0 = u.pm * BM + wr * 64 + fr; const int col0 = u.pn * BM + wc * 32 + 8 * fq;
#pragma unroll
        for (int ai = 0; ai < 2; ++ai)
#pragma unroll
            for (int m = 0; m < 4; ++m) { const size_t row = (size_t)(row0 + ai * HALF + m * 16); float ss = 0.f;
#pragma unroll
                for (int bj = 0; bj < 2; ++bj) { const size_t off = row * 1024 + col0 + bj * HALF;
                    const f32x4 x0 = *(const f32x4*)(x + off), x1 = *(const f32x4*)(x + off + 4);
                    const f32x4 v0 = acc[ai][bj][m][0] + x0, v1 = acc[ai][bj][m][1] + x1;
                    *(f32x4*)(out + off) = v0; *(f32x4*)(out + off + 4) = v1;
                    ss += (v0[0] * v0[0] + v0[1] * v0[1]) + (v0[2] * v0[2] + v0[3] * v0[3]) + (v1[0] * v1[0] + v1[1] * v1[1]) + (v1[2] * v1[2] + v1[3] * v1[3]);
                    u32x4 w; w.x = cvt_pk_bf16(v0[0], v0[1]); w.y = cvt_pk_bf16(v0[2], v0[3]); w.z = cvt_pk_bf16(v1[0], v1[1]); w.w = cvt_pk_bf16(v1[2], v1[3]);
                    *(u32x4*)(h1b + off) = w; }
                ss += __shfl_xor(ss, 16); ss += __shfl_xor(ss, 32);
                if (fq == 0) atomicAdd(sumsq + row, ss); }
    }
};

struct EpiQry {
    static constexpr bool PERM = true, AFTER_DRAIN = false;
    const float* sumsq; bf16_t* qry; float eps;
    __device__ __forceinline__ void operator()(const f32x4 (&acc)[2][2][4][2], const Unit& u, int wr, int wc, int fr, int fq) const {
        const int row0 = u.pm * BM + wr * 64 + fr; const int col0 = u.pn * BM + wc * 32 + 8 * fq;
#pragma unroll
        for (int ai = 0; ai < 2; ++ai)
#pragma unroll
            for (int m = 0; m < 4; ++m) { const size_t row = (size_t)(row0 + ai * HALF + m * 16);
                const float rs = __builtin_amdgcn_rsqf(__hip_atomic_load(sumsq + row, __ATOMIC_RELAXED, __HIP_MEMORY_SCOPE_AGENT) * (1.0f / 1024.0f) + eps);
#pragma unroll
                for (int bj = 0; bj < 2; ++bj) { const f32x4 v0 = acc[ai][bj][m][0] * rs, v1 = acc[ai][bj][m][1] * rs;
                    u32x4 w; w.x = cvt_pk_bf16(v0[0], v0[1]); w.y = cvt_pk_bf16(v0[2], v0[3]); w.z = cvt_pk_bf16(v1[0], v1[1]); w.w = cvt_pk_bf16(v1[2], v1[3]);
                    *(u32x4*)(qry + row * 2048 + col0 + bj * HALF) = w; } }
    }
};

template <class Epi, class Sched, bool ALIGN_EPI = false, bool SP2 = false>
__device__ __forceinline__ void gemm_phase(PG8_LAS unsigned char* lds, const Gemm g, const Sched& S, const Epi& E) {
    const int tid = threadIdx.x, wid = __builtin_amdgcn_readfirstlane(tid >> 6), lane = tid & 63, wr = wid >> 2, wc = wid & 3, fr = lane & 15, fq = lane >> 4;
    const int K = g.K, nt = K / BK;
    unsigned voffA[2], voffB[2];
#pragma unroll
    for (int i = 0; i < 2; ++i) { int R, C; stage_rc(tid * 16 + i * 8192, R, C); const int Rb = Epi::PERM ? ((R & ~31) + perm32(R & 31)) : R;
        voffA[i] = (unsigned)(R * g.lda + C) * 2u; voffB[i] = (unsigned)(Rb * g.ldb + C) * 2u; }
    const size_t kstep = (size_t)(BK * 2);
    const size_t hstepA = (size_t)HALF * g.lda * 2, hstepB = (size_t)HALF * g.ldb * 2;
    const unsigned ldsw = (unsigned)wid * 1024u;
    const int aoff = lds_byte(wr * 64 + fr, fq * 8), boff = lds_byte(wc * 32 + fr, fq * 8);
#define PG8_SA(b, h) (((b) * 2 + (h)) * HTB)
#define PG8_SB(b, h) ((4 + (b) * 2 + (h)) * HTB)
#define PG8_STAGE(bufoff, gbase, voff) do { _Pragma("unroll") for (int _i = 0; _i < 2; ++_i) \
        __builtin_amdgcn_global_load_lds((const unsigned*)((const char*)(gbase) + (voff)[_i]), (PG8_LAS unsigned*)(lds + (bufoff) + ldsw + _i * 8192), 16, 0, 0); } while (0)
#define PG8_LDA(dst, b, h) do { _Pragma("unroll") for (int m = 0; m < 4; ++m) _Pragma("unroll") for (int k = 0; k < 2; ++k) dst[m][k] = *(const PG8_LAS bf16x8*)(lds + PG8_SA(b, h) + aoff + m * 2048 + k * 1024); } while (0)
#define PG8_LDB(dst, b, h) do { _Pragma("unroll") for (int n = 0; n < 2; ++n) _Pragma("unroll") for (int k = 0; k < 2; ++k) dst[n][k] = *(const PG8_LAS bf16x8*)(lds + PG8_SB(b, h) + boff + n * 2048 + k * 1024); } while (0)
#define PG8_MMA(ai, bj, At, Bt) do { __builtin_amdgcn_s_setprio(1); _Pragma("unroll") for (int m = 0; m < 4; ++m) _Pragma("unroll") for (int n = 0; n < 2; ++n) _Pragma("unroll") for (int k = 0; k < 2; ++k) \
        acc[ai][bj][m][n] = __builtin_amdgcn_mfma_f32_16x16x32_bf16(Bt[n][k], At[m][k], acc[ai][bj][m][n], 0, 0, 0); __builtin_amdgcn_s_setprio(0); } while (0)
#define PG8_WAIT_V(n) asm volatile("s_waitcnt vmcnt(" #n ")" ::: "memory")
#define PG8_WAIT_L(n) asm volatile("s_waitcnt lgkmcnt(" #n ")" ::: "memory")
#define PG8_BAR __builtin_amdgcn_s_barrier()
#define PG8_SCHED __builtin_amdgcn_sched_barrier(0)
    Unit cur, nxt; int ui = 0;
    if (!S.next(0, cur)) return;
    f32x4 acc[2][2][4][2];
#pragma unroll
    for (int a = 0; a < 2; ++a)
#pragma unroll
        for (int b = 0; b < 2; ++b)
#pragma unroll
            for (int m = 0; m < 4; ++m)
#pragma unroll
                for (int n = 0; n < 2; ++n) acc[a][b][m][n] = (f32x4){0.f, 0.f, 0.f, 0.f};
    bf16x8 At[4][2], B0[2][2], B1[2][2];
    const char* cA = S.aptr(g, cur); const char* cB = S.bptr(g, cur);
    S.a_ready(cur);
    if constexpr (SP2) {
        PG8_STAGE(PG8_SB(0, 0), cB, voffB); PG8_STAGE(PG8_SB(0, 1), cB + hstepB, voffB); PG8_STAGE(PG8_SA(0, 0), cA, voffA); PG8_STAGE(PG8_SA(0, 1), cA + hstepA, voffA);
        if (wr == 1) PG8_BAR;
        PG8_WAIT_V(2); PG8_BAR;
        PG8_STAGE(PG8_SB(1, 0), cB + kstep, voffB); PG8_STAGE(PG8_SA(1, 0), cA + kstep, voffA); PG8_STAGE(PG8_SB(1, 1), cB + hstepB + kstep, voffB);
        PG8_WAIT_V(6); PG8_BAR;
    } else {
        PG8_STAGE(PG8_SB(0, 0), cB, voffB); PG8_STAGE(PG8_SA(0, 0), cA, voffA); PG8_STAGE(PG8_SB(0, 1), cB + hstepB, voffB); PG8_STAGE(PG8_SA(0, 1), cA + hstepA, voffA);
        if (wr == 1) PG8_BAR;
        PG8_WAIT_V(4); PG8_BAR;
        PG8_STAGE(PG8_SB(1, 0), cB + kstep, voffB); PG8_STAGE(PG8_SA(1, 0), cA + kstep, voffA); PG8_STAGE(PG8_SB(1, 1), cB + hstepB + kstep, voffB);
        PG8_WAIT_V(6); PG8_BAR;
    }
    for (;;) {
        const bool has_next = S.next(ui + 1, nxt);
        const char* nA = has_next ? S.aptr(g, nxt) : cA; const char* nB = has_next ? S.bptr(g, nxt) : cB;
        for (int t = 0; t < nt; t += 2) {
            const bool last = (t == nt - 2);
            const char* a1 = cA + (size_t)(t + 1) * kstep;
            const char* a2 = last ? nA : cA + (size_t)(t + 2) * kstep; const char* b2 = last ? nB : cB + (size_t)(t + 2) * kstep;
            const char* a3 = a2 + kstep; const char* b3 = b2 + kstep;
            if (last && has_next) S.a_ready(nxt);
            if constexpr (SP2) {
            PG8_LDB(B0, 0, 0); PG8_LDB(B1, 0, 1); PG8_SCHED; PG8_LDA(At, 0, 0); PG8_STAGE(PG8_SA(1, 1), a1 + hstepA, voffA);
            PG8_WAIT_V(8); PG8_WAIT_L(0); PG8_BAR; PG8_MMA(0, 0, At, B0); PG8_MMA(0, 1, At, B1); PG8_BAR; PG8_SCHED;
            PG8_LDA(At, 0, 1); PG8_STAGE(PG8_SB(0, 0), b2, voffB); PG8_STAGE(PG8_SB(0, 1), b2 + hstepB, voffB); PG8_STAGE(PG8_SA(0, 0), a2, voffA);
            PG8_WAIT_V(8); PG8_WAIT_L(0); PG8_BAR; PG8_MMA(1, 0, At, B0); PG8_MMA(1, 1, At, B1); PG8_BAR; PG8_SCHED;
            PG8_LDB(B0, 1, 0); PG8_LDB(B1, 1, 1); PG8_SCHED; PG8_LDA(At, 1, 0); PG8_STAGE(PG8_SA(0, 1), a2 + hstepA, voffA);
            PG8_WAIT_V(8); PG8_WAIT_L(0); PG8_BAR; PG8_MMA(0, 0, At, B0); PG8_MMA(0, 1, At, B1); PG8_BAR; PG8_SCHED;
            PG8_LDA(At, 1, 1); PG8_STAGE(PG8_SB(1, 0), b3, voffB); PG8_STAGE(PG8_SB(1, 1), b3 + hstepB, voffB); PG8_STAGE(PG8_SA(1, 0), a3, voffA);
            PG8_WAIT_V(8); PG8_WAIT_L(0); PG8_BAR; PG8_MMA(1, 0, At, B0); PG8_MMA(1, 1, At, B1); PG8_BAR; PG8_SCHED;
            } else {
            PG8_LDB(B0, 0, 0); PG8_SCHED; PG8_LDA(At, 0, 0); PG8_STAGE(PG8_SA(1, 1), a1 + hstepA, voffA);
            PG8_WAIT_L(8); PG8_BAR; PG8_WAIT_L(0); PG8_MMA(0, 0, At, B0); PG8_BAR; PG8_SCHED;
            PG8_LDB(B1, 0, 1); PG8_STAGE(PG8_SB(0, 0), b2, voffB);
            PG8_BAR; PG8_WAIT_L(0); PG8_MMA(0, 1, At, B1); PG8_BAR;
            PG8_LDA(At, 0, 1); PG8_STAGE(PG8_SA(0, 0), a2, voffA);
            PG8_BAR; PG8_WAIT_L(0); PG8_MMA(1, 0, At, B0); PG8_BAR; PG8_SCHED;
            PG8_STAGE(PG8_SB(0, 1), b2 + hstepB, voffB);
            PG8_WAIT_V(6); PG8_BAR; PG8_MMA(1, 1, At, B1); PG8_BAR;
            PG8_LDB(B0, 1, 0); PG8_SCHED; PG8_LDA(At, 1, 0); PG8_STAGE(PG8_SA(0, 1), a2 + hstepA, voffA);
            PG8_WAIT_L(8); PG8_BAR; PG8_WAIT_L(0); PG8_MMA(0, 0, At, B0); PG8_BAR; PG8_SCHED;
            PG8_LDB(B1, 1, 1); PG8_STAGE(PG8_SB(1, 0), b3, voffB);
            PG8_BAR; PG8_WAIT_L(0); PG8_MMA(0, 1, At, B1); PG8_BAR;
            PG8_LDA(At, 1, 1); PG8_STAGE(PG8_SA(1, 0), a3, voffA);
            PG8_BAR; PG8_WAIT_L(0); PG8_MMA(1, 0, At, B0); PG8_BAR; PG8_SCHED;
            PG8_STAGE(PG8_SB(1, 1), b3 + hstepB, voffB);
            PG8_WAIT_V(6); PG8_BAR; PG8_MMA(1, 1, At, B1); PG8_BAR;
            }
        }
        if constexpr (ALIGN_EPI) { if (wr == 0) PG8_BAR; }
        if constexpr (!Epi::AFTER_DRAIN) { E(acc, cur, wr, wc, fr, fq); S.done(cur); }
        if (!has_next) break;
#pragma unroll
        for (int a = 0; a < 2; ++a)
#pragma unroll
            for (int b = 0; b < 2; ++b)
#pragma unroll
                for (int m = 0; m < 4; ++m)
#pragma unroll
                    for (int n = 0; n < 2; ++n) acc[a][b][m][n] = (f32x4){0.f, 0.f, 0.f, 0.f};
        cur = nxt; cA = nA; cB = nB; ++ui;
        if constexpr (ALIGN_EPI) { if (wr == 1) PG8_BAR; }
    }
    PG8_WAIT_V(0);
    if constexpr (!ALIGN_EPI) { if (wr == 0) PG8_BAR; }
    PG8_BAR;
    if constexpr (Epi::AFTER_DRAIN) { E.fused(acc, cur, wr, wc, fr, fq, lds, wid, lane); S.done(cur); }
#undef PG8_SA
#undef PG8_SB
#undef PG8_STAGE
#undef PG8_LDA
#undef PG8_LDB
#undef PG8_MMA
#undef PG8_WAIT_V
#undef PG8_WAIT_L
#undef PG8_BAR
#undef PG8_SCHED
}
}

constexpr int NWAVES = 8;
constexpr int N_LAUNCHES = MK_N_LAUNCHES;
constexpr int PER_PHASE = 10;

constexpr int T_TOK = 16384, DM = 1024, SEQ = 8192;
constexpr float EPS = 1e-6f;
constexpr int W_IN_COLS = 7176;

constexpr size_t MiB = 1u << 20;
constexpr size_t WS_CTL = 0, CTL_ZERO_BYTES = 1 * MiB;
constexpr size_t WS_WIN = 1 * MiB, WS_WKV = 15 * MiB, WS_WBR = 17 * MiB, WS_WOUT = 20 * MiB, WS_WPQ = 22 * MiB, WS_PK = 26 * MiB;
constexpr size_t WS_KVMEM = 26 * MiB + 512 * 1024, WS_MEMN = 27 * MiB + 512 * 1024, WS_IGLF = 28 * MiB + 512 * 1024, WS_ND = 29 * MiB, WS_NS = 29 * MiB + 512 * 1024;
constexpr size_t WS_GATES = 30 * MiB;
constexpr size_t WS_MLQ = 126 * MiB, WS_MLK = 142 * MiB, WS_SBQ = 158 * MiB, WS_MLV = 174 * MiB, WS_MEMQ = 190 * MiB, WS_MLO = 206 * MiB, WS_SBK = 222 * MiB, WS_SBV = 238 * MiB;
constexpr size_t WS_UT = 30 * MiB, WS_VT = 62 * MiB;
constexpr size_t WS_H1B = 126 * MiB;
constexpr size_t WS_QRY = 158 * MiB;
constexpr size_t WS_CT = 222 * MiB;
constexpr size_t WS_MERGED = 222 * MiB;
constexpr size_t WS_IDX = 222 * MiB, WS_GW = 230 * MiB;
constexpr size_t WS_END = 254 * MiB;
constexpr size_t SPLIT_STRIDE = (size_t)T_TOK * 512;
constexpr size_t CTL_CHS = 256 * 1024, CTL_MS = 272 * 1024, CTL_SUMSQ = 512 * 1024;
constexpr int CW_BAR = 4096;

constexpr int RING_BYTES = 131072;
constexpr int LDSCTL_OFF = RING_BYTES, MISC_OFF = LDSCTL_OFF + 320;
constexpr int LDS_BYTES = 147456;

#define GAS __attribute__((address_space(1)))
#define LAS __attribute__((address_space(3)))
typedef unsigned short bf16;
typedef unsigned v4u __attribute__((ext_vector_type(4)));
typedef unsigned v2u __attribute__((ext_vector_type(2)));
typedef float f32x4 __attribute__((ext_vector_type(4)));
typedef short bf16x8 __attribute__((ext_vector_type(8)));
typedef GAS unsigned gu32;
#define RLX_AGENT __ATOMIC_RELAXED, __HIP_MEMORY_SCOPE_AGENT
#define LDS_WAIT() asm volatile("s_waitcnt lgkmcnt(0)" ::: "memory")
#define VM_WAIT() asm volatile("s_waitcnt vmcnt(0)" ::: "memory")
__device__ __forceinline__ unsigned f2bf(float f) { unsigned u = __builtin_bit_cast(unsigned, f); return (u + 0x7fffu + ((u >> 16) & 1u)) >> 16; }
__device__ __forceinline__ unsigned pk2(float lo, float hi) { return f2bf(lo) | (f2bf(hi) << 16); }
__device__ __forceinline__ float bflo(unsigned x) { return __uint_as_float(x << 16); }
__device__ __forceinline__ float bfhi(unsigned x) { return __uint_as_float(x & 0xffff0000u); }
__device__ __forceinline__ float sigm(float x) { return 1.0f / (1.0f + __expf(-x)); }
__device__ __forceinline__ float softplusf_(float z) { return fmaxf(z, 0.f) + __logf(1.0f + __expf(-fabsf(z))); }

#define XB_TMO      128
#define XB_XCNT(j)  (256  + 64 * (j))
#define XB_XSUB(j)  (1280 + 64 * (j))
#define XB_XGEN(j)  (2304 + 64 * (j))
#define XB_TOP      3328
#define XB_TOPGEN   3392
#define XCD_BAR_WORDS 3456
#define XB_SPIN_CAP (1u << 18)
__device__ __forceinline__ unsigned xb_ld(unsigned* p)              { return __hip_atomic_load(p, __ATOMIC_RELAXED, __HIP_MEMORY_SCOPE_AGENT); }
__device__ __forceinline__ unsigned xb_add(unsigned* p, unsigned v) { return __hip_atomic_fetch_add(p, v, __ATOMIC_RELAXED, __HIP_MEMORY_SCOPE_AGENT); }
__device__ __forceinline__ unsigned xb_xcc_id() { return (unsigned)__builtin_amdgcn_s_getreg((3 << 11) | 20) & 0xFu; }
#define XB_SPIN(cond, bar) do { unsigned _sp = 0; while (cond) { __builtin_amdgcn_s_sleep(1); \
    if ((++_sp & 255u) == 0u) { if (xb_ld(&(bar)[XB_TMO])) break; if (_sp > XB_SPIN_CAP) { atomicAdd(&(bar)[XB_TMO], 1u); break; } } } } while (0)
struct XcdBarrier { unsigned* bar; unsigned x; volatile LAS unsigned* st; };
__device__ __forceinline__ XcdBarrier xcd_barrier_post(unsigned* bar, volatile LAS unsigned* st) {
    XcdBarrier b; b.bar = bar; b.x = xb_xcc_id(); b.st = st;
    if (threadIdx.x == 0) (void)xb_add(&bar[XB_XCNT(b.x)], 1u);
    return b;
}
__device__ __forceinline__ void xcd_barrier_complete(unsigned* bar, unsigned x, unsigned& nloc, unsigned& nx) {
    const unsigned G = gridDim.x * gridDim.y * gridDim.z;
    unsigned sum, cnt, mine, sp = 0u;
    for (;;) {
        sum = 0u; cnt = 0u; mine = 0u;
#pragma unroll
        for (unsigned j = 0; j < 16; ++j) { const unsigned c = xb_ld(&bar[XB_XCNT(j)]); sum += c; cnt += (c > 0u) ? 1u : 0u; mine = (j == x) ? c : mine; }
        if (sum == G) break;
        __builtin_amdgcn_s_sleep(1);
        if ((++sp & 255u) == 0u) { if (xb_ld(&bar[XB_TMO])) break; if (sp > XB_SPIN_CAP) { atomicAdd(&bar[XB_TMO], 1u); break; } }
    }
    nloc = mine > 0u ? mine : 1u; nx = cnt > 0u ? cnt : 1u;
}
__device__ __forceinline__ void xcd_barrier(const XcdBarrier& b) {
    asm volatile("s_waitcnt vmcnt(0)" ::: "memory");
    __syncthreads();
    if (threadIdx.x == 0) {
        unsigned* bar = b.bar;
        __builtin_amdgcn_s_waitcnt(0);
        unsigned nloc = b.st[0], nx = b.st[1];
        if (nloc == 0u) { xcd_barrier_complete(bar, b.x, nloc, nx); b.st[0] = nloc; b.st[1] = nx; }
        const unsigned old = xb_add(&bar[XB_XSUB(b.x)], 1u);
        const unsigned gen = old / nloc;
        if (old + 1u == (gen + 1u) * nloc) {
            __builtin_amdgcn_fence(__ATOMIC_RELEASE, "agent");
            asm volatile("s_waitcnt vmcnt(0)" ::: "memory");
            const unsigned og = xb_add(&bar[XB_TOP], 1u);
            const unsigned tg = og / nx;
            if (og + 1u == (tg + 1u) * nx) xb_add(&bar[XB_TOPGEN], 1u);
            else XB_SPIN(xb_ld(&bar[XB_TOPGEN]) == tg, bar);
            __builtin_amdgcn_fence(__ATOMIC_ACQUIRE, "agent");
            xb_add(&bar[XB_XGEN(b.x)], 1u);
            asm volatile("s_waitcnt vmcnt(0)" ::: "memory");
        } else {
            XB_SPIN(xb_ld(&bar[XB_XGEN(b.x)]) == gen, bar);
            __builtin_amdgcn_fence(__ATOMIC_ACQUIRE, "agent");
            asm volatile("s_waitcnt vmcnt(0)" ::: "memory");
        }
    }
    __syncthreads();
}

struct Frame {
    LAS unsigned char* lds;
    volatile LAS unsigned* MISC;
    int tid, lane, wave, G;
    unsigned char* ws; float* out;
    const float* in[24];
};
__device__ __forceinline__ float wave_sum(float v) {
#pragma unroll
    for (int o = 1; o < 64; o <<= 1) v += __shfl_xor(v, o);
    return v;
}
__device__ __forceinline__ float wave_max(float v) {
#pragma unroll
    for (int o = 1; o < 64; o <<= 1) v = fmaxf(v, __shfl_xor(v, o));
    return v;
}

template <int NT, int KS>
__device__ __forceinline__ void wave_mma(f32x4 (&acc)[NT], const LAS unsigned char* A, int pitchA, int m0, const LAS unsigned char* Bt, int pitchB, int n0, int lane, int koffA = 0, int koffB = 0) {
    const int r = lane & 15, q = lane >> 4;
#pragma unroll
    for (int ks = 0; ks < KS; ++ks) {
        const bf16x8 a = *(const LAS bf16x8*)(A + (m0 + r) * pitchA + (koffA + ks * 32 + q * 8) * 2);
#pragma unroll
        for (int j = 0; j < NT; ++j) {
            const bf16x8 b = *(const LAS bf16x8*)(Bt + (n0 + 16 * j + r) * pitchB + (koffB + ks * 32 + q * 8) * 2);
            acc[j] = __builtin_amdgcn_mfma_f32_16x16x32_bf16(a, b, acc[j], 0, 0, 0);
        }
    }
}
__device__ __forceinline__ void lds_store_tr8(LAS unsigned char* base, int pitch, int d0, int col, v4u v) {
    *(LAS unsigned short*)(base + (d0 + 0) * pitch + col * 2) = (unsigned short)(v.x & 0xffffu); *(LAS unsigned short*)(base + (d0 + 1) * pitch + col * 2) = (unsigned short)(v.x >> 16);
    *(LAS unsigned short*)(base + (d0 + 2) * pitch + col * 2) = (unsigned short)(v.y & 0xffffu); *(LAS unsigned short*)(base + (d0 + 3) * pitch + col * 2) = (unsigned short)(v.y >> 16);
    *(LAS unsigned short*)(base + (d0 + 4) * pitch + col * 2) = (unsigned short)(v.z & 0xffffu); *(LAS unsigned short*)(base + (d0 + 5) * pitch + col * 2) = (unsigned short)(v.z >> 16);
    *(LAS unsigned short*)(base + (d0 + 6) * pitch + col * 2) = (unsigned short)(v.w & 0xffffu); *(LAS unsigned short*)(base + (d0 + 7) * pitch + col * 2) = (unsigned short)(v.w >> 16);
}

__device__ __forceinline__ void p0_transpose_item(const float* W, int ldsrc, int src_off, int K, int ncols, bf16* WT, int row_off, const float* kscale, LAS float* scr, int item, int lane) {
    const int nblk = ncols / 32, kb = item / nblk, nb = item % nblk, k0 = 64 * kb, n0 = 32 * nb;
#pragma unroll 8
    for (int i = 0; i < 32; ++i) { const int kk = 2 * i + (lane >> 5); float v = W[(size_t)(k0 + kk) * ldsrc + src_off + n0 + (lane & 31)]; if (kscale) v *= kscale[k0 + kk]; scr[kk * 33 + (lane & 31)] = v; }
    LDS_WAIT(); asm volatile("" ::: "memory");
    const int c = lane & 7;
#pragma unroll
    for (int j = 0; j < 4; ++j) { const int n = (lane >> 3) + 8 * j; const LAS float* s = scr + (8 * c) * 33 + n;
        v4u o; o.x = pk2(s[0 * 33], s[1 * 33]); o.y = pk2(s[2 * 33], s[3 * 33]); o.z = pk2(s[4 * 33], s[5 * 33]); o.w = pk2(s[6 * 33], s[7 * 33]);
        *(GAS v4u*)(WT + (size_t)(row_off + n0 + n) * K + k0 + 8 * c) = o; }
    LDS_WAIT(); asm volatile("" ::: "memory");
}

__device__ __forceinline__ void p0_prologue(Frame& F) {
    const float* x = F.in[0]; const float* mem = F.in[1]; const float* g_mix = F.in[2]; const float* w_in = F.in[3];
    const float* b_ig = F.in[4]; const float* b_fg = F.in[5]; const float* mem_g = F.in[9];
    bf16* XN = (bf16*)F.out;
    bf16* MEMN = (bf16*)(F.ws + WS_MEMN);
    float* IGLF = (float*)(F.ws + WS_IGLF);
    LAS float* gws = (LAS float*)(F.lds + 69632);
    for (int e = F.tid; e < 8192; e += 512) { const int c = e & 7, k = e >> 3; gws[c * 1024 + k] = w_in[(size_t)k * W_IN_COLS + 3072 + c]; }
    __syncthreads();
    const int gw = blockIdx.x * NWAVES + F.wave, NGW = F.G * NWAVES;
    for (int m = gw; m < T_TOK + 512; m += NGW) {
        const bool is_mem = m >= T_TOK;
        const float* src = is_mem ? mem + (size_t)(m - T_TOK) * DM : x + (size_t)m * DM;
        const float* gsrc = is_mem ? mem_g : g_mix;
        bf16* dst = is_mem ? MEMN + (size_t)(m - T_TOK) * DM : XN + (size_t)m * DM;
        const GAS f32x4* xr = (const GAS f32x4*)src + F.lane;
        f32x4 v[4]; float s = 0.f;
#pragma unroll
        for (int j = 0; j < 4; ++j) { v[j] = xr[64 * j]; s += (v[j].x * v[j].x + v[j].y * v[j].y) + (v[j].z * v[j].z + v[j].w * v[j].w); }
        const float rstd = 1.0f / sqrtf(wave_sum(s) * (1.f / DM) + EPS);
#pragma unroll
        for (int j = 0; j < 4; ++j) { const f32x4 gg = *((const GAS f32x4*)gsrc + F.lane + 64 * j); v[j] = v[j] * rstd * gg; }
        GAS unsigned long long* o8 = (GAS unsigned long long*)dst + F.lane;
#pragma unroll
        for (int j = 0; j < 4; ++j) o8[64 * j] = (unsigned long long)pk2(v[j].x, v[j].y) | ((unsigned long long)pk2(v[j].z, v[j].w) << 32);
        if (!is_mem) {
            float dots[8];
#pragma unroll
            for (int c = 0; c < 8; ++c) { float d = 0.f;
#pragma unroll
                for (int j = 0; j < 4; ++j) { const f32x4 wv = *(const LAS f32x4*)(gws + c * 1024 + 256 * j + 4 * F.lane); d += (v[j].x * wv.x + v[j].y * wv.y) + (v[j].z * wv.z + v[j].w * wv.w); }
                dots[c] = wave_sum(d); }
            if (F.lane == 0) {
                f32x4 o0, o1;
#pragma unroll
                for (int h = 0; h < 4; ++h) { o0[h] = dots[h] + b_ig[h]; const float fp = dots[4 + h] + b_fg[h]; o1[h] = fminf(fp, 0.f) - __logf(1.0f + __expf(-fabsf(fp))); }
                *(GAS f32x4*)(IGLF + (size_t)m * 8) = o0; *(GAS f32x4*)(IGLF + (size_t)m * 8 + 4) = o1;
            }
        }
    }
    { const float* k1 = F.in[20]; const float* k2 = F.in[21]; bf16* PK = (bf16*)(F.ws + WS_PK);
      for (int e = (blockIdx.x * 512 + F.tid) * 4; e < 2 * 131072; e += F.G * 512 * 4) {
          const f32x4 vv = (e < 131072) ? *(const GAS f32x4*)(k1 + e) : *(const GAS f32x4*)(k2 + e - 131072);
          v2u o; o.x = pk2(vv.x, vv.y); o.y = pk2(vv.z, vv.w); *(GAS v2u*)(PK + e) = o; } }
    __syncthreads();
    LAS float* scr = (LAS float*)(F.lds + F.wave * 8448);
    bf16* WIN = (bf16*)(F.ws + WS_WIN); bf16* WKV = (bf16*)(F.ws + WS_WKV); bf16* WBR = (bf16*)(F.ws + WS_WBR); bf16* WOUT = (bf16*)(F.ws + WS_WOUT); bf16* WPQ = (bf16*)(F.ws + WS_WPQ);
    constexpr int I_G = 16 * 96, I_5 = 16 * 16, I_KV = 16 * 32, I_BR = 8 * 32, I_OUT = 16 * 32, I_PQ = 16 * 64;
    constexpr int NITEMS = I_G + 8 * I_5 + I_KV + 3 * I_BR + I_OUT + I_PQ;
    for (int it = gw; it < NITEMS; it += NGW) {
        int r = it;
        if (r < I_G) { p0_transpose_item(w_in, W_IN_COLS, 4104, 1024, 3072, WIN, 0, nullptr, scr, r, F.lane); continue; } r -= I_G;
        if (r < I_5) { p0_transpose_item(w_in, W_IN_COLS, 1536, 1024, 512, WIN, 3072, nullptr, scr, r, F.lane); continue; } r -= I_5;
        if (r < I_5) { p0_transpose_item(w_in, W_IN_COLS, 2048, 1024, 512, WIN, 3584, nullptr, scr, r, F.lane); continue; } r -= I_5;
        if (r < I_5) { p0_transpose_item(w_in, W_IN_COLS, 0, 1024, 512, WIN, 4096, nullptr, scr, r, F.lane); continue; } r -= I_5;
        if (r < I_5) { p0_transpose_item(w_in, W_IN_COLS, 2560, 1024, 512, WIN, 4608, nullptr, scr, r, F.lane); continue; } r -= I_5;
        if (r < I_5) { p0_transpose_item(w_in, W_IN_COLS, 3592, 1024, 512, WIN, 5120, nullptr, scr, r, F.lane); continue; } r -= I_5;
        if (r < I_5) { p0_transpose_item(w_in, W_IN_COLS, 3080, 1024, 512, WIN, 5632, nullptr, scr, r, F.lane); continue; } r -= I_5;
        if (r < I_5) { p0_transpose_item(w_in, W_IN_COLS, 512, 1024, 512, WIN, 6144, nullptr, scr, r, F.lane); continue; } r -= I_5;
        if (r < I_5) { p0_transpose_item(w_in, W_IN_COLS, 1024, 1024, 512, WIN, 6656, nullptr, scr, r, F.lane); continue; } r -= I_5;
        if (r < I_KV) { p0_transpose_item(F.in[10], 1024, 0, 1024, 1024, WKV, 0, nullptr, scr, r, F.lane); continue; } r -= I_KV;
        if (r < I_BR) { p0_transpose_item(F.in[13], 1024, 0, 512, 1024, WBR, 0, nullptr, scr, r, F.lane); continue; } r -= I_BR;
        if (r < I_BR) { p0_transpose_item(F.in[14], 1024, 0, 512, 1024, WBR, 1024, nullptr, scr, r, F.lane); continue; } r -= I_BR;
        if (r < I_BR) { p0_transpose_item(F.in[15], 1024, 0, 512, 1024, WBR, 2048, nullptr, scr, r, F.lane); continue; } r -= I_BR;
        if (r < I_OUT) { p0_transpose_item(F.in[17], 1024, 0, 1024, 1024, WOUT, 0, nullptr, scr, r, F.lane); continue; } r -= I_OUT;
        p0_transpose_item(F.in[19], 2048, 0, 1024, 2048, WPQ, 0, F.in[18], scr, r, F.lane);
    }
}

__device__ __forceinline__ void sb_attn_item(Frame& F, int item) {
    const int bh = item >> 6, qb = item & 63, b = bh >> 3, h = bh & 7;
    const int tid = F.tid, lane = F.lane, w = F.wave;
    LAS unsigned char* Qs = F.lds;
    LAS unsigned char* Ks = F.lds + 18432;
    LAS unsigned char* VTs = F.lds + 27648;
    LAS unsigned char* Ss = F.lds + 36864;
    LAS unsigned char* Ps = F.lds + 71680;
    LAS float* red = (LAS float*)(F.lds + 90112);
    bf16* SBQ = (bf16*)(F.ws + WS_SBQ); const bf16* SBK = (const bf16*)(F.ws + WS_SBK); const bf16* SBV = (const bf16*)(F.ws + WS_SBV);
    const size_t row0 = (size_t)b * SEQ + (size_t)qb * 128;
    __syncthreads();
#pragma unroll
    for (int i = 0; i < 2; ++i) { const int p = tid + 512 * i, r = p >> 3, c = p & 7;
        const v4u v = *(const GAS v4u*)(SBQ + (row0 + r) * 512 + h * 64 + c * 8); *(LAS v4u*)(Qs + r * 144 + c * 16) = v; }
    f32x4 oacc[4];
#pragma unroll
    for (int j = 0; j < 4; ++j) oacc[j] = (f32x4){0.f, 0.f, 0.f, 0.f};
    float R = 0.f;
    const int r = tid >> 2, qd = tid & 3;
    const int tq = qb * 128 + r;
    for (int jb = 2 * qb + 1; jb >= 0; --jb) {
        __syncthreads();
        { const int key = tid >> 3, c = tid & 7; const size_t grow = (size_t)b * SEQ + (size_t)jb * 64 + key;
          const v4u kv = *(const GAS v4u*)(SBK + grow * 512 + h * 64 + c * 8); *(LAS v4u*)(Ks + key * 144 + c * 16) = kv;
          const v4u vv = *(const GAS v4u*)(SBV + grow * 512 + h * 64 + c * 8); lds_store_tr8(VTs, 144, c * 8, key, vv); }
        __syncthreads();
        { f32x4 sacc[4];
#pragma unroll
          for (int j = 0; j < 4; ++j) sacc[j] = (f32x4){0.f, 0.f, 0.f, 0.f};
          wave_mma<4, 2>(sacc, Qs, 144, 16 * w, Ks, 144, 0, lane);
#pragma unroll
          for (int j = 0; j < 4; ++j)
#pragma unroll
              for (int rg = 0; rg < 4; ++rg) *(LAS float*)(Ss + (16 * w + 4 * (lane >> 4) + rg) * 272 + (16 * j + (lane & 15)) * 4) = sacc[j][rg]; }
        __syncthreads();
        { float z[16];
#pragma unroll
          for (int i4 = 0; i4 < 4; ++i4) { const f32x4 t4 = *(const LAS f32x4*)(Ss + r * 272 + qd * 64 + i4 * 16); z[4 * i4] = t4.x; z[4 * i4 + 1] = t4.y; z[4 * i4 + 2] = t4.z; z[4 * i4 + 3] = t4.w; }
          const int s0 = jb * 64 + qd * 16;
          float suf[16], lb[16]; float run = 0.f;
#pragma unroll
          for (int i = 15; i >= 0; --i) { const float zz = z[i] * 0.125f; const bool mk = (s0 + i) < tq; const float sp = softplusf_(zz); lb[i] = zz - sp; suf[i] = run; run += mk ? -sp : 0.f; }
          const float a1 = __shfl_xor(run, 1), a2 = __shfl_xor(run, 2), a3 = __shfl_xor(run, 3);
          const float off = ((qd & 1) == 0 ? a1 : 0.f) + ((qd & 2) == 0 ? a2 : 0.f) + (qd < 2 ? a3 : 0.f);
          const float base = R + off;
          unsigned pw[8];
#pragma unroll
          for (int i = 0; i < 16; i += 2) { const float p0 = ((s0 + i) < tq) ? __expf(lb[i] + base + suf[i]) : 0.f; const float p1 = ((s0 + i + 1) < tq) ? __expf(lb[i + 1] + base + suf[i + 1]) : 0.f; pw[i >> 1] = pk2(p0, p1); }
          *(LAS v4u*)(Ps + r * 144 + qd * 32) = (v4u){pw[0], pw[1], pw[2], pw[3]}; *(LAS v4u*)(Ps + r * 144 + qd * 32 + 16) = (v4u){pw[4], pw[5], pw[6], pw[7]};
          R += run + a1 + a2 + a3; }
        const float rm = wave_max(R);
        if (lane == 0) red[w] = rm;
        __syncthreads();
        wave_mma<4, 2>(oacc, Ps, 144, 16 * w, VTs, 144, 0, lane);
        float rmax = red[0];
#pragma unroll
        for (int i = 1; i < 8; ++i) rmax = fmaxf(rmax, red[i]);
        if (rmax < -110.f) break;
    }
    LDS_WAIT();
#pragma unroll
    for (int j = 0; j < 4; ++j)
#pragma unroll
        for (int rg = 0; rg < 4; ++rg) *(LAS unsigned short*)(Ps + (16 * w + 4 * (lane >> 4) + rg) * 144 + (16 * j + (lane & 15)) * 2) = (unsigned short)f2bf(oacc[j][rg]);
    LDS_WAIT();
#pragma unroll
    for (int i = 0; i < 2; ++i) { const int p = lane + 64 * i, rr = 16 * w + (p >> 3), c = p & 7;
        const v4u v = *(const LAS v4u*)(Ps + rr * 144 + c * 16); *(GAS v4u*)(SBQ + (row0 + rr) * 512 + h * 64 + c * 8) = v; }
}

__device__ __forceinline__ void conv16(const bf16* src, int col, const float* cw, const float* cb, int ch, int b, int t, float (&y)[16]) {
#pragma unroll
    for (int i4 = 0; i4 < 4; ++i4) { const f32x4 bb = *(const GAS f32x4*)(cb + ch + 4 * i4); y[4 * i4] = bb.x; y[4 * i4 + 1] = bb.y; y[4 * i4 + 2] = bb.z; y[4 * i4 + 3] = bb.w; }
#pragma unroll
    for (int kk = 0; kk < 4; ++kk) { const int tt = t - 3 + kk;
        if (tt >= 0) { const bf16* p = src + ((size_t)b * SEQ + tt) * 512 + col; const v4u x0 = *(const GAS v4u*)p, x1 = *(const GAS v4u*)(p + 8);
            const float xs[16] = {bflo(x0.x), bfhi(x0.x), bflo(x0.y), bfhi(x0.y), bflo(x0.z), bfhi(x0.z), bflo(x0.w), bfhi(x0.w), bflo(x1.x), bfhi(x1.x), bflo(x1.y), bfhi(x1.y), bflo(x1.z), bfhi(x1.z), bflo(x1.w), bfhi(x1.w)};
#pragma unroll
            for (int i4 = 0; i4 < 4; ++i4) { const f32x4 wv = *(const GAS f32x4*)(cw + kk * 1024 + ch + 4 * i4);
                y[4 * i4] += wv.x * xs[4 * i4]; y[4 * i4 + 1] += wv.y * xs[4 * i4 + 1]; y[4 * i4 + 2] += wv.z * xs[4 * i4 + 2]; y[4 * i4 + 3] += wv.w * xs[4 * i4 + 3]; } } }
#pragma unroll
    for (int i = 0; i < 16; ++i) y[i] = y[i] * sigm(y[i]);
}

__device__ __forceinline__ void mlstm_local_item(Frame& F, int item) {
    const int bh = item >> 7, c = item & 127, b = bh >> 2, h = bh & 3;
    const int tid = F.tid, lane = F.lane, w = F.wave;
    LAS float* wsm = (LAS float*)F.lds;
    LAS unsigned char* WKT = F.lds + 256;
    LAS unsigned char* VT = F.lds + 256 + 18432;
    const float* IGLF = (const float*)(F.ws + WS_IGLF);
    float* CHS = (float*)(F.ws + WS_CTL + CTL_CHS);
    const bf16* MLK = (const bf16*)(F.ws + WS_MLK); const bf16* MLV = (const bf16*)(F.ws + WS_MLV);
    float* Dg = F.out + (size_t)item * 16384; float* NDg = (float*)(F.ws + WS_ND) + (size_t)item * 128;
    const int t0 = c * 64; const size_t row0 = (size_t)b * SEQ + t0;
    __syncthreads();
    if (w == 0) {
        const float lf = IGLF[(row0 + lane) * 8 + 4 + h], ig = IGLF[(row0 + lane) * 8 + h];
        float bs = lf;
#pragma unroll
        for (int o = 1; o < 64; o <<= 1) { const float v = __shfl_up(bs, o); if (lane >= o) bs += v; }
        const float blast = __shfl(bs, 63);
        const float a = blast - bs + ig; const float mu = wave_max(a);
        wsm[lane] = __expf(a - mu);
        if (lane == 0) { CHS[2 * item] = blast; CHS[2 * item + 1] = mu; }
    }
    __syncthreads();
    { const int s = tid >> 3, part = tid & 7; float y[16];
      conv16(MLK, h * 128 + part * 16, F.in[6], F.in[7], 512 + h * 128 + part * 16, b, t0 + s, y);
      const float sc = wsm[s] * 0.08838834764831845f;
      v4u k0, k1; k0.x = pk2(y[0] * sc, y[1] * sc); k0.y = pk2(y[2] * sc, y[3] * sc); k0.z = pk2(y[4] * sc, y[5] * sc); k0.w = pk2(y[6] * sc, y[7] * sc);
      k1.x = pk2(y[8] * sc, y[9] * sc); k1.y = pk2(y[10] * sc, y[11] * sc); k1.z = pk2(y[12] * sc, y[13] * sc); k1.w = pk2(y[14] * sc, y[15] * sc);
      lds_store_tr8(WKT, 144, part * 16, s, k0); lds_store_tr8(WKT, 144, part * 16 + 8, s, k1);
      const bf16* vp = MLV + (row0 + s) * 512 + h * 128 + part * 16; const v4u v0 = *(const GAS v4u*)vp, v1 = *(const GAS v4u*)(vp + 8);
      lds_store_tr8(VT, 144, part * 16, s, v0); lds_store_tr8(VT, 144, part * 16 + 8, s, v1); }
    __syncthreads();
    { f32x4 acc[8];
#pragma unroll
      for (int j = 0; j < 8; ++j) acc[j] = (f32x4){0.f, 0.f, 0.f, 0.f};
      wave_mma<8, 2>(acc, VT, 144, 16 * w, WKT, 144, 0, lane);
#pragma unroll
      for (int j = 0; j < 8; ++j)
#pragma unroll
          for (int rg = 0; rg < 4; ++rg) Dg[(16 * w + 4 * (lane >> 4) + rg) * 128 + 16 * j + (lane & 15)] = acc[j][rg]; }
    if (tid < 128) { float s = 0.f;
#pragma unroll
        for (int i = 0; i < 8; ++i) { const v4u v = *(const LAS v4u*)(WKT + tid * 144 + i * 16); s += (bflo(v.x) + bfhi(v.x)) + (bflo(v.y) + bfhi(v.y)) + (bflo(v.z) + bfhi(v.z)) + (bflo(v.w) + bfhi(v.w)); }
        NDg[tid] = s; }
}

__device__ __forceinline__ void mlstm_scan(Frame& F) {
    const float* CHS = (const float*)(F.ws + WS_CTL + CTL_CHS); float* MS = (float*)(F.ws + WS_CTL + CTL_MS);
    const float* Dg = F.out; bf16* CT = (bf16*)(F.ws + WS_CT);
    const float* NDg = (const float*)(F.ws + WS_ND); float* NS = (float*)(F.ws + WS_NS);
    for (int g = blockIdx.x * 512 + F.tid; g < 8 * 16384 + 8 * 128; g += F.G * 512) {
        const bool isn = g >= 8 * 16384; const int gg = isn ? g - 8 * 16384 : g;
        const int bh = isn ? (gg >> 7) : (gg >> 14), e = isn ? (gg & 127) : (gg & 16383);
        float st = 0.f, m = 0.f;
#pragma unroll 8
        for (int c = 0; c < 128; ++c) { const int item = bh * 128 + c;
            const float blast = CHS[2 * item], mu = CHS[2 * item + 1];
            const float d = isn ? NDg[(size_t)item * 128 + e] : Dg[(size_t)item * 16384 + e];
            if (isn) { NS[(size_t)item * 128 + e] = st; if (e == 0) MS[item] = m; } else CT[(size_t)item * 16384 + e] = (bf16)f2bf(st);
            const float mn = fmaxf(blast + m, mu);
            st = __expf(blast + m - mn) * st + __expf(mu - mn) * d; m = mn; }
    }
}

__device__ __forceinline__ void mem_attn_item(Frame& F, int item) {
    const int tile = item & 63, h = (item >> 6) & 3, b = item >> 8;
    const int tid = F.tid, lane = F.lane, w = F.wave;
    LAS unsigned char* Qs = F.lds;
    LAS unsigned char* KVs = F.lds + 34816;
    LAS unsigned char* Pw = F.lds + 34816 + 69632 + w * 2304;
    bf16* MEMQ = (bf16*)(F.ws + WS_MEMQ); const bf16* KV = (const bf16*)(F.ws + WS_KVMEM);
    const float* qg = F.in[11]; const float* kg = F.in[12];
    const size_t row0 = (size_t)b * SEQ + (size_t)tile * 128;
    __syncthreads();
    { const int r = tid >> 2, part = tid & 3; const bf16* p = MEMQ + (row0 + r) * 512 + h * 128 + part * 32;
      v4u x[4]; float s = 0.f;
#pragma unroll
      for (int i = 0; i < 4; ++i) { x[i] = *(const GAS v4u*)(p + 8 * i);
          s += (bflo(x[i].x) * bflo(x[i].x) + bfhi(x[i].x) * bfhi(x[i].x)) + (bflo(x[i].y) * bflo(x[i].y) + bfhi(x[i].y) * bfhi(x[i].y)) + (bflo(x[i].z) * bflo(x[i].z) + bfhi(x[i].z) * bfhi(x[i].z)) + (bflo(x[i].w) * bflo(x[i].w) + bfhi(x[i].w) * bfhi(x[i].w)); }
      s += __shfl_xor(s, 1); s += __shfl_xor(s, 2);
      const float rs = 0.08838834764831845f / sqrtf(s * (1.f / 128.f) + EPS);
#pragma unroll
      for (int i = 0; i < 4; ++i) { const f32x4 g0 = *(const GAS f32x4*)(qg + part * 32 + 8 * i), g1 = *(const GAS f32x4*)(qg + part * 32 + 8 * i + 4);
          v4u o; o.x = pk2(bflo(x[i].x) * rs * g0.x, bfhi(x[i].x) * rs * g0.y); o.y = pk2(bflo(x[i].y) * rs * g0.z, bfhi(x[i].y) * rs * g0.w);
          o.z = pk2(bflo(x[i].z) * rs * g1.x, bfhi(x[i].z) * rs * g1.y); o.w = pk2(bflo(x[i].w) * rs * g1.z, bfhi(x[i].w) * rs * g1.w);
          *(LAS v4u*)(Qs + r * 272 + part * 64 + i * 16) = o; } }
    { const int key = tid >> 1, half = tid & 1; const bf16* p = KV + ((size_t)b * 256 + key) * 1024 + h * 128 + half * 64;
      v4u x[8]; float s = 0.f;
#pragma unroll
      for (int i = 0; i < 8; ++i) { x[i] = *(const GAS v4u*)(p + 8 * i);
          s += (bflo(x[i].x) * bflo(x[i].x) + bfhi(x[i].x) * bfhi(x[i].x)) + (bflo(x[i].y) * bflo(x[i].y) + bfhi(x[i].y) * bfhi(x[i].y)) + (bflo(x[i].z) * bflo(x[i].z) + bfhi(x[i].z) * bfhi(x[i].z)) + (bflo(x[i].w) * bflo(x[i].w) + bfhi(x[i].w) * bfhi(x[i].w)); }
      s += __shfl_xor(s, 1);
      const float rs = 1.0f / sqrtf(s * (1.f / 128.f) + EPS);
#pragma unroll
      for (int i = 0; i < 8; ++i) { const f32x4 g0 = *(const GAS f32x4*)(kg + half * 64 + 8 * i), g1 = *(const GAS f32x4*)(kg + half * 64 + 8 * i + 4);
          v4u o; o.x = pk2(bflo(x[i].x) * rs * g0.x, bfhi(x[i].x) * rs * g0.y); o.y = pk2(bflo(x[i].y) * rs * g0.z, bfhi(x[i].y) * rs * g0.w);
          o.z = pk2(bflo(x[i].z) * rs * g1.x, bfhi(x[i].z) * rs * g1.y); o.w = pk2(bflo(x[i].w) * rs * g1.z, bfhi(x[i].w) * rs * g1.w);
          *(LAS v4u*)(KVs + key * 272 + half * 128 + i * 16) = o; } }
    __syncthreads();
    f32x4 sacc[16];
#pragma unroll
    for (int j = 0; j < 16; ++j) sacc[j] = (f32x4){0.f, 0.f, 0.f, 0.f};
    wave_mma<16, 4>(sacc, Qs, 272, 16 * w, KVs, 272, 0, lane);
    float rsum[4];
#pragma unroll
    for (int rg = 0; rg < 4; ++rg) { float mx = sacc[0][rg];
#pragma unroll
        for (int j = 1; j < 16; ++j) mx = fmaxf(mx, sacc[j][rg]);
        mx = fmaxf(mx, __shfl_xor(mx, 1)); mx = fmaxf(mx, __shfl_xor(mx, 2)); mx = fmaxf(mx, __shfl_xor(mx, 4)); mx = fmaxf(mx, __shfl_xor(mx, 8));
        float sm = 0.f;
#pragma unroll
        for (int j = 0; j < 16; ++j) { const float p = __expf(sacc[j][rg] - mx); sacc[j][rg] = p; sm += p; }
        sm += __shfl_xor(sm, 1); sm += __shfl_xor(sm, 2); sm += __shfl_xor(sm, 4); sm += __shfl_xor(sm, 8);
        rsum[rg] = 1.0f / sm; }
    __syncthreads();
#pragma unroll
    for (int i = 0; i < 8; ++i) { const int p = tid + 512 * i, key = p >> 4, c = p & 15;
        const v4u v = *(const GAS v4u*)(KV + ((size_t)b * 256 + key) * 1024 + 512 + h * 128 + c * 8); lds_store_tr8(KVs, 528, c * 8, key, v); }
    __syncthreads();
    f32x4 oacc[8];
#pragma unroll
    for (int j = 0; j < 8; ++j) oacc[j] = (f32x4){0.f, 0.f, 0.f, 0.f};
#pragma unroll
    for (int kc = 0; kc < 4; ++kc) {
        LDS_WAIT();
#pragma unroll
        for (int jj = 0; jj < 4; ++jj)
#pragma unroll
            for (int rg = 0; rg < 4; ++rg) *(LAS unsigned short*)(Pw + (4 * (lane >> 4) + rg) * 144 + (16 * jj + (lane & 15)) * 2) = (unsigned short)f2bf(sacc[4 * kc + jj][rg]);
        LDS_WAIT();
        wave_mma<8, 2>(oacc, Pw, 144, 0, KVs, 528, 0, lane, 0, 64 * kc);
    }
    LDS_WAIT();
#pragma unroll
    for (int j = 0; j < 8; ++j)
#pragma unroll
        for (int rg = 0; rg < 4; ++rg) *(LAS unsigned short*)(Qs + (16 * w + 4 * (lane >> 4) + rg) * 272 + (16 * j + (lane & 15)) * 2) = (unsigned short)f2bf(oacc[j][rg] * rsum[rg]);
    LDS_WAIT();
#pragma unroll
    for (int i = 0; i < 4; ++i) { const int p = lane + 64 * i, rr = 16 * w + (p >> 4), c = p & 15;
        const v4u v = *(const LAS v4u*)(Qs + rr * 272 + c * 16); *(GAS v4u*)(MEMQ + (row0 + rr) * 512 + h * 128 + c * 8) = v; }
}

__device__ __forceinline__ void mlstm_out_item(Frame& F, int item) {
    const int bh = item >> 7, c = item & 127, b = bh >> 2, h = bh & 3;
    const int tid = F.tid, lane = F.lane, w = F.wave;
    LAS unsigned char* Qs = F.lds;
    LAS unsigned char* Ks = F.lds + 17408;
    LAS unsigned char* VT = F.lds + 34816;
    LAS unsigned char* CTs = F.lds + 53248;
    LAS unsigned char* Ss = F.lds + 88064;
    LAS unsigned char* Ws = F.lds + 105472;
    LAS float* bcum = (LAS float*)(F.lds + 114688);
    LAS float* igs = bcum + 64;
    LAS float* nsv = bcum + 128;
    LAS float* rden = bcum + 256;
    const float* IGLF = (const float*)(F.ws + WS_IGLF);
    const bf16* MLQ = (const bf16*)(F.ws + WS_MLQ); const bf16* MLK = (const bf16*)(F.ws + WS_MLK); bf16* MLV = (bf16*)(F.ws + WS_MLV); const bf16* MLO = (const bf16*)(F.ws + WS_MLO);
    const bf16* CT = (const bf16*)(F.ws + WS_CT) + (size_t)item * 16384;
    const float* NS = (const float*)(F.ws + WS_NS) + (size_t)item * 128;
    const float mc = ((const float*)(F.ws + WS_CTL + CTL_MS))[item];
    const int t0 = c * 64; const size_t row0 = (size_t)b * SEQ + t0;
    __syncthreads();
    if (w == 0) {
        const float lf = IGLF[(row0 + lane) * 8 + 4 + h], ig = IGLF[(row0 + lane) * 8 + h];
        float bs = lf;
#pragma unroll
        for (int o = 1; o < 64; o <<= 1) { const float v = __shfl_up(bs, o); if (lane >= o) bs += v; }
        bcum[lane] = bs; igs[lane] = ig;
    } else if (w == 1 || w == 2) { const int i = tid - 64; nsv[i] = NS[i]; }
    { const int s = tid >> 3, part = tid & 7; float y[16];
      conv16(MLQ, h * 128 + part * 16, F.in[6], F.in[7], h * 128 + part * 16, b, t0 + s, y);
      v4u q0, q1; q0.x = pk2(y[0], y[1]); q0.y = pk2(y[2], y[3]); q0.z = pk2(y[4], y[5]); q0.w = pk2(y[6], y[7]); q1.x = pk2(y[8], y[9]); q1.y = pk2(y[10], y[11]); q1.z = pk2(y[12], y[13]); q1.w = pk2(y[14], y[15]);
      *(LAS v4u*)(Qs + s * 272 + part * 32) = q0; *(LAS v4u*)(Qs + s * 272 + part * 32 + 16) = q1;
      conv16(MLK, h * 128 + part * 16, F.in[6], F.in[7], 512 + h * 128 + part * 16, b, t0 + s, y);
      const float sc = 0.08838834764831845f;
      q0.x = pk2(y[0] * sc, y[1] * sc); q0.y = pk2(y[2] * sc, y[3] * sc); q0.z = pk2(y[4] * sc, y[5] * sc); q0.w = pk2(y[6] * sc, y[7] * sc);
      q1.x = pk2(y[8] * sc, y[9] * sc); q1.y = pk2(y[10] * sc, y[11] * sc); q1.z = pk2(y[12] * sc, y[13] * sc); q1.w = pk2(y[14] * sc, y[15] * sc);
      *(LAS v4u*)(Ks + s * 272 + part * 32) = q0; *(LAS v4u*)(Ks + s * 272 + part * 32 + 16) = q1;
      const bf16* vp = MLV + (row0 + s) * 512 + h * 128 + part * 16; const v4u v0 = *(const GAS v4u*)vp, v1 = *(const GAS v4u*)(vp + 8);
      lds_store_tr8(VT, 144, part * 16, s, v0); lds_store_tr8(VT, 144, part * 16 + 8, s, v1); }
#pragma unroll
    for (int i = 0; i < 4; ++i) { const int p = tid + 512 * i, rr = p >> 4, cc = p & 15; const v4u v = *(const GAS v4u*)(CT + rr * 128 + cc * 8); *(LAS v4u*)(CTs + rr * 272 + cc * 16) = v; }
    __syncthreads();
    { f32x4 sacc[2];
      sacc[0] = (f32x4){0.f, 0.f, 0.f, 0.f}; sacc[1] = (f32x4){0.f, 0.f, 0.f, 0.f};
      wave_mma<2, 4>(sacc, Qs, 272, 16 * (w >> 1), Ks, 272, 32 * (w & 1), lane);
#pragma unroll
      for (int j = 0; j < 2; ++j)
#pragma unroll
          for (int rg = 0; rg < 4; ++rg) *(LAS float*)(Ss + (16 * (w >> 1) + 4 * (lane >> 4) + rg) * 272 + (32 * (w & 1) + 16 * j + (lane & 15)) * 4) = sacc[j][rg]; }
    __syncthreads();
    { const int t = tid >> 3, seg = tid & 7;
      const float bt = bcum[t];
      const f32x4 s0 = *(const LAS f32x4*)(Ss + t * 272 + seg * 32), s1 = *(const LAS f32x4*)(Ss + t * 272 + seg * 32 + 16);
      const float sv[8] = {s0.x, s0.y, s0.z, s0.w, s1.x, s1.y, s1.z, s1.w};
      float dm[8]; float mx = -3.0e38f;
#pragma unroll
      for (int i = 0; i < 8; ++i) { const int s = seg * 8 + i; dm[i] = bt - bcum[s] + igs[s]; if (s <= t) mx = fmaxf(mx, dm[i]); }
      mx = fmaxf(mx, __shfl_xor(mx, 1)); mx = fmaxf(mx, __shfl_xor(mx, 2)); mx = fmaxf(mx, __shfl_xor(mx, 4));
      const float minter = bt + mc; const float mt = fmaxf(minter, mx);
      float wv[8]; float den = 0.f;
#pragma unroll
      for (int i = 0; i < 8; ++i) { const int s = seg * 8 + i; wv[i] = (s <= t) ? sv[i] * __expf(dm[i] - mt) : 0.f; den += wv[i]; }
      *(LAS v4u*)(Ws + t * 144 + seg * 16) = (v4u){pk2(wv[0], wv[1]), pk2(wv[2], wv[3]), pk2(wv[4], wv[5]), pk2(wv[6], wv[7])};
      const float inter = __expf(minter - mt);
      v4u qa = *(const LAS v4u*)(Qs + t * 272 + seg * 32), qb2 = *(const LAS v4u*)(Qs + t * 272 + seg * 32 + 16);
      const float qf[16] = {bflo(qa.x), bfhi(qa.x), bflo(qa.y), bfhi(qa.y), bflo(qa.z), bfhi(qa.z), bflo(qa.w), bfhi(qa.w), bflo(qb2.x), bfhi(qb2.x), bflo(qb2.y), bfhi(qb2.y), bflo(qb2.z), bfhi(qb2.z), bflo(qb2.w), bfhi(qb2.w)};
      float qn = 0.f;
#pragma unroll
      for (int i = 0; i < 16; ++i) qn += qf[i] * nsv[seg * 16 + i];
      den += inter * qn;
      den += __shfl_xor(den, 1); den += __shfl_xor(den, 2); den += __shfl_xor(den, 4);
      qa.x = pk2(qf[0] * inter, qf[1] * inter); qa.y = pk2(qf[2] * inter, qf[3] * inter); qa.z = pk2(qf[4] * inter, qf[5] * inter); qa.w = pk2(qf[6] * inter, qf[7] * inter);
      qb2.x = pk2(qf[8] * inter, qf[9] * inter); qb2.y = pk2(qf[10] * inter, qf[11] * inter); qb2.z = pk2(qf[12] * inter, qf[13] * inter); qb2.w = pk2(qf[14] * inter, qf[15] * inter);
      *(LAS v4u*)(Qs + t * 272 + seg * 32) = qa; *(LAS v4u*)(Qs + t * 272 + seg * 32 + 16) = qb2;
      if (seg == 0) rden[t] = 1.0f / fmaxf(fabsf(den), __expf(-mt)); }
    __syncthreads();
    f32x4 acc[4];
#pragma unroll
    for (int j = 0; j < 4; ++j) acc[j] = (f32x4){0.f, 0.f, 0.f, 0.f};
    wave_mma<4, 2>(acc, Ws, 144, 16 * (w >> 1), VT, 144, 64 * (w & 1), lane);
    wave_mma<4, 4>(acc, Qs, 272, 16 * (w >> 1), CTs, 272, 64 * (w & 1), lane);
    __syncthreads();
    LAS unsigned char* Hs = CTs;
#pragma unroll
    for (int j = 0; j < 4; ++j)
#pragma unroll
        for (int rg = 0; rg < 4; ++rg) { const int row = 16 * (w >> 1) + 4 * (lane >> 4) + rg; *(LAS float*)(Hs + row * 528 + (64 * (w & 1) + 16 * j + (lane & 15)) * 4) = acc[j][rg] * rden[row]; }
    __syncthreads();
    { const int t = tid >> 3, seg = tid & 7; float hv[16]; float ss = 0.f;
#pragma unroll
      for (int i4 = 0; i4 < 4; ++i4) { const f32x4 v = *(const LAS f32x4*)(Hs + t * 528 + seg * 64 + i4 * 16); hv[4 * i4] = v.x; hv[4 * i4 + 1] = v.y; hv[4 * i4 + 2] = v.z; hv[4 * i4 + 3] = v.w; ss += (v.x * v.x + v.y * v.y) + (v.z * v.z + v.w * v.w); }
      ss += __shfl_xor(ss, 1); ss += __shfl_xor(ss, 2); ss += __shfl_xor(ss, 4);
      const float rs = 1.0f / sqrtf(ss * (1.f / 128.f) + EPS);
      const float* mg = F.in[8] + seg * 16;
      const bf16* op = MLO + (row0 + t) * 512 + h * 128 + seg * 16; const v4u o0 = *(const GAS v4u*)op, o1 = *(const GAS v4u*)(op + 8);
      const float og[16] = {bflo(o0.x), bfhi(o0.x), bflo(o0.y), bfhi(o0.y), bflo(o0.z), bfhi(o0.z), bflo(o0.w), bfhi(o0.w), bflo(o1.x), bfhi(o1.x), bflo(o1.y), bfhi(o1.y), bflo(o1.z), bfhi(o1.z), bflo(o1.w), bfhi(o1.w)};
      float yv[16];
#pragma unroll
      for (int i = 0; i < 16; ++i) yv[i] = hv[i] * rs * mg[i] * og[i];
      v4u y0, y1; y0.x = pk2(yv[0], yv[1]); y0.y = pk2(yv[2], yv[3]); y0.z = pk2(yv[4], yv[5]); y0.w = pk2(yv[6], yv[7]); y1.x = pk2(yv[8], yv[9]); y1.y = pk2(yv[10], yv[11]); y1.z = pk2(yv[12], yv[13]); y1.w = pk2(yv[14], yv[15]);
      bf16* yp = MLV + (row0 + t) * 512 + h * 128 + seg * 16; *(GAS v4u*)yp = y0; *(GAS v4u*)(yp + 8) = y1; }
}

#define PEER_INS(L, v) do { L[15] = __builtin_amdgcn_fmed3f(L[14], L[15], v); L[14] = __builtin_amdgcn_fmed3f(L[13], L[14], v); L[13] = __builtin_amdgcn_fmed3f(L[12], L[13], v); \
    L[12] = __builtin_amdgcn_fmed3f(L[11], L[12], v); L[11] = __builtin_amdgcn_fmed3f(L[10], L[11], v); L[10] = __builtin_amdgcn_fmed3f(L[9], L[10], v); L[9] = __builtin_amdgcn_fmed3f(L[8], L[9], v); \
    L[8] = __builtin_amdgcn_fmed3f(L[7], L[8], v); L[7] = __builtin_amdgcn_fmed3f(L[6], L[7], v); L[6] = __builtin_amdgcn_fmed3f(L[5], L[6], v); L[5] = __builtin_amdgcn_fmed3f(L[4], L[5], v); \
    L[4] = __builtin_amdgcn_fmed3f(L[3], L[4], v); L[3] = __builtin_amdgcn_fmed3f(L[2], L[3], v); L[2] = __builtin_amdgcn_fmed3f(L[1], L[2], v); L[1] = __builtin_amdgcn_fmed3f(L[0], L[1], v); L[0] = fmaxf(L[0], v); } while (0)

__device__ __forceinline__ void peer_route_item(Frame& F, int item) {
    const int h = item & 7, tile = item >> 3;
    const int tid = F.tid, lane = F.lane, w = F.wave;
    LAS unsigned char* K1s = F.lds;
    LAS unsigned char* Ss = F.lds + 69632;
    LAS float* Ls = (LAS float*)(F.lds + 69632 + 66560);
    const bf16* QRY = (const bf16*)(F.ws + WS_QRY); const bf16* PK = (const bf16*)(F.ws + WS_PK);
    int* IDX = (int*)(F.ws + WS_IDX); float* GW = (float*)(F.ws + WS_GW);
    const size_t row0 = (size_t)tile * 64;
    __syncthreads();
#pragma unroll
    for (int i = 0; i < 8; ++i) { const int p = tid + 512 * i, kr = p >> 4, c = p & 15, half = kr >> 7, key = kr & 127;
        const v4u v = *(const GAS v4u*)(PK + ((size_t)(half * 8 + h) * 128 + key) * 128 + c * 8); *(LAS v4u*)(K1s + kr * 272 + c * 16) = v; }
    __syncthreads();
    { const int mt = w & 3, half = w >> 2; f32x4 acc[8];
#pragma unroll
      for (int j = 0; j < 8; ++j) acc[j] = (f32x4){0.f, 0.f, 0.f, 0.f};
      const bf16* ap = QRY + (row0 + 16 * mt + (lane & 15)) * 2048 + h * 256 + half * 128 + (lane >> 4) * 8;
#pragma unroll
      for (int ks = 0; ks < 4; ++ks) { const bf16x8 a = *(const GAS bf16x8*)(ap + ks * 32);
#pragma unroll
          for (int j = 0; j < 8; ++j) { const bf16x8 bb = *(const LAS bf16x8*)(K1s + (half * 128 + 16 * j + (lane & 15)) * 272 + (ks * 32 + (lane >> 4) * 8) * 2);
              acc[j] = __builtin_amdgcn_mfma_f32_16x16x32_bf16(a, bb, acc[j], 0, 0, 0); } }
#pragma unroll
      for (int j = 0; j < 8; ++j)
#pragma unroll
          for (int rg = 0; rg < 4; ++rg) *(LAS float*)(Ss + (16 * mt + 4 * (lane >> 4) + rg) * 1040 + (half * 128 + 16 * j + (lane & 15)) * 4) = acc[j][rg]; }
    __syncthreads();
    if (w < 2) {
        float L[16];
#pragma unroll
        for (int i = 0; i < 16; ++i) L[i] = -3.0e38f;
        const LAS unsigned char* sp = Ss + lane * 1040 + w * 512;
#pragma unroll 4
        for (int i4 = 0; i4 < 32; ++i4) { const f32x4 v = *(const LAS f32x4*)(sp + i4 * 16);
            const float e0 = __uint_as_float((__float_as_uint(v.x) & 0xFFFFFF80u) | (unsigned)(4 * i4)), e1 = __uint_as_float((__float_as_uint(v.y) & 0xFFFFFF80u) | (unsigned)(4 * i4 + 1));
            const float e2 = __uint_as_float((__float_as_uint(v.z) & 0xFFFFFF80u) | (unsigned)(4 * i4 + 2)), e3 = __uint_as_float((__float_as_uint(v.w) & 0xFFFFFF80u) | (unsigned)(4 * i4 + 3));
            PEER_INS(L, e0); PEER_INS(L, e1); PEER_INS(L, e2); PEER_INS(L, e3); }
#pragma unroll
        for (int i = 0; i < 16; ++i) Ls[(w * 16 + i) * 64 + lane] = L[i];
    }
    __syncthreads();
    if (w == 0) {
        float A1[16], A2[16];
#pragma unroll
        for (int i = 0; i < 16; ++i) { A1[i] = Ls[i * 64 + lane]; A2[i] = Ls[(16 + i) * 64 + lane]; }
        float Tt[16];
#pragma unroll
        for (int i = 0; i < 16; ++i) Tt[i] = -3.0e38f;
#pragma unroll
        for (int i = 0; i < 16; ++i)
#pragma unroll
            for (int j = 0; j < 16; ++j) if ((i + 1) * (j + 1) <= 16) { const float cv = __uint_as_float((__float_as_uint(A1[i] + A2[j]) & 0xFFFFFF00u) | (unsigned)(i * 16 + j)); PEER_INS(Tt, cv); }
        float ex[16]; float sm = 0.f;
#pragma unroll
        for (int i = 0; i < 16; ++i) { ex[i] = __expf(Tt[i] - Tt[0]); sm += ex[i]; }
        const float inv = 1.0f / sm;
        int* ip = IDX + (row0 + lane) * 128 + h * 16; float* gp = GW + (row0 + lane) * 128 + h * 16;
#pragma unroll
        for (int i4 = 0; i4 < 4; ++i4) { int ev[4]; float gv[4];
#pragma unroll
            for (int e = 0; e < 4; ++e) { const unsigned code = __float_as_uint(Tt[4 * i4 + e]) & 0xFFu; const unsigned i1 = code >> 4, i2 = code & 15u;
                const unsigned e1 = __float_as_uint(Ls[i1 * 64 + lane]) & 0x7Fu, e2 = __float_as_uint(Ls[(16 + i2) * 64 + lane]) & 0x7Fu;
                ev[e] = (int)(e1 * 128u + e2); gv[e] = ex[4 * i4 + e] * inv; }
            *(GAS v4u*)(ip + 4 * i4) = (v4u){(unsigned)ev[0], (unsigned)ev[1], (unsigned)ev[2], (unsigned)ev[3]}; *(GAS f32x4*)(gp + 4 * i4) = (f32x4){gv[0], gv[1], gv[2], gv[3]}; }
    }
}

__device__ __forceinline__ float dot2bf(unsigned a, unsigned b, float c) {
    typedef __bf16 bf2 __attribute__((ext_vector_type(2)));
    return __builtin_amdgcn_fdot2_f32_bf16(__builtin_bit_cast(bf2, a), __builtin_bit_cast(bf2, b), c, false);
}
__device__ __forceinline__ void peer_expert_token(Frame& F, int m) {
    const int lane = F.lane;
    const bf16* H1B = (const bf16*)(F.ws + WS_H1B); const bf16* UT = (const bf16*)(F.ws + WS_UT); const bf16* VTb = (const bf16*)(F.ws + WS_VT);
    const int* IDX = (const int*)(F.ws + WS_IDX); const float* GW = (const float*)(F.ws + WS_GW);
    const float* SUMSQ = (const float*)(F.ws + WS_CTL + CTL_SUMSQ); const float* gf = F.in[18];
    const float rs = 1.0f / sqrtf(SUMSQ[m] * (1.f / 1024.f) + EPS);
    unsigned xb[8];
#pragma unroll
    for (int hf = 0; hf < 2; ++hf) { const v4u hv = *(const GAS v4u*)(H1B + (size_t)m * 1024 + hf * 512 + 8 * lane);
        const f32x4 g0 = *(const GAS f32x4*)(gf + hf * 512 + 8 * lane), g1 = *(const GAS f32x4*)(gf + hf * 512 + 8 * lane + 4);
        xb[4 * hf + 0] = pk2(bflo(hv.x) * rs * g0.x, bfhi(hv.x) * rs * g0.y); xb[4 * hf + 1] = pk2(bflo(hv.y) * rs * g0.z, bfhi(hv.y) * rs * g0.w);
        xb[4 * hf + 2] = pk2(bflo(hv.z) * rs * g1.x, bfhi(hv.z) * rs * g1.y); xb[4 * hf + 3] = pk2(bflo(hv.w) * rs * g1.z, bfhi(hv.w) * rs * g1.w); }
    const int id0 = IDX[(size_t)m * 128 + lane], id1 = IDX[(size_t)m * 128 + 64 + lane];
    const float gw0 = GW[(size_t)m * 128 + lane], gw1 = GW[(size_t)m * 128 + 64 + lane];
    float oa[16];
#pragma unroll
    for (int i = 0; i < 16; ++i) oa[i] = 0.f;
    for (int hd = 0; hd < 8; ++hd) {
        const int idv = (hd < 4) ? id0 : id1; const float gwv = (hd < 4) ? gw0 : gw1; const int lb = (hd & 3) * 16;
        float pd[16];
#pragma unroll
        for (int e0 = 0; e0 < 16; e0 += 8) {
            v4u ua[8], ub[8];
#pragma unroll
            for (int e = 0; e < 8; ++e) { const int row = __builtin_amdgcn_readlane(idv, lb + e0 + e); const bf16* up = UT + (size_t)row * 1024 + 8 * lane; ua[e] = *(const GAS v4u*)up; ub[e] = *(const GAS v4u*)(up + 512); }
#pragma unroll
            for (int e = 0; e < 8; ++e) { float d = dot2bf(ua[e].x, xb[0], 0.f); d = dot2bf(ua[e].y, xb[1], d); d = dot2bf(ua[e].z, xb[2], d); d = dot2bf(ua[e].w, xb[3], d);
                d = dot2bf(ub[e].x, xb[4], d); d = dot2bf(ub[e].y, xb[5], d); d = dot2bf(ub[e].z, xb[6], d); d = dot2bf(ub[e].w, xb[7], d); pd[e0 + e] = d; }
        }
#pragma unroll
        for (int i = 0; i < 8; ++i) { const bool up = (lane & 8) != 0; const float send = up ? pd[i] : pd[i + 8]; const float keep = up ? pd[i + 8] : pd[i]; pd[i] = keep + __shfl_xor(send, 8); }
#pragma unroll
        for (int i = 0; i < 4; ++i) { const bool up = (lane & 4) != 0; const float send = up ? pd[i] : pd[i + 4]; const float keep = up ? pd[i + 4] : pd[i]; pd[i] = keep + __shfl_xor(send, 4); }
#pragma unroll
        for (int i = 0; i < 2; ++i) { const bool up = (lane & 2) != 0; const float send = up ? pd[i] : pd[i + 2]; const float keep = up ? pd[i + 2] : pd[i]; pd[i] = keep + __shfl_xor(send, 2); }
        { const bool up = (lane & 1) != 0; const float send = up ? pd[0] : pd[1]; const float keep = up ? pd[1] : pd[0]; pd[0] = keep + __shfl_xor(send, 1); }
        float dt = pd[0]; dt += __shfl_xor(dt, 16); dt += __shfl_xor(dt, 32);
        const float gl = __shfl(gwv, lb + (lane & 15));
        const float wgt = gl * 0.5f * dt * (1.0f + erff(dt * 0.70710678118654752f));
#pragma unroll
        for (int e0 = 0; e0 < 16; e0 += 8) {
            v4u va[8], vb[8];
#pragma unroll
            for (int e = 0; e < 8; ++e) { const int row = __builtin_amdgcn_readlane(idv, lb + e0 + e); const bf16* vp = VTb + (size_t)row * 1024 + 8 * lane; va[e] = *(const GAS v4u*)vp; vb[e] = *(const GAS v4u*)(vp + 512); }
#pragma unroll
            for (int e = 0; e < 8; ++e) { const float we = __uint_as_float((unsigned)__builtin_amdgcn_readlane((int)__float_as_uint(wgt), e0 + e));
                oa[0] += we * bflo(va[e].x); oa[1] += we * bfhi(va[e].x); oa[2] += we * bflo(va[e].y); oa[3] += we * bfhi(va[e].y);
                oa[4] += we * bflo(va[e].z); oa[5] += we * bfhi(va[e].z); oa[6] += we * bflo(va[e].w); oa[7] += we * bfhi(va[e].w);
                oa[8] += we * bflo(vb[e].x); oa[9] += we * bfhi(vb[e].x); oa[10] += we * bflo(vb[e].y); oa[11] += we * bfhi(vb[e].y);
                oa[12] += we * bflo(vb[e].z); oa[13] += we * bfhi(vb[e].z); oa[14] += we * bflo(vb[e].w); oa[15] += we * bfhi(vb[e].w); }
        }
    }
    float* op = F.out + (size_t)m * 1024 + 8 * lane;
#pragma unroll
    for (int hf = 0; hf < 2; ++hf) { f32x4 a = *(GAS f32x4*)(op + hf * 512), bq = *(GAS f32x4*)(op + hf * 512 + 4);
        a.x += oa[8 * hf + 0]; a.y += oa[8 * hf + 1]; a.z += oa[8 * hf + 2]; a.w += oa[8 * hf + 3]; bq.x += oa[8 * hf + 4]; bq.y += oa[8 * hf + 5]; bq.z += oa[8 * hf + 6]; bq.w += oa[8 * hf + 7];
        *(GAS f32x4*)(op + hf * 512) = a; *(GAS f32x4*)(op + hf * 512 + 4) = bq; }
}

struct Args { const float* in[24]; float* out; unsigned char* ws; int ph_lo, ph_hi, li, pad; };
__global__ void __launch_bounds__(NWAVES * 64, 2) hybrid_fwd(Args args) {
    extern __shared__ __attribute__((aligned(16))) unsigned char lds[];
    Frame F;
    F.lds = (LAS unsigned char*)lds;
    F.MISC = (volatile LAS unsigned*)(F.lds + MISC_OFF);
    F.tid = threadIdx.x; F.lane = F.tid & 63; F.wave = __builtin_amdgcn_readfirstlane(F.tid >> 6);
    F.G = gridDim.x; F.ws = args.ws; F.out = args.out;
#pragma unroll
    for (int i = 0; i < 24; ++i) F.in[i] = args.in[i];
    for (int u = F.tid; u < (LDS_BYTES - LDSCTL_OFF) / 4; u += NWAVES * 64) ((LAS unsigned*)(F.lds + LDSCTL_OFF))[u] = 0u;
    __syncthreads();
    unsigned* ctl = (unsigned*)(F.ws + WS_CTL);
    XcdBarrier bar; bar.bar = ctl + CW_BAR; bar.x = 0; bar.st = nullptr;
    if (N_LAUNCHES != PER_PHASE) bar = xcd_barrier_post(ctl + CW_BAR, F.MISC + 8);
#define GRID_BAR() do { if (N_LAUNCHES != PER_PHASE) xcd_barrier(bar); } while (0)
    const int lo = args.ph_lo, hi = args.ph_hi;
#define IN(k) (lo <= (k) && (k) < hi)
#define BOTH(k) (IN(k) && IN((k) + 1))
    const int bx = blockIdx.x;

    if (IN(0)) { p0_prologue(F); if (BOTH(0)) GRID_BAR(); }

    if (IN(1)) {
        pg8::Gemm g{(const bf16*)F.out, (const bf16*)(F.ws + WS_WIN), 1024, 1024, 1024}; pg8::StaticOrder S; S.init(T_TOK, 7168, F.G, bx);
        pg8::EpiProj E{(bf16*)(F.ws + WS_GATES), 512, F.in[16], 512, SPLIT_STRIDE, 12, 22, 24};
        pg8::gemm_phase<pg8::EpiProj, pg8::StaticOrder, true, true>(F.lds, g, S, E);
        if (BOTH(1)) GRID_BAR();
    }

    if (IN(2)) {
        { pg8::Gemm g{(const bf16*)(F.ws + WS_MEMN), (const bf16*)(F.ws + WS_WKV), 1024, 1024, 1024}; pg8::FewOrder S{4, 8, bx};
          pg8::EpiProj E{(bf16*)(F.ws + WS_KVMEM), 1024, nullptr, 0, 0, 0, 0, 0};
          pg8::gemm_phase<pg8::EpiProj, pg8::FewOrder, false, true>(F.lds, g, S, E); }
        for (int it = bx; it < 1024; it += F.G) sb_attn_item(F, it);
        for (int it = bx; it < 1024; it += F.G) mlstm_local_item(F, it);
        if (BOTH(2)) GRID_BAR();
    }

    if (IN(3)) {
        mlstm_scan(F);
        for (int it = bx; it < 512; it += F.G) mem_attn_item(F, it);
        if (BOTH(3)) GRID_BAR();
    }

    if (IN(4)) {
        for (int it = bx; it < 1024; it += F.G) mlstm_out_item(F, it);
        if (BOTH(4)) GRID_BAR();
    }

    if (IN(5)) {
        pg8::Gemm g{(const bf16*)(F.ws + WS_SBQ), (const bf16*)(F.ws + WS_WBR), 512, 512, 512};
        pg8::GroupOrder S; S.so.init(T_TOK, 1024, F.G, bx); S.ng = 3; S.a_gstride = 16 * MiB; S.b_gstride = (size_t)1024 * 512 * 2;
        pg8::EpiBranch E{(const bf16*)(F.ws + WS_GATES), SPLIT_STRIDE, (bf16*)(F.ws + WS_MERGED)};
        pg8::gemm_phase<pg8::EpiBranch, pg8::GroupOrder, false, true>(F.lds, g, S, E);
        if (BOTH(5)) GRID_BAR();
    }

    if (IN(6)) {
        { pg8::Gemm g{(const bf16*)(F.ws + WS_MERGED), (const bf16*)(F.ws + WS_WOUT), 1024, 1024, 1024}; pg8::StaticOrder S; S.init(T_TOK, 1024, F.G, bx);
          pg8::EpiOut E{F.in[0], F.out, (bf16*)(F.ws + WS_H1B), (float*)(F.ws + WS_CTL + CTL_SUMSQ)};
          pg8::gemm_phase<pg8::EpiOut, pg8::StaticOrder, false, true>(F.lds, g, S, E); }
        { const float* pu = F.in[22]; const float* pv = F.in[23]; bf16* UT = (bf16*)(F.ws + WS_UT); bf16* VT = (bf16*)(F.ws + WS_VT);
          const size_t n8 = (size_t)16384 * 1024 / 8;
          for (size_t e = (size_t)bx * 512 + F.tid; e < 2 * n8; e += (size_t)F.G * 512) {
              const bool second = e >= n8; const size_t ee = second ? e - n8 : e; const float* src = (second ? pv : pu) + ee * 8;
              const f32x4 a = __builtin_nontemporal_load((const GAS f32x4*)src), b2 = __builtin_nontemporal_load((const GAS f32x4*)(src + 4));
              v4u o; o.x = pk2(a.x, a.y); o.y = pk2(a.z, a.w); o.z = pk2(b2.x, b2.y); o.w = pk2(b2.z, b2.w);
              *(GAS v4u*)((second ? VT : UT) + ee * 8) = o; } }
        if (BOTH(6)) GRID_BAR();
    }

    if (IN(7)) {
        pg8::Gemm g{(const bf16*)(F.ws + WS_H1B), (const bf16*)(F.ws + WS_WPQ), 1024, 1024, 1024}; pg8::StaticOrder S; S.init(T_TOK, 2048, F.G, bx);
        pg8::EpiQry E{(const float*)(F.ws + WS_CTL + CTL_SUMSQ), (bf16*)(F.ws + WS_QRY), EPS};
        pg8::gemm_phase<pg8::EpiQry, pg8::StaticOrder, true, true>(F.lds, g, S, E);
        if (BOTH(7)) GRID_BAR();
    }

    if (IN(8)) {
        for (int it = bx; it < 2048; it += F.G) peer_route_item(F, it);
        if (BOTH(8)) GRID_BAR();
    }

    if (IN(9)) {
        for (int m = bx * NWAVES + F.wave; m < T_TOK; m += F.G * NWAVES) peer_expert_token(F, m);
    }
#undef IN
#undef BOTH
#undef GRID_BAR
}

extern "C" void kernel_launch(void* const* d_in, const int* in_sizes, int n_in, void* d_out, int out_size, void* d_ws, size_t ws_size, hipStream_t stream) {
    static int grid = 0;
    if (grid == 0) {
        if (n_in != 24 || out_size != T_TOK * DM || ws_size < WS_END) { fprintf(stderr, "kernel_launch: unexpected problem (n_in %d, out %d, ws %zu); nothing launched\n", n_in, out_size, ws_size); grid = -1; return; }
        int dev = 0, cus = 0, per_cu = 0;
        if (hipGetDevice(&dev) != hipSuccess || hipDeviceGetAttribute(&cus, hipDeviceAttributeMultiprocessorCount, dev) != hipSuccess) { grid = -1; return; }
        if (hipFuncSetAttribute((const void*)hybrid_fwd, hipFuncAttributeMaxDynamicSharedMemorySize, LDS_BYTES) != hipSuccess) { fprintf(stderr, "kernel_launch: hipFuncSetAttribute failed\n"); grid = -1; return; }
        if (hipOccupancyMaxActiveBlocksPerMultiprocessor(&per_cu, (const void*)hybrid_fwd, NWAVES * 64, LDS_BYTES) != hipSuccess || per_cu < 1)
            fprintf(stderr, "kernel_launch: note: occupancy query reports %d workgroups per CU\n", per_cu);
        (void)hipGetLastError();
        grid = cus;
    }
    if (grid < 0) return;
    if (hipMemsetAsync((char*)d_ws + WS_CTL, 0, CTL_ZERO_BYTES, stream) != hipSuccess) { fprintf(stderr, "kernel_launch: memset failed\n"); return; }
    Args a{};
    for (int i = 0; i < 24; ++i) a.in[i] = (const float*)d_in[i];
    a.out = (float*)d_out; a.ws = (unsigned char*)d_ws;
    for (int li = 0; li < N_LAUNCHES; ++li) {
        a.ph_lo = (N_LAUNCHES == PER_PHASE) ? li : 0; a.ph_hi = (N_LAUNCHES == PER_PHASE) ? li + 1 : PER_PHASE; a.li = li;
        hipLaunchKernelGGL(hybrid_fwd, dim3(grid), dim3(NWAVES * 64), LDS_BYTES, stream, a);
        const hipError_t le = hipPeekAtLastError();
        if (le != hipSuccess) { fprintf(stderr, "kernel_launch: launch %d failed: %s\n", li, hipGetErrorName(le)); break; }
    }
}
```

```cpp
#include <hip/hip_runtime.h>
#include <cstdio>
#include <cstdint>

#ifndef MK_N_LAUNCHES
#define MK_N_LAUNCHES 1
#endif

namespace pg8 {
#define PG8_LAS __attribute__((address_space(3)))
typedef unsigned short bf16_t;
typedef short bf16x8 __attribute__((ext_vector_type(8)));
typedef float f32x4 __attribute__((ext_vector_type(4)));
typedef unsigned u32x4 __attribute__((ext_vector_type(4)));
constexpr int BM = 256, BK = 64, HALF = 128, HTB = HALF * BK * 2  , STAGE_BYTES = 8 * HTB, NXCD = 8, WGM = 8;

__host__ __device__ __forceinline__ int lds_byte(int r, int c) { const int st = (r >> 4) * 2 + (c >> 5), rr = r & 15, cc = c & 31, ob = rr * 64 + cc * 2; return st * 1024 + (ob ^ (((ob >> 9) & 1) << 5)); }
__host__ __device__ __forceinline__ void stage_rc(int b, int& R, int& C) { const int st = b / 1024, sb = b % 1024, swz = sb ^ (((sb >> 9) & 1) << 5); R = (st >> 1) * 16 + swz / 64; C = (st & 1) * 32 + (swz % 64) / 2; }
__host__ __device__ __forceinline__ int perm32(int rho) { const int n = rho >> 4, i = rho & 15; return 8 * (i >> 2) + 4 * n + (i & 3); }

struct Unit { int pm, pn, g; };
struct Gemm { const bf16_t* A; const bf16_t* Bt; int lda, ldb, K; };

struct StaticOrder {
    int nM, nN, nwg, G, c;
    __host__ __device__ void init(int M, int N, int G_, int c_) { nM = M / BM; nN = N / BM; nwg = nM * nN; G = G_; c = c_; }
    __host__ __device__ bool next(int i, Unit& u) const {
        const long L = (long)i * G + c; if (L >= nwg) return false;
        int wgid = (int)L; { const int q = nwg / NXCD, r = nwg % NXCD, xcd = wgid % NXCD, off = wgid / NXCD; wgid = (xcd < r ? xcd * (q + 1) : r * (q + 1) + (xcd - r) * q) + off; }
        const int nig = WGM * nN, gid = wgid / nig, fm = gid * WGM, gsz = (nM - fm) < WGM ? (nM - fm) : WGM;
        u.pm = fm + ((wgid % nig) % gsz); u.pn = (wgid % nig) / gsz; u.g = 0; return true;
    }
    __device__ __forceinline__ const char* aptr(const Gemm& g, const Unit& u) const { return (const char*)g.A + (size_t)u.pm * BM * g.lda * 2; }
    __device__ __forceinline__ const char* bptr(const Gemm& g, const Unit& u) const { return (const char*)g.Bt + (size_t)u.pn * BM * g.ldb * 2; }
    __device__ __forceinline__ void a_ready(const Unit&) const {}
    __device__ __forceinline__ void done(const Unit&) const {}
};
struct FewOrder {
    int nN, n, c;
    __device__ bool next(int i, Unit& u) const { if (i > 0 || c >= n) return false; u.pm = c / nN; u.pn = c % nN; u.g = 0; return true; }
    __device__ __forceinline__ const char* aptr(const Gemm& g, const Unit& u) const { return (const char*)g.A + (size_t)u.pm * BM * g.lda * 2; }
    __device__ __forceinline__ const char* bptr(const Gemm& g, const Unit& u) const { return (const char*)g.Bt + (size_t)u.pn * BM * g.ldb * 2; }
    __device__ __forceinline__ void a_ready(const Unit&) const {}
    __device__ __forceinline__ void done(const Unit&) const {}
};
struct GroupOrder {
    StaticOrder so; int ng; size_t a_gstride, b_gstride;
    __device__ bool next(int i, Unit& u) const { if (i >= ng) return false; if (!so.next(0, u)) return false; u.g = i; return true; }
    __device__ __forceinline__ const char* aptr(const Gemm& g, const Unit& u) const { return (const char*)g.A + (size_t)u.g * a_gstride + (size_t)u.pm * BM * g.lda * 2; }
    __device__ __forceinline__ const char* bptr(const Gemm& g, const Unit& u) const { return (const char*)g.Bt + (size_t)u.g * b_gstride + (size_t)u.pn * BM * g.ldb * 2; }
    __device__ __forceinline__ void a_ready(const Unit&) const {}
    __device__ __forceinline__ void done(const Unit&) const {}
};

__device__ __forceinline__ unsigned cvt_pk_bf16(float lo, float hi) { unsigned r; asm volatile("v_cvt_pk_bf16_f32 %0, %1, %2" : "=v"(r) : "v"(lo), "v"(hi)); return r; }
__device__ __forceinline__ float bf_lo(unsigned x) { return __uint_as_float(x << 16); }
__device__ __forceinline__ float bf_hi(unsigned x) { return __uint_as_float(x & 0xffff0000u); }
__device__ __forceinline__ float sigmoidf_(float x) { return 1.0f / (1.0f + __expf(-x)); }

struct EpiProj {
    static constexpr bool PERM = true, AFTER_DRAIN = false;
    bf16_t* O; int ldc; const float* bias; int split_cols; size_t split_stride; int n_sig_bias, sig_lo, sig_hi;
    __device__ __forceinline__ void operator()(const f32x4 (&acc)[2][2][4][2], const Unit& u, int wr, int wc, int fr, int fq) const {
        const int row0 = u.pm * BM + wr * 64 + fr; int colt = u.pn * BM; bf16_t* base = O;
        if (split_cols) { const int t = colt / split_cols; base += (size_t)t * split_stride; colt -= t * split_cols; }
        const int col0 = colt + wc * 32 + 8 * fq, bcol0 = u.pn * BM + wc * 32 + 8 * fq;
        const int mode = (u.pn < n_sig_bias) ? 1 : ((u.pn >= sig_lo && u.pn < sig_hi) ? 2 : 0);
        f32x4 bv[2][2];
#pragma unroll
        for (int bj = 0; bj < 2; ++bj)
#pragma unroll
            for (int n = 0; n < 2; ++n) bv[bj][n] = (mode == 1) ? *(const f32x4*)(bias + bcol0 + bj * HALF + 4 * n) : (f32x4){0.f, 0.f, 0.f, 0.f};
#pragma unroll
        for (int ai = 0; ai < 2; ++ai)
#pragma unroll
            for (int m = 0; m < 4; ++m) { bf16_t* rowp = base + (size_t)(row0 + ai * HALF + m * 16) * ldc + col0;
#pragma unroll
                for (int bj = 0; bj < 2; ++bj) { f32x4 v0 = acc[ai][bj][m][0] + bv[bj][0], v1 = acc[ai][bj][m][1] + bv[bj][1];
                    if (mode != 0) {
#pragma unroll
                        for (int e = 0; e < 4; ++e) { v0[e] = sigmoidf_(v0[e]); v1[e] = sigmoidf_(v1[e]); } }
                    u32x4 w; w.x = cvt_pk_bf16(v0[0], v0[1]); w.y = cvt_pk_bf16(v0[2], v0[3]); w.z = cvt_pk_bf16(v1[0], v1[1]); w.w = cvt_pk_bf16(v1[2], v1[3]);
                    *(u32x4*)(rowp + bj * HALF) = w; } }
    }
};

struct EpiBranch {
    static constexpr bool PERM = true, AFTER_DRAIN = false;
    const bf16_t* gates; size_t gate_stride; bf16_t* merged;
    __device__ __forceinline__ void operator()(const f32x4 (&acc)[2][2][4][2], const Unit& u, int wr, int wc, int fr, int fq) const {
        const int row0 = u.pm * BM + wr * 64 + fr; const int col0 = u.pn * BM + wc * 32 + 8 * fq;
#pragma unroll
        for (int ai = 0; ai < 2; ++ai)
#pragma unroll
            for (int m = 0; m < 4; ++m) { const size_t row = (size_t)(row0 + ai * HALF + m * 16);
#pragma unroll
                for (int bj = 0; bj < 2; ++bj) { const int c = col0 + bj * HALF; const int gc = u.g * 1024 + c;
                    const u32x4 gw = *(const u32x4*)(gates + (size_t)(gc >> 9) * gate_stride + row * 512 + (gc & 511));
                    bf16_t* mp = merged + row * 1024 + c;
                    f32x4 v0 = acc[ai][bj][m][0], v1 = acc[ai][bj][m][1];
                    v0[0] *= bf_lo(gw.x); v0[1] *= bf_hi(gw.x); v0[2] *= bf_lo(gw.y); v0[3] *= bf_hi(gw.y);
                    v1[0] *= bf_lo(gw.z); v1[1] *= bf_hi(gw.z); v1[2] *= bf_lo(gw.w); v1[3] *= bf_hi(gw.w);
                    if (u.g > 0) { const u32x4 pv = *(const u32x4*)mp;
                        v0[0] += bf_lo(pv.x); v0[1] += bf_hi(pv.x); v0[2] += bf_lo(pv.y); v0[3] += bf_hi(pv.y);
                        v1[0] += bf_lo(pv.z); v1[1] += bf_hi(pv.z); v1[2] += bf_lo(pv.w); v1[3] += bf_hi(pv.w); }
                    u32x4 w; w.x = cvt_pk_bf16(v0[0], v0[1]); w.y = cvt_pk_bf16(v0[2], v0[3]); w.z = cvt_pk_bf16(v1[0], v1[1]); w.w = cvt_pk_bf16(v1[2], v1[3]);
                    *(u32x4*)mp = w; } }
    }
};

struct EpiOut {
    static constexpr bool PERM = true, AFTER_DRAIN = false;
    const float* x; float* out; bf16_t* h1b; float* sumsq;
    __device__ __forceinline__ void operator()(const f32x4 (&acc)[2][2][4][2], const Unit& u, int wr, int wc, int fr, int fq) const {
        const int row0 = u.pm * BM + wr * 64 + fr; const int col0 = u.pn * BM + wc * 32 + 8 * fq;
#pragma unroll
        for (int ai = 0; ai < 2; ++ai)
#pragma unroll
            for (int m = 0; m < 4; ++m) { const size_t row = (size_t)(row0 + ai * HALF + m * 16); float ss = 0.f;
#pragma unroll
                for (int bj = 0; bj < 2; ++bj) { const size_t off = row * 1024 + col0 + bj * HALF;
                    const f32x4 x0 = *(const f32x4*)(x + off), x1 = *(const f32x4*)(x + off + 4);
                    const f32x4 v0 = acc[ai][bj][m][0] + x0, v1 = acc[ai][bj][m][1] + x1;
                    *(f32x4*)(out + off) = v0; *(f32x4*)(out + off + 4) = v1;
                    ss += (v0[0] * v0[0] + v0[1] * v0[1]) + (v0[2] * v0[2] + v0[3] * v0[3]) + (v1[0] * v1[0] + v1[1] * v1[1]) + (v1[2] * v1[2] + v1[3] * v1[3]);
                    u32x4 w; w.x = cvt_pk_bf16(v0[0], v0[1]); w.y = cvt_pk_bf16(v0[2], v0[3]); w.z = cvt_pk_bf16(v1[0], v1[1]); w.w = cvt_pk_bf16(v1[2], v1[3]);
                    *(u32x4*)(h1b + off) = w; }
                ss += __shfl_xor(ss, 16); ss += __shfl_xor(ss, 32);
                if (fq == 0) atomicAdd(sumsq + row, ss); }
    }
};

struct EpiQry {
    static constexpr bool PERM = true, AFTER_DRAIN = false;
    const float* sumsq; bf16_t* qry; float eps;
    __device__ __forceinline__ void operator()(const f32x4 (&acc)[2][2][4][2], const Unit& u, int wr, int wc, int fr, int fq) const {
        const int row0 = u.pm * BM + wr * 64 + fr; const int col0 = u.pn * BM + wc * 32 + 8 * fq;
#pragma unroll
        for (int ai = 0; ai < 2; ++ai)
#pragma unroll
            for (int m = 0; m < 4; ++m) { const size_t row = (size_t)(row0 + ai * HALF + m * 16);
                const float rs = __builtin_amdgcn_rsqf(__hip_atomic_load(sumsq + row, __ATOMIC_RELAXED, __HIP_MEMORY_SCOPE_AGENT) * (1.0f / 1024.0f) + eps);
#pragma unroll
                for (int bj = 0; bj < 2; ++bj) { const f32x4 v0 = acc[ai][bj][m][0] * rs, v1 = acc[ai][bj][m][1] * rs;
                    u32x4 w; w.x = cvt_pk_bf16(v0[0], v0[1]); w.y = cvt_pk_bf16(v0[2], v0[3]); w.z = cvt_pk_bf16(v1[0], v1[1]); w.w = cvt_pk_bf16(v1[2], v1[3]);
                    *(u32x4*)(qry + row * 2048 + col0 + bj * HALF) = w; } }
    }
};

template <class Epi, class Sched, bool ALIGN_EPI = false, bool SP2 = false>
__device__ __forceinline__ void gemm_phase(PG8_LAS unsigned char* lds, const Gemm g, const Sched& S, const Epi& E) {
    const int tid = threadIdx.x, wid = __builtin_amdgcn_readfirstlane(tid >> 6), lane = tid & 63, wr = wid >> 2, wc = wid & 3, fr = lane & 15, fq = lane >> 4;
    const int K = g.K, nt = K / BK;
    unsigned voffA[2], voffB[2];
#pragma unroll
    for (int i = 0; i < 2; ++i) { int R, C; stage_rc(tid * 16 + i * 8192, R, C); const int Rb = Epi::PERM ? ((R & ~31) + perm32(R & 31)) : R;
        voffA[i] = (unsigned)(R * g.lda + C) * 2u; voffB[i] = (unsigned)(Rb * g.ldb + C) * 2u; }
    const size_t kstep = (size_t)(BK * 2);
    const size_t hstepA = (size_t)HALF * g.lda * 2, hstepB = (size_t)HALF * g.ldb * 2;
    const unsigned ldsw = (unsigned)wid * 1024u;
    const int aoff = lds_byte(wr * 64 + fr, fq * 8), boff = lds_byte(wc * 32 + fr, fq * 8);
#define PG8_SA(b, h) (((b) * 2 + (h)) * HTB)
#define PG8_SB(b, h) ((4 + (b) * 2 + (h)) * HTB)
#define PG8_STAGE(bufoff, gbase, voff) do { _Pragma("unroll") for (int _i = 0; _i < 2; ++_i) \
        __builtin_amdgcn_global_load_lds((const unsigned*)((const char*)(gbase) + (voff)[_i]), (PG8_LAS unsigned*)(lds + (bufoff) + ldsw + _i * 8192), 16, 0, 0); } while (0)
#define PG8_LDA(dst, b, h) do { _Pragma("unroll") for (int m = 0; m < 4; ++m) _Pragma("unroll") for (int k = 0; k < 2; ++k) dst[m][k] = *(const PG8_LAS bf16x8*)(lds + PG8_SA(b, h) + aoff + m * 2048 + k * 1024); } while (0)
#define PG8_LDB(dst, b, h) do { _Pragma("unroll") for (int n = 0; n < 2; ++n) _Pragma("unroll") for (int k = 0; k < 2; ++k) dst[n][k] = *(const PG8_LAS bf16x8*)(lds + PG8_SB(b, h) + boff + n * 2048 + k * 1024); } while (0)
#define PG8_MMA(ai, bj, At, Bt) do { __builtin_amdgcn_s_setprio(1); _Pragma("unroll") for (int m = 0; m < 4; ++m) _Pragma("unroll") for (int n = 0; n < 2; ++n) _Pragma("unroll") for (int k = 0; k < 2; ++k) \
        acc[ai][bj][m][n] = __builtin_amdgcn_mfma_f32_16x16x32_bf16(Bt[n][k], At[m][k], acc[ai][bj][m][n], 0, 0, 0); __builtin_amdgcn_s_setprio(0); } while (0)
#define PG8_WAIT_V(n) asm volatile("s_waitcnt vmcnt(" #n ")" ::: "memory")
#define PG8_WAIT_L(n) asm volatile("s_waitcnt lgkmcnt(" #n ")" ::: "memory")
#define PG8_BAR __builtin_amdgcn_s_barrier()
#define PG8_SCHED __builtin_amdgcn_sched_barrier(0)
    Unit cur, nxt; int ui = 0;
    if (!S.next(0, cur)) return;
    f32x4 acc[2][2][4][2];
#pragma unroll
    for (int a = 0; a < 2; ++a)
#pragma unroll
        for (int b = 0; b < 2; ++b)
#pragma unroll
            for (int m = 0; m < 4; ++m)
#pragma unroll
                for (int n = 0; n < 2; ++n) acc[a][b][m][n] = (f32x4){0.f, 0.f, 0.f, 0.f};
    bf16x8 At[4][2], B0[2][2], B1[2][2];
    const char* cA = S.aptr(g, cur); const char* cB = S.bptr(g, cur);
    S.a_ready(cur);
    if constexpr (SP2) {
        PG8_STAGE(PG8_SB(0, 0), cB, voffB); PG8_STAGE(PG8_SB(0, 1), cB + hstepB, voffB); PG8_STAGE(PG8_SA(0, 0), cA, voffA); PG8_STAGE(PG8_SA(0, 1), cA + hstepA, voffA);
        if (wr == 1) PG8_BAR;
        PG8_WAIT_V(2); PG8_BAR;
        PG8_STAGE(PG8_SB(1, 0), cB + kstep, voffB); PG8_STAGE(PG8_SA(1, 0), cA + kstep, voffA); PG8_STAGE(PG8_SB(1, 1), cB + hstepB + kstep, voffB);
        PG8_WAIT_V(6); PG8_BAR;
    } else {
        PG8_STAGE(PG8_SB(0, 0), cB, voffB); PG8_STAGE(PG8_SA(0, 0), cA, voffA); PG8_STAGE(PG8_SB(0, 1), cB + hstepB, voffB); PG8_STAGE(PG8_SA(0, 1), cA + hstepA, voffA);
        if (wr == 1) PG8_BAR;
        PG8_WAIT_V(4); PG8_BAR;
        PG8_STAGE(PG8_SB(1, 0), cB + kstep, voffB); PG8_STAGE(PG8_SA(1, 0), cA + kstep, voffA); PG8_STAGE(PG8_SB(1, 1), cB + hstepB + kstep, voffB);
        PG8_WAIT_V(6); PG8_BAR;
    }
    for (;;) {
        const bool has_next = S.next(ui + 1, nxt);
        const char* nA = has_next ? S.aptr(g, nxt) : cA; const char* nB = has_next ? S.bptr(g, nxt) : cB;
        for (int t = 0; t < nt; t += 2) {
            const bool last = (t == nt - 2);
            const char* a1 = cA + (size_t)(t + 1) * kstep;
            const char* a2 = last ? nA : cA + (size_t)(t + 2) * kstep; const char* b2 = last ? nB : cB + (size_t)(t + 2) * kstep;
            const char* a3 = a2 + kstep; const char* b3 = b2 + kstep;
            if (last && has_next) S.a_ready(nxt);
            if constexpr (SP2) {
            PG8_LDB(B0, 0, 0); PG8_LDB(B1, 0, 1); PG8_SCHED; PG8_LDA(At, 0, 0); PG8_STAGE(PG8_SA(1, 1), a1 + hstepA, voffA);
            PG8_WAIT_V(8); PG8_WAIT_L(0); PG8_BAR; PG8_MMA(0, 0, At, B0); PG8_MMA(0, 1, At, B1); PG8_BAR; PG8_SCHED;
            PG8_LDA(At, 0, 1); PG8_STAGE(PG8_SB(0, 0), b2, voffB); PG8_STAGE(PG8_SB(0, 1), b2 + hstepB, voffB); PG8_STAGE(PG8_SA(0, 0), a2, voffA);
            PG8_WAIT_V(8); PG8_WAIT_L(0); PG8_BAR; PG8_MMA(1, 0, At, B0); PG8_MMA(1, 1, At, B1); PG8_BAR; PG8_SCHED;
            PG8_LDB(B0, 1, 0); PG8_LDB(B1, 1, 1); PG8_SCHED; PG8_LDA(At, 1, 0); PG8_STAGE(PG8_SA(0, 1), a2 + hstepA, voffA);
            PG8_WAIT_V(8); PG8_WAIT_L(0); PG8_BAR; PG8_MMA(0, 0, At, B0); PG8_MMA(0, 1, At, B1); PG8_BAR; PG8_SCHED;
            PG8_LDA(At, 1, 1); PG8_STAGE(PG8_SB(1, 0), b3, voffB); PG8_STAGE(PG8_SB(1, 1), b3 + hstepB, voffB); PG8_STAGE(PG8_SA(1, 0), a3, voffA);
            PG8_WAIT_V(8); PG8_WAIT_L(0); PG8_BAR; PG8_MMA(1, 0, At, B0); PG8_MMA(1, 1, At, B1); PG8_BAR; PG8_SCHED;
            } else {
            PG8_LDB(B0, 0, 0); PG8_SCHED; PG8_LDA(At, 0, 0); PG8_STAGE(PG8_SA(1, 1), a1 + hstepA, voffA);
            PG8_WAIT_L(8); PG8_BAR; PG8_WAIT_L(0); PG8_MMA(0, 0, At, B0); PG8_BAR; PG8_SCHED;
            PG8_LDB(B1, 0, 1); PG8_STAGE(PG8_SB(0, 0), b2, voffB);
            PG8_BAR; PG8_WAIT_L(0); PG8_MMA(0, 1, At, B1); PG8_BAR;
            PG8_LDA(At, 0, 1); PG8_STAGE(PG8_SA(0, 0), a2, voffA);
            PG8_BAR; PG8_WAIT_L(0); PG8_MMA(1, 0, At, B0); PG8_BAR; PG8_SCHED;
            PG8_STAGE(PG8_SB(0, 1), b2 + hstepB, voffB);
            PG8_WAIT_V(6); PG8_BAR; PG8_MMA(1, 1, At, B1); PG8_BAR;
            PG8_LDB(B0, 1, 0); PG8_SCHED; PG8_LDA(At, 1, 0); PG8_STAGE(PG8_SA(0, 1), a2 + hstepA, voffA);
            PG8_WAIT_L(8); PG8_BAR; PG8_WAIT_L(0); PG8_MMA(0, 0, At, B0); PG8_BAR; PG8_SCHED;
            PG8_LDB(B1, 1, 1); PG8_STAGE(PG8_SB(1, 0), b3, voffB);
            PG8_BAR; PG8_WAIT_L(0); PG8_MMA(0, 1, At, B1); PG8_BAR;
            PG8_LDA(At, 1, 1); PG8_STAGE(PG8_SA(1, 0), a3, voffA);
            PG8_BAR; PG8_WAIT_L(0); PG8_MMA(1, 0, At, B0); PG8_BAR; PG8_SCHED;
            PG8_STAGE(PG8_SB(1, 1), b3 + hstepB, voffB);
            PG8_WAIT_V(6); PG8_BAR; PG8_MMA(1, 1, At, B1); PG8_BAR;
            }
        }
        if constexpr (ALIGN_EPI) { if (wr == 0) PG8_BAR; }
        if constexpr (!Epi::AFTER_DRAIN) { E(acc, cur, wr, wc, fr, fq); S.done(cur); }
        if (!has_next) break;
#pragma unroll
        for (int a = 0; a < 2; ++a)
#pragma unroll
            for (int b = 0; b < 2; ++b)
#pragma unroll
                for (int m = 0; m < 4; ++m)
#pragma unroll
                    for (int n = 0; n < 2; ++n) acc[a][b][m][n] = (f32x4){0.f, 0.f, 0.f, 0.f};
        cur = nxt; cA = nA; cB = nB; ++ui;
        if constexpr (ALIGN_EPI) { if (wr == 1) PG8_BAR; }
    }
    PG8_WAIT_V(0);
    if constexpr (!ALIGN_EPI) { if (wr == 0) PG8_BAR; }
    PG8_BAR;
    if constexpr (Epi::AFTER_DRAIN) { E.fused(acc, cur, wr, wc, fr, fq, lds, wid, lane); S.done(cur); }
#undef PG8_SA
#undef PG8_SB
#undef PG8_STAGE
#undef PG8_LDA
#undef PG8_LDB
#undef PG8_MMA
#undef PG8_WAIT_V
#undef PG8_WAIT_L
#undef PG8_BAR
#undef PG8_SCHED
}
}

constexpr int NWAVES = 8;
constexpr int N_LAUNCHES = MK_N_LAUNCHES;
constexpr int PER_PHASE = 10;

constexpr int T_TOK = 16384, DM = 1024, SEQ = 8192;
constexpr float EPS = 1e-6f;
constexpr int W_IN_COLS = 7176;

constexpr size_t MiB = 1u << 20;
constexpr size_t WS_CTL = 0, CTL_ZERO_BYTES = 1 * MiB;
constexpr size_t WS_WIN = 1 * MiB, WS_WKV = 15 * MiB, WS_WBR = 17 * MiB, WS_WOUT = 20 * MiB, WS_WPQ = 22 * MiB, WS_PK = 26 * MiB;
constexpr size_t WS_KVMEM = 26 * MiB + 512 * 1024, WS_MEMN = 27 * MiB + 512 * 1024, WS_IGLF = 28 * MiB + 512 * 1024, WS_ND = 29 * MiB, WS_NS = 29 * MiB + 512 * 1024;
constexpr size_t WS_GATES = 30 * MiB;
constexpr size_t WS_MLQ = 126 * MiB, WS_MLK = 142 * MiB, WS_SBQ = 158 * MiB, WS_MLV = 174 * MiB, WS_MEMQ = 190 * MiB, WS_MLO = 206 * MiB, WS_SBK = 222 * MiB, WS_SBV = 238 * MiB;
constexpr size_t WS_UT8 = 30 * MiB, WS_VT8 = 46 * MiB, WS_USC = 94 * MiB, WS_VSC = 94 * MiB + 65536;
constexpr size_t WS_H1B = 126 * MiB;
constexpr size_t WS_QRY = 158 * MiB;
constexpr size_t WS_CT = 222 * MiB;
constexpr size_t WS_MERGED = 222 * MiB;
constexpr size_t WS_IDX = 222 * MiB, WS_GW = 230 * MiB;
constexpr size_t WS_END = 254 * MiB;
constexpr size_t SPLIT_STRIDE = (size_t)T_TOK * 512;
constexpr size_t CTL_CHS = 256 * 1024, CTL_MS = 272 * 1024, CTL_SUMSQ = 512 * 1024;
constexpr int CW_BAR = 4096;

constexpr int RING_BYTES = 131072;
constexpr int LDSCTL_OFF = RING_BYTES, MISC_OFF = LDSCTL_OFF + 320;
constexpr int LDS_BYTES = 147456;

#define GAS __attribute__((address_space(1)))
#define LAS __attribute__((address_space(3)))
typedef unsigned short bf16;
typedef unsigned v4u __attribute__((ext_vector_type(4)));
typedef unsigned v2u __attribute__((ext_vector_type(2)));
typedef float f32x4 __attribute__((ext_vector_type(4)));
typedef short bf16x8 __attribute__((ext_vector_type(8)));
typedef GAS unsigned gu32;
#define RLX_AGENT __ATOMIC_RELAXED, __HIP_MEMORY_SCOPE_AGENT
#define LDS_WAIT() asm volatile("s_waitcnt lgkmcnt(0)" ::: "memory")
#define VM_WAIT() asm volatile("s_waitcnt vmcnt(0)" ::: "memory")
__device__ __forceinline__ unsigned f2bf(float f) { unsigned u = __builtin_bit_cast(unsigned, f); return (u + 0x7fffu + ((u >> 16) & 1u)) >> 16; }
__device__ __forceinline__ unsigned pk2(float lo, float hi) { return f2bf(lo) | (f2bf(hi) << 16); }
__device__ __forceinline__ float bflo(unsigned x) { return __uint_as_float(x << 16); }
__device__ __forceinline__ float bfhi(unsigned x) { return __uint_as_float(x & 0xffff0000u); }
__device__ __forceinline__ float sigm(float x) { return 1.0f / (1.0f + __expf(-x)); }
__device__ __forceinline__ float softplusf_(float z) { return fmaxf(z, 0.f) + __logf(1.0f + __expf(-fabsf(z))); }

#define XB_TMO      128
#define XB_XCNT(j)  (256  + 64 * (j))
#define XB_XSUB(j)  (1280 + 64 * (j))
#define XB_XGEN(j)  (2304 + 64 * (j))
#define XB_TOP      3328
#define XB_TOPGEN   3392
#define XCD_BAR_WORDS 3456
#define XB_SPIN_CAP (1u << 18)
__device__ __forceinline__ unsigned xb_ld(unsigned* p)              { return __hip_atomic_load(p, __ATOMIC_RELAXED, __HIP_MEMORY_SCOPE_AGENT); }
__device__ __forceinline__ unsigned xb_add(unsigned* p, unsigned v) { return __hip_atomic_fetch_add(p, v, __ATOMIC_RELAXED, __HIP_MEMORY_SCOPE_AGENT); }
__device__ __forceinline__ unsigned xb_xcc_id() { return (unsigned)__builtin_amdgcn_s_getreg((3 << 11) | 20) & 0xFu; }
#define XB_SPIN(cond, bar) do { unsigned _sp = 0; while (cond) { __builtin_amdgcn_s_sleep(1); \
    if ((++_sp & 255u) == 0u) { if (xb_ld(&(bar)[XB_TMO])) break; if (_sp > XB_SPIN_CAP) { atomicAdd(&(bar)[XB_TMO], 1u); break; } } } } while (0)
struct XcdBarrier { unsigned* bar; unsigned x; volatile LAS unsigned* st; };
__device__ __forceinline__ XcdBarrier xcd_barrier_post(unsigned* bar, volatile LAS unsigned* st) {
    XcdBarrier b; b.bar = bar; b.x = xb_xcc_id(); b.st = st;
    if (threadIdx.x == 0) (void)xb_add(&bar[XB_XCNT(b.x)], 1u);
    return b;
}
__device__ __forceinline__ void xcd_barrier_complete(unsigned* bar, unsigned x, unsigned& nloc, unsigned& nx) {
    const unsigned G = gridDim.x * gridDim.y * gridDim.z;
    unsigned sum, cnt, mine, sp = 0u;
    for (;;) {
        sum = 0u; cnt = 0u; mine = 0u;
#pragma unroll
        for (unsigned j = 0; j < 16; ++j) { const unsigned c = xb_ld(&bar[XB_XCNT(j)]); sum += c; cnt += (c > 0u) ? 1u : 0u; mine = (j == x) ? c : mine; }
        if (sum == G) break;
        __builtin_amdgcn_s_sleep(1);
        if ((++sp & 255u) == 0u) { if (xb_ld(&bar[XB_TMO])) break; if (sp > XB_SPIN_CAP) { atomicAdd(&bar[XB_TMO], 1u); break; } }
    }
    nloc = mine > 0u ? mine : 1u; nx = cnt > 0u ? cnt : 1u;
}
__device__ __forceinline__ void xcd_barrier(const XcdBarrier& b) {
    asm volatile("s_waitcnt vmcnt(0)" ::: "memory");
    __syncthreads();
    if (threadIdx.x == 0) {
        unsigned* bar = b.bar;
        __builtin_amdgcn_s_waitcnt(0);
        unsigned nloc = b.st[0], nx = b.st[1];
        if (nloc == 0u) { xcd_barrier_complete(bar, b.x, nloc, nx); b.st[0] = nloc; b.st[1] = nx; }
        const unsigned old = xb_add(&bar[XB_XSUB(b.x)], 1u);
        const unsigned gen = old / nloc;
        if (old + 1u == (gen + 1u) * nloc) {
            __builtin_amdgcn_fence(__ATOMIC_RELEASE, "agent");
            asm volatile("s_waitcnt vmcnt(0)" ::: "memory");
            const unsigned og = xb_add(&bar[XB_TOP], 1u);
            const unsigned tg = og / nx;
            if (og + 1u == (tg + 1u) * nx) xb_add(&bar[XB_TOPGEN], 1u);
            else XB_SPIN(xb_ld(&bar[XB_TOPGEN]) == tg, bar);
            __builtin_amdgcn_fence(__ATOMIC_ACQUIRE, "agent");
            xb_add(&bar[XB_XGEN(b.x)], 1u);
            asm volatile("s_waitcnt vmcnt(0)" ::: "memory");
        } else {
            XB_SPIN(xb_ld(&bar[XB_XGEN(b.x)]) == gen, bar);
            __builtin_amdgcn_fence(__ATOMIC_ACQUIRE, "agent");
            asm volatile("s_waitcnt vmcnt(0)" ::: "memory");
        }
    }
    __syncthreads();
}

struct Frame {
    LAS unsigned char* lds;
    volatile LAS unsigned* MISC;
    int tid, lane, wave, G;
    unsigned char* ws; float* out;
    const float* in[24];
};
__device__ __forceinline__ float wave_sum(float v) {
#pragma unroll
    for (int o = 1; o < 64; o <<= 1) v += __shfl_xor(v, o);
    return v;
}
__device__ __forceinline__ float wave_max(float v) {
#pragma unroll
    for (int o = 1; o < 64; o <<= 1) v = fmaxf(v, __shfl_xor(v, o));
    return v;
}

template <int NT, int KS>
__device__ __forceinline__ void wave_mma(f32x4 (&acc)[NT], const LAS unsigned char* A, int pitchA, int m0, const LAS unsigned char* Bt, int pitchB, int n0, int lane, int koffA = 0, int koffB = 0) {
    const int r = lane & 15, q = lane >> 4;
#pragma unroll
    for (int ks = 0; ks < KS; ++ks) {
        const bf16x8 a = *(const LAS bf16x8*)(A + (m0 + r) * pitchA + (koffA + ks * 32 + q * 8) * 2);
#pragma unroll
        for (int j = 0; j < NT; ++j) {
            const bf16x8 b = *(const LAS bf16x8*)(Bt + (n0 + 16 * j + r) * pitchB + (koffB + ks * 32 + q * 8) * 2);
            acc[j] = __builtin_amdgcn_mfma_f32_16x16x32_bf16(a, b, acc[j], 0, 0, 0);
        }
    }
}
__device__ __forceinline__ void lds_store_tr8(LAS unsigned char* base, int pitch, int d0, int col, v4u v) {
    *(LAS unsigned short*)(base + (d0 + 0) * pitch + col * 2) = (unsigned short)(v.x & 0xffffu); *(LAS unsigned short*)(base + (d0 + 1) * pitch + col * 2) = (unsigned short)(v.x >> 16);
    *(LAS unsigned short*)(base + (d0 + 2) * pitch + col * 2) = (unsigned short)(v.y & 0xffffu); *(LAS unsigned short*)(base + (d0 + 3) * pitch + col * 2) = (unsigned short)(v.y >> 16);
    *(LAS unsigned short*)(base + (d0 + 4) * pitch + col * 2) = (unsigned short)(v.z & 0xffffu); *(LAS unsigned short*)(base + (d0 + 5) * pitch + col * 2) = (unsigned short)(v.z >> 16);
    *(LAS unsigned short*)(base + (d0 + 6) * pitch + col * 2) = (unsigned short)(v.w & 0xffffu); *(LAS unsigned short*)(base + (d0 + 7) * pitch + col * 2) = (unsigned short)(v.w >> 16);
}

__device__ __forceinline__ void p0_transpose_item(const float* W, int ldsrc, int src_off, int K, int ncols, bf16* WT, int row_off, const float* kscale, LAS float* scr, int item, int lane) {
    const int nblk = ncols / 32, kb = item / nblk, nb = item % nblk, k0 = 64 * kb, n0 = 32 * nb;
#pragma unroll 8
    for (int i = 0; i < 32; ++i) { const int kk = 2 * i + (lane >> 5); float v = W[(size_t)(k0 + kk) * ldsrc + src_off + n0 + (lane & 31)]; if (kscale) v *= kscale[k0 + kk]; scr[kk * 33 + (lane & 31)] = v; }
    LDS_WAIT(); asm volatile("" ::: "memory");
    const int c = lane & 7;
#pragma unroll
    for (int j = 0; j < 4; ++j) { const int n = (lane >> 3) + 8 * j; const LAS float* s = scr + (8 * c) * 33 + n;
        v4u o; o.x = pk2(s[0 * 33], s[1 * 33]); o.y = pk2(s[2 * 33], s[3 * 33]); o.z = pk2(s[4 * 33], s[5 * 33]); o.w = pk2(s[6 * 33], s[7 * 33]);
        *(GAS v4u*)(WT + (size_t)(row_off + n0 + n) * K + k0 + 8 * c) = o; }
    LDS_WAIT(); asm volatile("" ::: "memory");
}

__device__ __forceinline__ void p0_prologue(Frame& F) {
    const float* x = F.in[0]; const float* mem = F.in[1]; const float* g_mix = F.in[2]; const float* w_in = F.in[3];
    const float* b_ig = F.in[4]; const float* b_fg = F.in[5]; const float* mem_g = F.in[9];
    bf16* XN = (bf16*)F.out;
    bf16* MEMN = (bf16*)(F.ws + WS_MEMN);
    float* IGLF = (float*)(F.ws + WS_IGLF);
    LAS float* gws = (LAS float*)(F.lds + 69632);
    for (int e = F.tid; e < 8192; e += 512) { const int c = e & 7, k = e >> 3; gws[c * 1024 + k] = w_in[(size_t)k * W_IN_COLS + 3072 + c]; }
    __syncthreads();
    const int gw = blockIdx.x * NWAVES + F.wave, NGW = F.G * NWAVES;
    for (int m = gw; m < T_TOK + 512; m += NGW) {
        const bool is_mem = m >= T_TOK;
        const float* src = is_mem ? mem + (size_t)(m - T_TOK) * DM : x + (size_t)m * DM;
        const float* gsrc = is_mem ? mem_g : g_mix;
        bf16* dst = is_mem ? MEMN + (size_t)(m - T_TOK) * DM : XN + (size_t)m * DM;
        const GAS f32x4* xr = (const GAS f32x4*)src + F.lane;
        f32x4 v[4]; float s = 0.f;
#pragma unroll
        for (int j = 0; j < 4; ++j) { v[j] = xr[64 * j]; s += (v[j].x * v[j].x + v[j].y * v[j].y) + (v[j].z * v[j].z + v[j].w * v[j].w); }
        const float rstd = 1.0f / sqrtf(wave_sum(s) * (1.f / DM) + EPS);
#pragma unroll
        for (int j = 0; j < 4; ++j) { const f32x4 gg = *((const GAS f32x4*)gsrc + F.lane + 64 * j); v[j] = v[j] * rstd * gg; }
        GAS unsigned long long* o8 = (GAS unsigned long long*)dst + F.lane;
#pragma unroll
        for (int j = 0; j < 4; ++j) o8[64 * j] = (unsigned long long)pk2(v[j].x, v[j].y) | ((unsigned long long)pk2(v[j].z, v[j].w) << 32);
        if (!is_mem) {
            float dots[8];
#pragma unroll
            for (int c = 0; c < 8; ++c) { float d = 0.f;
#pragma unroll
                for (int j = 0; j < 4; ++j) { const f32x4 wv = *(const LAS f32x4*)(gws + c * 1024 + 256 * j + 4 * F.lane); d += (v[j].x * wv.x + v[j].y * wv.y) + (v[j].z * wv.z + v[j].w * wv.w); }
                dots[c] = wave_sum(d); }
            if (F.lane == 0) {
                f32x4 o0, o1;
#pragma unroll
                for (int h = 0; h < 4; ++h) { o0[h] = dots[h] + b_ig[h]; const float fp = dots[4 + h] + b_fg[h]; o1[h] = fminf(fp, 0.f) - __logf(1.0f + __expf(-fabsf(fp))); }
                *(GAS f32x4*)(IGLF + (size_t)m * 8) = o0; *(GAS f32x4*)(IGLF + (size_t)m * 8 + 4) = o1;
            }
        }
    }
    { const float* k1 = F.in[20]; const float* k2 = F.in[21]; bf16* PK = (bf16*)(F.ws + WS_PK);
      for (int e = (blockIdx.x * 512 + F.tid) * 4; e < 2 * 131072; e += F.G * 512 * 4) {
          const f32x4 vv = (e < 131072) ? *(const GAS f32x4*)(k1 + e) : *(const GAS f32x4*)(k2 + e - 131072);
          v2u o; o.x = pk2(vv.x, vv.y); o.y = pk2(vv.z, vv.w); *(GAS v2u*)(PK + e) = o; } }
    __syncthreads();
    LAS float* scr = (LAS float*)(F.lds + F.wave * 8448);
    bf16* WIN = (bf16*)(F.ws + WS_WIN); bf16* WKV = (bf16*)(F.ws + WS_WKV); bf16* WBR = (bf16*)(F.ws + WS_WBR); bf16* WOUT = (bf16*)(F.ws + WS_WOUT); bf16* WPQ = (bf16*)(F.ws + WS_WPQ);
    constexpr int I_G = 16 * 96, I_5 = 16 * 16, I_KV = 16 * 32, I_BR = 8 * 32, I_OUT = 16 * 32, I_PQ = 16 * 64;
    constexpr int NITEMS = I_G + 8 * I_5 + I_KV + 3 * I_BR + I_OUT + I_PQ;
    for (int it = gw; it < NITEMS; it += NGW) {
        int r = it;
        if (r < I_G) { p0_transpose_item(w_in, W_IN_COLS, 4104, 1024, 3072, WIN, 0, nullptr, scr, r, F.lane); continue; } r -= I_G;
        if (r < I_5) { p0_transpose_item(w_in, W_IN_COLS, 1536, 1024, 512, WIN, 3072, nullptr, scr, r, F.lane); continue; } r -= I_5;
        if (r < I_5) { p0_transpose_item(w_in, W_IN_COLS, 2048, 1024, 512, WIN, 3584, nullptr, scr, r, F.lane); continue; } r -= I_5;
        if (r < I_5) { p0_transpose_item(w_in, W_IN_COLS, 0, 1024, 512, WIN, 4096, nullptr, scr, r, F.lane); continue; } r -= I_5;
        if (r < I_5) { p0_transpose_item(w_in, W_IN_COLS, 2560, 1024, 512, WIN, 4608, nullptr, scr, r, F.lane); continue; } r -= I_5;
        if (r < I_5) { p0_transpose_item(w_in, W_IN_COLS, 3592, 1024, 512, WIN, 5120, nullptr, scr, r, F.lane); continue; } r -= I_5;
        if (r < I_5) { p0_transpose_item(w_in, W_IN_COLS, 3080, 1024, 512, WIN, 5632, nullptr, scr, r, F.lane); continue; } r -= I_5;
        if (r < I_5) { p0_transpose_item(w_in, W_IN_COLS, 512, 1024, 512, WIN, 6144, nullptr, scr, r, F.lane); continue; } r -= I_5;
        if (r < I_5) { p0_transpose_item(w_in, W_IN_COLS, 1024, 1024, 512, WIN, 6656, nullptr, scr, r, F.lane); continue; } r -= I_5;
        if (r < I_KV) { p0_transpose_item(F.in[10], 1024, 0, 1024, 1024, WKV, 0, nullptr, scr, r, F.lane); continue; } r -= I_KV;
        if (r < I_BR) { p0_transpose_item(F.in[13], 1024, 0, 512, 1024, WBR, 0, nullptr, scr, r, F.lane); continue; } r -= I_BR;
        if (r < I_BR) { p0_transpose_item(F.in[14], 1024, 0, 512, 1024, WBR, 1024, nullptr, scr, r, F.lane); continue; } r -= I_BR;
        if (r < I_BR) { p0_transpose_item(F.in[15], 1024, 0, 512, 1024, WBR, 2048, nullptr, scr, r, F.lane); continue; } r -= I_BR;
        if (r < I_OUT) { p0_transpose_item(F.in[17], 1024, 0, 1024, 1024, WOUT, 0, nullptr, scr, r, F.lane); continue; } r -= I_OUT;
        p0_transpose_item(F.in[19], 2048, 0, 1024, 2048, WPQ, 0, F.in[18], scr, r, F.lane);
    }
}

__device__ __forceinline__ void sb_attn_item(Frame& F, int item) {
    const int bh = item >> 6, qb = item & 63, b = bh >> 3, h = bh & 7;
    const int tid = F.tid, lane = F.lane, w = F.wave;
    LAS unsigned char* Qs = F.lds;
    LAS unsigned char* Ks = F.lds + 18432;
    LAS unsigned char* VTs = F.lds + 27648;
    LAS unsigned char* Ss = F.lds + 36864;
    LAS unsigned char* Ps = F.lds + 71680;
    LAS float* red = (LAS float*)(F.lds + 90112);
    bf16* SBQ = (bf16*)(F.ws + WS_SBQ); const bf16* SBK = (const bf16*)(F.ws + WS_SBK); const bf16* SBV = (const bf16*)(F.ws + WS_SBV);
    const size_t row0 = (size_t)b * SEQ + (size_t)qb * 128;
    __syncthreads();
#pragma unroll
    for (int i = 0; i < 2; ++i) { const int p = tid + 512 * i, r = p >> 3, c = p & 7;
        const v4u v = *(const GAS v4u*)(SBQ + (row0 + r) * 512 + h * 64 + c * 8); *(LAS v4u*)(Qs + r * 144 + c * 16) = v; }
    f32x4 oacc[4];
#pragma unroll
    for (int j = 0; j < 4; ++j) oacc[j] = (f32x4){0.f, 0.f, 0.f, 0.f};
    float R = 0.f;
    const int r = tid >> 2, qd = tid & 3;
    const int tq = qb * 128 + r;
    for (int jb = 2 * qb + 1; jb >= 0; --jb) {
        __syncthreads();
        { const int key = tid >> 3, c = tid & 7; const size_t grow = (size_t)b * SEQ + (size_t)jb * 64 + key;
          const v4u kv = *(const GAS v4u*)(SBK + grow * 512 + h * 64 + c * 8); *(LAS v4u*)(Ks + key * 144 + c * 16) = kv;
          const v4u vv = *(const GAS v4u*)(SBV + grow * 512 + h * 64 + c * 8); lds_store_tr8(VTs, 144, c * 8, key, vv); }
        __syncthreads();
        { f32x4 sacc[4];
#pragma unroll
          for (int j = 0; j < 4; ++j) sacc[j] = (f32x4){0.f, 0.f, 0.f, 0.f};
          wave_mma<4, 2>(sacc, Qs, 144, 16 * w, Ks, 144, 0, lane);
#pragma unroll
          for (int j = 0; j < 4; ++j)
#pragma unroll
              for (int rg = 0; rg < 4; ++rg) *(LAS float*)(Ss + (16 * w + 4 * (lane >> 4) + rg) * 272 + (16 * j + (lane & 15)) * 4) = sacc[j][rg]; }
        __syncthreads();
        { float z[16];
#pragma unroll
          for (int i4 = 0; i4 < 4; ++i4) { const f32x4 t4 = *(const LAS f32x4*)(Ss + r * 272 + qd * 64 + i4 * 16); z[4 * i4] = t4.x; z[4 * i4 + 1] = t4.y; z[4 * i4 + 2] = t4.z; z[4 * i4 + 3] = t4.w; }
          const int s0 = jb * 64 + qd * 16;
          float suf[16], lb[16]; float run = 0.f;
#pragma unroll
          for (int i = 15; i >= 0; --i) { const float zz = z[i] * 0.125f; const bool mk = (s0 + i) < tq; const float sp = softplusf_(zz); lb[i] = zz - sp; suf[i] = run; run += mk ? -sp : 0.f; }
          const float a1 = __shfl_xor(run, 1), a2 = __shfl_xor(run, 2), a3 = __shfl_xor(run, 3);
          const float off = ((qd & 1) == 0 ? a1 : 0.f) + ((qd & 2) == 0 ? a2 : 0.f) + (qd < 2 ? a3 : 0.f);
          const float base = R + off;
          unsigned pw[8];
#pragma unroll
          for (int i = 0; i < 16; i += 2) { const float p0 = ((s0 + i) < tq) ? __expf(lb[i] + base + suf[i]) : 0.f; const float p1 = ((s0 + i + 1) < tq) ? __expf(lb[i + 1] + base + suf[i + 1]) : 0.f; pw[i >> 1] = pk2(p0, p1); }
          *(LAS v4u*)(Ps + r * 144 + qd * 32) = (v4u){pw[0], pw[1], pw[2], pw[3]}; *(LAS v4u*)(Ps + r * 144 + qd * 32 + 16) = (v4u){pw[4], pw[5], pw[6], pw[7]};
          R += run + a1 + a2 + a3; }
        const float rm = wave_max(R);
        if (lane == 0) red[w] = rm;
        __syncthreads();
        wave_mma<4, 2>(oacc, Ps, 144, 16 * w, VTs, 144, 0, lane);
        float rmax = red[0];
#pragma unroll
        for (int i = 1; i < 8; ++i) rmax = fmaxf(rmax, red[i]);
        if (rmax < -110.f) break;
    }
    LDS_WAIT();
#pragma unroll
    for (int j = 0; j < 4; ++j)
#pragma unroll
        for (int rg = 0; rg < 4; ++rg) *(LAS unsigned short*)(Ps + (16 * w + 4 * (lane >> 4) + rg) * 144 + (16 * j + (lane & 15)) * 2) = (unsigned short)f2bf(oacc[j][rg]);
    LDS_WAIT();
#pragma unroll
    for (int i = 0; i < 2; ++i) { const int p = lane + 64 * i, rr = 16 * w + (p >> 3), c = p & 7;
        const v4u v = *(const LAS v4u*)(Ps + rr * 144 + c * 16); *(GAS v4u*)(SBQ + (row0 + rr) * 512 + h * 64 + c * 8) = v; }
}

__device__ __forceinline__ void conv16(const bf16* src, int col, const float* cw, const float* cb, int ch, int b, int t, float (&y)[16]) {
#pragma unroll
    for (int i4 = 0; i4 < 4; ++i4) { const f32x4 bb = *(const GAS f32x4*)(cb + ch + 4 * i4); y[4 * i4] = bb.x; y[4 * i4 + 1] = bb.y; y[4 * i4 + 2] = bb.z; y[4 * i4 + 3] = bb.w; }
#pragma unroll
    for (int kk = 0; kk < 4; ++kk) { const int tt = t - 3 + kk;
        if (tt >= 0) { const bf16* p = src + ((size_t)b * SEQ + tt) * 512 + col; const v4u x0 = *(const GAS v4u*)p, x1 = *(const GAS v4u*)(p + 8);
            const float xs[16] = {bflo(x0.x), bfhi(x0.x), bflo(x0.y), bfhi(x0.y), bflo(x0.z), bfhi(x0.z), bflo(x0.w), bfhi(x0.w), bflo(x1.x), bfhi(x1.x), bflo(x1.y), bfhi(x1.y), bflo(x1.z), bfhi(x1.z), bflo(x1.w), bfhi(x1.w)};
#pragma unroll
            for (int i4 = 0; i4 < 4; ++i4) { const f32x4 wv = *(const GAS f32x4*)(cw + kk * 1024 + ch + 4 * i4);
                y[4 * i4] += wv.x * xs[4 * i4]; y[4 * i4 + 1] += wv.y * xs[4 * i4 + 1]; y[4 * i4 + 2] += wv.z * xs[4 * i4 + 2]; y[4 * i4 + 3] += wv.w * xs[4 * i4 + 3]; } } }
#pragma unroll
    for (int i = 0; i < 16; ++i) y[i] = y[i] * sigm(y[i]);
}

__device__ __forceinline__ void mlstm_local_item(Frame& F, int item) {
    const int bh = item >> 7, c = item & 127, b = bh >> 2, h = bh & 3;
    const int tid = F.tid, lane = F.lane, w = F.wave;
    LAS float* wsm = (LAS float*)F.lds;
    LAS unsigned char* WKT = F.lds + 256;
    LAS unsigned char* VT = F.lds + 256 + 18432;
    const float* IGLF = (const float*)(F.ws + WS_IGLF);
    float* CHS = (float*)(F.ws + WS_CTL + CTL_CHS);
    const bf16* MLK = (const bf16*)(F.ws + WS_MLK); const bf16* MLV = (const bf16*)(F.ws + WS_MLV);
    float* Dg = F.out + (size_t)item * 16384; float* NDg = (float*)(F.ws + WS_ND) + (size_t)item * 128;
    const int t0 = c * 64; const size_t row0 = (size_t)b * SEQ + t0;
    __syncthreads();
    if (w == 0) {
        const float lf = IGLF[(row0 + lane) * 8 + 4 + h], ig = IGLF[(row0 + lane) * 8 + h];
        float bs = lf;
#pragma unroll
        for (int o = 1; o < 64; o <<= 1) { const float v = __shfl_up(bs, o); if (lane >= o) bs += v; }
        const float blast = __shfl(bs, 63);
        const float a = blast - bs + ig; const float mu = wave_max(a);
        wsm[lane] = __expf(a - mu);
        if (lane == 0) { CHS[2 * item] = blast; CHS[2 * item + 1] = mu; }
    }
    __syncthreads();
    { const int s = tid >> 3, part = tid & 7; float y[16];
      conv16(MLK, h * 128 + part * 16, F.in[6], F.in[7], 512 + h * 128 + part * 16, b, t0 + s, y);
      const float sc = wsm[s] * 0.08838834764831845f;
      v4u k0, k1; k0.x = pk2(y[0] * sc, y[1] * sc); k0.y = pk2(y[2] * sc, y[3] * sc); k0.z = pk2(y[4] * sc, y[5] * sc); k0.w = pk2(y[6] * sc, y[7] * sc);
      k1.x = pk2(y[8] * sc, y[9] * sc); k1.y = pk2(y[10] * sc, y[11] * sc); k1.z = pk2(y[12] * sc, y[13] * sc); k1.w = pk2(y[14] * sc, y[15] * sc);
      lds_store_tr8(WKT, 144, part * 16, s, k0); lds_store_tr8(WKT, 144, part * 16 + 8, s, k1);
      const bf16* vp = MLV + (row0 + s) * 512 + h * 128 + part * 16; const v4u v0 = *(const GAS v4u*)vp, v1 = *(const GAS v4u*)(vp + 8);
      lds_store_tr8(VT, 144, part * 16, s, v0); lds_store_tr8(VT, 144, part * 16 + 8, s, v1); }
    __syncthreads();
    { f32x4 acc[8];
#pragma unroll
      for (int j = 0; j < 8; ++j) acc[j] = (f32x4){0.f, 0.f, 0.f, 0.f};
      wave_mma<8, 2>(acc, VT, 144, 16 * w, WKT, 144, 0, lane);
#pragma unroll
      for (int j = 0; j < 8; ++j)
#pragma unroll
          for (int rg = 0; rg < 4; ++rg) Dg[(16 * w + 4 * (lane >> 4) + rg) * 128 + 16 * j + (lane & 15)] = acc[j][rg]; }
    if (tid < 128) { float s = 0.f;
#pragma unroll
        for (int i = 0; i < 8; ++i) { const v4u v = *(const LAS v4u*)(WKT + tid * 144 + i * 16); s += (bflo(v.x) + bfhi(v.x)) + (bflo(v.y) + bfhi(v.y)) + (bflo(v.z) + bfhi(v.z)) + (bflo(v.w) + bfhi(v.w)); }
        NDg[tid] = s; }
}

__device__ __forceinline__ void mlstm_scan(Frame& F) {
    const float* CHS = (const float*)(F.ws + WS_CTL + CTL_CHS); float* MS = (float*)(F.ws + WS_CTL + CTL_MS);
    const float* Dg = F.out; bf16* CT = (bf16*)(F.ws + WS_CT);
    const float* NDg = (const float*)(F.ws + WS_ND); float* NS = (float*)(F.ws + WS_NS);
    for (int g = blockIdx.x * 512 + F.tid; g < 8 * 16384 + 8 * 128; g += F.G * 512) {
        const bool isn = g >= 8 * 16384; const int gg = isn ? g - 8 * 16384 : g;
        const int bh = isn ? (gg >> 7) : (gg >> 14), e = isn ? (gg & 127) : (gg & 16383);
        float st = 0.f, m = 0.f;
#pragma unroll 8
        for (int c = 0; c < 128; ++c) { const int item = bh * 128 + c;
            const float blast = CHS[2 * item], mu = CHS[2 * item + 1];
            const float d = isn ? NDg[(size_t)item * 128 + e] : Dg[(size_t)item * 16384 + e];
            if (isn) { NS[(size_t)item * 128 + e] = st; if (e == 0) MS[item] = m; } else CT[(size_t)item * 16384 + e] = (bf16)f2bf(st);
            const float mn = fmaxf(blast + m, mu);
            st = __expf(blast + m - mn) * st + __expf(mu - mn) * d; m = mn; }
    }
}

__device__ __forceinline__ void mem_attn_item(Frame& F, int item) {
    const int tile = item & 63, h = (item >> 6) & 3, b = item >> 8;
    const int tid = F.tid, lane = F.lane, w = F.wave;
    LAS unsigned char* Qs = F.lds;
    LAS unsigned char* KVs = F.lds + 34816;
    LAS unsigned char* Pw = F.lds + 34816 + 69632 + w * 2304;
    bf16* MEMQ = (bf16*)(F.ws + WS_MEMQ); const bf16* KV = (const bf16*)(F.ws + WS_KVMEM);
    const float* qg = F.in[11]; const float* kg = F.in[12];
    const size_t row0 = (size_t)b * SEQ + (size_t)tile * 128;
    __syncthreads();
    { const int r = tid >> 2, part = tid & 3; const bf16* p = MEMQ + (row0 + r) * 512 + h * 128 + part * 32;
      v4u x[4]; float s = 0.f;
#pragma unroll
      for (int i = 0; i < 4; ++i) { x[i] = *(const GAS v4u*)(p + 8 * i);
          s += (bflo(x[i].x) * bflo(x[i].x) + bfhi(x[i].x) * bfhi(x[i].x)) + (bflo(x[i].y) * bflo(x[i].y) + bfhi(x[i].y) * bfhi(x[i].y)) + (bflo(x[i].z) * bflo(x[i].z) + bfhi(x[i].z) * bfhi(x[i].z)) + (bflo(x[i].w) * bflo(x[i].w) + bfhi(x[i].w) * bfhi(x[i].w)); }
      s += __shfl_xor(s, 1); s += __shfl_xor(s, 2);
      const float rs = 0.08838834764831845f / sqrtf(s * (1.f / 128.f) + EPS);
#pragma unroll
      for (int i = 0; i < 4; ++i) { const f32x4 g0 = *(const GAS f32x4*)(qg + part * 32 + 8 * i), g1 = *(const GAS f32x4*)(qg + part * 32 + 8 * i + 4);
          v4u o; o.x = pk2(bflo(x[i].x) * rs * g0.x, bfhi(x[i].x) * rs * g0.y); o.y = pk2(bflo(x[i].y) * rs * g0.z, bfhi(x[i].y) * rs * g0.w);
          o.z = pk2(bflo(x[i].z) * rs * g1.x, bfhi(x[i].z) * rs * g1.y); o.w = pk2(bflo(x[i].w) * rs * g1.z, bfhi(x[i].w) * rs * g1.w);
          *(LAS v4u*)(Qs + r * 272 + part * 64 + i * 16) = o; } }
    { const int key = tid >> 1, half = tid & 1; const bf16* p = KV + ((size_t)b * 256 + key) * 1024 + h * 128 + half * 64;
      v4u x[8]; float s = 0.f;
#pragma unroll
      for (int i = 0; i < 8; ++i) { x[i] = *(const GAS v4u*)(p + 8 * i);
          s += (bflo(x[i].x) * bflo(x[i].x) + bfhi(x[i].x) * bfhi(x[i].x)) + (bflo(x[i].y) * bflo(x[i].y) + bfhi(x[i].y) * bfhi(x[i].y)) + (bflo(x[i].z) * bflo(x[i].z) + bfhi(x[i].z) * bfhi(x[i].z)) + (bflo(x[i].w) * bflo(x[i].w) + bfhi(x[i].w) * bfhi(x[i].w)); }
      s += __shfl_xor(s, 1);
      const float rs = 1.0f / sqrtf(s * (1.f / 128.f) + EPS);
#pragma unroll
      for (int i = 0; i < 8; ++i) { const f32x4 g0 = *(const GAS f32x4*)(kg + half * 64 + 8 * i), g1 = *(const GAS f32x4*)(kg + half * 64 + 8 * i + 4);
          v4u o; o.x = pk2(bflo(x[i].x) * rs * g0.x, bfhi(x[i].x) * rs * g0.y); o.y = pk2(bflo(x[i].y) * rs * g0.z, bfhi(x[i].y) * rs * g0.w);
          o.z = pk2(bflo(x[i].z) * rs * g1.x, bfhi(x[i].z) * rs * g1.y); o.w = pk2(bflo(x[i].w) * rs * g1.z, bfhi(x[i].w) * rs * g1.w);
          *(LAS v4u*)(KVs + key * 272 + half * 128 + i * 16) = o; } }
    __syncthreads();
    f32x4 sacc[16];
#pragma unroll
    for (int j = 0; j < 16; ++j) sacc[j] = (f32x4){0.f, 0.f, 0.f, 0.f};
    wave_mma<16, 4>(sacc, Qs, 272, 16 * w, KVs, 272, 0, lane);
    float rsum[4];
#pragma unroll
    for (int rg = 0; rg < 4; ++rg) { float mx = sacc[0][rg];
#pragma unroll
        for (int j = 1; j < 16; ++j) mx = fmaxf(mx, sacc[j][rg]);
        mx = fmaxf(mx, __shfl_xor(mx, 1)); mx = fmaxf(mx, __shfl_xor(mx, 2)); mx = fmaxf(mx, __shfl_xor(mx, 4)); mx = fmaxf(mx, __shfl_xor(mx, 8));
        float sm = 0.f;
#pragma unroll
        for (int j = 0; j < 16; ++j) { const float p = __expf(sacc[j][rg] - mx); sacc[j][rg] = p; sm += p; }
        sm += __shfl_xor(sm, 1); sm += __shfl_xor(sm, 2); sm += __shfl_xor(sm, 4); sm += __shfl_xor(sm, 8);
        rsum[rg] = 1.0f / sm; }
    __syncthreads();
#pragma unroll
    for (int i = 0; i < 8; ++i) { const int p = tid + 512 * i, key = p >> 4, c = p & 15;
        const v4u v = *(const GAS v4u*)(KV + ((size_t)b * 256 + key) * 1024 + 512 + h * 128 + c * 8); lds_store_tr8(KVs, 528, c * 8, key, v); }
    __syncthreads();
    f32x4 oacc[8];
#pragma unroll
    for (int j = 0; j < 8; ++j) oacc[j] = (f32x4){0.f, 0.f, 0.f, 0.f};
#pragma unroll
    for (int kc = 0; kc < 4; ++kc) {
        LDS_WAIT();
#pragma unroll
        for (int jj = 0; jj < 4; ++jj)
#pragma unroll
            for (int rg = 0; rg < 4; ++rg) *(LAS unsigned short*)(Pw + (4 * (lane >> 4) + rg) * 144 + (16 * jj + (lane & 15)) * 2) = (unsigned short)f2bf(sacc[4 * kc + jj][rg]);
        LDS_WAIT();
        wave_mma<8, 2>(oacc, Pw, 144, 0, KVs, 528, 0, lane, 0, 64 * kc);
    }
    LDS_WAIT();
#pragma unroll
    for (int j = 0; j < 8; ++j)
#pragma unroll
        for (int rg = 0; rg < 4; ++rg) *(LAS unsigned short*)(Qs + (16 * w + 4 * (lane >> 4) + rg) * 272 + (16 * j + (lane & 15)) * 2) = (unsigned short)f2bf(oacc[j][rg] * rsum[rg]);
    LDS_WAIT();
#pragma unroll
    for (int i = 0; i < 4; ++i) { const int p = lane + 64 * i, rr = 16 * w + (p >> 4), c = p & 15;
        const v4u v = *(const LAS v4u*)(Qs + rr * 272 + c * 16); *(GAS v4u*)(MEMQ + (row0 + rr) * 512 + h * 128 + c * 8) = v; }
}

__device__ __forceinline__ void mlstm_out_item(Frame& F, int item) {
    const int bh = item >> 7, c = item & 127, b = bh >> 2, h = bh & 3;
    const int tid = F.tid, lane = F.lane, w = F.wave;
    LAS unsigned char* Qs = F.lds;
    LAS unsigned char* Ks = F.lds + 17408;
    LAS unsigned char* VT = F.lds + 34816;
    LAS unsigned char* CTs = F.lds + 53248;
    LAS unsigned char* Ss = F.lds + 88064;
    LAS unsigned char* Ws = F.lds + 105472;
    LAS float* bcum = (LAS float*)(F.lds + 114688);
    LAS float* igs = bcum + 64;
    LAS float* nsv = bcum + 128;
    LAS float* rden = bcum + 256;
    const float* IGLF = (const float*)(F.ws + WS_IGLF);
    const bf16* MLQ = (const bf16*)(F.ws + WS_MLQ); const bf16* MLK = (const bf16*)(F.ws + WS_MLK); bf16* MLV = (bf16*)(F.ws + WS_MLV); const bf16* MLO = (const bf16*)(F.ws + WS_MLO);
    const bf16* CT = (const bf16*)(F.ws + WS_CT) + (size_t)item * 16384;
    const float* NS = (const float*)(F.ws + WS_NS) + (size_t)item * 128;
    const float mc = ((const float*)(F.ws + WS_CTL + CTL_MS))[item];
    const int t0 = c * 64; const size_t row0 = (size_t)b * SEQ + t0;
    __syncthreads();
    if (w == 0) {
        const float lf = IGLF[(row0 + lane) * 8 + 4 + h], ig = IGLF[(row0 + lane) * 8 + h];
        float bs = lf;
#pragma unroll
        for (int o = 1; o < 64; o <<= 1) { const float v = __shfl_up(bs, o); if (lane >= o) bs += v; }
        bcum[lane] = bs; igs[lane] = ig;
    } else if (w == 1 || w == 2) { const int i = tid - 64; nsv[i] = NS[i]; }
    { const int s = tid >> 3, part = tid & 7; float y[16];
      conv16(MLQ, h * 128 + part * 16, F.in[6], F.in[7], h * 128 + part * 16, b, t0 + s, y);
      v4u q0, q1; q0.x = pk2(y[0], y[1]); q0.y = pk2(y[2], y[3]); q0.z = pk2(y[4], y[5]); q0.w = pk2(y[6], y[7]); q1.x = pk2(y[8], y[9]); q1.y = pk2(y[10], y[11]); q1.z = pk2(y[12], y[13]); q1.w = pk2(y[14], y[15]);
      *(LAS v4u*)(Qs + s * 272 + part * 32) = q0; *(LAS v4u*)(Qs + s * 272 + part * 32 + 16) = q1;
      conv16(MLK, h * 128 + part * 16, F.in[6], F.in[7], 512 + h * 128 + part * 16, b, t0 + s, y);
      const float sc = 0.08838834764831845f;
      q0.x = pk2(y[0] * sc, y[1] * sc); q0.y = pk2(y[2] * sc, y[3] * sc); q0.z = pk2(y[4] * sc, y[5] * sc); q0.w = pk2(y[6] * sc, y[7] * sc);
      q1.x = pk2(y[8] * sc, y[9] * sc); q1.y = pk2(y[10] * sc, y[11] * sc); q1.z = pk2(y[12] * sc, y[13] * sc); q1.w = pk2(y[14] * sc, y[15] * sc);
      *(LAS v4u*)(Ks + s * 272 + part * 32) = q0; *(LAS v4u*)(Ks + s * 272 + part * 32 + 16) = q1;
      const bf16* vp = MLV + (row0 + s) * 512 + h * 128 + part * 16; const v4u v0 = *(const GAS v4u*)vp, v1 = *(const GAS v4u*)(vp + 8);
      lds_store_tr8(VT, 144, part * 16, s, v0); lds_store_tr8(VT, 144, part * 16 + 8, s, v1); }
#pragma unroll
    for (int i = 0; i < 4; ++i) { const int p = tid + 512 * i, rr = p >> 4, cc = p & 15; const v4u v = *(const GAS v4u*)(CT + rr * 128 + cc * 8); *(LAS v4u*)(CTs + rr * 272 + cc * 16) = v; }
    __syncthreads();
    { f32x4 sacc[2];
      sacc[0] = (f32x4){0.f, 0.f, 0.f, 0.f}; sacc[1] = (f32x4){0.f, 0.f, 0.f, 0.f};
      wave_mma<2, 4>(sacc, Qs, 272, 16 * (w >> 1), Ks, 272, 32 * (w & 1), lane);
#pragma unroll
      for (int j = 0; j < 2; ++j)
#pragma unroll
          for (int rg = 0; rg < 4; ++rg) *(LAS float*)(Ss + (16 * (w >> 1) + 4 * (lane >> 4) + rg) * 272 + (32 * (w & 1) + 16 * j + (lane & 15)) * 4) = sacc[j][rg]; }
    __syncthreads();
    { const int t = tid >> 3, seg = tid & 7;
      const float bt = bcum[t];
      const f32x4 s0 = *(const LAS f32x4*)(Ss + t * 272 + seg * 32), s1 = *(const LAS f32x4*)(Ss + t * 272 + seg * 32 + 16);
      const float sv[8] = {s0.x, s0.y, s0.z, s0.w, s1.x, s1.y, s1.z, s1.w};
      float dm[8]; float mx = -3.0e38f;
#pragma unroll
      for (int i = 0; i < 8; ++i) { const int s = seg * 8 + i; dm[i] = bt - bcum[s] + igs[s]; if (s <= t) mx = fmaxf(mx, dm[i]); }
      mx = fmaxf(mx, __shfl_xor(mx, 1)); mx = fmaxf(mx, __shfl_xor(mx, 2)); mx = fmaxf(mx, __shfl_xor(mx, 4));
      const float minter = bt + mc; const float mt = fmaxf(minter, mx);
      float wv[8]; float den = 0.f;
#pragma unroll
      for (int i = 0; i < 8; ++i) { const int s = seg * 8 + i; wv[i] = (s <= t) ? sv[i] * __expf(dm[i] - mt) : 0.f; den += wv[i]; }
      *(LAS v4u*)(Ws + t * 144 + seg * 16) = (v4u){pk2(wv[0], wv[1]), pk2(wv[2], wv[3]), pk2(wv[4], wv[5]), pk2(wv[6], wv[7])};
      const float inter = __expf(minter - mt);
      v4u qa = *(const LAS v4u*)(Qs + t * 272 + seg * 32), qb2 = *(const LAS v4u*)(Qs + t * 272 + seg * 32 + 16);
      const float qf[16] = {bflo(qa.x), bfhi(qa.x), bflo(qa.y), bfhi(qa.y), bflo(qa.z), bfhi(qa.z), bflo(qa.w), bfhi(qa.w), bflo(qb2.x), bfhi(qb2.x), bflo(qb2.y), bfhi(qb2.y), bflo(qb2.z), bfhi(qb2.z), bflo(qb2.w), bfhi(qb2.w)};
      float qn = 0.f;
#pragma unroll
      for (int i = 0; i < 16; ++i) qn += qf[i] * nsv[seg * 16 + i];
      den += inter * qn;
      den += __shfl_xor(den, 1); den += __shfl_xor(den, 2); den += __shfl_xor(den, 4);
      qa.x = pk2(qf[0] * inter, qf[1] * inter); qa.y = pk2(qf[2] * inter, qf[3] * inter); qa.z = pk2(qf[4] * inter, qf[5] * inter); qa.w = pk2(qf[6] * inter, qf[7] * inter);
      qb2.x = pk2(qf[8] * inter, qf[9] * inter); qb2.y = pk2(qf[10] * inter, qf[11] * inter); qb2.z = pk2(qf[12] * inter, qf[13] * inter); qb2.w = pk2(qf[14] * inter, qf[15] * inter);
      *(LAS v4u*)(Qs + t * 272 + seg * 32) = qa; *(LAS v4u*)(Qs + t * 272 + seg * 32 + 16) = qb2;
      if (seg == 0) rden[t] = 1.0f / fmaxf(fabsf(den), __expf(-mt)); }
    __syncthreads();
    f32x4 acc[4];
#pragma unroll
    for (int j = 0; j < 4; ++j) acc[j] = (f32x4){0.f, 0.f, 0.f, 0.f};
    wave_mma<4, 2>(acc, Ws, 144, 16 * (w >> 1), VT, 144, 64 * (w & 1), lane);
    wave_mma<4, 4>(acc, Qs, 272, 16 * (w >> 1), CTs, 272, 64 * (w & 1), lane);
    __syncthreads();
    LAS unsigned char* Hs = CTs;
#pragma unroll
    for (int j = 0; j < 4; ++j)
#pragma unroll
        for (int rg = 0; rg < 4; ++rg) { const int row = 16 * (w >> 1) + 4 * (lane >> 4) + rg; *(LAS float*)(Hs + row * 528 + (64 * (w & 1) + 16 * j + (lane & 15)) * 4) = acc[j][rg] * rden[row]; }
    __syncthreads();
    { const int t = tid >> 3, seg = tid & 7; float hv[16]; float ss = 0.f;
#pragma unroll
      for (int i4 = 0; i4 < 4; ++i4) { const f32x4 v = *(const LAS f32x4*)(Hs + t * 528 + seg * 64 + i4 * 16); hv[4 * i4] = v.x; hv[4 * i4 + 1] = v.y; hv[4 * i4 + 2] = v.z; hv[4 * i4 + 3] = v.w; ss += (v.x * v.x + v.y * v.y) + (v.z * v.z + v.w * v.w); }
      ss += __shfl_xor(ss, 1); ss += __shfl_xor(ss, 2); ss += __shfl_xor(ss, 4);
      const float rs = 1.0f / sqrtf(ss * (1.f / 128.f) + EPS);
      const float* mg = F.in[8] + seg * 16;
      const bf16* op = MLO + (row0 + t) * 512 + h * 128 + seg * 16; const v4u o0 = *(const GAS v4u*)op, o1 = *(const GAS v4u*)(op + 8);
      const float og[16] = {bflo(o0.x), bfhi(o0.x), bflo(o0.y), bfhi(o0.y), bflo(o0.z), bfhi(o0.z), bflo(o0.w), bfhi(o0.w), bflo(o1.x), bfhi(o1.x), bflo(o1.y), bfhi(o1.y), bflo(o1.z), bfhi(o1.z), bflo(o1.w), bfhi(o1.w)};
      float yv[16];
#pragma unroll
      for (int i = 0; i < 16; ++i) yv[i] = hv[i] * rs * mg[i] * og[i];
      v4u y0, y1; y0.x = pk2(yv[0], yv[1]); y0.y = pk2(yv[2], yv[3]); y0.z = pk2(yv[4], yv[5]); y0.w = pk2(yv[6], yv[7]); y1.x = pk2(yv[8], yv[9]); y1.y = pk2(yv[10], yv[11]); y1.z = pk2(yv[12], yv[13]); y1.w = pk2(yv[14], yv[15]);
      bf16* yp = MLV + (row0 + t) * 512 + h * 128 + seg * 16; *(GAS v4u*)yp = y0; *(GAS v4u*)(yp + 8) = y1; }
}

#define PEER_INS(L, v) do { L[15] = __builtin_amdgcn_fmed3f(L[14], L[15], v); L[14] = __builtin_amdgcn_fmed3f(L[13], L[14], v); L[13] = __builtin_amdgcn_fmed3f(L[12], L[13], v); \
    L[12] = __builtin_amdgcn_fmed3f(L[11], L[12], v); L[11] = __builtin_amdgcn_fmed3f(L[10], L[11], v); L[10] = __builtin_amdgcn_fmed3f(L[9], L[10], v); L[9] = __builtin_amdgcn_fmed3f(L[8], L[9], v); \
    L[8] = __builtin_amdgcn_fmed3f(L[7], L[8], v); L[7] = __builtin_amdgcn_fmed3f(L[6], L[7], v); L[6] = __builtin_amdgcn_fmed3f(L[5], L[6], v); L[5] = __builtin_amdgcn_fmed3f(L[4], L[5], v); \
    L[4] = __builtin_amdgcn_fmed3f(L[3], L[4], v); L[3] = __builtin_amdgcn_fmed3f(L[2], L[3], v); L[2] = __builtin_amdgcn_fmed3f(L[1], L[2], v); L[1] = __builtin_amdgcn_fmed3f(L[0], L[1], v); L[0] = fmaxf(L[0], v); } while (0)

__device__ __forceinline__ void peer_route_item(Frame& F, int item) {
    const int h = item & 7, tile = item >> 3;
    const int tid = F.tid, lane = F.lane, w = F.wave;
    LAS unsigned char* K1s = F.lds;
    LAS unsigned char* Ss = F.lds + 69632;
    LAS float* Ls = (LAS float*)(F.lds + 69632 + 66560);
    const bf16* QRY = (const bf16*)(F.ws + WS_QRY); const bf16* PK = (const bf16*)(F.ws + WS_PK);
    int* IDX = (int*)(F.ws + WS_IDX); float* GW = (float*)(F.ws + WS_GW);
    const size_t row0 = (size_t)tile * 64;
    __syncthreads();
#pragma unroll
    for (int i = 0; i < 8; ++i) { const int p = tid + 512 * i, kr = p >> 4, c = p & 15, half = kr >> 7, key = kr & 127;
        const v4u v = *(const GAS v4u*)(PK + ((size_t)(half * 8 + h) * 128 + key) * 128 + c * 8); *(LAS v4u*)(K1s + kr * 272 + c * 16) = v; }
    __syncthreads();
    { const int mt = w & 3, half = w >> 2; f32x4 acc[8];
#pragma unroll
      for (int j = 0; j < 8; ++j) acc[j] = (f32x4){0.f, 0.f, 0.f, 0.f};
      const bf16* ap = QRY + (row0 + 16 * mt + (lane & 15)) * 2048 + h * 256 + half * 128 + (lane >> 4) * 8;
#pragma unroll
      for (int ks = 0; ks < 4; ++ks) { const bf16x8 a = *(const GAS bf16x8*)(ap + ks * 32);
#pragma unroll
          for (int j = 0; j < 8; ++j) { const bf16x8 bb = *(const LAS bf16x8*)(K1s + (half * 128 + 16 * j + (lane & 15)) * 272 + (ks * 32 + (lane >> 4) * 8) * 2);
              acc[j] = __builtin_amdgcn_mfma_f32_16x16x32_bf16(a, bb, acc[j], 0, 0, 0); } }
#pragma unroll
      for (int j = 0; j < 8; ++j)
#pragma unroll
          for (int rg = 0; rg < 4; ++rg) *(LAS float*)(Ss + (16 * mt + 4 * (lane >> 4) + rg) * 1040 + (half * 128 + 16 * j + (lane & 15)) * 4) = acc[j][rg]; }
    __syncthreads();
    if (w < 2) {
        float L[16];
#pragma unroll
        for (int i = 0; i < 16; ++i) L[i] = -3.0e38f;
        const LAS unsigned char* sp = Ss + lane * 1040 + w * 512;
#pragma unroll 4
        for (int i4 = 0; i4 < 32; ++i4) { const f32x4 v = *(const LAS f32x4*)(sp + i4 * 16);
            const float e0 = __uint_as_float((__float_as_uint(v.x) & 0xFFFFFF80u) | (unsigned)(4 * i4)), e1 = __uint_as_float((__float_as_uint(v.y) & 0xFFFFFF80u) | (unsigned)(4 * i4 + 1));
            const float e2 = __uint_as_float((__float_as_uint(v.z) & 0xFFFFFF80u) | (unsigned)(4 * i4 + 2)), e3 = __uint_as_float((__float_as_uint(v.w) & 0xFFFFFF80u) | (unsigned)(4 * i4 + 3));
            PEER_INS(L, e0); PEER_INS(L, e1); PEER_INS(L, e2); PEER_INS(L, e3); }
#pragma unroll
        for (int i = 0; i < 16; ++i) Ls[(w * 16 + i) * 64 + lane] = L[i];
    }
    __syncthreads();
    if (w == 0) {
        float A1[16], A2[16];
#pragma unroll
        for (int i = 0; i < 16; ++i) { A1[i] = Ls[i * 64 + lane]; A2[i] = Ls[(16 + i) * 64 + lane]; }
        float Tt[16];
#pragma unroll
        for (int i = 0; i < 16; ++i) Tt[i] = -3.0e38f;
#pragma unroll
        for (int i = 0; i < 16; ++i)
#pragma unroll
            for (int j = 0; j < 16; ++j) if ((i + 1) * (j + 1) <= 16) { const float cv = __uint_as_float((__float_as_uint(A1[i] + A2[j]) & 0xFFFFFF00u) | (unsigned)(i * 16 + j)); PEER_INS(Tt, cv); }
        float ex[16]; float sm = 0.f;
#pragma unroll
        for (int i = 0; i < 16; ++i) { ex[i] = __expf(Tt[i] - Tt[0]); sm += ex[i]; }
        const float inv = 1.0f / sm;
        int* ip = IDX + (row0 + lane) * 128 + h * 16; float* gp = GW + (row0 + lane) * 128 + h * 16;
#pragma unroll
        for (int i4 = 0; i4 < 4; ++i4) { int ev[4]; float gv[4];
#pragma unroll
            for (int e = 0; e < 4; ++e) { const unsigned code = __float_as_uint(Tt[4 * i4 + e]) & 0xFFu; const unsigned i1 = code >> 4, i2 = code & 15u;
                const unsigned e1 = __float_as_uint(Ls[i1 * 64 + lane]) & 0x7Fu, e2 = __float_as_uint(Ls[(16 + i2) * 64 + lane]) & 0x7Fu;
                ev[e] = (int)(e1 * 128u + e2); gv[e] = ex[4 * i4 + e] * inv; }
            *(GAS v4u*)(ip + 4 * i4) = (v4u){(unsigned)ev[0], (unsigned)ev[1], (unsigned)ev[2], (unsigned)ev[3]}; *(GAS f32x4*)(gp + 4 * i4) = (f32x4){gv[0], gv[1], gv[2], gv[3]}; }
    }
}

typedef float f32x2 __attribute__((ext_vector_type(2)));
#define PEER_LOADROWS(dst, tab, idv, lb) do { _Pragma("unroll") for (int e_ = 0; e_ < 16; ++e_) { const int row_ = __builtin_amdgcn_readlane(idv, (lb) + e_); \
    dst[e_] = *(const GAS v4u*)((tab) + (size_t)row_ * 1024 + 16 * lane); } } while (0)
__device__ __forceinline__ void peer_expert_token(Frame& F, int m, float* outbase) {
    const int lane = F.lane;
    const bf16* H1B = (const bf16*)(F.ws + WS_H1B); const unsigned char* UT8 = F.ws + WS_UT8; const unsigned char* VT8 = F.ws + WS_VT8;
    const float* USC = (const float*)(F.ws + WS_USC); const float* VSC = (const float*)(F.ws + WS_VSC);
    const int* IDX = (const int*)(F.ws + WS_IDX); const float* GW = (const float*)(F.ws + WS_GW);
    const float* SUMSQ = (const float*)(F.ws + WS_CTL + CTL_SUMSQ); const float* gf = F.in[18];
    const float rs = 1.0f / sqrtf(SUMSQ[m] * (1.f / 1024.f) + EPS);
    f32x2 xh[8];
    { const v4u h0 = *(const GAS v4u*)(H1B + (size_t)m * 1024 + 16 * lane), h1 = *(const GAS v4u*)(H1B + (size_t)m * 1024 + 16 * lane + 8);
      const f32x4 g0 = *(const GAS f32x4*)(gf + 16 * lane), g1 = *(const GAS f32x4*)(gf + 16 * lane + 4), g2 = *(const GAS f32x4*)(gf + 16 * lane + 8), g3 = *(const GAS f32x4*)(gf + 16 * lane + 12);
      xh[0] = (f32x2){bflo(h0.x) * rs * g0.x, bfhi(h0.x) * rs * g0.y}; xh[1] = (f32x2){bflo(h0.y) * rs * g0.z, bfhi(h0.y) * rs * g0.w};
      xh[2] = (f32x2){bflo(h0.z) * rs * g1.x, bfhi(h0.z) * rs * g1.y}; xh[3] = (f32x2){bflo(h0.w) * rs * g1.z, bfhi(h0.w) * rs * g1.w};
      xh[4] = (f32x2){bflo(h1.x) * rs * g2.x, bfhi(h1.x) * rs * g2.y}; xh[5] = (f32x2){bflo(h1.y) * rs * g2.z, bfhi(h1.y) * rs * g2.w};
      xh[6] = (f32x2){bflo(h1.z) * rs * g3.x, bfhi(h1.z) * rs * g3.y}; xh[7] = (f32x2){bflo(h1.w) * rs * g3.z, bfhi(h1.w) * rs * g3.w}; }
    const int id0 = IDX[(size_t)m * 128 + lane], id1 = IDX[(size_t)m * 128 + 64 + lane];
    const float gw0 = GW[(size_t)m * 128 + lane], gw1 = GW[(size_t)m * 128 + 64 + lane];
    const float us0 = USC[id0], us1 = USC[id1], vs0 = VSC[id0], vs1 = VSC[id1];
    f32x2 oa[8];
#pragma unroll
    for (int i = 0; i < 8; ++i) oa[i] = (f32x2){0.f, 0.f};
    v4u ur[16], vr[16];
    PEER_LOADROWS(ur, UT8, id0, 0);
    for (int hd = 0; hd < 8; ++hd) {
        const int idv = (hd < 4) ? id0 : id1; const float gwv = (hd < 4) ? gw0 : gw1; const float usv = (hd < 4) ? us0 : us1; const float vsv = (hd < 4) ? vs0 : vs1; const int lb = (hd & 3) * 16;
        PEER_LOADROWS(vr, VT8, idv, lb);
        float pd[16];
#pragma unroll
        for (int e = 0; e < 16; ++e) { f32x2 d2 = (f32x2){0.f, 0.f};
            const unsigned uw[4] = {ur[e].x, ur[e].y, ur[e].z, ur[e].w};
#pragma unroll
            for (int q = 0; q < 4; ++q) { const f32x2 lo = __builtin_amdgcn_cvt_pk_f32_fp8((int)uw[q], false), hi = __builtin_amdgcn_cvt_pk_f32_fp8((int)uw[q], true);
                d2 = __builtin_elementwise_fma(lo, xh[2 * q], d2); d2 = __builtin_elementwise_fma(hi, xh[2 * q + 1], d2); }
            pd[e] = d2.x + d2.y; }
#pragma unroll
        for (int i = 0; i < 8; ++i) { const bool up = (lane & 8) != 0; const float send = up ? pd[i] : pd[i + 8]; const float keep = up ? pd[i + 8] : pd[i]; pd[i] = keep + __shfl_xor(send, 8); }
#pragma unroll
        for (int i = 0; i < 4; ++i) { const bool up = (lane & 4) != 0; const float send = up ? pd[i] : pd[i + 4]; const float keep = up ? pd[i + 4] : pd[i]; pd[i] = keep + __shfl_xor(send, 4); }
#pragma unroll
        for (int i = 0; i < 2; ++i) { const bool up = (lane & 2) != 0; const float send = up ? pd[i] : pd[i + 2]; const float keep = up ? pd[i + 2] : pd[i]; pd[i] = keep + __shfl_xor(send, 2); }
        { const bool up = (lane & 1) != 0; const float send = up ? pd[0] : pd[1]; const float keep = up ? pd[1] : pd[0]; pd[0] = keep + __shfl_xor(send, 1); }
        float dt = pd[0]; dt += __shfl_xor(dt, 16); dt += __shfl_xor(dt, 32);
        const int src = lb + (lane & 15);
        dt *= __shfl(usv, src);
        const float wgt = __shfl(gwv, src) * __shfl(vsv, src) * 0.5f * dt * (1.0f + erff(dt * 0.70710678118654752f));
        if (hd < 7) { const int idn = (hd + 1 < 4) ? id0 : id1; const int lbn = ((hd + 1) & 3) * 16; PEER_LOADROWS(ur, UT8, idn, lbn); }
#pragma unroll
        for (int e = 0; e < 16; ++e) { const float we = __uint_as_float((unsigned)__builtin_amdgcn_readlane((int)__float_as_uint(wgt), e)); const f32x2 w2 = (f32x2){we, we};
            const unsigned vw[4] = {vr[e].x, vr[e].y, vr[e].z, vr[e].w};
#pragma unroll
            for (int q = 0; q < 4; ++q) { const f32x2 lo = __builtin_amdgcn_cvt_pk_f32_fp8((int)vw[q], false), hi = __builtin_amdgcn_cvt_pk_f32_fp8((int)vw[q], true);
                oa[2 * q] = __builtin_elementwise_fma(lo, w2, oa[2 * q]); oa[2 * q + 1] = __builtin_elementwise_fma(hi, w2, oa[2 * q + 1]); } }
    }
    float* op = outbase + (size_t)m * 1024 + 16 * lane;
#pragma unroll
    for (int q = 0; q < 4; ++q) { f32x4 a = *(GAS f32x4*)(op + 4 * q); a.x += oa[2 * q].x; a.y += oa[2 * q].y; a.z += oa[2 * q + 1].x; a.w += oa[2 * q + 1].y; *(GAS f32x4*)(op + 4 * q) = a; }
}
__device__ __forceinline__ void peer_table_row_fp8(const float* src, unsigned char* dst, float* sc, int lane) {
    f32x4 v[4]; float am = 0.f;
#pragma unroll
    for (int j = 0; j < 4; ++j) { v[j] = __builtin_nontemporal_load((const GAS f32x4*)(src + 256 * j + 4 * lane)); am = fmaxf(am, fmaxf(fmaxf(fabsf(v[j].x), fabsf(v[j].y)), fmaxf(fabsf(v[j].z), fabsf(v[j].w)))); }
    am = fmaxf(wave_max(am), 1e-30f);
    const float s = 224.0f / am;
#pragma unroll
    for (int j = 0; j < 4; ++j) { int p = 0; p = __builtin_amdgcn_cvt_pk_fp8_f32(v[j].x * s, v[j].y * s, p, false); p = __builtin_amdgcn_cvt_pk_fp8_f32(v[j].z * s, v[j].w * s, p, true);
        *(GAS unsigned*)(dst + 256 * j + 4 * lane) = (unsigned)p; }
    if (lane == 0) *sc = am * (1.0f / 224.0f);
}

struct Args { const float* in[24]; float* out; unsigned char* ws; int ph_lo, ph_hi, li, pad; };
__global__ void __launch_bounds__(NWAVES * 64, 2) hybrid_fwd(Args args) {
    extern __shared__ __attribute__((aligned(16))) unsigned char lds[];
    Frame F;
    F.lds = (LAS unsigned char*)lds;
    F.MISC = (volatile LAS unsigned*)(F.lds + MISC_OFF);
    F.tid = threadIdx.x; F.lane = F.tid & 63; F.wave = __builtin_amdgcn_readfirstlane(F.tid >> 6);
    F.G = gridDim.x; F.ws = args.ws; F.out = args.out;
#pragma unroll
    for (int i = 0; i < 24; ++i) F.in[i] = args.in[i];
    for (int u = F.tid; u < (LDS_BYTES - LDSCTL_OFF) / 4; u += NWAVES * 64) ((LAS unsigned*)(F.lds + LDSCTL_OFF))[u] = 0u;
    __syncthreads();
    unsigned* ctl = (unsigned*)(F.ws + WS_CTL);
    XcdBarrier bar; bar.bar = ctl + CW_BAR; bar.x = 0; bar.st = nullptr;
    if (N_LAUNCHES != PER_PHASE) bar = xcd_barrier_post(ctl + CW_BAR, F.MISC + 8);
#define GRID_BAR() do { if (N_LAUNCHES != PER_PHASE) xcd_barrier(bar); } while (0)
    const int lo = args.ph_lo, hi = args.ph_hi;
#define IN(k) (lo <= (k) && (k) < hi)
#define BOTH(k) (IN(k) && IN((k) + 1))
    const int bx = blockIdx.x;

    if (IN(0)) { p0_prologue(F); if (BOTH(0)) GRID_BAR(); }

    if (IN(1)) {
        pg8::Gemm g{(const bf16*)F.out, (const bf16*)(F.ws + WS_WIN), 1024, 1024, 1024}; pg8::StaticOrder S; S.init(T_TOK, 7168, F.G, bx);
        pg8::EpiProj E{(bf16*)(F.ws + WS_GATES), 512, F.in[16], 512, SPLIT_STRIDE, 12, 22, 24};
        pg8::gemm_phase<pg8::EpiProj, pg8::StaticOrder, true, true>(F.lds, g, S, E);
        if (BOTH(1)) GRID_BAR();
    }

    if (IN(2)) {
        { pg8::Gemm g{(const bf16*)(F.ws + WS_MEMN), (const bf16*)(F.ws + WS_WKV), 1024, 1024, 1024}; pg8::FewOrder S{4, 8, bx};
          pg8::EpiProj E{(bf16*)(F.ws + WS_KVMEM), 1024, nullptr, 0, 0, 0, 0, 0};
          pg8::gemm_phase<pg8::EpiProj, pg8::FewOrder, false, true>(F.lds, g, S, E); }
        for (int it = bx; it < 1024; it += F.G) sb_attn_item(F, it);
        for (int it = bx; it < 1024; it += F.G) mlstm_local_item(F, it);
        if (BOTH(2)) GRID_BAR();
    }

    if (IN(3)) {
        mlstm_scan(F);
        for (int it = bx; it < 512; it += F.G) mem_attn_item(F, it);
        if (BOTH(3)) GRID_BAR();
    }

    if (IN(4)) {
        for (int it = bx; it < 1024; it += F.G) mlstm_out_item(F, it);
        if (BOTH(4)) GRID_BAR();
    }

    if (IN(5)) {
        pg8::Gemm g{(const bf16*)(F.ws + WS_SBQ), (const bf16*)(F.ws + WS_WBR), 512, 512, 512};
        pg8::GroupOrder S; S.so.init(T_TOK, 1024, F.G, bx); S.ng = 3; S.a_gstride = 16 * MiB; S.b_gstride = (size_t)1024 * 512 * 2;
        pg8::EpiBranch E{(const bf16*)(F.ws + WS_GATES), SPLIT_STRIDE, (bf16*)(F.ws + WS_MERGED)};
        pg8::gemm_phase<pg8::EpiBranch, pg8::GroupOrder, false, true>(F.lds, g, S, E);
        if (BOTH(5)) GRID_BAR();
    }

    if (IN(6)) {
        { pg8::Gemm g{(const bf16*)(F.ws + WS_MERGED), (const bf16*)(F.ws + WS_WOUT), 1024, 1024, 1024}; pg8::StaticOrder S; S.init(T_TOK, 1024, F.G, bx);
          pg8::EpiOut E{F.in[0], F.out, (bf16*)(F.ws + WS_H1B), (float*)(F.ws + WS_CTL + CTL_SUMSQ)};
          pg8::gemm_phase<pg8::EpiOut, pg8::StaticOrder, false, true>(F.lds, g, S, E); }
        for (int r = bx * NWAVES + F.wave; r < 2 * 16384; r += F.G * NWAVES) { const bool second = r >= 16384; const int rr = second ? r - 16384 : r;
            peer_table_row_fp8((second ? F.in[23] : F.in[22]) + (size_t)rr * 1024, F.ws + (second ? WS_VT8 : WS_UT8) + (size_t)rr * 1024, (float*)(F.ws + (second ? WS_VSC : WS_USC)) + rr, F.lane); }
        if (BOTH(6)) GRID_BAR();
    }

    if (IN(7)) {
        pg8::Gemm g{(const bf16*)(F.ws + WS_H1B), (const bf16*)(F.ws + WS_WPQ), 1024, 1024, 1024}; pg8::StaticOrder S; S.init(T_TOK, 2048, F.G, bx);
        pg8::EpiQry E{(const float*)(F.ws + WS_CTL + CTL_SUMSQ), (bf16*)(F.ws + WS_QRY), EPS};
        pg8::gemm_phase<pg8::EpiQry, pg8::StaticOrder, true, true>(F.lds, g, S, E);
        if (BOTH(7)) GRID_BAR();
    }

    if (IN(8)) {
        for (int it = bx; it < 2048; it += F.G) peer_route_item(F, it);
        if (BOTH(8)) GRID_BAR();
    }

    if (IN(9)) {
        for (int m = bx * NWAVES + F.wave; m < T_TOK; m += F.G * NWAVES) peer_expert_token(F, m, F.out);
    }
#undef IN
#undef BOTH
#undef GRID_BAR
}

extern "C" void kernel_launch(void* const* d_in, const int* in_sizes, int n_in, void* d_out, int out_size, void* d_ws, size_t ws_size, hipStream_t stream) {
    static int grid = 0;
    if (grid == 0) {
        if (n_in != 24 || out_size != T_TOK * DM || ws_size < WS_END) { fprintf(stderr, "kernel_launch: unexpected problem (n_in %d, out %d, ws %zu); nothing launched\n", n_in, out_size, ws_size); grid = -1; return; }
        int dev = 0, cus = 0, per_cu = 0;
        if (hipGetDevice(&dev) != hipSuccess || hipDeviceGetAttribute(&cus, hipDeviceAttributeMultiprocessorCount, dev) != hipSuccess) { grid = -1; return; }
        if (hipFuncSetAttribute((const void*)hybrid_fwd, hipFuncAttributeMaxDynamicSharedMemorySize, LDS_BYTES) != hipSuccess) { fprintf(stderr, "kernel_launch: hipFuncSetAttribute failed\n"); grid = -1; return; }
        if (hipOccupancyMaxActiveBlocksPerMultiprocessor(&per_cu, (const void*)hybrid_fwd, NWAVES * 64, LDS_BYTES) != hipSuccess || per_cu < 1)
            fprintf(stderr, "kernel_launch: note: occupancy query reports %d workgroups per CU\n", per_cu);
        (void)hipGetLastError();
        grid = cus;
    }
    if (grid < 0) return;
    if (hipMemsetAsync((char*)d_ws + WS_CTL, 0, CTL_ZERO_BYTES, stream) != hipSuccess) { fprintf(stderr, "kernel_launch: memset failed\n"); return; }
    Args a{};
    for (int i = 0; i < 24; ++i) a.in[i] = (const float*)d_in[i];
    a.out = (float*)d_out; a.ws = (unsigned char*)d_ws;
    for (int li = 0; li < N_LAUNCHES; ++li) {
        a.ph_lo = (N_LAUNCHES == PER_PHASE) ? li : 0; a.ph_hi = (N_LAUNCHES == PER_PHASE) ? li + 1 : PER_PHASE; a.li = li;
        hipLaunchKernelGGL(hybrid_fwd, dim3(grid), dim3(NWAVES * 64), LDS_BYTES, stream, a);
        const hipError_t le = hipPeekAtLastError();
        if (le != hipSuccess) { fprintf(stderr, "kernel_launch: launch %d failed: %s\n", li, hipGetErrorName(le)); break; }
    }
}
```

```cpp
#include <hip/hip_runtime.h>
#include <cstdio>
#include <cstdint>

#ifndef MK_N_LAUNCHES
#define MK_N_LAUNCHES 1
#endif

namespace pg8 {
#define PG8_LAS __attribute__((address_space(3)))
typedef unsigned short bf16_t;
typedef short bf16x8 __attribute__((ext_vector_type(8)));
typedef float f32x4 __attribute__((ext_vector_type(4)));
typedef unsigned u32x4 __attribute__((ext_vector_type(4)));
constexpr int BM = 256, BK = 64, HALF = 128, HTB = HALF * BK * 2  , STAGE_BYTES = 8 * HTB, NXCD = 8, WGM = 8;

__host__ __device__ __forceinline__ int lds_byte(int r, int c) { const int st = (r >> 4) * 2 + (c >> 5), rr = r & 15, cc = c & 31, ob = rr * 64 + cc * 2; return st * 1024 + (ob ^ (((ob >> 9) & 1) << 5)); }
__host__ __device__ __forceinline__ void stage_rc(int b, int& R, int& C) { const int st = b / 1024, sb = b % 1024, swz = sb ^ (((sb >> 9) & 1) << 5); R = (st >> 1) * 16 + swz / 64; C = (st & 1) * 32 + (swz % 64) / 2; }
__host__ __device__ __forceinline__ int perm32(int rho) { const int n = rho >> 4, i = rho & 15; return 8 * (i >> 2) + 4 * n + (i & 3); }

struct Unit { int pm, pn, g; };
struct Gemm { const bf16_t* A; const bf16_t* Bt; int lda, ldb, K; };

struct StaticOrder {
    int nM, nN, nwg, G, c;
    __host__ __device__ void init(int M, int N, int G_, int c_) { nM = M / BM; nN = N / BM; nwg = nM * nN; G = G_; c = c_; }
    __host__ __device__ bool next(int i, Unit& u) const {
        const long L = (long)i * G + c; if (L >= nwg) return false;
        int wgid = (int)L; { const int q = nwg / NXCD, r = nwg % NXCD, xcd = wgid % NXCD, off = wgid / NXCD; wgid = (xcd < r ? xcd * (q + 1) : r * (q + 1) + (xcd - r) * q) + off; }
        const int nig = WGM * nN, gid = wgid / nig, fm = gid * WGM, gsz = (nM - fm) < WGM ? (nM - fm) : WGM;
        u.pm = fm + ((wgid % nig) % gsz); u.pn = (wgid % nig) / gsz; u.g = 0; return true;
    }
    __device__ __forceinline__ const char* aptr(const Gemm& g, const Unit& u) const { return (const char*)g.A + (size_t)u.pm * BM * g.lda * 2; }
    __device__ __forceinline__ const char* bptr(const Gemm& g, const Unit& u) const { return (const char*)g.Bt + (size_t)u.pn * BM * g.ldb * 2; }
    __device__ __forceinline__ void a_ready(const Unit&) const {}
    __device__ __forceinline__ void done(const Unit&) const {}
};
struct FewOrder {
    int nN, n, c;
    __device__ bool next(int i, Unit& u) const { if (i > 0 || c >= n) return false; u.pm = c / nN; u.pn = c % nN; u.g = 0; return true; }
    __device__ __forceinline__ const char* aptr(const Gemm& g, const Unit& u) const { return (const char*)g.A + (size_t)u.pm * BM * g.lda * 2; }
    __device__ __forceinline__ const char* bptr(const Gemm& g, const Unit& u) const { return (const char*)g.Bt + (size_t)u.pn * BM * g.ldb * 2; }
    __device__ __forceinline__ void a_ready(const Unit&) const {}
    __device__ __forceinline__ void done(const Unit&) const {}
};
struct GroupOrder {
    StaticOrder so; int ng; size_t a_gstride, b_gstride;
    __device__ bool next(int i, Unit& u) const { if (i >= ng) return false; if (!so.next(0, u)) return false; u.g = i; return true; }
    __device__ __forceinline__ const char* aptr(const Gemm& g, const Unit& u) const { return (const char*)g.A + (size_t)u.g * a_gstride + (size_t)u.pm * BM * g.lda * 2; }
    __device__ __forceinline__ const char* bptr(const Gemm& g, const Unit& u) const { return (const char*)g.Bt + (size_t)u.g * b_gstride + (size_t)u.pn * BM * g.ldb * 2; }
    __device__ __forceinline__ void a_ready(const Unit&) const {}
    __device__ __forceinline__ void done(const Unit&) const {}
};

__device__ __forceinline__ unsigned cvt_pk_bf16(float lo, float hi) { unsigned r; asm volatile("v_cvt_pk_bf16_f32 %0, %1, %2" : "=v"(r) : "v"(lo), "v"(hi)); return r; }
__device__ __forceinline__ float bf_lo(unsigned x) { return __uint_as_float(x << 16); }
__device__ __forceinline__ float bf_hi(unsigned x) { return __uint_as_float(x & 0xffff0000u); }
__device__ __forceinline__ float sigmoidf_(float x) { return 1.0f / (1.0f + __expf(-x)); }

struct EpiProj {
    static constexpr bool PERM = true, AFTER_DRAIN = false;
    bf16_t* O; int ldc; const float* bias; int split_cols; size_t split_stride; int n_sig_bias, sig_lo, sig_hi;
    __device__ __forceinline__ void operator()(const f32x4 (&acc)[2][2][4][2], const Unit& u, int wr, int wc, int fr, int fq) const {
        const int row0 = u.pm * BM + wr * 64 + fr; int colt = u.pn * BM; bf16_t* base = O;
        if (split_cols) { const int t = colt / split_cols; base += (size_t)t * split_stride; colt -= t * split_cols; }
        const int col0 = colt + wc * 32 + 8 * fq, bcol0 = u.pn * BM + wc * 32 + 8 * fq;
        const int mode = (u.pn < n_sig_bias) ? 1 : ((u.pn >= sig_lo && u.pn < sig_hi) ? 2 : 0);
        f32x4 bv[2][2];
#pragma unroll
        for (int bj = 0; bj < 2; ++bj)
#pragma unroll
            for (int n = 0; n < 2; ++n) bv[bj][n] = (mode == 1) ? *(const f32x4*)(bias + bcol0 + bj * HALF + 4 * n) : (f32x4){0.f, 0.f, 0.f, 0.f};
#pragma unroll
        for (int ai = 0; ai < 2; ++ai)
#pragma unroll
            for (int m = 0; m < 4; ++m) { bf16_t* rowp = base + (size_t)(row0 + ai * HALF + m * 16) * ldc + col0;
#pragma unroll
                for (int bj = 0; bj < 2; ++bj) { f32x4 v0 = acc[ai][bj][m][0] + bv[bj][0], v1 = acc[ai][bj][m][1] + bv[bj][1];
                    if (mode != 0) {
#pragma unroll
                        for (int e = 0; e < 4; ++e) { v0[e] = sigmoidf_(v0[e]); v1[e] = sigmoidf_(v1[e]); } }
                    u32x4 w; w.x = cvt_pk_bf16(v0[0], v0[1]); w.y = cvt_pk_bf16(v0[2], v0[3]); w.z = cvt_pk_bf16(v1[0], v1[1]); w.w = cvt_pk_bf16(v1[2], v1[3]);
                    *(u32x4*)(rowp + bj * HALF) = w; } }
    }
};

struct EpiBranch {
    static constexpr bool PERM = true, AFTER_DRAIN = false;
    const bf16_t* gates; size_t gate_stride; bf16_t* merged;
    __device__ __forceinline__ void operator()(const f32x4 (&acc)[2][2][4][2], const Unit& u, int wr, int wc, int fr, int fq) const {
        const int row0 = u.pm * BM + wr * 64 + fr; const int col0 = u.pn * BM + wc * 32 + 8 * fq;
#pragma unroll
        for (int ai = 0; ai < 2; ++ai)
#pragma unroll
            for (int m = 0; m < 4; ++m) { const size_t row = (size_t)(row0 + ai * HALF + m * 16);
#pragma unroll
                for (int bj = 0; bj < 2; ++bj) { const int c = col0 + bj * HALF; const int gc = u.g * 1024 + c;
                    const u32x4 gw = *(const u32x4*)(gates + (size_t)(gc >> 9) * gate_stride + row * 512 + (gc & 511));
                    bf16_t* mp = merged + row * 1024 + c;
                    f32x4 v0 = acc[ai][bj][m][0], v1 = acc[ai][bj][m][1];
                    v0[0] *= bf_lo(gw.x); v0[1] *= bf_hi(gw.x); v0[2] *= bf_lo(gw.y); v0[3] *= bf_hi(gw.y);
                    v1[0] *= bf_lo(gw.z); v1[1] *= bf_hi(gw.z); v1[2] *= bf_lo(gw.w); v1[3] *= bf_hi(gw.w);
                    if (u.g > 0) { const u32x4 pv = *(const u32x4*)mp;
                        v0[0] += bf_lo(pv.x); v0[1] += bf_hi(pv.x); v0[2] += bf_lo(pv.y); v0[3] += bf_hi(pv.y);
                        v1[0] += bf_lo(pv.z); v1[1] += bf_hi(pv.z); v1[2] += bf_lo(pv.w); v1[3] += bf_hi(pv.w); }
                    u32x4 w; w.x = cvt_pk_bf16(v0[0], v0[1]); w.y = cvt_pk_bf16(v0[2], v0[3]); w.z = cvt_pk_bf16(v1[0], v1[1]); w.w = cvt_pk_bf16(v1[2], v1[3]);
                    *(u32x4*)mp = w; } }
    }
};

struct EpiOut {
    static constexpr bool PERM = true, AFTER_DRAIN = false;
    const float* x; float* out; bf16_t* h1b; float* sumsq;
    __device__ __forceinline__ void operator()(const f32x4 (&acc)[2][2][4][2], const Unit& u, int wr, int wc, int fr, int fq) const {
        const int row0 = u.pm * BM + wr * 64 + fr; const int col0 = u.pn * BM + wc * 32 + 8 * fq;
#pragma unroll
        for (int ai = 0; ai < 2; ++ai)
#pragma unroll
            for (int m = 0; m < 4; ++m) { const size_t row = (size_t)(row0 + ai * HALF + m * 16); float ss = 0.f;
#pragma unroll
                for (int bj = 0; bj < 2; ++bj) { const size_t off = row * 1024 + col0 + bj * HALF;
                    const f32x4 x0 = *(const f32x4*)(x + off), x1 = *(const f32x4*)(x + off + 4);
                    const f32x4 v0 = acc[ai][bj][m][0] + x0, v1 = acc[ai][bj][m][1] + x1;
                    *(f32x4*)(out + off) = v0; *(f32x4*)(out + off + 4) = v1;
                    ss += (v0[0] * v0[0] + v0[1] * v0[1]) + (v0[2] * v0[2] + v0[3] * v0[3]) + (v1[0] * v1[0] + v1[1] * v1[1]) + (v1[2] * v1[2] + v1[3] * v1[3]);
                    u32x4 w; w.x = cvt_pk_bf16(v0[0], v0[1]); w.y = cvt_pk_bf16(v0[2], v0[3]); w.z = cvt_pk_bf16(v1[0], v1[1]); w.w = cvt_pk_bf16(v1[2], v1[3]);
                    *(u32x4*)(h1b + off) = w; }
                ss += __shfl_xor(ss, 16); ss += __shfl_xor(ss, 32);
                if (fq == 0) atomicAdd(sumsq + row, ss); }
    }
};

struct EpiQry {
    static constexpr bool PERM = true, AFTER_DRAIN = false;
    const float* sumsq; bf16_t* qry; float eps;
    __device__ __forceinline__ void operator()(const f32x4 (&acc)[2][2][4][2], const Unit& u, int wr, int wc, int fr, int fq) const {
        const int row0 = u.pm * BM + wr * 64 + fr; const int col0 = u.pn * BM + wc * 32 + 8 * fq;
#pragma unroll
        for (int ai = 0; ai < 2; ++ai)
#pragma unroll
            for (int m = 0; m < 4; ++m) { const size_t row = (size_t)(row0 + ai * HALF + m * 16);
                const float rs = __builtin_amdgcn_rsqf(__hip_atomic_load(sumsq + row, __ATOMIC_RELAXED, __HIP_MEMORY_SCOPE_AGENT) * (1.0f / 1024.0f) + eps);
#pragma unroll
                for (int bj = 0; bj < 2; ++bj) { const f32x4 v0 = acc[ai][bj][m][0] * rs, v1 = acc[ai][bj][m][1] * rs;
                    u32x4 w; w.x = cvt_pk_bf16(v0[0], v0[1]); w.y = cvt_pk_bf16(v0[2], v0[3]); w.z = cvt_pk_bf16(v1[0], v1[1]); w.w = cvt_pk_bf16(v1[2], v1[3]);
                    *(u32x4*)(qry + row * 2048 + col0 + bj * HALF) = w; } }
    }
};

template <class Epi, class Sched, bool ALIGN_EPI = false, bool SP2 = false>
__device__ __forceinline__ void gemm_phase(PG8_LAS unsigned char* lds, const Gemm g, const Sched& S, const Epi& E) {
    const int tid = threadIdx.x, wid = __builtin_amdgcn_readfirstlane(tid >> 6), lane = tid & 63, wr = wid >> 2, wc = wid & 3, fr = lane & 15, fq = lane >> 4;
    const int K = g.K, nt = K / BK;
    unsigned voffA[2], voffB[2];
#pragma unroll
    for (int i = 0; i < 2; ++i) { int R, C; stage_rc(tid * 16 + i * 8192, R, C); const int Rb = Epi::PERM ? ((R & ~31) + perm32(R & 31)) : R;
        voffA[i] = (unsigned)(R * g.lda + C) * 2u; voffB[i] = (unsigned)(Rb * g.ldb + C) * 2u; }
    const size_t kstep = (size_t)(BK * 2);
    const size_t hstepA = (size_t)HALF * g.lda * 2, hstepB = (size_t)HALF * g.ldb * 2;
    const unsigned ldsw = (unsigned)wid * 1024u;
    const int aoff = lds_byte(wr * 64 + fr, fq * 8), boff = lds_byte(wc * 32 + fr, fq * 8);
#define PG8_SA(b, h) (((b) * 2 + (h)) * HTB)
#define PG8_SB(b, h) ((4 + (b) * 2 + (h)) * HTB)
#define PG8_STAGE(bufoff, gbase, voff) do { _Pragma("unroll") for (int _i = 0; _i < 2; ++_i) \
        __builtin_amdgcn_global_load_lds((const unsigned*)((const char*)(gbase) + (voff)[_i]), (PG8_LAS unsigned*)(lds + (bufoff) + ldsw + _i * 8192), 16, 0, 0); } while (0)
#define PG8_LDA(dst, b, h) do { _Pragma("unroll") for (int m = 0; m < 4; ++m) _Pragma("unroll") for (int k = 0; k < 2; ++k) dst[m][k] = *(const PG8_LAS bf16x8*)(lds + PG8_SA(b, h) + aoff + m * 2048 + k * 1024); } while (0)
#define PG8_LDB(dst, b, h) do { _Pragma("unroll") for (int n = 0; n < 2; ++n) _Pragma("unroll") for (int k = 0; k < 2; ++k) dst[n][k] = *(const PG8_LAS bf16x8*)(lds + PG8_SB(b, h) + boff + n * 2048 + k * 1024); } while (0)
#define PG8_MMA(ai, bj, At, Bt) do { __builtin_amdgcn_s_setprio(1); _Pragma("unroll") for (int m = 0; m < 4; ++m) _Pragma("unroll") for (int n = 0; n < 2; ++n) _Pragma("unroll") for (int k = 0; k < 2; ++k) \
        acc[ai][bj][m][n] = __builtin_amdgcn_mfma_f32_16x16x32_bf16(Bt[n][k], At[m][k], acc[ai][bj][m][n], 0, 0, 0); __builtin_amdgcn_s_setprio(0); } while (0)
#define PG8_WAIT_V(n) asm volatile("s_waitcnt vmcnt(" #n ")" ::: "memory")
#define PG8_WAIT_L(n) asm volatile("s_waitcnt lgkmcnt(" #n ")" ::: "memory")
#define PG8_BAR __builtin_amdgcn_s_barrier()
#define PG8_SCHED __builtin_amdgcn_sched_barrier(0)
    Unit cur, nxt; int ui = 0;
    if (!S.next(0, cur)) return;
    f32x4 acc[2][2][4][2];
#pragma unroll
    for (int a = 0; a < 2; ++a)
#pragma unroll
        for (int b = 0; b < 2; ++b)
#pragma unroll
            for (int m = 0; m < 4; ++m)
#pragma unroll
                for (int n = 0; n < 2; ++n) acc[a][b][m][n] = (f32x4){0.f, 0.f, 0.f, 0.f};
    bf16x8 At[4][2], B0[2][2], B1[2][2];
    const char* cA = S.aptr(g, cur); const char* cB = S.bptr(g, cur);
    S.a_ready(cur);
    if constexpr (SP2) {
        PG8_STAGE(PG8_SB(0, 0), cB, voffB); PG8_STAGE(PG8_SB(0, 1), cB + hstepB, voffB); PG8_STAGE(PG8_SA(0, 0), cA, voffA); PG8_STAGE(PG8_SA(0, 1), cA + hstepA, voffA);
        if (wr == 1) PG8_BAR;
        PG8_WAIT_V(2); PG8_BAR;
        PG8_STAGE(PG8_SB(1, 0), cB + kstep, voffB); PG8_STAGE(PG8_SA(1, 0), cA + kstep, voffA); PG8_STAGE(PG8_SB(1, 1), cB + hstepB + kstep, voffB);
        PG8_WAIT_V(6); PG8_BAR;
    } else {
        PG8_STAGE(PG8_SB(0, 0), cB, voffB); PG8_STAGE(PG8_SA(0, 0), cA, voffA); PG8_STAGE(PG8_SB(0, 1), cB + hstepB, voffB); PG8_STAGE(PG8_SA(0, 1), cA + hstepA, voffA);
        if (wr == 1) PG8_BAR;
        PG8_WAIT_V(4); PG8_BAR;
        PG8_STAGE(PG8_SB(1, 0), cB + kstep, voffB); PG8_STAGE(PG8_SA(1, 0), cA + kstep, voffA); PG8_STAGE(PG8_SB(1, 1), cB + hstepB + kstep, voffB);
        PG8_WAIT_V(6); PG8_BAR;
    }
    for (;;) {
        const bool has_next = S.next(ui + 1, nxt);
        const char* nA = has_next ? S.aptr(g, nxt) : cA; const char* nB = has_next ? S.bptr(g, nxt) : cB;
        for (int t = 0; t < nt; t += 2) {
            const bool last = (t == nt - 2);
            const char* a1 = cA + (size_t)(t + 1) * kstep;
            const char* a2 = last ? nA : cA + (size_t)(t + 2) * kstep; const char* b2 = last ? nB : cB + (size_t)(t + 2) * kstep;
            const char* a3 = a2 + kstep; const char* b3 = b2 + kstep;
            if (last && has_next) S.a_ready(nxt);
            if constexpr (SP2) {
            PG8_LDB(B0, 0, 0); PG8_LDB(B1, 0, 1); PG8_SCHED; PG8_LDA(At, 0, 0); PG8_STAGE(PG8_SA(1, 1), a1 + hstepA, voffA);
            PG8_WAIT_V(8); PG8_WAIT_L(0); PG8_BAR; PG8_MMA(0, 0, At, B0); PG8_MMA(0, 1, At, B1); PG8_BAR; PG8_SCHED;
            PG8_LDA(At, 0, 1); PG8_STAGE(PG8_SB(0, 0), b2, voffB); PG8_STAGE(PG8_SB(0, 1), b2 + hstepB, voffB); PG8_STAGE(PG8_SA(0, 0), a2, voffA);
            PG8_WAIT_V(8); PG8_WAIT_L(0); PG8_BAR; PG8_MMA(1, 0, At, B0); PG8_MMA(1, 1, At, B1); PG8_BAR; PG8_SCHED;
            PG8_LDB(B0, 1, 0); PG8_LDB(B1, 1, 1); PG8_SCHED; PG8_LDA(At, 1, 0); PG8_STAGE(PG8_SA(0, 1), a2 + hstepA, voffA);
            PG8_WAIT_V(8); PG8_WAIT_L(0); PG8_BAR; PG8_MMA(0, 0, At, B0); PG8_MMA(0, 1, At, B1); PG8_BAR; PG8_SCHED;
            PG8_LDA(At, 1, 1); PG8_STAGE(PG8_SB(1, 0), b3, voffB); PG8_STAGE(PG8_SB(1, 1), b3 + hstepB, voffB); PG8_STAGE(PG8_SA(1, 0), a3, voffA);
            PG8_WAIT_V(8); PG8_WAIT_L(0); PG8_BAR; PG8_MMA(1, 0, At, B0); PG8_MMA(1, 1, At, B1); PG8_BAR; PG8_SCHED;
            } else {
            PG8_LDB(B0, 0, 0); PG8_SCHED; PG8_LDA(At, 0, 0); PG8_STAGE(PG8_SA(1, 1), a1 + hstepA, voffA);
            PG8_WAIT_L(8); PG8_BAR; PG8_WAIT_L(0); PG8_MMA(0, 0, At, B0); PG8_BAR; PG8_SCHED;
            PG8_LDB(B1, 0, 1); PG8_STAGE(PG8_SB(0, 0), b2, voffB);
            PG8_BAR; PG8_WAIT_L(0); PG8_MMA(0, 1, At, B1); PG8_BAR;
            PG8_LDA(At, 0, 1); PG8_STAGE(PG8_SA(0, 0), a2, voffA);
            PG8_BAR; PG8_WAIT_L(0); PG8_MMA(1, 0, At, B0); PG8_BAR; PG8_SCHED;
            PG8_STAGE(PG8_SB(0, 1), b2 + hstepB, voffB);
            PG8_WAIT_V(6); PG8_BAR; PG8_MMA(1, 1, At, B1); PG8_BAR;
            PG8_LDB(B0, 1, 0); PG8_SCHED; PG8_LDA(At, 1, 0); PG8_STAGE(PG8_SA(0, 1), a2 + hstepA, voffA);
            PG8_WAIT_L(8); PG8_BAR; PG8_WAIT_L(0); PG8_MMA(0, 0, At, B0); PG8_BAR; PG8_SCHED;
            PG8_LDB(B1, 1, 1); PG8_STAGE(PG8_SB(1, 0), b3, voffB);
            PG8_BAR; PG8_WAIT_L(0); PG8_MMA(0, 1, At, B1); PG8_BAR;
            PG8_LDA(At, 1, 1); PG8_STAGE(PG8_SA(1, 0), a3, voffA);
            PG8_BAR; PG8_WAIT_L(0); PG8_MMA(1, 0, At, B0); PG8_BAR; PG8_SCHED;
            PG8_STAGE(PG8_SB(1, 1), b3 + hstepB, voffB);
            PG8_WAIT_V(6); PG8_BAR; PG8_MMA(1, 1, At, B1); PG8_BAR;
            }
        }
        if constexpr (ALIGN_EPI) { if (wr == 0) PG8_BAR; }
        if constexpr (!Epi::AFTER_DRAIN) { E(acc, cur, wr, wc, fr, fq); S.done(cur); }
        if (!has_next) break;
#pragma unroll
        for (int a = 0; a < 2; ++a)
#pragma unroll
            for (int b = 0; b < 2; ++b)
#pragma unroll
                for (int m = 0; m < 4; ++m)
#pragma unroll
                    for (int n = 0; n < 2; ++n) acc[a][b][m][n] = (f32x4){0.f, 0.f, 0.f, 0.f};
        cur = nxt; cA = nA; cB = nB; ++ui;
        if constexpr (ALIGN_EPI) { if (wr == 1) PG8_BAR; }
    }
    PG8_WAIT_V(0);
    if constexpr (!ALIGN_EPI) { if (wr == 0) PG8_BAR; }
    PG8_BAR;
    if constexpr (Epi::AFTER_DRAIN) { E.fused(acc, cur, wr, wc, fr, fq, lds, wid, lane); S.done(cur); }
#undef PG8_SA
#undef PG8_SB
#undef PG8_STAGE
#undef PG8_LDA
#undef PG8_LDB
#undef PG8_MMA
#undef PG8_WAIT_V
#undef PG8_WAIT_L
#undef PG8_BAR
#undef PG8_SCHED
}
}

#ifndef PROBE_PH
#define PROBE_PH -1
#endif
constexpr int NWAVES = 8;
constexpr int N_LAUNCHES = MK_N_LAUNCHES;
constexpr int PER_PHASE = 9;

constexpr int T_TOK = 16384, DM = 1024, SEQ = 8192;
constexpr float EPS = 1e-6f;
constexpr int W_IN_COLS = 7176;

constexpr size_t MiB = 1u << 20;
constexpr size_t WS_CTL = 0, CTL_ZERO_BYTES = 1 * MiB;
constexpr size_t WS_WIN = 1 * MiB, WS_WKV = 15 * MiB, WS_WBR = 17 * MiB, WS_WOUT = 20 * MiB, WS_WPQ = 22 * MiB, WS_PK = 26 * MiB;
constexpr size_t WS_KVMEM = 26 * MiB + 512 * 1024, WS_MEMN = 27 * MiB + 512 * 1024, WS_IGLF = 28 * MiB + 512 * 1024, WS_ND = 29 * MiB, WS_NS = 29 * MiB + 512 * 1024;
constexpr size_t WS_GATES = 30 * MiB;
constexpr size_t WS_MLQ = 126 * MiB, WS_MLK = 142 * MiB, WS_SBQ = 158 * MiB, WS_MLV = 174 * MiB, WS_MEMQ = 190 * MiB, WS_MLO = 206 * MiB, WS_SBK = 222 * MiB, WS_SBV = 238 * MiB;
constexpr size_t WS_UT8 = 30 * MiB, WS_VT8 = 46 * MiB, WS_USC = 94 * MiB, WS_VSC = 94 * MiB + 65536;
constexpr size_t WS_H1B = 126 * MiB;
constexpr size_t WS_QRY = 158 * MiB;
constexpr size_t WS_CT = 222 * MiB;
constexpr size_t WS_MERGED = 222 * MiB;
constexpr size_t WS_IDX = 222 * MiB, WS_GW = 230 * MiB;
constexpr size_t WS_END = 254 * MiB;
constexpr size_t SPLIT_STRIDE = (size_t)T_TOK * 512;
constexpr size_t CTL_CHS = 256 * 1024, CTL_MS = 272 * 1024, CTL_SUMSQ = 512 * 1024;
constexpr int CW_BAR = 4096;

constexpr int RING_BYTES = 131072;
constexpr int LDSCTL_OFF = RING_BYTES, MISC_OFF = LDSCTL_OFF + 320;
constexpr int LDS_BYTES = 147456;

#define GAS __attribute__((address_space(1)))
#define LAS __attribute__((address_space(3)))
typedef unsigned short bf16;
typedef unsigned v4u __attribute__((ext_vector_type(4)));
typedef unsigned v2u __attribute__((ext_vector_type(2)));
typedef float f32x4 __attribute__((ext_vector_type(4)));
typedef short bf16x8 __attribute__((ext_vector_type(8)));
typedef GAS unsigned gu32;
#define RLX_AGENT __ATOMIC_RELAXED, __HIP_MEMORY_SCOPE_AGENT
#define LDS_WAIT() asm volatile("s_waitcnt lgkmcnt(0)" ::: "memory")
#define VM_WAIT() asm volatile("s_waitcnt vmcnt(0)" ::: "memory")
__device__ __forceinline__ unsigned f2bf(float f) { unsigned u = __builtin_bit_cast(unsigned, f); return (u + 0x7fffu + ((u >> 16) & 1u)) >> 16; }
__device__ __forceinline__ unsigned pk2(float lo, float hi) { return f2bf(lo) | (f2bf(hi) << 16); }
__device__ __forceinline__ float bflo(unsigned x) { return __uint_as_float(x << 16); }
__device__ __forceinline__ float bfhi(unsigned x) { return __uint_as_float(x & 0xffff0000u); }
__device__ __forceinline__ float sigm(float x) { return 1.0f / (1.0f + __expf(-x)); }
__device__ __forceinline__ float softplusf_(float z) { return fmaxf(z, 0.f) + __logf(1.0f + __expf(-fabsf(z))); }

#define XB_TMO      128
#define XB_XCNT(j)  (256  + 64 * (j))
#define XB_XSUB(j)  (1280 + 64 * (j))
#define XB_XGEN(j)  (2304 + 64 * (j))
#define XB_TOP      3328
#define XB_TOPGEN   3392
#define XCD_BAR_WORDS 3456
#define XB_SPIN_CAP (1u << 18)
__device__ __forceinline__ unsigned xb_ld(unsigned* p)              { return __hip_atomic_load(p, __ATOMIC_RELAXED, __HIP_MEMORY_SCOPE_AGENT); }
__device__ __forceinline__ unsigned xb_add(unsigned* p, unsigned v) { return __hip_atomic_fetch_add(p, v, __ATOMIC_RELAXED, __HIP_MEMORY_SCOPE_AGENT); }
__device__ __forceinline__ unsigned xb_xcc_id() { return (unsigned)__builtin_amdgcn_s_getreg((3 << 11) | 20) & 0xFu; }
#define XB_SPIN(cond, bar) do { unsigned _sp = 0; while (cond) { __builtin_amdgcn_s_sleep(1); \
    if ((++_sp & 255u) == 0u) { if (xb_ld(&(bar)[XB_TMO])) break; if (_sp > XB_SPIN_CAP) { atomicAdd(&(bar)[XB_TMO], 1u); break; } } } } while (0)
struct XcdBarrier { unsigned* bar; unsigned x; volatile LAS unsigned* st; };
__device__ __forceinline__ XcdBarrier xcd_barrier_post(unsigned* bar, volatile LAS unsigned* st) {
    XcdBarrier b; b.bar = bar; b.x = xb_xcc_id(); b.st = st;
    if (threadIdx.x == 0) (void)xb_add(&bar[XB_XCNT(b.x)], 1u);
    return b;
}
__device__ __forceinline__ void xcd_barrier_complete(unsigned* bar, unsigned x, unsigned& nloc, unsigned& nx) {
    const unsigned G = gridDim.x * gridDim.y * gridDim.z;
    unsigned sum, cnt, mine, sp = 0u;
    for (;;) {
        sum = 0u; cnt = 0u; mine = 0u;
#pragma unroll
        for (unsigned j = 0; j < 16; ++j) { const unsigned c = xb_ld(&bar[XB_XCNT(j)]); sum += c; cnt += (c > 0u) ? 1u : 0u; mine = (j == x) ? c : mine; }
        if (sum == G) break;
        __builtin_amdgcn_s_sleep(1);
        if ((++sp & 255u) == 0u) { if (xb_ld(&bar[XB_TMO])) break; if (sp > XB_SPIN_CAP) { atomicAdd(&bar[XB_TMO], 1u); break; } }
    }
    nloc = mine > 0u ? mine : 1u; nx = cnt > 0u ? cnt : 1u;
}
__device__ __forceinline__ void xcd_barrier(const XcdBarrier& b) {
    asm volatile("s_waitcnt vmcnt(0)" ::: "memory");
    __syncthreads();
    if (threadIdx.x == 0) {
        unsigned* bar = b.bar;
        __builtin_amdgcn_s_waitcnt(0);
        unsigned nloc = b.st[0], nx = b.st[1];
        if (nloc == 0u) { xcd_barrier_complete(bar, b.x, nloc, nx); b.st[0] = nloc; b.st[1] = nx; }
        const unsigned old = xb_add(&bar[XB_XSUB(b.x)], 1u);
        const unsigned gen = old / nloc;
        if (old + 1u == (gen + 1u) * nloc) {
            __builtin_amdgcn_fence(__ATOMIC_RELEASE, "agent");
            asm volatile("s_waitcnt vmcnt(0)" ::: "memory");
            const unsigned og = xb_add(&bar[XB_TOP], 1u);
            const unsigned tg = og / nx;
            if (og + 1u == (tg + 1u) * nx) xb_add(&bar[XB_TOPGEN], 1u);
            else XB_SPIN(xb_ld(&bar[XB_TOPGEN]) == tg, bar);
            __builtin_amdgcn_fence(__ATOMIC_ACQUIRE, "agent");
            xb_add(&bar[XB_XGEN(b.x)], 1u);
            asm volatile("s_waitcnt vmcnt(0)" ::: "memory");
        } else {
            XB_SPIN(xb_ld(&bar[XB_XGEN(b.x)]) == gen, bar);
            __builtin_amdgcn_fence(__ATOMIC_ACQUIRE, "agent");
            asm volatile("s_waitcnt vmcnt(0)" ::: "memory");
        }
    }
    __syncthreads();
}

struct Frame {
    LAS unsigned char* lds;
    volatile LAS unsigned* MISC;
    int tid, lane, wave, G;
    unsigned char* ws; float* out;
    const float* in[24];
};
__device__ __forceinline__ float wave_sum(float v) {
#pragma unroll
    for (int o = 1; o < 64; o <<= 1) v += __shfl_xor(v, o);
    return v;
}
__device__ __forceinline__ float wave_max(float v) {
#pragma unroll
    for (int o = 1; o < 64; o <<= 1) v = fmaxf(v, __shfl_xor(v, o));
    return v;
}

template <int NT, int KS>
__device__ __forceinline__ void wave_mma(f32x4 (&acc)[NT], const LAS unsigned char* A, int pitchA, int m0, const LAS unsigned char* Bt, int pitchB, int n0, int lane, int koffA = 0, int koffB = 0) {
    const int r = lane & 15, q = lane >> 4;
#pragma unroll
    for (int ks = 0; ks < KS; ++ks) {
        const bf16x8 a = *(const LAS bf16x8*)(A + (m0 + r) * pitchA + (koffA + ks * 32 + q * 8) * 2);
#pragma unroll
        for (int j = 0; j < NT; ++j) {
            const bf16x8 b = *(const LAS bf16x8*)(Bt + (n0 + 16 * j + r) * pitchB + (koffB + ks * 32 + q * 8) * 2);
            acc[j] = __builtin_amdgcn_mfma_f32_16x16x32_bf16(a, b, acc[j], 0, 0, 0);
        }
    }
}
__device__ __forceinline__ void lds_store_tr8(LAS unsigned char* base, int pitch, int d0, int col, v4u v) {
    *(LAS unsigned short*)(base + (d0 + 0) * pitch + col * 2) = (unsigned short)(v.x & 0xffffu); *(LAS unsigned short*)(base + (d0 + 1) * pitch + col * 2) = (unsigned short)(v.x >> 16);
    *(LAS unsigned short*)(base + (d0 + 2) * pitch + col * 2) = (unsigned short)(v.y & 0xffffu); *(LAS unsigned short*)(base + (d0 + 3) * pitch + col * 2) = (unsigned short)(v.y >> 16);
    *(LAS unsigned short*)(base + (d0 + 4) * pitch + col * 2) = (unsigned short)(v.z & 0xffffu); *(LAS unsigned short*)(base + (d0 + 5) * pitch + col * 2) = (unsigned short)(v.z >> 16);
    *(LAS unsigned short*)(base + (d0 + 6) * pitch + col * 2) = (unsigned short)(v.w & 0xffffu); *(LAS unsigned short*)(base + (d0 + 7) * pitch + col * 2) = (unsigned short)(v.w >> 16);
}

__device__ __forceinline__ void p0_transpose_item(const float* W, int ldsrc, int src_off, int K, int ncols, bf16* WT, int row_off, const float* kscale, LAS float* scr, int item, int lane) {
    const int nblk = ncols / 32, kb = item / nblk, nb = item % nblk, k0 = 64 * kb, n0 = 32 * nb;
#pragma unroll 8
    for (int i = 0; i < 32; ++i) { const int kk = 2 * i + (lane >> 5); float v = W[(size_t)(k0 + kk) * ldsrc + src_off + n0 + (lane & 31)]; if (kscale) v *= kscale[k0 + kk]; scr[kk * 33 + (lane & 31)] = v; }
    LDS_WAIT(); asm volatile("" ::: "memory");
    const int c = lane & 7;
#pragma unroll
    for (int j = 0; j < 4; ++j) { const int n = (lane >> 3) + 8 * j; const LAS float* s = scr + (8 * c) * 33 + n;
        v4u o; o.x = pk2(s[0 * 33], s[1 * 33]); o.y = pk2(s[2 * 33], s[3 * 33]); o.z = pk2(s[4 * 33], s[5 * 33]); o.w = pk2(s[6 * 33], s[7 * 33]);
        *(GAS v4u*)(WT + (size_t)(row_off + n0 + n) * K + k0 + 8 * c) = o; }
    LDS_WAIT(); asm volatile("" ::: "memory");
}

__device__ __forceinline__ void p0_prologue(Frame& F) {
    const float* x = F.in[0]; const float* mem = F.in[1]; const float* g_mix = F.in[2]; const float* w_in = F.in[3];
    const float* b_ig = F.in[4]; const float* b_fg = F.in[5]; const float* mem_g = F.in[9];
    bf16* XN = (bf16*)F.out;
    bf16* MEMN = (bf16*)(F.ws + WS_MEMN);
    float* IGLF = (float*)(F.ws + WS_IGLF);
    LAS float* gws = (LAS float*)(F.lds + 69632);
    for (int e = F.tid; e < 8192; e += 512) { const int c = e & 7, k = e >> 3; gws[c * 1024 + k] = w_in[(size_t)k * W_IN_COLS + 3072 + c]; }
    __syncthreads();
    const int gw = blockIdx.x * NWAVES + F.wave, NGW = F.G * NWAVES;
    for (int m = gw; m < T_TOK + 512; m += NGW) {
        const bool is_mem = m >= T_TOK;
        const float* src = is_mem ? mem + (size_t)(m - T_TOK) * DM : x + (size_t)m * DM;
        const float* gsrc = is_mem ? mem_g : g_mix;
        bf16* dst = is_mem ? MEMN + (size_t)(m - T_TOK) * DM : XN + (size_t)m * DM;
        const GAS f32x4* xr = (const GAS f32x4*)src + F.lane;
        f32x4 v[4]; float s = 0.f;
#pragma unroll
        for (int j = 0; j < 4; ++j) { v[j] = xr[64 * j]; s += (v[j].x * v[j].x + v[j].y * v[j].y) + (v[j].z * v[j].z + v[j].w * v[j].w); }
        const float rstd = 1.0f / sqrtf(wave_sum(s) * (1.f / DM) + EPS);
#pragma unroll
        for (int j = 0; j < 4; ++j) { const f32x4 gg = *((const GAS f32x4*)gsrc + F.lane + 64 * j); v[j] = v[j] * rstd * gg; }
        GAS unsigned long long* o8 = (GAS unsigned long long*)dst + F.lane;
#pragma unroll
        for (int j = 0; j < 4; ++j) o8[64 * j] = (unsigned long long)pk2(v[j].x, v[j].y) | ((unsigned long long)pk2(v[j].z, v[j].w) << 32);
        if (!is_mem) {
            float dots[8];
#pragma unroll
            for (int c = 0; c < 8; ++c) { float d = 0.f;
#pragma unroll
                for (int j = 0; j < 4; ++j) { const f32x4 wv = *(const LAS f32x4*)(gws + c * 1024 + 256 * j + 4 * F.lane); d += (v[j].x * wv.x + v[j].y * wv.y) + (v[j].z * wv.z + v[j].w * wv.w); }
                dots[c] = wave_sum(d); }
            if (F.lane == 0) {
                f32x4 o0, o1;
#pragma unroll
                for (int h = 0; h < 4; ++h) { o0[h] = dots[h] + b_ig[h]; const float fp = dots[4 + h] + b_fg[h]; o1[h] = fminf(fp, 0.f) - __logf(1.0f + __expf(-fabsf(fp))); }
                *(GAS f32x4*)(IGLF + (size_t)m * 8) = o0; *(GAS f32x4*)(IGLF + (size_t)m * 8 + 4) = o1;
            }
        }
    }
    { const float* k1 = F.in[20]; const float* k2 = F.in[21]; bf16* PK = (bf16*)(F.ws + WS_PK);
      for (int e = (blockIdx.x * 512 + F.tid) * 4; e < 2 * 131072; e += F.G * 512 * 4) {
          const f32x4 vv = (e < 131072) ? *(const GAS f32x4*)(k1 + e) : *(const GAS f32x4*)(k2 + e - 131072);
          v2u o; o.x = pk2(vv.x, vv.y); o.y = pk2(vv.z, vv.w); *(GAS v2u*)(PK + e) = o; } }
    __syncthreads();
    LAS float* scr = (LAS float*)(F.lds + F.wave * 8448);
    bf16* WIN = (bf16*)(F.ws + WS_WIN); bf16* WKV = (bf16*)(F.ws + WS_WKV); bf16* WBR = (bf16*)(F.ws + WS_WBR); bf16* WOUT = (bf16*)(F.ws + WS_WOUT); bf16* WPQ = (bf16*)(F.ws + WS_WPQ);
    constexpr int I_G = 16 * 96, I_5 = 16 * 16, I_KV = 16 * 32, I_BR = 8 * 32, I_OUT = 16 * 32, I_PQ = 16 * 64;
    constexpr int NITEMS = I_G + 8 * I_5 + I_KV + 3 * I_BR + I_OUT + I_PQ;
    for (int it = gw; it < NITEMS; it += NGW) {
        int r = it;
        if (r < I_G) { p0_transpose_item(w_in, W_IN_COLS, 4104, 1024, 3072, WIN, 0, nullptr, scr, r, F.lane); continue; } r -= I_G;
        if (r < I_5) { p0_transpose_item(w_in, W_IN_COLS, 1536, 1024, 512, WIN, 3072, nullptr, scr, r, F.lane); continue; } r -= I_5;
        if (r < I_5) { p0_transpose_item(w_in, W_IN_COLS, 2048, 1024, 512, WIN, 3584, nullptr, scr, r, F.lane); continue; } r -= I_5;
        if (r < I_5) { p0_transpose_item(w_in, W_IN_COLS, 0, 1024, 512, WIN, 4096, nullptr, scr, r, F.lane); continue; } r -= I_5;
        if (r < I_5) { p0_transpose_item(w_in, W_IN_COLS, 2560, 1024, 512, WIN, 4608, nullptr, scr, r, F.lane); continue; } r -= I_5;
        if (r < I_5) { p0_transpose_item(w_in, W_IN_COLS, 3592, 1024, 512, WIN, 5120, nullptr, scr, r, F.lane); continue; } r -= I_5;
        if (r < I_5) { p0_transpose_item(w_in, W_IN_COLS, 3080, 1024, 512, WIN, 5632, nullptr, scr, r, F.lane); continue; } r -= I_5;
        if (r < I_5) { p0_transpose_item(w_in, W_IN_COLS, 512, 1024, 512, WIN, 6144, nullptr, scr, r, F.lane); continue; } r -= I_5;
        if (r < I_5) { p0_transpose_item(w_in, W_IN_COLS, 1024, 1024, 512, WIN, 6656, nullptr, scr, r, F.lane); continue; } r -= I_5;
        if (r < I_KV) { p0_transpose_item(F.in[10], 1024, 0, 1024, 1024, WKV, 0, nullptr, scr, r, F.lane); continue; } r -= I_KV;
        if (r < I_BR) { p0_transpose_item(F.in[13], 1024, 0, 512, 1024, WBR, 0, nullptr, scr, r, F.lane); continue; } r -= I_BR;
        if (r < I_BR) { p0_transpose_item(F.in[14], 1024, 0, 512, 1024, WBR, 1024, nullptr, scr, r, F.lane); continue; } r -= I_BR;
        if (r < I_BR) { p0_transpose_item(F.in[15], 1024, 0, 512, 1024, WBR, 2048, nullptr, scr, r, F.lane); continue; } r -= I_BR;
        if (r < I_OUT) { p0_transpose_item(F.in[17], 1024, 0, 1024, 1024, WOUT, 0, nullptr, scr, r, F.lane); continue; } r -= I_OUT;
        p0_transpose_item(F.in[19], 2048, 0, 1024, 2048, WPQ, 0, F.in[18], scr, r, F.lane);
    }
}

__device__ __forceinline__ void sb_attn_item(Frame& F, int item, bf16* outp, size_t rmask) {
    const int bh = item >> 6, qb = item & 63, b = bh >> 3, h = bh & 7;
    const int tid = F.tid, lane = F.lane, w = F.wave;
    LAS unsigned char* Qs = F.lds;
    LAS unsigned char* Ks = F.lds + 18432;
    LAS unsigned char* VTs = F.lds + 27648;
    LAS unsigned char* Ss = F.lds + 36864;
    LAS unsigned char* Ps = F.lds + 71680;
    LAS float* red = (LAS float*)(F.lds + 90112);
    bf16* SBQ = (bf16*)(F.ws + WS_SBQ); const bf16* SBK = (const bf16*)(F.ws + WS_SBK); const bf16* SBV = (const bf16*)(F.ws + WS_SBV);
    const size_t row0 = (size_t)b * SEQ + (size_t)qb * 128;
    __syncthreads();
#pragma unroll
    for (int i = 0; i < 2; ++i) { const int p = tid + 512 * i, r = p >> 3, c = p & 7;
        const v4u v = *(const GAS v4u*)(SBQ + (row0 + r) * 512 + h * 64 + c * 8); *(LAS v4u*)(Qs + r * 144 + c * 16) = v; }
    f32x4 oacc[4];
#pragma unroll
    for (int j = 0; j < 4; ++j) oacc[j] = (f32x4){0.f, 0.f, 0.f, 0.f};
    float R = 0.f;
    const int r = tid >> 2, qd = tid & 3;
    const int tq = qb * 128 + r;
    const int skey = tid >> 3, sc8 = tid & 7;
    v4u kv, vv;
    { const size_t grow = (size_t)b * SEQ + (size_t)(2 * qb + 1) * 64 + skey; kv = *(const GAS v4u*)(SBK + grow * 512 + h * 64 + sc8 * 8); vv = *(const GAS v4u*)(SBV + grow * 512 + h * 64 + sc8 * 8); }
    for (int jb = 2 * qb + 1; jb >= 0; --jb) {
        __syncthreads();
        *(LAS v4u*)(Ks + skey * 144 + sc8 * 16) = kv; lds_store_tr8(VTs, 144, sc8 * 8, skey, vv);
        if (jb > 0) { const size_t grow = (size_t)b * SEQ + (size_t)(jb - 1) * 64 + skey; kv = *(const GAS v4u*)(SBK + grow * 512 + h * 64 + sc8 * 8); vv = *(const GAS v4u*)(SBV + grow * 512 + h * 64 + sc8 * 8); }
        __syncthreads();
        { f32x4 sacc[4];
#pragma unroll
          for (int j = 0; j < 4; ++j) sacc[j] = (f32x4){0.f, 0.f, 0.f, 0.f};
          wave_mma<4, 2>(sacc, Qs, 144, 16 * w, Ks, 144, 0, lane);
#pragma unroll
          for (int j = 0; j < 4; ++j)
#pragma unroll
              for (int rg = 0; rg < 4; ++rg) *(LAS float*)(Ss + (16 * w + 4 * (lane >> 4) + rg) * 272 + (16 * j + (lane & 15)) * 4) = sacc[j][rg]; }
        __syncthreads();
        { float z[16];
#pragma unroll
          for (int i4 = 0; i4 < 4; ++i4) { const f32x4 t4 = *(const LAS f32x4*)(Ss + r * 272 + qd * 64 + i4 * 16); z[4 * i4] = t4.x; z[4 * i4 + 1] = t4.y; z[4 * i4 + 2] = t4.z; z[4 * i4 + 3] = t4.w; }
          const int s0 = jb * 64 + qd * 16;
          float suf[16], lb[16]; float run = 0.f;
#pragma unroll
          for (int i = 15; i >= 0; --i) { const float zz = z[i] * 0.125f; const bool mk = (s0 + i) < tq; const float sp = softplusf_(zz); lb[i] = zz - sp; suf[i] = run; run += mk ? -sp : 0.f; }
          const float a1 = __shfl_xor(run, 1), a2 = __shfl_xor(run, 2), a3 = __shfl_xor(run, 3);
          const float off = ((qd & 1) == 0 ? a1 : 0.f) + ((qd & 2) == 0 ? a2 : 0.f) + (qd < 2 ? a3 : 0.f);
          const float base = R + off;
          unsigned pw[8];
#pragma unroll
          for (int i = 0; i < 16; i += 2) { const float p0 = ((s0 + i) < tq) ? __expf(lb[i] + base + suf[i]) : 0.f; const float p1 = ((s0 + i + 1) < tq) ? __expf(lb[i + 1] + base + suf[i + 1]) : 0.f; pw[i >> 1] = pk2(p0, p1); }
          *(LAS v4u*)(Ps + r * 144 + qd * 32) = (v4u){pw[0], pw[1], pw[2], pw[3]}; *(LAS v4u*)(Ps + r * 144 + qd * 32 + 16) = (v4u){pw[4], pw[5], pw[6], pw[7]};
          R += run + a1 + a2 + a3; }
        const float rm = wave_max(R);
        if (lane == 0) red[w] = rm;
        __syncthreads();
        wave_mma<4, 2>(oacc, Ps, 144, 16 * w, VTs, 144, 0, lane);
        float rmax = red[0];
#pragma unroll
        for (int i = 1; i < 8; ++i) rmax = fmaxf(rmax, red[i]);
        if (rmax < -110.f) break;
    }
    LDS_WAIT();
#pragma unroll
    for (int j = 0; j < 4; ++j)
#pragma unroll
        for (int rg = 0; rg < 4; ++rg) *(LAS unsigned short*)(Ps + (16 * w + 4 * (lane >> 4) + rg) * 144 + (16 * j + (lane & 15)) * 2) = (unsigned short)f2bf(oacc[j][rg]);
    LDS_WAIT();
#pragma unroll
    for (int i = 0; i < 2; ++i) { const int p = lane + 64 * i, rr = 16 * w + (p >> 3), c = p & 7;
        const v4u v = *(const LAS v4u*)(Ps + rr * 144 + c * 16); *(GAS v4u*)(outp + ((row0 + rr) & rmask) * 512 + h * 64 + c * 8) = v; }
}

__device__ __forceinline__ void conv16(const bf16* src, int col, const float* cw, const float* cb, int ch, int b, int t, float (&y)[16]) {
#pragma unroll
    for (int i4 = 0; i4 < 4; ++i4) { const f32x4 bb = *(const GAS f32x4*)(cb + ch + 4 * i4); y[4 * i4] = bb.x; y[4 * i4 + 1] = bb.y; y[4 * i4 + 2] = bb.z; y[4 * i4 + 3] = bb.w; }
#pragma unroll
    for (int kk = 0; kk < 4; ++kk) { const int tt = t - 3 + kk;
        if (tt >= 0) { const bf16* p = src + ((size_t)b * SEQ + tt) * 512 + col; const v4u x0 = *(const GAS v4u*)p, x1 = *(const GAS v4u*)(p + 8);
            const float xs[16] = {bflo(x0.x), bfhi(x0.x), bflo(x0.y), bfhi(x0.y), bflo(x0.z), bfhi(x0.z), bflo(x0.w), bfhi(x0.w), bflo(x1.x), bfhi(x1.x), bflo(x1.y), bfhi(x1.y), bflo(x1.z), bfhi(x1.z), bflo(x1.w), bfhi(x1.w)};
#pragma unroll
            for (int i4 = 0; i4 < 4; ++i4) { const f32x4 wv = *(const GAS f32x4*)(cw + kk * 1024 + ch + 4 * i4);
                y[4 * i4] += wv.x * xs[4 * i4]; y[4 * i4 + 1] += wv.y * xs[4 * i4 + 1]; y[4 * i4 + 2] += wv.z * xs[4 * i4 + 2]; y[4 * i4 + 3] += wv.w * xs[4 * i4 + 3]; } } }
#pragma unroll
    for (int i = 0; i < 16; ++i) y[i] = y[i] * sigm(y[i]);
}

__device__ __forceinline__ void mlstm_local_item(Frame& F, int item) {
    const int bh = item >> 7, c = item & 127, b = bh >> 2, h = bh & 3;
    const int tid = F.tid, lane = F.lane, w = F.wave;
    LAS float* wsm = (LAS float*)F.lds;
    LAS unsigned char* WKT = F.lds + 256;
    LAS unsigned char* VT = F.lds + 256 + 18432;
    const float* IGLF = (const float*)(F.ws + WS_IGLF);
    float* CHS = (float*)(F.ws + WS_CTL + CTL_CHS);
    const bf16* MLK = (const bf16*)(F.ws + WS_MLK); const bf16* MLV = (const bf16*)(F.ws + WS_MLV);
    float* Dg = F.out + (size_t)item * 16384; float* NDg = (float*)(F.ws + WS_ND) + (size_t)item * 128;
    const int t0 = c * 64; const size_t row0 = (size_t)b * SEQ + t0;
    __syncthreads();
    if (w == 0) {
        const float lf = IGLF[(row0 + lane) * 8 + 4 + h], ig = IGLF[(row0 + lane) * 8 + h];
        float bs = lf;
#pragma unroll
        for (int o = 1; o < 64; o <<= 1) { const float v = __shfl_up(bs, o); if (lane >= o) bs += v; }
        const float blast = __shfl(bs, 63);
        const float a = blast - bs + ig; const float mu = wave_max(a);
        wsm[lane] = __expf(a - mu);
        if (lane == 0) { CHS[2 * item] = blast; CHS[2 * item + 1] = mu; }
    }
    __syncthreads();
    { const int s = tid >> 3, part = tid & 7; float y[16];
      conv16(MLK, h * 128 + part * 16, F.in[6], F.in[7], 512 + h * 128 + part * 16, b, t0 + s, y);
      const float sc = wsm[s] * 0.08838834764831845f;
      v4u k0, k1; k0.x = pk2(y[0] * sc, y[1] * sc); k0.y = pk2(y[2] * sc, y[3] * sc); k0.z = pk2(y[4] * sc, y[5] * sc); k0.w = pk2(y[6] * sc, y[7] * sc);
      k1.x = pk2(y[8] * sc, y[9] * sc); k1.y = pk2(y[10] * sc, y[11] * sc); k1.z = pk2(y[12] * sc, y[13] * sc); k1.w = pk2(y[14] * sc, y[15] * sc);
      lds_store_tr8(WKT, 144, part * 16, s, k0); lds_store_tr8(WKT, 144, part * 16 + 8, s, k1);
      const bf16* vp = MLV + (row0 + s) * 512 + h * 128 + part * 16; const v4u v0 = *(const GAS v4u*)vp, v1 = *(const GAS v4u*)(vp + 8);
      lds_store_tr8(VT, 144, part * 16, s, v0); lds_store_tr8(VT, 144, part * 16 + 8, s, v1); }
    __syncthreads();
    { f32x4 acc[8];
#pragma unroll
      for (int j = 0; j < 8; ++j) acc[j] = (f32x4){0.f, 0.f, 0.f, 0.f};
      wave_mma<8, 2>(acc, VT, 144, 16 * w, WKT, 144, 0, lane);
#pragma unroll
      for (int j = 0; j < 8; ++j)
#pragma unroll
          for (int rg = 0; rg < 4; ++rg) Dg[(16 * w + 4 * (lane >> 4) + rg) * 128 + 16 * j + (lane & 15)] = acc[j][rg]; }
    if (tid < 128) { float s = 0.f;
#pragma unroll
        for (int i = 0; i < 8; ++i) { const v4u v = *(const LAS v4u*)(WKT + tid * 144 + i * 16); s += (bflo(v.x) + bfhi(v.x)) + (bflo(v.y) + bfhi(v.y)) + (bflo(v.z) + bfhi(v.z)) + (bflo(v.w) + bfhi(v.w)); }
        NDg[tid] = s; }
}

__device__ __forceinline__ void mlstm_scan(Frame& F) {
    const float* CHS = (const float*)(F.ws + WS_CTL + CTL_CHS); float* MS = (float*)(F.ws + WS_CTL + CTL_MS);
    const float* Dg = F.out; bf16* CT = (bf16*)(F.ws + WS_CT);
    const float* NDg = (const float*)(F.ws + WS_ND); float* NS = (float*)(F.ws + WS_NS);
    LAS float* chs = (LAS float*)F.lds;
    __syncthreads();
    for (int i = F.tid; i < 2048; i += 512) chs[i] = CHS[i];
    __syncthreads();
    if (F.tid < 8) { float m = 0.f;
        for (int c = 0; c < 128; ++c) { const int item = F.tid * 128 + c; const float blast = chs[2 * item], mu = chs[2 * item + 1];
            if (blockIdx.x == 0) MS[item] = m;
            const float mn = fmaxf(blast + m, mu); chs[2 * item] = __expf(blast + m - mn); chs[2 * item + 1] = __expf(mu - mn); m = mn; } }
    __syncthreads();
    for (int g = blockIdx.x * 512 + F.tid; g < 8 * 16384; g += F.G * 512) {
        const int bh = g >> 14, e = g & 16383; float st = 0.f;
        const float* dp = Dg + (size_t)bh * 128 * 16384 + e; bf16* cp = CT + (size_t)bh * 128 * 16384 + e;
        for (int c0 = 0; c0 < 128; c0 += 16) { float d[16];
#pragma unroll
            for (int k = 0; k < 16; ++k) d[k] = __builtin_nontemporal_load(dp + (size_t)(c0 + k) * 16384);
#pragma unroll
            for (int k = 0; k < 16; ++k) { cp[(size_t)(c0 + k) * 16384] = (bf16)f2bf(st); st = chs[2 * (bh * 128 + c0 + k)] * st + chs[2 * (bh * 128 + c0 + k) + 1] * d[k]; } }
    }
    for (int g = blockIdx.x * 512 + F.tid; g < 8 * 128; g += F.G * 512) {
        const int bh = g >> 7, e = g & 127; float st = 0.f;
        for (int c = 0; c < 128; ++c) { const int item = bh * 128 + c; NS[(size_t)item * 128 + e] = st; st = chs[2 * item] * st + chs[2 * item + 1] * NDg[(size_t)item * 128 + e]; }
    }
}

__device__ __forceinline__ void mem_attn_item(Frame& F, int item, bf16* outp, size_t rmask) {
    const int tile = item & 63, h = (item >> 6) & 3, b = item >> 8;
    const int tid = F.tid, lane = F.lane, w = F.wave;
    LAS unsigned char* Qs = F.lds;
    LAS unsigned char* KVs = F.lds + 34816;
    LAS unsigned char* Pw = F.lds + 34816 + 69632 + w * 2304;
    bf16* MEMQ = (bf16*)(F.ws + WS_MEMQ); const bf16* KV = (const bf16*)(F.ws + WS_KVMEM);
    const float* qg = F.in[11]; const float* kg = F.in[12];
    const size_t row0 = (size_t)b * SEQ + (size_t)tile * 128;
    __syncthreads();
    { const int r = tid >> 2, part = tid & 3; const bf16* p = MEMQ + (row0 + r) * 512 + h * 128 + part * 32;
      v4u x[4]; float s = 0.f;
#pragma unroll
      for (int i = 0; i < 4; ++i) { x[i] = *(const GAS v4u*)(p + 8 * i);
          s += (bflo(x[i].x) * bflo(x[i].x) + bfhi(x[i].x) * bfhi(x[i].x)) + (bflo(x[i].y) * bflo(x[i].y) + bfhi(x[i].y) * bfhi(x[i].y)) + (bflo(x[i].z) * bflo(x[i].z) + bfhi(x[i].z) * bfhi(x[i].z)) + (bflo(x[i].w) * bflo(x[i].w) + bfhi(x[i].w) * bfhi(x[i].w)); }
      s += __shfl_xor(s, 1); s += __shfl_xor(s, 2);
      const float rs = 0.08838834764831845f / sqrtf(s * (1.f / 128.f) + EPS);
#pragma unroll
      for (int i = 0; i < 4; ++i) { const f32x4 g0 = *(const GAS f32x4*)(qg + part * 32 + 8 * i), g1 = *(const GAS f32x4*)(qg + part * 32 + 8 * i + 4);
          v4u o; o.x = pk2(bflo(x[i].x) * rs * g0.x, bfhi(x[i].x) * rs * g0.y); o.y = pk2(bflo(x[i].y) * rs * g0.z, bfhi(x[i].y) * rs * g0.w);
          o.z = pk2(bflo(x[i].z) * rs * g1.x, bfhi(x[i].z) * rs * g1.y); o.w = pk2(bflo(x[i].w) * rs * g1.z, bfhi(x[i].w) * rs * g1.w);
          *(LAS v4u*)(Qs + r * 272 + part * 64 + i * 16) = o; } }
    { const int key = tid >> 1, half = tid & 1; const bf16* p = KV + ((size_t)b * 256 + key) * 1024 + h * 128 + half * 64;
      v4u x[8]; float s = 0.f;
#pragma unroll
      for (int i = 0; i < 8; ++i) { x[i] = *(const GAS v4u*)(p + 8 * i);
          s += (bflo(x[i].x) * bflo(x[i].x) + bfhi(x[i].x) * bfhi(x[i].x)) + (bflo(x[i].y) * bflo(x[i].y) + bfhi(x[i].y) * bfhi(x[i].y)) + (bflo(x[i].z) * bflo(x[i].z) + bfhi(x[i].z) * bfhi(x[i].z)) + (bflo(x[i].w) * bflo(x[i].w) + bfhi(x[i].w) * bfhi(x[i].w)); }
      s += __shfl_xor(s, 1);
      const float rs = 1.0f / sqrtf(s * (1.f / 128.f) + EPS);
#pragma unroll
      for (int i = 0; i < 8; ++i) { const f32x4 g0 = *(const GAS f32x4*)(kg + half * 64 + 8 * i), g1 = *(const GAS f32x4*)(kg + half * 64 + 8 * i + 4);
          v4u o; o.x = pk2(bflo(x[i].x) * rs * g0.x, bfhi(x[i].x) * rs * g0.y); o.y = pk2(bflo(x[i].y) * rs * g0.z, bfhi(x[i].y) * rs * g0.w);
          o.z = pk2(bflo(x[i].z) * rs * g1.x, bfhi(x[i].z) * rs * g1.y); o.w = pk2(bflo(x[i].w) * rs * g1.z, bfhi(x[i].w) * rs * g1.w);
          *(LAS v4u*)(KVs + key * 272 + half * 128 + i * 16) = o; } }
    __syncthreads();
    f32x4 sacc[16];
#pragma unroll
    for (int j = 0; j < 16; ++j) sacc[j] = (f32x4){0.f, 0.f, 0.f, 0.f};
    wave_mma<16, 4>(sacc, Qs, 272, 16 * w, KVs, 272, 0, lane);
    float rsum[4];
#pragma unroll
    for (int rg = 0; rg < 4; ++rg) { float mx = sacc[0][rg];
#pragma unroll
        for (int j = 1; j < 16; ++j) mx = fmaxf(mx, sacc[j][rg]);
        mx = fmaxf(mx, __shfl_xor(mx, 1)); mx = fmaxf(mx, __shfl_xor(mx, 2)); mx = fmaxf(mx, __shfl_xor(mx, 4)); mx = fmaxf(mx, __shfl_xor(mx, 8));
        float sm = 0.f;
#pragma unroll
        for (int j = 0; j < 16; ++j) { const float p = __expf(sacc[j][rg] - mx); sacc[j][rg] = p; sm += p; }
        sm += __shfl_xor(sm, 1); sm += __shfl_xor(sm, 2); sm += __shfl_xor(sm, 4); sm += __shfl_xor(sm, 8);
        rsum[rg] = 1.0f / sm; }
    __syncthreads();
#pragma unroll
    for (int i = 0; i < 8; ++i) { const int p = tid + 512 * i, key = p >> 4, c = p & 15;
        const v4u v = *(const GAS v4u*)(KV + ((size_t)b * 256 + key) * 1024 + 512 + h * 128 + c * 8); lds_store_tr8(KVs, 528, c * 8, key, v); }
    __syncthreads();
    f32x4 oacc[8];
#pragma unroll
    for (int j = 0; j < 8; ++j) oacc[j] = (f32x4){0.f, 0.f, 0.f, 0.f};
#pragma unroll
    for (int kc = 0; kc < 4; ++kc) {
        LDS_WAIT();
#pragma unroll
        for (int jj = 0; jj < 4; ++jj)
#pragma unroll
            for (int rg = 0; rg < 4; ++rg) *(LAS unsigned short*)(Pw + (4 * (lane >> 4) + rg) * 144 + (16 * jj + (lane & 15)) * 2) = (unsigned short)f2bf(sacc[4 * kc + jj][rg]);
        LDS_WAIT();
        wave_mma<8, 2>(oacc, Pw, 144, 0, KVs, 528, 0, lane, 0, 64 * kc);
    }
    LDS_WAIT();
#pragma unroll
    for (int j = 0; j < 8; ++j)
#pragma unroll
        for (int rg = 0; rg < 4; ++rg) *(LAS unsigned short*)(Qs + (16 * w + 4 * (lane >> 4) + rg) * 272 + (16 * j + (lane & 15)) * 2) = (unsigned short)f2bf(oacc[j][rg] * rsum[rg]);
    LDS_WAIT();
#pragma unroll
    for (int i = 0; i < 4; ++i) { const int p = lane + 64 * i, rr = 16 * w + (p >> 4), c = p & 15;
        const v4u v = *(const LAS v4u*)(Qs + rr * 272 + c * 16); *(GAS v4u*)(outp + ((row0 + rr) & rmask) * 512 + h * 128 + c * 8) = v; }
}

__device__ __forceinline__ void mlstm_out_item(Frame& F, int item, bf16* outp, size_t rmask) {
    const int bh = item >> 7, c = item & 127, b = bh >> 2, h = bh & 3;
    const int tid = F.tid, lane = F.lane, w = F.wave;
    LAS unsigned char* Qs = F.lds;
    LAS unsigned char* Ks = F.lds + 17408;
    LAS unsigned char* VT = F.lds + 34816;
    LAS unsigned char* CTs = F.lds + 53248;
    LAS unsigned char* Ss = F.lds + 88064;
    LAS unsigned char* Ws = F.lds + 105472;
    LAS float* bcum = (LAS float*)(F.lds + 114688);
    LAS float* igs = bcum + 64;
    LAS float* nsv = bcum + 128;
    LAS float* rden = bcum + 256;
    const float* IGLF = (const float*)(F.ws + WS_IGLF);
    const bf16* MLQ = (const bf16*)(F.ws + WS_MLQ); const bf16* MLK = (const bf16*)(F.ws + WS_MLK); bf16* MLV = (bf16*)(F.ws + WS_MLV); const bf16* MLO = (const bf16*)(F.ws + WS_MLO);
    const bf16* CT = (const bf16*)(F.ws + WS_CT) + (size_t)item * 16384;
    const float* NS = (const float*)(F.ws + WS_NS) + (size_t)item * 128;
    const float mc = ((const float*)(F.ws + WS_CTL + CTL_MS))[item];
    const int t0 = c * 64; const size_t row0 = (size_t)b * SEQ + t0;
    __syncthreads();
    if (w == 0) {
        const float lf = IGLF[(row0 + lane) * 8 + 4 + h], ig = IGLF[(row0 + lane) * 8 + h];
        float bs = lf;
#pragma unroll
        for (int o = 1; o < 64; o <<= 1) { const float v = __shfl_up(bs, o); if (lane >= o) bs += v; }
        bcum[lane] = bs; igs[lane] = ig;
    } else if (w == 1 || w == 2) { const int i = tid - 64; nsv[i] = NS[i]; }
    { const int s = tid >> 3, part = tid & 7; float y[16];
      conv16(MLQ, h * 128 + part * 16, F.in[6], F.in[7], h * 128 + part * 16, b, t0 + s, y);
      v4u q0, q1; q0.x = pk2(y[0], y[1]); q0.y = pk2(y[2], y[3]); q0.z = pk2(y[4], y[5]); q0.w = pk2(y[6], y[7]); q1.x = pk2(y[8], y[9]); q1.y = pk2(y[10], y[11]); q1.z = pk2(y[12], y[13]); q1.w = pk2(y[14], y[15]);
      *(LAS v4u*)(Qs + s * 272 + part * 32) = q0; *(LAS v4u*)(Qs + s * 272 + part * 32 + 16) = q1;
      conv16(MLK, h * 128 + part * 16, F.in[6], F.in[7], 512 + h * 128 + part * 16, b, t0 + s, y);
      const float sc = 0.08838834764831845f;
      q0.x = pk2(y[0] * sc, y[1] * sc); q0.y = pk2(y[2] * sc, y[3] * sc); q0.z = pk2(y[4] * sc, y[5] * sc); q0.w = pk2(y[6] * sc, y[7] * sc);
      q1.x = pk2(y[8] * sc, y[9] * sc); q1.y = pk2(y[10] * sc, y[11] * sc); q1.z = pk2(y[12] * sc, y[13] * sc); q1.w = pk2(y[14] * sc, y[15] * sc);
      *(LAS v4u*)(Ks + s * 272 + part * 32) = q0; *(LAS v4u*)(Ks + s * 272 + part * 32 + 16) = q1;
      const bf16* vp = MLV + (row0 + s) * 512 + h * 128 + part * 16; const v4u v0 = *(const GAS v4u*)vp, v1 = *(const GAS v4u*)(vp + 8);
      lds_store_tr8(VT, 144, part * 16, s, v0); lds_store_tr8(VT, 144, part * 16 + 8, s, v1); }
#pragma unroll
    for (int i = 0; i < 4; ++i) { const int p = tid + 512 * i, rr = p >> 4, cc = p & 15; const v4u v = *(const GAS v4u*)(CT + rr * 128 + cc * 8); *(LAS v4u*)(CTs + rr * 272 + cc * 16) = v; }
    __syncthreads();
    { f32x4 sacc[2];
      sacc[0] = (f32x4){0.f, 0.f, 0.f, 0.f}; sacc[1] = (f32x4){0.f, 0.f, 0.f, 0.f};
      wave_mma<2, 4>(sacc, Qs, 272, 16 * (w >> 1), Ks, 272, 32 * (w & 1), lane);
#pragma unroll
      for (int j = 0; j < 2; ++j)
#pragma unroll
          for (int rg = 0; rg < 4; ++rg) *(LAS float*)(Ss + (16 * (w >> 1) + 4 * (lane >> 4) + rg) * 272 + (32 * (w & 1) + 16 * j + (lane & 15)) * 4) = sacc[j][rg]; }
    __syncthreads();
    { const int t = tid >> 3, seg = tid & 7;
      const float bt = bcum[t];
      const f32x4 s0 = *(const LAS f32x4*)(Ss + t * 272 + seg * 32), s1 = *(const LAS f32x4*)(Ss + t * 272 + seg * 32 + 16);
      const float sv[8] = {s0.x, s0.y, s0.z, s0.w, s1.x, s1.y, s1.z, s1.w};
      float dm[8]; float mx = -3.0e38f;
#pragma unroll
      for (int i = 0; i < 8; ++i) { const int s = seg * 8 + i; dm[i] = bt - bcum[s] + igs[s]; if (s <= t) mx = fmaxf(mx, dm[i]); }
      mx = fmaxf(mx, __shfl_xor(mx, 1)); mx = fmaxf(mx, __shfl_xor(mx, 2)); mx = fmaxf(mx, __shfl_xor(mx, 4));
      const float minter = bt + mc; const float mt = fmaxf(minter, mx);
      float wv[8]; float den = 0.f;
#pragma unroll
      for (int i = 0; i < 8; ++i) { const int s = seg * 8 + i; wv[i] = (s <= t) ? sv[i] * __expf(dm[i] - mt) : 0.f; den += wv[i]; }
      *(LAS v4u*)(Ws + t * 144 + seg * 16) = (v4u){pk2(wv[0], wv[1]), pk2(wv[2], wv[3]), pk2(wv[4], wv[5]), pk2(wv[6], wv[7])};
      const float inter = __expf(minter - mt);
      v4u qa = *(const LAS v4u*)(Qs + t * 272 + seg * 32), qb2 = *(const LAS v4u*)(Qs + t * 272 + seg * 32 + 16);
      const float qf[16] = {bflo(qa.x), bfhi(qa.x), bflo(qa.y), bfhi(qa.y), bflo(qa.z), bfhi(qa.z), bflo(qa.w), bfhi(qa.w), bflo(qb2.x), bfhi(qb2.x), bflo(qb2.y), bfhi(qb2.y), bflo(qb2.z), bfhi(qb2.z), bflo(qb2.w), bfhi(qb2.w)};
      float qn = 0.f;
#pragma unroll
      for (int i = 0; i < 16; ++i) qn += qf[i] * nsv[seg * 16 + i];
      den += inter * qn;
      den += __shfl_xor(den, 1); den += __shfl_xor(den, 2); den += __shfl_xor(den, 4);
      qa.x = pk2(qf[0] * inter, qf[1] * inter); qa.y = pk2(qf[2] * inter, qf[3] * inter); qa.z = pk2(qf[4] * inter, qf[5] * inter); qa.w = pk2(qf[6] * inter, qf[7] * inter);
      qb2.x = pk2(qf[8] * inter, qf[9] * inter); qb2.y = pk2(qf[10] * inter, qf[11] * inter); qb2.z = pk2(qf[12] * inter, qf[13] * inter); qb2.w = pk2(qf[14] * inter, qf[15] * inter);
      *(LAS v4u*)(Qs + t * 272 + seg * 32) = qa; *(LAS v4u*)(Qs + t * 272 + seg * 32 + 16) = qb2;
      if (seg == 0) rden[t] = 1.0f / fmaxf(fabsf(den), __expf(-mt)); }
    __syncthreads();
    f32x4 acc[4];
#pragma unroll
    for (int j = 0; j < 4; ++j) acc[j] = (f32x4){0.f, 0.f, 0.f, 0.f};
    wave_mma<4, 2>(acc, Ws, 144, 16 * (w >> 1), VT, 144, 64 * (w & 1), lane);
    wave_mma<4, 4>(acc, Qs, 272, 16 * (w >> 1), CTs, 272, 64 * (w & 1), lane);
    __syncthreads();
    LAS unsigned char* Hs = CTs;
#pragma unroll
    for (int j = 0; j < 4; ++j)
#pragma unroll
        for (int rg = 0; rg < 4; ++rg) { const int row = 16 * (w >> 1) + 4 * (lane >> 4) + rg; *(LAS float*)(Hs + row * 528 + (64 * (w & 1) + 16 * j + (lane & 15)) * 4) = acc[j][rg] * rden[row]; }
    __syncthreads();
    { const int t = tid >> 3, seg = tid & 7; float hv[16]; float ss = 0.f;
#pragma unroll
      for (int i4 = 0; i4 < 4; ++i4) { const f32x4 v = *(const LAS f32x4*)(Hs + t * 528 + seg * 64 + i4 * 16); hv[4 * i4] = v.x; hv[4 * i4 + 1] = v.y; hv[4 * i4 + 2] = v.z; hv[4 * i4 + 3] = v.w; ss += (v.x * v.x + v.y * v.y) + (v.z * v.z + v.w * v.w); }
      ss += __shfl_xor(ss, 1); ss += __shfl_xor(ss, 2); ss += __shfl_xor(ss, 4);
      const float rs = 1.0f / sqrtf(ss * (1.f / 128.f) + EPS);
      const float* mg = F.in[8] + seg * 16;
      const bf16* op = MLO + (row0 + t) * 512 + h * 128 + seg * 16; const v4u o0 = *(const GAS v4u*)op, o1 = *(const GAS v4u*)(op + 8);
      const float og[16] = {bflo(o0.x), bfhi(o0.x), bflo(o0.y), bfhi(o0.y), bflo(o0.z), bfhi(o0.z), bflo(o0.w), bfhi(o0.w), bflo(o1.x), bfhi(o1.x), bflo(o1.y), bfhi(o1.y), bflo(o1.z), bfhi(o1.z), bflo(o1.w), bfhi(o1.w)};
      float yv[16];
#pragma unroll
      for (int i = 0; i < 16; ++i) yv[i] = hv[i] * rs * mg[i] * og[i];
      v4u y0, y1; y0.x = pk2(yv[0], yv[1]); y0.y = pk2(yv[2], yv[3]); y0.z = pk2(yv[4], yv[5]); y0.w = pk2(yv[6], yv[7]); y1.x = pk2(yv[8], yv[9]); y1.y = pk2(yv[10], yv[11]); y1.z = pk2(yv[12], yv[13]); y1.w = pk2(yv[14], yv[15]);
      bf16* yp = outp + ((row0 + t) & rmask) * 512 + h * 128 + seg * 16; *(GAS v4u*)yp = y0; *(GAS v4u*)(yp + 8) = y1; }
}

#define PEER_INS(L, v) do { L[15] = __builtin_amdgcn_fmed3f(L[14], L[15], v); L[14] = __builtin_amdgcn_fmed3f(L[13], L[14], v); L[13] = __builtin_amdgcn_fmed3f(L[12], L[13], v); \
    L[12] = __builtin_amdgcn_fmed3f(L[11], L[12], v); L[11] = __builtin_amdgcn_fmed3f(L[10], L[11], v); L[10] = __builtin_amdgcn_fmed3f(L[9], L[10], v); L[9] = __builtin_amdgcn_fmed3f(L[8], L[9], v); \
    L[8] = __builtin_amdgcn_fmed3f(L[7], L[8], v); L[7] = __builtin_amdgcn_fmed3f(L[6], L[7], v); L[6] = __builtin_amdgcn_fmed3f(L[5], L[6], v); L[5] = __builtin_amdgcn_fmed3f(L[4], L[5], v); \
    L[4] = __builtin_amdgcn_fmed3f(L[3], L[4], v); L[3] = __builtin_amdgcn_fmed3f(L[2], L[3], v); L[2] = __builtin_amdgcn_fmed3f(L[1], L[2], v); L[1] = __builtin_amdgcn_fmed3f(L[0], L[1], v); L[0] = fmaxf(L[0], v); } while (0)

constexpr int PEER_IDX_OFF = 0, PEER_GW_OFF = 33024, PEER_LST_OFF = 69632;
__device__ __forceinline__ void peer_route_tile(Frame& F, int tile) {
    const int tid = F.tid, lane = F.lane, w = F.wave;
    LAS unsigned char* K1s = F.lds;
    LAS float* LST = (LAS float*)(F.lds + PEER_LST_OFF);
    const bf16* QRY = (const bf16*)(F.ws + WS_QRY); const bf16* PK = (const bf16*)(F.ws + WS_PK);
    const size_t row0 = (size_t)tile * 64;
    const int mt = w & 3, half = w >> 2;
    for (int h = 0; h < 8; ++h) {
        __syncthreads();
#pragma unroll
        for (int i = 0; i < 8; ++i) { const int p = tid + 512 * i, kr = p >> 4, c = p & 15, hf = kr >> 7, key = kr & 127;
            const v4u v = *(const GAS v4u*)(PK + ((size_t)(hf * 8 + h) * 128 + key) * 128 + c * 8); *(LAS v4u*)(K1s + kr * 272 + c * 16) = v; }
        __syncthreads();
        f32x4 acc[8];
#pragma unroll
        for (int j = 0; j < 8; ++j) acc[j] = (f32x4){0.f, 0.f, 0.f, 0.f};
        const bf16* qp = QRY + (row0 + 16 * mt + (lane & 15)) * 2048 + h * 256 + half * 128 + (lane >> 4) * 8;
#pragma unroll
        for (int ks = 0; ks < 4; ++ks) { const bf16x8 q = *(const GAS bf16x8*)(qp + ks * 32);
#pragma unroll
            for (int j = 0; j < 8; ++j) { const bf16x8 kf = *(const LAS bf16x8*)(K1s + (half * 128 + 16 * j + (lane & 15)) * 272 + (ks * 32 + (lane >> 4) * 8) * 2);
                acc[j] = __builtin_amdgcn_mfma_f32_16x16x32_bf16(kf, q, acc[j], 0, 0, 0); } }
        float L[16];
#pragma unroll
        for (int i = 0; i < 16; ++i) L[i] = -3.0e38f;
#pragma unroll
        for (int j = 0; j < 8; ++j)
#pragma unroll
            for (int rg = 0; rg < 4; ++rg) { const float v = __uint_as_float((__float_as_uint(acc[j][rg]) & 0xFFFFFF80u) | (unsigned)(16 * j + 4 * (lane >> 4) + rg)); PEER_INS(L, v); }
#pragma unroll
        for (int step = 16; step <= 32; step <<= 1) { float P[16];
#pragma unroll
            for (int i = 0; i < 16; ++i) P[i] = __shfl_xor(L[i], step);
#pragma unroll
            for (int i = 0; i < 16; ++i) PEER_INS(L, P[i]); }
        if (lane < 16) {
#pragma unroll
            for (int i = 0; i < 16; ++i) LST[((h * 2 + half) * 16 + i) * 64 + 16 * mt + lane] = L[i]; }
    }
    __syncthreads();
    {
        const int h = w;
        float A1[16], A2[16];
#pragma unroll
        for (int i = 0; i < 16; ++i) { A1[i] = LST[((h * 2) * 16 + i) * 64 + lane]; A2[i] = LST[((h * 2 + 1) * 16 + i) * 64 + lane]; }
        float Tt[16];
#pragma unroll
        for (int i = 0; i < 16; ++i) Tt[i] = -3.0e38f;
#pragma unroll
        for (int i = 0; i < 16; ++i)
#pragma unroll
            for (int j = 0; j < 16; ++j) if ((i + 1) * (j + 1) <= 16) { const float cv = __uint_as_float((__float_as_uint(A1[i] + A2[j]) & 0xFFFFFF00u) | (unsigned)(i * 16 + j)); PEER_INS(Tt, cv); }
        float ex[16]; float sm = 0.f;
#pragma unroll
        for (int i = 0; i < 16; ++i) { ex[i] = __expf(Tt[i] - Tt[0]); sm += ex[i]; }
        const float inv = 1.0f / sm;
        LAS int* ip = (LAS int*)(F.lds + PEER_IDX_OFF) + lane * 129 + h * 16; LAS float* gp = (LAS float*)(F.lds + PEER_GW_OFF) + lane * 129 + h * 16;
#pragma unroll
        for (int i = 0; i < 16; ++i) { const unsigned code = __float_as_uint(Tt[i]) & 0xFFu; const unsigned i1 = code >> 4, i2 = code & 15u;
            const unsigned e1 = __float_as_uint(LST[((h * 2) * 16 + i1) * 64 + lane]) & 0x7Fu, e2 = __float_as_uint(LST[((h * 2 + 1) * 16 + i2) * 64 + lane]) & 0x7Fu;
            ip[i] = (int)(e1 * 128u + e2); gp[i] = ex[i] * inv; }
    }
    __syncthreads();
}

typedef float f32x2 __attribute__((ext_vector_type(2)));
#define PEER_LOADROWS(dst, tab, idv, lb) do { _Pragma("unroll") for (int e_ = 0; e_ < 16; ++e_) { const int row_ = __builtin_amdgcn_readlane(idv, (lb) + e_); \
    dst[e_] = *(const GAS v4u*)((tab) + (size_t)row_ * 1024 + 16 * lane); } } while (0)
__device__ __forceinline__ void peer_expert_token(Frame& F, int m, int tl, float* outbase) {
    const int lane = F.lane;
    const bf16* H1B = (const bf16*)(F.ws + WS_H1B); const unsigned char* UT8 = F.ws + WS_UT8; const unsigned char* VT8 = F.ws + WS_VT8;
    const float* USC = (const float*)(F.ws + WS_USC); const float* VSC = (const float*)(F.ws + WS_VSC);
    const float* SUMSQ = (const float*)(F.ws + WS_CTL + CTL_SUMSQ); const float* gf = F.in[18];
    const float rs = 1.0f / sqrtf(SUMSQ[m] * (1.f / 1024.f) + EPS);
    f32x2 xh[8];
    { const v4u h0 = *(const GAS v4u*)(H1B + (size_t)m * 1024 + 16 * lane), h1 = *(const GAS v4u*)(H1B + (size_t)m * 1024 + 16 * lane + 8);
      const f32x4 g0 = *(const GAS f32x4*)(gf + 16 * lane), g1 = *(const GAS f32x4*)(gf + 16 * lane + 4), g2 = *(const GAS f32x4*)(gf + 16 * lane + 8), g3 = *(const GAS f32x4*)(gf + 16 * lane + 12);
      xh[0] = (f32x2){bflo(h0.x) * rs * g0.x, bfhi(h0.x) * rs * g0.y}; xh[1] = (f32x2){bflo(h0.y) * rs * g0.z, bfhi(h0.y) * rs * g0.w};
      xh[2] = (f32x2){bflo(h0.z) * rs * g1.x, bfhi(h0.z) * rs * g1.y}; xh[3] = (f32x2){bflo(h0.w) * rs * g1.z, bfhi(h0.w) * rs * g1.w};
      xh[4] = (f32x2){bflo(h1.x) * rs * g2.x, bfhi(h1.x) * rs * g2.y}; xh[5] = (f32x2){bflo(h1.y) * rs * g2.z, bfhi(h1.y) * rs * g2.w};
      xh[6] = (f32x2){bflo(h1.z) * rs * g3.x, bfhi(h1.z) * rs * g3.y}; xh[7] = (f32x2){bflo(h1.w) * rs * g3.z, bfhi(h1.w) * rs * g3.w}; }
    const LAS int* ipl = (const LAS int*)(F.lds + PEER_IDX_OFF) + tl * 129; const LAS float* gpl = (const LAS float*)(F.lds + PEER_GW_OFF) + tl * 129;
    const int id0 = ipl[lane], id1 = ipl[64 + lane];
    const float gw0 = gpl[lane], gw1 = gpl[64 + lane];
    const float us0 = USC[id0], us1 = USC[id1], vs0 = VSC[id0], vs1 = VSC[id1];
    f32x2 oa[8];
#pragma unroll
    for (int i = 0; i < 8; ++i) oa[i] = (f32x2){0.f, 0.f};
    v4u ur[16], vr[16];
    PEER_LOADROWS(ur, UT8, id0, 0);
    for (int hd = 0; hd < 8; ++hd) {
        const int idv = (hd < 4) ? id0 : id1; const float gwv = (hd < 4) ? gw0 : gw1; const float usv = (hd < 4) ? us0 : us1; const float vsv = (hd < 4) ? vs0 : vs1; const int lb = (hd & 3) * 16;
        PEER_LOADROWS(vr, VT8, idv, lb);
        float pd[16];
#pragma unroll
        for (int e = 0; e < 16; ++e) { f32x2 d2 = (f32x2){0.f, 0.f};
            const unsigned uw[4] = {ur[e].x, ur[e].y, ur[e].z, ur[e].w};
#pragma unroll
            for (int q = 0; q < 4; ++q) { const f32x2 lo = __builtin_amdgcn_cvt_pk_f32_fp8((int)uw[q], false), hi = __builtin_amdgcn_cvt_pk_f32_fp8((int)uw[q], true);
                d2 = __builtin_elementwise_fma(lo, xh[2 * q], d2); d2 = __builtin_elementwise_fma(hi, xh[2 * q + 1], d2); }
            pd[e] = d2.x + d2.y; }
#pragma unroll
        for (int i = 0; i < 8; ++i) { const bool up = (lane & 8) != 0; const float send = up ? pd[i] : pd[i + 8]; const float keep = up ? pd[i + 8] : pd[i]; pd[i] = keep + __shfl_xor(send, 8); }
#pragma unroll
        for (int i = 0; i < 4; ++i) { const bool up = (lane & 4) != 0; const float send = up ? pd[i] : pd[i + 4]; const float keep = up ? pd[i + 4] : pd[i]; pd[i] = keep + __shfl_xor(send, 4); }
#pragma unroll
        for (int i = 0; i < 2; ++i) { const bool up = (lane & 2) != 0; const float send = up ? pd[i] : pd[i + 2]; const float keep = up ? pd[i + 2] : pd[i]; pd[i] = keep + __shfl_xor(send, 2); }
        { const bool up = (lane & 1) != 0; const float send = up ? pd[0] : pd[1]; const float keep = up ? pd[1] : pd[0]; pd[0] = keep + __shfl_xor(send, 1); }
        float dt = pd[0]; dt += __shfl_xor(dt, 16); dt += __shfl_xor(dt, 32);
        const int src = lb + (lane & 15);
        dt *= __shfl(usv, src);
        const float wgt = __shfl(gwv, src) * __shfl(vsv, src) * 0.5f * dt * (1.0f + erff(dt * 0.70710678118654752f));
        if (hd < 7) { const int idn = (hd + 1 < 4) ? id0 : id1; const int lbn = ((hd + 1) & 3) * 16; PEER_LOADROWS(ur, UT8, idn, lbn); }
#pragma unroll
        for (int e = 0; e < 16; ++e) { const float we = __uint_as_float((unsigned)__builtin_amdgcn_readlane((int)__float_as_uint(wgt), e)); const f32x2 w2 = (f32x2){we, we};
            const unsigned vw[4] = {vr[e].x, vr[e].y, vr[e].z, vr[e].w};
#pragma unroll
            for (int q = 0; q < 4; ++q) { const f32x2 lo = __builtin_amdgcn_cvt_pk_f32_fp8((int)vw[q], false), hi = __builtin_amdgcn_cvt_pk_f32_fp8((int)vw[q], true);
                oa[2 * q] = __builtin_elementwise_fma(lo, w2, oa[2 * q]); oa[2 * q + 1] = __builtin_elementwise_fma(hi, w2, oa[2 * q + 1]); } }
    }
    float* op = outbase + (size_t)m * 1024 + 16 * lane;
#pragma unroll
    for (int q = 0; q < 4; ++q) { f32x4 a = *(GAS f32x4*)(op + 4 * q); a.x += oa[2 * q].x; a.y += oa[2 * q].y; a.z += oa[2 * q + 1].x; a.w += oa[2 * q + 1].y; *(GAS f32x4*)(op + 4 * q) = a; }
}
__device__ __forceinline__ void peer_table_row_fp8(const float* src, unsigned char* dst, float* sc, int lane) {
    f32x4 v[4]; float am = 0.f;
#pragma unroll
    for (int j = 0; j < 4; ++j) { v[j] = __builtin_nontemporal_load((const GAS f32x4*)(src + 256 * j + 4 * lane)); am = fmaxf(am, fmaxf(fmaxf(fabsf(v[j].x), fabsf(v[j].y)), fmaxf(fabsf(v[j].z), fabsf(v[j].w)))); }
    am = fmaxf(wave_max(am), 1e-30f);
    const float s = 224.0f / am;
#pragma unroll
    for (int j = 0; j < 4; ++j) { int p = 0; p = __builtin_amdgcn_cvt_pk_fp8_f32(v[j].x * s, v[j].y * s, p, false); p = __builtin_amdgcn_cvt_pk_fp8_f32(v[j].z * s, v[j].w * s, p, true);
        *(GAS unsigned*)(dst + 256 * j + 4 * lane) = (unsigned)p; }
    if (lane == 0) *sc = am * (1.0f / 224.0f);
}

struct Args { const float* in[24]; float* out; unsigned char* ws; int ph_lo, ph_hi, li, pad; };
__global__ void __launch_bounds__(NWAVES * 64, 2) hybrid_fwd(Args args) {
    extern __shared__ __attribute__((aligned(16))) unsigned char lds[];
    Frame F;
    F.lds = (LAS unsigned char*)lds;
    F.MISC = (volatile LAS unsigned*)(F.lds + MISC_OFF);
    F.tid = threadIdx.x; F.lane = F.tid & 63; F.wave = __builtin_amdgcn_readfirstlane(F.tid >> 6);
    F.G = gridDim.x; F.ws = args.ws; F.out = args.out;
#pragma unroll
    for (int i = 0; i < 24; ++i) F.in[i] = args.in[i];
    for (int u = F.tid; u < (LDS_BYTES - LDSCTL_OFF) / 4; u += NWAVES * 64) ((LAS unsigned*)(F.lds + LDSCTL_OFF))[u] = 0u;
    __syncthreads();
    unsigned* ctl = (unsigned*)(F.ws + WS_CTL);
    XcdBarrier bar; bar.bar = ctl + CW_BAR; bar.x = 0; bar.st = nullptr;
    if (N_LAUNCHES != PER_PHASE) bar = xcd_barrier_post(ctl + CW_BAR, F.MISC + 8);
#define REP(k) for (int rep_ = ((PROBE_PH == (k)) ? 0 : 1); rep_ < 2; ++rep_)
#define DUMMY (rep_ == 0)
#define GRID_BAR() do { if (N_LAUNCHES != PER_PHASE) xcd_barrier(bar); } while (0)
    const int lo = args.ph_lo, hi = args.ph_hi;
#define IN(k) (lo <= (k) && (k) < hi)
#define BOTH(k) (IN(k) && IN((k) + 1))
    const int bx = blockIdx.x;

    if (IN(0)) { REP(0) { p0_prologue(F); __syncthreads(); } if (BOTH(0)) GRID_BAR(); }

    if (IN(1)) {
        pg8::Gemm g{(const bf16*)F.out, (const bf16*)(F.ws + WS_WIN), 1024, 1024, 1024}; pg8::StaticOrder S; S.init(T_TOK, 7168, F.G, bx);
        pg8::EpiProj E{(bf16*)(F.ws + WS_GATES), 512, F.in[16], 512, SPLIT_STRIDE, 12, 22, 24};
        REP(1) pg8::gemm_phase<pg8::EpiProj, pg8::StaticOrder, true, true>(F.lds, g, S, E);
        if (BOTH(1)) GRID_BAR();
    }

    if (IN(2)) {
        { pg8::Gemm g{(const bf16*)(F.ws + WS_MEMN), (const bf16*)(F.ws + WS_WKV), 1024, 1024, 1024}; pg8::FewOrder S{4, 8, bx};
          pg8::EpiProj E{(bf16*)(F.ws + WS_KVMEM), 1024, nullptr, 0, 0, 0, 0, 0};
          pg8::gemm_phase<pg8::EpiProj, pg8::FewOrder, false, true>(F.lds, g, S, E); }
        for (;;) {
            __syncthreads();
            if (F.tid == 0) F.MISC[16] = __hip_atomic_fetch_add(ctl + 1024, 1u, __ATOMIC_RELAXED, __HIP_MEMORY_SCOPE_AGENT);
            __syncthreads();
            const int it = (int)F.MISC[16];
            if (it >= 2048) break;
            if (it < 1024) sb_attn_item(F, it, (bf16*)(F.ws + WS_SBQ), ~(size_t)0); else mlstm_local_item(F, it - 1024);
        }
        if (BOTH(2)) GRID_BAR();
    }

    if (IN(3)) {
        REP(3) mlstm_scan(F);
        REP(13) for (int it = bx; it < 512; it += F.G) mem_attn_item(F, it, DUMMY ? (bf16*)(F.ws + WS_END) : (bf16*)(F.ws + WS_MEMQ), DUMMY ? (size_t)1023 : ~(size_t)0);
        if (BOTH(3)) GRID_BAR();
    }

    if (IN(4)) {
        REP(4) for (int it = bx; it < 1024; it += F.G) mlstm_out_item(F, it, DUMMY ? (bf16*)(F.ws + WS_END) : (bf16*)(F.ws + WS_MLV), DUMMY ? (size_t)1023 : ~(size_t)0);
        if (BOTH(4)) GRID_BAR();
    }

    if (IN(5)) {
        pg8::Gemm g{(const bf16*)(F.ws + WS_SBQ), (const bf16*)(F.ws + WS_WBR), 512, 512, 512};
        pg8::GroupOrder S; S.so.init(T_TOK, 1024, F.G, bx); S.ng = 3; S.a_gstride = 16 * MiB; S.b_gstride = (size_t)1024 * 512 * 2;
        pg8::EpiBranch E{(const bf16*)(F.ws + WS_GATES), SPLIT_STRIDE, (bf16*)(F.ws + WS_MERGED)};
        REP(5) pg8::gemm_phase<pg8::EpiBranch, pg8::GroupOrder, false, true>(F.lds, g, S, E);
        if (BOTH(5)) GRID_BAR();
    }

    if (IN(6)) {
        { pg8::Gemm g{(const bf16*)(F.ws + WS_MERGED), (const bf16*)(F.ws + WS_WOUT), 1024, 1024, 1024}; pg8::StaticOrder S; S.init(T_TOK, 1024, F.G, bx);
          REP(6) { pg8::EpiOut E{F.in[0], F.out, (bf16*)(F.ws + WS_H1B), (float*)(F.ws + WS_CTL + (DUMMY ? 768 * 1024 : CTL_SUMSQ))};
          pg8::gemm_phase<pg8::EpiOut, pg8::StaticOrder, false, true>(F.lds, g, S, E); } }
        REP(16) for (int r = bx * NWAVES + F.wave; r < 2 * 16384; r += F.G * NWAVES) { const bool second = r >= 16384; const int rr = second ? r - 16384 : r;
            peer_table_row_fp8((second ? F.in[23] : F.in[22]) + (size_t)rr * 1024, F.ws + (second ? WS_VT8 : WS_UT8) + (size_t)rr * 1024, (float*)(F.ws + (second ? WS_VSC : WS_USC)) + rr, F.lane); }
        if (BOTH(6)) GRID_BAR();
    }

    if (IN(7)) {
        pg8::Gemm g{(const bf16*)(F.ws + WS_H1B), (const bf16*)(F.ws + WS_WPQ), 1024, 1024, 1024}; pg8::StaticOrder S; S.init(T_TOK, 2048, F.G, bx);
        pg8::EpiQry E{(const float*)(F.ws + WS_CTL + CTL_SUMSQ), (bf16*)(F.ws + WS_QRY), EPS};
        REP(7) pg8::gemm_phase<pg8::EpiQry, pg8::StaticOrder, true, true>(F.lds, g, S, E);
        if (BOTH(7)) GRID_BAR();
    }

    if (IN(8)) {
        for (int tile = bx; tile < 256; tile += F.G) {
            peer_route_tile(F, tile);
            for (int j = 0; j < 8; ++j) { const int tl = F.wave + 8 * j; peer_expert_token(F, tile * 64 + tl, tl, F.out); }
        }
    }
#undef IN
#undef BOTH
#undef GRID_BAR
#undef REP
#undef DUMMY
}

extern "C" void kernel_launch(void* const* d_in, const int* in_sizes, int n_in, void* d_out, int out_size, void* d_ws, size_t ws_size, hipStream_t stream) {
    static int grid = 0;
    if (grid == 0) {
        if (n_in != 24 || out_size != T_TOK * DM || ws_size < WS_END) { fprintf(stderr, "kernel_launch: unexpected problem (n_in %d, out %d, ws %zu); nothing launched\n", n_in, out_size, ws_size); grid = -1; return; }
        int dev = 0, cus = 0, per_cu = 0;
        if (hipGetDevice(&dev) != hipSuccess || hipDeviceGetAttribute(&cus, hipDeviceAttributeMultiprocessorCount, dev) != hipSuccess) { grid = -1; return; }
        if (hipFuncSetAttribute((const void*)hybrid_fwd, hipFuncAttributeMaxDynamicSharedMemorySize, LDS_BYTES) != hipSuccess) { fprintf(stderr, "kernel_launch: hipFuncSetAttribute failed\n"); grid = -1; return; }
        if (hipOccupancyMaxActiveBlocksPerMultiprocessor(&per_cu, (const void*)hybrid_fwd, NWAVES * 64, LDS_BYTES) != hipSuccess || per_cu < 1)
            fprintf(stderr, "kernel_launch: note: occupancy query reports %d workgroups per CU\n", per_cu);
        (void)hipGetLastError();
        grid = cus;
    }
    if (grid < 0) return;
    if (hipMemsetAsync((char*)d_ws + WS_CTL, 0, CTL_ZERO_BYTES, stream) != hipSuccess) { fprintf(stderr, "kernel_launch: memset failed\n"); return; }
    Args a{};
    for (int i = 0; i < 24; ++i) a.in[i] = (const float*)d_in[i];
    a.out = (float*)d_out; a.ws = (unsigned char*)d_ws;
    for (int li = 0; li < N_LAUNCHES; ++li) {
        a.ph_lo = (N_LAUNCHES == PER_PHASE) ? li : 0; a.ph_hi = (N_LAUNCHES == PER_PHASE) ? li + 1 : PER_PHASE; a.li = li;
        hipLaunchKernelGGL(hybrid_fwd, dim3(grid), dim3(NWAVES * 64), LDS_BYTES, stream, a);
        const hipError_t le = hipPeekAtLastError();
        if (le != hipSuccess) { fprintf(stderr, "kernel_launch: launch %d failed: %s\n", li, hipGetErrorName(le)); break; }
    }
}
```

```cpp
#include <hip/hip_runtime.h>
#include <cstdio>
#include <cstdint>

#ifndef MK_N_LAUNCHES
#define MK_N_LAUNCHES 1
#endif

namespace pg8 {
#define PG8_LAS __attribute__((address_space(3)))
typedef unsigned short bf16_t;
typedef short bf16x8 __attribute__((ext_vector_type(8)));
typedef float f32x4 __attribute__((ext_vector_type(4)));
typedef unsigned u32x4 __attribute__((ext_vector_type(4)));
constexpr int BM = 256, BK = 64, HALF = 128, HTB = HALF * BK * 2  , STAGE_BYTES = 8 * HTB, NXCD = 8, WGM = 8;

__host__ __device__ __forceinline__ int lds_byte(int r, int c) { const int st = (r >> 4) * 2 + (c >> 5), rr = r & 15, cc = c & 31, ob = rr * 64 + cc * 2; return st * 1024 + (ob ^ (((ob >> 9) & 1) << 5)); }
__host__ __device__ __forceinline__ void stage_rc(int b, int& R, int& C) { const int st = b / 1024, sb = b % 1024, swz = sb ^ (((sb >> 9) & 1) << 5); R = (st >> 1) * 16 + swz / 64; C = (st & 1) * 32 + (swz % 64) / 2; }
__host__ __device__ __forceinline__ int perm32(int rho) { const int n = rho >> 4, i = rho & 15; return 8 * (i >> 2) + 4 * n + (i & 3); }

struct Unit { int pm, pn, g; };
struct Gemm { const bf16_t* A; const bf16_t* Bt; int lda, ldb, K; };

struct StaticOrder {
    int nM, nN, nwg, G, c;
    __host__ __device__ void init(int M, int N, int G_, int c_) { nM = M / BM; nN = N / BM; nwg = nM * nN; G = G_; c = c_; }
    __host__ __device__ bool next(int i, Unit& u) const {
        const long L = (long)i * G + c; if (L >= nwg) return false;
        int wgid = (int)L; { const int q = nwg / NXCD, r = nwg % NXCD, xcd = wgid % NXCD, off = wgid / NXCD; wgid = (xcd < r ? xcd * (q + 1) : r * (q + 1) + (xcd - r) * q) + off; }
        const int nig = WGM * nN, gid = wgid / nig, fm = gid * WGM, gsz = (nM - fm) < WGM ? (nM - fm) : WGM;
        u.pm = fm + ((wgid % nig) % gsz); u.pn = (wgid % nig) / gsz; u.g = 0; return true;
    }
    __device__ __forceinline__ const char* aptr(const Gemm& g, const Unit& u) const { return (const char*)g.A + (size_t)u.pm * BM * g.lda * 2; }
    __device__ __forceinline__ const char* bptr(const Gemm& g, const Unit& u) const { return (const char*)g.Bt + (size_t)u.pn * BM * g.ldb * 2; }
    __device__ __forceinline__ void a_ready(const Unit&) const {}
    __device__ __forceinline__ void done(const Unit&) const {}
};
struct FewOrder {
    int nN, n, c;
    __device__ bool next(int i, Unit& u) const { if (i > 0 || c >= n) return false; u.pm = c / nN; u.pn = c % nN; u.g = 0; return true; }
    __device__ __forceinline__ const char* aptr(const Gemm& g, const Unit& u) const { return (const char*)g.A + (size_t)u.pm * BM * g.lda * 2; }
    __device__ __forceinline__ const char* bptr(const Gemm& g, const Unit& u) const { return (const char*)g.Bt + (size_t)u.pn * BM * g.ldb * 2; }
    __device__ __forceinline__ void a_ready(const Unit&) const {}
    __device__ __forceinline__ void done(const Unit&) const {}
};
struct GroupOrder {
    StaticOrder so; int ng; size_t a_gstride, b_gstride;
    __device__ bool next(int i, Unit& u) const { if (i >= ng) return false; if (!so.next(0, u)) return false; u.g = i; return true; }
    __device__ __forceinline__ const char* aptr(const Gemm& g, const Unit& u) const { return (const char*)g.A + (size_t)u.g * a_gstride + (size_t)u.pm * BM * g.lda * 2; }
    __device__ __forceinline__ const char* bptr(const Gemm& g, const Unit& u) const { return (const char*)g.Bt + (size_t)u.g * b_gstride + (size_t)u.pn * BM * g.ldb * 2; }
    __device__ __forceinline__ void a_ready(const Unit&) const {}
    __device__ __forceinline__ void done(const Unit&) const {}
};

__device__ __forceinline__ unsigned cvt_pk_bf16(float lo, float hi) { unsigned r; asm volatile("v_cvt_pk_bf16_f32 %0, %1, %2" : "=v"(r) : "v"(lo), "v"(hi)); return r; }
__device__ __forceinline__ float bf_lo(unsigned x) { return __uint_as_float(x << 16); }
__device__ __forceinline__ float bf_hi(unsigned x) { return __uint_as_float(x & 0xffff0000u); }
__device__ __forceinline__ float sigmoidf_(float x) { return 1.0f / (1.0f + __expf(-x)); }

struct EpiProj {
    static constexpr bool PERM = true, AFTER_DRAIN = false;
    bf16_t* O; int ldc; const float* bias; int split_cols; size_t split_stride; int n_sig_bias, sig_lo, sig_hi;
    __device__ __forceinline__ void operator()(const f32x4 (&acc)[2][2][4][2], const Unit& u, int wr, int wc, int fr, int fq) const {
        const int row0 = u.pm * BM + wr * 64 + fr; int colt = u.pn * BM; bf16_t* base = O;
        if (split_cols) { const int t = colt / split_cols; base += (size_t)t * split_stride; colt -= t * split_cols; }
        const int col0 = colt + wc * 32 + 8 * fq, bcol0 = u.pn * BM + wc * 32 + 8 * fq;
        const int mode = (u.pn < n_sig_bias) ? 1 : ((u.pn >= sig_lo && u.pn < sig_hi) ? 2 : 0);
        f32x4 bv[2][2];
#pragma unroll
        for (int bj = 0; bj < 2; ++bj)
#pragma unroll
            for (int n = 0; n < 2; ++n) bv[bj][n] = (mode == 1) ? *(const f32x4*)(bias + bcol0 + bj * HALF + 4 * n) : (f32x4){0.f, 0.f, 0.f, 0.f};
#pragma unroll
        for (int ai = 0; ai < 2; ++ai)
#pragma unroll
            for (int m = 0; m < 4; ++m) { bf16_t* rowp = base + (size_t)(row0 + ai * HALF + m * 16) * ldc + col0;
#pragma unroll
                for (int bj = 0; bj < 2; ++bj) { f32x4 v0 = acc[ai][bj][m][0] + bv[bj][0], v1 = acc[ai][bj][m][1] + bv[bj][1];
                    if (mode != 0) {
#pragma unroll
                        for (int e = 0; e < 4; ++e) { v0[e] = sigmoidf_(v0[e]); v1[e] = sigmoidf_(v1[e]); } }
                    u32x4 w; w.x = cvt_pk_bf16(v0[0], v0[1]); w.y = cvt_pk_bf16(v0[2], v0[3]); w.z = cvt_pk_bf16(v1[0], v1[1]); w.w = cvt_pk_bf16(v1[2], v1[3]);
                    *(u32x4*)(rowp + bj * HALF) = w; } }
    }
};

struct EpiBranch {
    static constexpr bool PERM = true, AFTER_DRAIN = false;
    const bf16_t* gates; size_t gate_stride; bf16_t* merged;
    __device__ __forceinline__ void operator()(const f32x4 (&acc)[2][2][4][2], const Unit& u, int wr, int wc, int fr, int fq) const {
        const int row0 = u.pm * BM + wr * 64 + fr; const int col0 = u.pn * BM + wc * 32 + 8 * fq;
#pragma unroll
        for (int ai = 0; ai < 2; ++ai)
#pragma unroll
            for (int m = 0; m < 4; ++m) { const size_t row = (size_t)(row0 + ai * HALF + m * 16);
#pragma unroll
                for (int bj = 0; bj < 2; ++bj) { const int c = col0 + bj * HALF; const int gc = u.g * 1024 + c;
                    const u32x4 gw = *(const u32x4*)(gates + (size_t)(gc >> 9) * gate_stride + row * 512 + (gc & 511));
                    bf16_t* mp = merged + row * 1024 + c;
                    f32x4 v0 = acc[ai][bj][m][0], v1 = acc[ai][bj][m][1];
                    v0[0] *= bf_lo(gw.x); v0[1] *= bf_hi(gw.x); v0[2] *= bf_lo(gw.y); v0[3] *= bf_hi(gw.y);
                    v1[0] *= bf_lo(gw.z); v1[1] *= bf_hi(gw.z); v1[2] *= bf_lo(gw.w); v1[3] *= bf_hi(gw.w);
                    if (u.g > 0) { const u32x4 pv = *(const u32x4*)mp;
                        v0[0] += bf_lo(pv.x); v0[1] += bf_hi(pv.x); v0[2] += bf_lo(pv.y); v0[3] += bf_hi(pv.y);
                        v1[0] += bf_lo(pv.z); v1[1] += bf_hi(pv.z); v1[2] += bf_lo(pv.w); v1[3] += bf_hi(pv.w); }
                    u32x4 w; w.x = cvt_pk_bf16(v0[0], v0[1]); w.y = cvt_pk_bf16(v0[2], v0[3]); w.z = cvt_pk_bf16(v1[0], v1[1]); w.w = cvt_pk_bf16(v1[2], v1[3]);
                    *(u32x4*)mp = w; } }
    }
};

struct EpiOut {
    static constexpr bool PERM = true, AFTER_DRAIN = false;
    const float* x; float* out; bf16_t* h1b; float* sumsq;
    __device__ __forceinline__ void operator()(const f32x4 (&acc)[2][2][4][2], const Unit& u, int wr, int wc, int fr, int fq) const {
        const int row0 = u.pm * BM + wr * 64 + fr; const int col0 = u.pn * BM + wc * 32 + 8 * fq;
#pragma unroll
        for (int ai = 0; ai < 2; ++ai)
#pragma unroll
            for (int m = 0; m < 4; ++m) { const size_t row = (size_t)(row0 + ai * HALF + m * 16); float ss = 0.f;
#pragma unroll
                for (int bj = 0; bj < 2; ++bj) { const size_t off = row * 1024 + col0 + bj * HALF;
                    const f32x4 x0 = *(const f32x4*)(x + off), x1 = *(const f32x4*)(x + off + 4);
                    const f32x4 v0 = acc[ai][bj][m][0] + x0, v1 = acc[ai][bj][m][1] + x1;
                    *(f32x4*)(out + off) = v0; *(f32x4*)(out + off + 4) = v1;
                    ss += (v0[0] * v0[0] + v0[1] * v0[1]) + (v0[2] * v0[2] + v0[3] * v0[3]) + (v1[0] * v1[0] + v1[1] * v1[1]) + (v1[2] * v1[2] + v1[3] * v1[3]);
                    u32x4 w; w.x = cvt_pk_bf16(v0[0], v0[1]); w.y = cvt_pk_bf16(v0[2], v0[3]); w.z = cvt_pk_bf16(v1[0], v1[1]); w.w = cvt_pk_bf16(v1[2], v1[3]);
                    *(u32x4*)(h1b + off) = w; }
                ss += __shfl_xor(ss, 16); ss += __shfl_xor(ss, 32);
                if (fq == 0) atomicAdd(sumsq + row, ss); }
    }
};

struct EpiQry {
    static constexpr bool PERM = true, AFTER_DRAIN = false;
    const float* sumsq; bf16_t* qry; float eps;
    __device__ __forceinline__ void operator()(const f32x4 (&acc)[2][2][4][2], const Unit& u, int wr, int wc, int fr, int fq) const {
        const int row0 = u.pm * BM + wr * 64 + fr; const int col0 = u.pn * BM + wc * 32 + 8 * fq;
#pragma unroll
        for (int ai = 0; ai < 2; ++ai)
#pragma unroll
            for (int m = 0; m < 4; ++m) { const size_t row = (size_t)(row0 + ai * HALF + m * 16);
                const float rs = __builtin_amdgcn_rsqf(__hip_atomic_load(sumsq + row, __ATOMIC_RELAXED, __HIP_MEMORY_SCOPE_AGENT) * (1.0f / 1024.0f) + eps);
#pragma unroll
                for (int bj = 0; bj < 2; ++bj) { const f32x4 v0 = acc[ai][bj][m][0] * rs, v1 = acc[ai][bj][m][1] * rs;
                    u32x4 w; w.x = cvt_pk_bf16(v0[0], v0[1]); w.y = cvt_pk_bf16(v0[2], v0[3]); w.z = cvt_pk_bf16(v1[0], v1[1]); w.w = cvt_pk_bf16(v1[2], v1[3]);
                    *(u32x4*)(qry + row * 2048 + col0 + bj * HALF) = w; } }
    }
};

template <class Epi, class Sched, bool ALIGN_EPI = false, bool SP2 = false>
__device__ __forceinline__ void gemm_phase(PG8_LAS unsigned char* lds, const Gemm g, const Sched& S, const Epi& E) {
    const int tid = threadIdx.x, wid = __builtin_amdgcn_readfirstlane(tid >> 6), lane = tid & 63, wr = wid >> 2, wc = wid & 3, fr = lane & 15, fq = lane >> 4;
    const int K = g.K, nt = K / BK;
    unsigned voffA[2], voffB[2];
#pragma unroll
    for (int i = 0; i < 2; ++i) { int R, C; stage_rc(tid * 16 + i * 8192, R, C); const int Rb = Epi::PERM ? ((R & ~31) + perm32(R & 31)) : R;
        voffA[i] = (unsigned)(R * g.lda + C) * 2u; voffB[i] = (unsigned)(Rb * g.ldb + C) * 2u; }
    const size_t kstep = (size_t)(BK * 2);
    const size_t hstepA = (size_t)HALF * g.lda * 2, hstepB = (size_t)HALF * g.ldb * 2;
    const unsigned ldsw = (unsigned)wid * 1024u;
    const int aoff = lds_byte(wr * 64 + fr, fq * 8), boff = lds_byte(wc * 32 + fr, fq * 8);
#define PG8_SA(b, h) (((b) * 2 + (h)) * HTB)
#define PG8_SB(b, h) ((4 + (b) * 2 + (h)) * HTB)
#define PG8_STAGE(bufoff, gbase, voff) do { _Pragma("unroll") for (int _i = 0; _i < 2; ++_i) \
        __builtin_amdgcn_global_load_lds((const unsigned*)((const char*)(gbase) + (voff)[_i]), (PG8_LAS unsigned*)(lds + (bufoff) + ldsw + _i * 8192), 16, 0, 0); } while (0)
#define PG8_LDA(dst, b, h) do { _Pragma("unroll") for (int m = 0; m < 4; ++m) _Pragma("unroll") for (int k = 0; k < 2; ++k) dst[m][k] = *(const PG8_LAS bf16x8*)(lds + PG8_SA(b, h) + aoff + m * 2048 + k * 1024); } while (0)
#define PG8_LDB(dst, b, h) do { _Pragma("unroll") for (int n = 0; n < 2; ++n) _Pragma("unroll") for (int k = 0; k < 2; ++k) dst[n][k] = *(const PG8_LAS bf16x8*)(lds + PG8_SB(b, h) + boff + n * 2048 + k * 1024); } while (0)
#define PG8_MMA(ai, bj, At, Bt) do { __builtin_amdgcn_s_setprio(1); _Pragma("unroll") for (int m = 0; m < 4; ++m) _Pragma("unroll") for (int n = 0; n < 2; ++n) _Pragma("unroll") for (int k = 0; k < 2; ++k) \
        acc[ai][bj][m][n] = __builtin_amdgcn_mfma_f32_16x16x32_bf16(Bt[n][k], At[m][k], acc[ai][bj][m][n], 0, 0, 0); __builtin_amdgcn_s_setprio(0); } while (0)
#define PG8_WAIT_V(n) asm volatile("s_waitcnt vmcnt(" #n ")" ::: "memory")
#define PG8_WAIT_L(n) asm volatile("s_waitcnt lgkmcnt(" #n ")" ::: "memory")
#define PG8_BAR __builtin_amdgcn_s_barrier()
#define PG8_SCHED __builtin_amdgcn_sched_barrier(0)
    Unit cur, nxt; int ui = 0;
    if (!S.next(0, cur)) return;
    f32x4 acc[2][2][4][2];
#pragma unroll
    for (int a = 0; a < 2; ++a)
#pragma unroll
        for (int b = 0; b < 2; ++b)
#pragma unroll
            for (int m = 0; m < 4; ++m)
#pragma unroll
                for (int n = 0; n < 2; ++n) acc[a][b][m][n] = (f32x4){0.f, 0.f, 0.f, 0.f};
    bf16x8 At[4][2], B0[2][2], B1[2][2];
    const char* cA = S.aptr(g, cur); const char* cB = S.bptr(g, cur);
    S.a_ready(cur);
    if constexpr (SP2) {
        PG8_STAGE(PG8_SB(0, 0), cB, voffB); PG8_STAGE(PG8_SB(0, 1), cB + hstepB, voffB); PG8_STAGE(PG8_SA(0, 0), cA, voffA); PG8_STAGE(PG8_SA(0, 1), cA + hstepA, voffA);
        if (wr == 1) PG8_BAR;
        PG8_WAIT_V(2); PG8_BAR;
        PG8_STAGE(PG8_SB(1, 0), cB + kstep, voffB); PG8_STAGE(PG8_SA(1, 0), cA + kstep, voffA); PG8_STAGE(PG8_SB(1, 1), cB + hstepB + kstep, voffB);
        PG8_WAIT_V(6); PG8_BAR;
    } else {
        PG8_STAGE(PG8_SB(0, 0), cB, voffB); PG8_STAGE(PG8_SA(0, 0), cA, voffA); PG8_STAGE(PG8_SB(0, 1), cB + hstepB, voffB); PG8_STAGE(PG8_SA(0, 1), cA + hstepA, voffA);
        if (wr == 1) PG8_BAR;
        PG8_WAIT_V(4); PG8_BAR;
        PG8_STAGE(PG8_SB(1, 0), cB + kstep, voffB); PG8_STAGE(PG8_SA(1, 0), cA + kstep, voffA); PG8_STAGE(PG8_SB(1, 1), cB + hstepB + kstep, voffB);
        PG8_WAIT_V(6); PG8_BAR;
    }
    for (;;) {
        const bool has_next = S.next(ui + 1, nxt);
        const char* nA = has_next ? S.aptr(g, nxt) : cA; const char* nB = has_next ? S.bptr(g, nxt) : cB;
        for (int t = 0; t < nt; t += 2) {
            const bool last = (t == nt - 2);
            const char* a1 = cA + (size_t)(t + 1) * kstep;
            const char* a2 = last ? nA : cA + (size_t)(t + 2) * kstep; const char* b2 = last ? nB : cB + (size_t)(t + 2) * kstep;
            const char* a3 = a2 + kstep; const char* b3 = b2 + kstep;
            if (last && has_next) S.a_ready(nxt);
            if constexpr (SP2) {
            PG8_LDB(B0, 0, 0); PG8_LDB(B1, 0, 1); PG8_SCHED; PG8_LDA(At, 0, 0); PG8_STAGE(PG8_SA(1, 1), a1 + hstepA, voffA);
            PG8_WAIT_V(8); PG8_WAIT_L(0); PG8_BAR; PG8_MMA(0, 0, At, B0); PG8_MMA(0, 1, At, B1); PG8_BAR; PG8_SCHED;
            PG8_LDA(At, 0, 1); PG8_STAGE(PG8_SB(0, 0), b2, voffB); PG8_STAGE(PG8_SB(0, 1), b2 + hstepB, voffB); PG8_STAGE(PG8_SA(0, 0), a2, voffA);
            PG8_WAIT_V(8); PG8_WAIT_L(0); PG8_BAR; PG8_MMA(1, 0, At, B0); PG8_MMA(1, 1, At, B1); PG8_BAR; PG8_SCHED;
            PG8_LDB(B0, 1, 0); PG8_LDB(B1, 1, 1); PG8_SCHED; PG8_LDA(At, 1, 0); PG8_STAGE(PG8_SA(0, 1), a2 + hstepA, voffA);
            PG8_WAIT_V(8); PG8_WAIT_L(0); PG8_BAR; PG8_MMA(0, 0, At, B0); PG8_MMA(0, 1, At, B1); PG8_BAR; PG8_SCHED;
            PG8_LDA(At, 1, 1); PG8_STAGE(PG8_SB(1, 0), b3, voffB); PG8_STAGE(PG8_SB(1, 1), b3 + hstepB, voffB); PG8_STAGE(PG8_SA(1, 0), a3, voffA);
            PG8_WAIT_V(8); PG8_WAIT_L(0); PG8_BAR; PG8_MMA(1, 0, At, B0); PG8_MMA(1, 1, At, B1); PG8_BAR; PG8_SCHED;
            } else {
            PG8_LDB(B0, 0, 0); PG8_SCHED; PG8_LDA(At, 0, 0); PG8_STAGE(PG8_SA(1, 1), a1 + hstepA, voffA);
            PG8_WAIT_L(8); PG8_BAR; PG8_WAIT_L(0); PG8_MMA(0, 0, At, B0); PG8_BAR; PG8_SCHED;
            PG8_LDB(B1, 0, 1); PG8_STAGE(PG8_SB(0, 0), b2, voffB);
            PG8_BAR; PG8_WAIT_L(0); PG8_MMA(0, 1, At, B1); PG8_BAR;
            PG8_LDA(At, 0, 1); PG8_STAGE(PG8_SA(0, 0), a2, voffA);
            PG8_BAR; PG8_WAIT_L(0); PG8_MMA(1, 0, At, B0); PG8_BAR; PG8_SCHED;
            PG8_STAGE(PG8_SB(0, 1), b2 + hstepB, voffB);
            PG8_WAIT_V(6); PG8_BAR; PG8_MMA(1, 1, At, B1); PG8_BAR;
            PG8_LDB(B0, 1, 0); PG8_SCHED; PG8_LDA(At, 1, 0); PG8_STAGE(PG8_SA(0, 1), a2 + hstepA, voffA);
            PG8_WAIT_L(8); PG8_BAR; PG8_WAIT_L(0); PG8_MMA(0, 0, At, B0); PG8_BAR; PG8_SCHED;
            PG8_LDB(B1, 1, 1); PG8_STAGE(PG8_SB(1, 0), b3, voffB);
            PG8_BAR; PG8_WAIT_L(0); PG8_MMA(0, 1, At, B1); PG8_BAR;
            PG8_LDA(At, 1, 1); PG8_STAGE(PG8_SA(1, 0), a3, voffA);
            PG8_BAR; PG8_WAIT_L(0); PG8_MMA(1, 0, At, B0); PG8_BAR; PG8_SCHED;
            PG8_STAGE(PG8_SB(1, 1), b3 + hstepB, voffB);
            PG8_WAIT_V(6); PG8_BAR; PG8_MMA(1, 1, At, B1); PG8_BAR;
            }
        }
        if constexpr (ALIGN_EPI) { if (wr == 0) PG8_BAR; }
        if constexpr (!Epi::AFTER_DRAIN) { E(acc, cur, wr, wc, fr, fq); S.done(cur); }
        if (!has_next) break;
#pragma unroll
        for (int a = 0; a < 2; ++a)
#pragma unroll
            for (int b = 0; b < 2; ++b)
#pragma unroll
                for (int m = 0; m < 4; ++m)
#pragma unroll
                    for (int n = 0; n < 2; ++n) acc[a][b][m][n] = (f32x4){0.f, 0.f, 0.f, 0.f};
        cur = nxt; cA = nA; cB = nB; ++ui;
        if constexpr (ALIGN_EPI) { if (wr == 1) PG8_BAR; }
    }
    PG8_WAIT_V(0);
    if constexpr (!ALIGN_EPI) { if (wr == 0) PG8_BAR; }
    PG8_BAR;
    if constexpr (Epi::AFTER_DRAIN) { E.fused(acc, cur, wr, wc, fr, fq, lds, wid, lane); S.done(cur); }
#undef PG8_SA
#undef PG8_SB
#undef PG8_STAGE
#undef PG8_LDA
#undef PG8_LDB
#undef PG8_MMA
#undef PG8_WAIT_V
#undef PG8_WAIT_L
#undef PG8_BAR
#undef PG8_SCHED
}
}

#ifndef PROBE_PH
#define PROBE_PH -1
#endif
constexpr int NWAVES = 8;
constexpr int N_LAUNCHES = MK_N_LAUNCHES;
constexpr int PER_PHASE = 12;

constexpr int T_TOK = 16384, DM = 1024, SEQ = 8192;
constexpr float EPS = 1e-6f;
constexpr int W_IN_COLS = 7176;

constexpr size_t MiB = 1u << 20;
constexpr size_t WS_CTL = 0, CTL_ZERO_BYTES = 1 * MiB;
constexpr size_t WS_WIN = 1 * MiB, WS_WKV = 15 * MiB, WS_WBR = 17 * MiB, WS_WOUT = 20 * MiB, WS_WPQ = 22 * MiB, WS_PK = 26 * MiB;
constexpr size_t WS_KVMEM = 26 * MiB + 512 * 1024, WS_MEMN = 27 * MiB + 512 * 1024, WS_IGLF = 28 * MiB + 512 * 1024, WS_ND = 29 * MiB, WS_NS = 29 * MiB + 512 * 1024;
constexpr size_t WS_GATES = 30 * MiB;
constexpr size_t WS_MLQ = 126 * MiB, WS_MLK = 142 * MiB, WS_SBQ = 158 * MiB, WS_MLV = 174 * MiB, WS_MEMQ = 190 * MiB, WS_MLO = 206 * MiB, WS_SBK = 222 * MiB, WS_SBV = 238 * MiB;
constexpr size_t WS_UT8 = 30 * MiB, WS_VT8 = 46 * MiB, WS_USC = 94 * MiB, WS_VSC = 94 * MiB + 65536;
constexpr size_t WS_H1B = 126 * MiB;
constexpr size_t WS_QRY = 158 * MiB;
constexpr size_t WS_CT = 222 * MiB;
constexpr size_t WS_MERGED = 222 * MiB;
constexpr size_t WS_IDX = 222 * MiB, WS_GW = 230 * MiB;
constexpr size_t WS_PD = 158 * MiB;
constexpr size_t WS_END = 254 * MiB;
constexpr size_t SPLIT_STRIDE = (size_t)T_TOK * 512;
constexpr size_t CTL_CHS = 256 * 1024, CTL_MS = 272 * 1024, CTL_SUMSQ = 512 * 1024;
constexpr int CW_BAR = 4096;

constexpr int RING_BYTES = 131072;
constexpr int LDSCTL_OFF = 155648, MISC_OFF = LDSCTL_OFF + 320;
constexpr int LDS_BYTES = 163840;

#define GAS __attribute__((address_space(1)))
#define LAS __attribute__((address_space(3)))
typedef unsigned short bf16;
typedef unsigned v4u __attribute__((ext_vector_type(4)));
typedef unsigned v2u __attribute__((ext_vector_type(2)));
typedef float f32x4 __attribute__((ext_vector_type(4)));
typedef short bf16x8 __attribute__((ext_vector_type(8)));
typedef GAS unsigned gu32;
#define RLX_AGENT __ATOMIC_RELAXED, __HIP_MEMORY_SCOPE_AGENT
#define LDS_WAIT() asm volatile("s_waitcnt lgkmcnt(0)" ::: "memory")
#define VM_WAIT() asm volatile("s_waitcnt vmcnt(0)" ::: "memory")
__device__ __forceinline__ unsigned f2bf(float f) { unsigned u = __builtin_bit_cast(unsigned, f); return (u + 0x7fffu + ((u >> 16) & 1u)) >> 16; }
__device__ __forceinline__ unsigned pk2(float lo, float hi) { return f2bf(lo) | (f2bf(hi) << 16); }
__device__ __forceinline__ float bflo(unsigned x) { return __uint_as_float(x << 16); }
__device__ __forceinline__ float bfhi(unsigned x) { return __uint_as_float(x & 0xffff0000u); }
__device__ __forceinline__ float sigm(float x) { return 1.0f / (1.0f + __expf(-x)); }
__device__ __forceinline__ float softplusf_(float z) { return fmaxf(z, 0.f) + __logf(1.0f + __expf(-fabsf(z))); }

#define XB_TMO      128
#define XB_XCNT(j)  (256  + 64 * (j))
#define XB_XSUB(j)  (1280 + 64 * (j))
#define XB_XGEN(j)  (2304 + 64 * (j))
#define XB_TOP      3328
#define XB_TOPGEN   3392
#define XCD_BAR_WORDS 3456
#define XB_SPIN_CAP (1u << 18)
__device__ __forceinline__ unsigned xb_ld(unsigned* p)              { return __hip_atomic_load(p, __ATOMIC_RELAXED, __HIP_MEMORY_SCOPE_AGENT); }
__device__ __forceinline__ unsigned xb_add(unsigned* p, unsigned v) { return __hip_atomic_fetch_add(p, v, __ATOMIC_RELAXED, __HIP_MEMORY_SCOPE_AGENT); }
__device__ __forceinline__ unsigned xb_xcc_id() { return (unsigned)__builtin_amdgcn_s_getreg((3 << 11) | 20) & 0xFu; }
#define XB_SPIN(cond, bar) do { unsigned _sp = 0; while (cond) { __builtin_amdgcn_s_sleep(1); \
    if ((++_sp & 255u) == 0u) { if (xb_ld(&(bar)[XB_TMO])) break; if (_sp > XB_SPIN_CAP) { atomicAdd(&(bar)[XB_TMO], 1u); break; } } } } while (0)
struct XcdBarrier { unsigned* bar; unsigned x; volatile LAS unsigned* st; };
__device__ __forceinline__ XcdBarrier xcd_barrier_post(unsigned* bar, volatile LAS unsigned* st) {
    XcdBarrier b; b.bar = bar; b.x = xb_xcc_id(); b.st = st;
    if (threadIdx.x == 0) (void)xb_add(&bar[XB_XCNT(b.x)], 1u);
    return b;
}
__device__ __forceinline__ void xcd_barrier_complete(unsigned* bar, unsigned x, unsigned& nloc, unsigned& nx) {
    const unsigned G = gridDim.x * gridDim.y * gridDim.z;
    unsigned sum, cnt, mine, sp = 0u;
    for (;;) {
        sum = 0u; cnt = 0u; mine = 0u;
#pragma unroll
        for (unsigned j = 0; j < 16; ++j) { const unsigned c = xb_ld(&bar[XB_XCNT(j)]); sum += c; cnt += (c > 0u) ? 1u : 0u; mine = (j == x) ? c : mine; }
        if (sum == G) break;
        __builtin_amdgcn_s_sleep(1);
        if ((++sp & 255u) == 0u) { if (xb_ld(&bar[XB_TMO])) break; if (sp > XB_SPIN_CAP) { atomicAdd(&bar[XB_TMO], 1u); break; } }
    }
    nloc = mine > 0u ? mine : 1u; nx = cnt > 0u ? cnt : 1u;
}
__device__ __forceinline__ void xcd_barrier(const XcdBarrier& b) {
    asm volatile("s_waitcnt vmcnt(0)" ::: "memory");
    __syncthreads();
    if (threadIdx.x == 0) {
        unsigned* bar = b.bar;
        __builtin_amdgcn_s_waitcnt(0);
        unsigned nloc = b.st[0], nx = b.st[1];
        if (nloc == 0u) { xcd_barrier_complete(bar, b.x, nloc, nx); b.st[0] = nloc; b.st[1] = nx; }
        const unsigned old = xb_add(&bar[XB_XSUB(b.x)], 1u);
        const unsigned gen = old / nloc;
        if (old + 1u == (gen + 1u) * nloc) {
            __builtin_amdgcn_fence(__ATOMIC_RELEASE, "agent");
            asm volatile("s_waitcnt vmcnt(0)" ::: "memory");
            const unsigned og = xb_add(&bar[XB_TOP], 1u);
            const unsigned tg = og / nx;
            if (og + 1u == (tg + 1u) * nx) xb_add(&bar[XB_TOPGEN], 1u);
            else XB_SPIN(xb_ld(&bar[XB_TOPGEN]) == tg, bar);
            __builtin_amdgcn_fence(__ATOMIC_ACQUIRE, "agent");
            xb_add(&bar[XB_XGEN(b.x)], 1u);
            asm volatile("s_waitcnt vmcnt(0)" ::: "memory");
        } else {
            XB_SPIN(xb_ld(&bar[XB_XGEN(b.x)]) == gen, bar);
            __builtin_amdgcn_fence(__ATOMIC_ACQUIRE, "agent");
            asm volatile("s_waitcnt vmcnt(0)" ::: "memory");
        }
    }
    __syncthreads();
}

struct Frame {
    LAS unsigned char* lds;
    volatile LAS unsigned* MISC;
    int tid, lane, wave, G;
    unsigned char* ws; float* out;
    const float* in[24];
};
__device__ __forceinline__ float wave_sum(float v) {
#pragma unroll
    for (int o = 1; o < 64; o <<= 1) v += __shfl_xor(v, o);
    return v;
}
__device__ __forceinline__ float wave_max(float v) {
#pragma unroll
    for (int o = 1; o < 64; o <<= 1) v = fmaxf(v, __shfl_xor(v, o));
    return v;
}

template <int NT, int KS>
__device__ __forceinline__ void wave_mma(f32x4 (&acc)[NT], const LAS unsigned char* A, int pitchA, int m0, const LAS unsigned char* Bt, int pitchB, int n0, int lane, int koffA = 0, int koffB = 0) {
    const int r = lane & 15, q = lane >> 4;
#pragma unroll
    for (int ks = 0; ks < KS; ++ks) {
        const bf16x8 a = *(const LAS bf16x8*)(A + (m0 + r) * pitchA + (koffA + ks * 32 + q * 8) * 2);
#pragma unroll
        for (int j = 0; j < NT; ++j) {
            const bf16x8 b = *(const LAS bf16x8*)(Bt + (n0 + 16 * j + r) * pitchB + (koffB + ks * 32 + q * 8) * 2);
            acc[j] = __builtin_amdgcn_mfma_f32_16x16x32_bf16(a, b, acc[j], 0, 0, 0);
        }
    }
}
__device__ __forceinline__ void lds_store_tr8(LAS unsigned char* base, int pitch, int d0, int col, v4u v) {
    *(LAS unsigned short*)(base + (d0 + 0) * pitch + col * 2) = (unsigned short)(v.x & 0xffffu); *(LAS unsigned short*)(base + (d0 + 1) * pitch + col * 2) = (unsigned short)(v.x >> 16);
    *(LAS unsigned short*)(base + (d0 + 2) * pitch + col * 2) = (unsigned short)(v.y & 0xffffu); *(LAS unsigned short*)(base + (d0 + 3) * pitch + col * 2) = (unsigned short)(v.y >> 16);
    *(LAS unsigned short*)(base + (d0 + 4) * pitch + col * 2) = (unsigned short)(v.z & 0xffffu); *(LAS unsigned short*)(base + (d0 + 5) * pitch + col * 2) = (unsigned short)(v.z >> 16);
    *(LAS unsigned short*)(base + (d0 + 6) * pitch + col * 2) = (unsigned short)(v.w & 0xffffu); *(LAS unsigned short*)(base + (d0 + 7) * pitch + col * 2) = (unsigned short)(v.w >> 16);
}

__device__ __forceinline__ void p0_transpose_item(const float* W, int ldsrc, int src_off, int K, int ncols, bf16* WT, int row_off, const float* kscale, LAS float* scr, int item, int lane) {
    const int nblk = ncols / 32, kb = item / nblk, nb = item % nblk, k0 = 64 * kb, n0 = 32 * nb;
#pragma unroll 8
    for (int i = 0; i < 32; ++i) { const int kk = 2 * i + (lane >> 5); float v = W[(size_t)(k0 + kk) * ldsrc + src_off + n0 + (lane & 31)]; if (kscale) v *= kscale[k0 + kk]; scr[kk * 33 + (lane & 31)] = v; }
    LDS_WAIT(); asm volatile("" ::: "memory");
    const int c = lane & 7;
#pragma unroll
    for (int j = 0; j < 4; ++j) { const int n = (lane >> 3) + 8 * j; const LAS float* s = scr + (8 * c) * 33 + n;
        v4u o; o.x = pk2(s[0 * 33], s[1 * 33]); o.y = pk2(s[2 * 33], s[3 * 33]); o.z = pk2(s[4 * 33], s[5 * 33]); o.w = pk2(s[6 * 33], s[7 * 33]);
        *(GAS v4u*)(WT + (size_t)(row_off + n0 + n) * K + k0 + 8 * c) = o; }
    LDS_WAIT(); asm volatile("" ::: "memory");
}

__device__ __forceinline__ void p0_prologue(Frame& F) {
    const float* x = F.in[0]; const float* mem = F.in[1]; const float* g_mix = F.in[2]; const float* w_in = F.in[3];
    const float* b_ig = F.in[4]; const float* b_fg = F.in[5]; const float* mem_g = F.in[9];
    bf16* XN = (bf16*)F.out;
    bf16* MEMN = (bf16*)(F.ws + WS_MEMN);
    float* IGLF = (float*)(F.ws + WS_IGLF);
    LAS float* gws = (LAS float*)(F.lds + 69632);
    for (int e = F.tid; e < 8192; e += 512) { const int c = e & 7, k = e >> 3; gws[c * 1024 + k] = w_in[(size_t)k * W_IN_COLS + 3072 + c]; }
    __syncthreads();
    const int gw = blockIdx.x * NWAVES + F.wave, NGW = F.G * NWAVES;
    for (int m = gw; m < T_TOK + 512; m += NGW) {
        const bool is_mem = m >= T_TOK;
        const float* src = is_mem ? mem + (size_t)(m - T_TOK) * DM : x + (size_t)m * DM;
        const float* gsrc = is_mem ? mem_g : g_mix;
        bf16* dst = is_mem ? MEMN + (size_t)(m - T_TOK) * DM : XN + (size_t)m * DM;
        const GAS f32x4* xr = (const GAS f32x4*)src + F.lane;
        f32x4 v[4]; float s = 0.f;
#pragma unroll
        for (int j = 0; j < 4; ++j) { v[j] = xr[64 * j]; s += (v[j].x * v[j].x + v[j].y * v[j].y) + (v[j].z * v[j].z + v[j].w * v[j].w); }
        const float rstd = 1.0f / sqrtf(wave_sum(s) * (1.f / DM) + EPS);
#pragma unroll
        for (int j = 0; j < 4; ++j) { const f32x4 gg = *((const GAS f32x4*)gsrc + F.lane + 64 * j); v[j] = v[j] * rstd * gg; }
        GAS unsigned long long* o8 = (GAS unsigned long long*)dst + F.lane;
#pragma unroll
        for (int j = 0; j < 4; ++j) o8[64 * j] = (unsigned long long)pk2(v[j].x, v[j].y) | ((unsigned long long)pk2(v[j].z, v[j].w) << 32);
        if (!is_mem) {
            float dots[8];
#pragma unroll
            for (int c = 0; c < 8; ++c) { float d = 0.f;
#pragma unroll
                for (int j = 0; j < 4; ++j) { const f32x4 wv = *(const LAS f32x4*)(gws + c * 1024 + 256 * j + 4 * F.lane); d += (v[j].x * wv.x + v[j].y * wv.y) + (v[j].z * wv.z + v[j].w * wv.w); }
                dots[c] = wave_sum(d); }
            if (F.lane == 0) {
                f32x4 o0, o1;
#pragma unroll
                for (int h = 0; h < 4; ++h) { o0[h] = dots[h] + b_ig[h]; const float fp = dots[4 + h] + b_fg[h]; o1[h] = fminf(fp, 0.f) - __logf(1.0f + __expf(-fabsf(fp))); }
                *(GAS f32x4*)(IGLF + (size_t)m * 8) = o0; *(GAS f32x4*)(IGLF + (size_t)m * 8 + 4) = o1;
            }
        }
    }
    { const float* k1 = F.in[20]; const float* k2 = F.in[21]; bf16* PK = (bf16*)(F.ws + WS_PK);
      for (int e = (blockIdx.x * 512 + F.tid) * 4; e < 2 * 131072; e += F.G * 512 * 4) {
          const f32x4 vv = (e < 131072) ? *(const GAS f32x4*)(k1 + e) : *(const GAS f32x4*)(k2 + e - 131072);
          v2u o; o.x = pk2(vv.x, vv.y); o.y = pk2(vv.z, vv.w); *(GAS v2u*)(PK + e) = o; } }
    __syncthreads();
    LAS float* scr = (LAS float*)(F.lds + F.wave * 8448);
    bf16* WIN = (bf16*)(F.ws + WS_WIN); bf16* WKV = (bf16*)(F.ws + WS_WKV); bf16* WBR = (bf16*)(F.ws + WS_WBR); bf16* WOUT = (bf16*)(F.ws + WS_WOUT); bf16* WPQ = (bf16*)(F.ws + WS_WPQ);
    constexpr int I_G = 16 * 96, I_5 = 16 * 16, I_KV = 16 * 32, I_BR = 8 * 32, I_OUT = 16 * 32, I_PQ = 16 * 64;
    constexpr int NITEMS = I_G + 8 * I_5 + I_KV + 3 * I_BR + I_OUT + I_PQ;
    for (int it = gw; it < NITEMS; it += NGW) {
        int r = it;
        if (r < I_G) { p0_transpose_item(w_in, W_IN_COLS, 4104, 1024, 3072, WIN, 0, nullptr, scr, r, F.lane); continue; } r -= I_G;
        if (r < I_5) { p0_transpose_item(w_in, W_IN_COLS, 1536, 1024, 512, WIN, 3072, nullptr, scr, r, F.lane); continue; } r -= I_5;
        if (r < I_5) { p0_transpose_item(w_in, W_IN_COLS, 2048, 1024, 512, WIN, 3584, nullptr, scr, r, F.lane); continue; } r -= I_5;
        if (r < I_5) { p0_transpose_item(w_in, W_IN_COLS, 0, 1024, 512, WIN, 4096, nullptr, scr, r, F.lane); continue; } r -= I_5;
        if (r < I_5) { p0_transpose_item(w_in, W_IN_COLS, 2560, 1024, 512, WIN, 4608, nullptr, scr, r, F.lane); continue; } r -= I_5;
        if (r < I_5) { p0_transpose_item(w_in, W_IN_COLS, 3592, 1024, 512, WIN, 5120, nullptr, scr, r, F.lane); continue; } r -= I_5;
        if (r < I_5) { p0_transpose_item(w_in, W_IN_COLS, 3080, 1024, 512, WIN, 5632, nullptr, scr, r, F.lane); continue; } r -= I_5;
        if (r < I_5) { p0_transpose_item(w_in, W_IN_COLS, 512, 1024, 512, WIN, 6144, nullptr, scr, r, F.lane); continue; } r -= I_5;
        if (r < I_5) { p0_transpose_item(w_in, W_IN_COLS, 1024, 1024, 512, WIN, 6656, nullptr, scr, r, F.lane); continue; } r -= I_5;
        if (r < I_KV) { p0_transpose_item(F.in[10], 1024, 0, 1024, 1024, WKV, 0, nullptr, scr, r, F.lane); continue; } r -= I_KV;
        if (r < I_BR) { p0_transpose_item(F.in[13], 1024, 0, 512, 1024, WBR, 0, nullptr, scr, r, F.lane); continue; } r -= I_BR;
        if (r < I_BR) { p0_transpose_item(F.in[14], 1024, 0, 512, 1024, WBR, 1024, nullptr, scr, r, F.lane); continue; } r -= I_BR;
        if (r < I_BR) { p0_transpose_item(F.in[15], 1024, 0, 512, 1024, WBR, 2048, nullptr, scr, r, F.lane); continue; } r -= I_BR;
        if (r < I_OUT) { p0_transpose_item(F.in[17], 1024, 0, 1024, 1024, WOUT, 0, nullptr, scr, r, F.lane); continue; } r -= I_OUT;
        p0_transpose_item(F.in[19], 2048, 0, 1024, 2048, WPQ, 0, F.in[18], scr, r, F.lane);
    }
}

__device__ __forceinline__ void sb_attn_item(Frame& F, int item, bf16* outp, size_t rmask) {
    const int bh = item >> 6, qb = item & 63, b = bh >> 3, h = bh & 7;
    const int tid = F.tid, lane = F.lane, w = F.wave;
    LAS unsigned char* Qs = F.lds;
    LAS unsigned char* Ks = F.lds + 18432;
    LAS unsigned char* VTs = F.lds + 27648;
    LAS unsigned char* Ss = F.lds + 36864;
    LAS unsigned char* Ps = F.lds + 71680;
    LAS float* red = (LAS float*)(F.lds + 90112);
    bf16* SBQ = (bf16*)(F.ws + WS_SBQ); const bf16* SBK = (const bf16*)(F.ws + WS_SBK); const bf16* SBV = (const bf16*)(F.ws + WS_SBV);
    const size_t row0 = (size_t)b * SEQ + (size_t)qb * 128;
    __syncthreads();
#pragma unroll
    for (int i = 0; i < 2; ++i) { const int p = tid + 512 * i, r = p >> 3, c = p & 7;
        const v4u v = *(const GAS v4u*)(SBQ + (row0 + r) * 512 + h * 64 + c * 8); *(LAS v4u*)(Qs + r * 144 + c * 16) = v; }
    f32x4 oacc[4];
#pragma unroll
    for (int j = 0; j < 4; ++j) oacc[j] = (f32x4){0.f, 0.f, 0.f, 0.f};
    float R = 0.f;
    const int r = tid >> 2, qd = tid & 3;
    const int tq = qb * 128 + r;
    const int skey = tid >> 3, sc8 = tid & 7;
    v4u kv, vv;
    { const size_t grow = (size_t)b * SEQ + (size_t)(2 * qb + 1) * 64 + skey; kv = *(const GAS v4u*)(SBK + grow * 512 + h * 64 + sc8 * 8); vv = *(const GAS v4u*)(SBV + grow * 512 + h * 64 + sc8 * 8); }
    for (int jb = 2 * qb + 1; jb >= 0; --jb) {
        __syncthreads();
        *(LAS v4u*)(Ks + skey * 144 + sc8 * 16) = kv; lds_store_tr8(VTs, 144, sc8 * 8, skey, vv);
        if (jb > 0) { const size_t grow = (size_t)b * SEQ + (size_t)(jb - 1) * 64 + skey; kv = *(const GAS v4u*)(SBK + grow * 512 + h * 64 + sc8 * 8); vv = *(const GAS v4u*)(SBV + grow * 512 + h * 64 + sc8 * 8); }
        __syncthreads();
        { f32x4 sacc[4];
#pragma unroll
          for (int j = 0; j < 4; ++j) sacc[j] = (f32x4){0.f, 0.f, 0.f, 0.f};
          wave_mma<4, 2>(sacc, Qs, 144, 16 * w, Ks, 144, 0, lane);
#pragma unroll
          for (int j = 0; j < 4; ++j)
#pragma unroll
              for (int rg = 0; rg < 4; ++rg) *(LAS float*)(Ss + (16 * w + 4 * (lane >> 4) + rg) * 272 + (16 * j + (lane & 15)) * 4) = sacc[j][rg]; }
        __syncthreads();
        { float z[16];
#pragma unroll
          for (int i4 = 0; i4 < 4; ++i4) { const f32x4 t4 = *(const LAS f32x4*)(Ss + r * 272 + qd * 64 + i4 * 16); z[4 * i4] = t4.x; z[4 * i4 + 1] = t4.y; z[4 * i4 + 2] = t4.z; z[4 * i4 + 3] = t4.w; }
          const int s0 = jb * 64 + qd * 16;
          float suf[16], lb[16]; float run = 0.f;
#pragma unroll
          for (int i = 15; i >= 0; --i) { const float zz = z[i] * 0.125f; const bool mk = (s0 + i) < tq; const float sp = softplusf_(zz); lb[i] = zz - sp; suf[i] = run; run += mk ? -sp : 0.f; }
          const float a1 = __shfl_xor(run, 1), a2 = __shfl_xor(run, 2), a3 = __shfl_xor(run, 3);
          const float off = ((qd & 1) == 0 ? a1 : 0.f) + ((qd & 2) == 0 ? a2 : 0.f) + (qd < 2 ? a3 : 0.f);
          const float base = R + off;
          unsigned pw[8];
#pragma unroll
          for (int i = 0; i < 16; i += 2) { const float p0 = ((s0 + i) < tq) ? __expf(lb[i] + base + suf[i]) : 0.f; const float p1 = ((s0 + i + 1) < tq) ? __expf(lb[i + 1] + base + suf[i + 1]) : 0.f; pw[i >> 1] = pk2(p0, p1); }
          *(LAS v4u*)(Ps + r * 144 + qd * 32) = (v4u){pw[0], pw[1], pw[2], pw[3]}; *(LAS v4u*)(Ps + r * 144 + qd * 32 + 16) = (v4u){pw[4], pw[5], pw[6], pw[7]};
          R += run + a1 + a2 + a3; }
        const float rm = wave_max(R);
        if (lane == 0) red[w] = rm;
        __syncthreads();
        wave_mma<4, 2>(oacc, Ps, 144, 16 * w, VTs, 144, 0, lane);
        float rmax = red[0];
#pragma unroll
        for (int i = 1; i < 8; ++i) rmax = fmaxf(rmax, red[i]);
        if (rmax < -110.f) break;
    }
    LDS_WAIT();
#pragma unroll
    for (int j = 0; j < 4; ++j)
#pragma unroll
        for (int rg = 0; rg < 4; ++rg) *(LAS unsigned short*)(Ps + (16 * w + 4 * (lane >> 4) + rg) * 144 + (16 * j + (lane & 15)) * 2) = (unsigned short)f2bf(oacc[j][rg]);
    LDS_WAIT();
#pragma unroll
    for (int i = 0; i < 2; ++i) { const int p = lane + 64 * i, rr = 16 * w + (p >> 3), c = p & 7;
        const v4u v = *(const LAS v4u*)(Ps + rr * 144 + c * 16); *(GAS v4u*)(outp + ((row0 + rr) & rmask) * 512 + h * 64 + c * 8) = v; }
}

__device__ __forceinline__ void conv16(const bf16* src, int col, const float* cw, const float* cb, int ch, int b, int t, float (&y)[16]) {
#pragma unroll
    for (int i4 = 0; i4 < 4; ++i4) { const f32x4 bb = *(const GAS f32x4*)(cb + ch + 4 * i4); y[4 * i4] = bb.x; y[4 * i4 + 1] = bb.y; y[4 * i4 + 2] = bb.z; y[4 * i4 + 3] = bb.w; }
#pragma unroll
    for (int kk = 0; kk < 4; ++kk) { const int tt = t - 3 + kk;
        if (tt >= 0) { const bf16* p = src + ((size_t)b * SEQ + tt) * 512 + col; const v4u x0 = *(const GAS v4u*)p, x1 = *(const GAS v4u*)(p + 8);
            const float xs[16] = {bflo(x0.x), bfhi(x0.x), bflo(x0.y), bfhi(x0.y), bflo(x0.z), bfhi(x0.z), bflo(x0.w), bfhi(x0.w), bflo(x1.x), bfhi(x1.x), bflo(x1.y), bfhi(x1.y), bflo(x1.z), bfhi(x1.z), bflo(x1.w), bfhi(x1.w)};
#pragma unroll
            for (int i4 = 0; i4 < 4; ++i4) { const f32x4 wv = *(const GAS f32x4*)(cw + kk * 1024 + ch + 4 * i4);
                y[4 * i4] += wv.x * xs[4 * i4]; y[4 * i4 + 1] += wv.y * xs[4 * i4 + 1]; y[4 * i4 + 2] += wv.z * xs[4 * i4 + 2]; y[4 * i4 + 3] += wv.w * xs[4 * i4 + 3]; } } }
#pragma unroll
    for (int i = 0; i < 16; ++i) y[i] = y[i] * sigm(y[i]);
}

__device__ __forceinline__ void mlstm_local_item(Frame& F, int item) {
    const int bh = item >> 7, c = item & 127, b = bh >> 2, h = bh & 3;
    const int tid = F.tid, lane = F.lane, w = F.wave;
    LAS float* wsm = (LAS float*)F.lds;
    LAS unsigned char* WKT = F.lds + 256;
    LAS unsigned char* VT = F.lds + 256 + 18432;
    const float* IGLF = (const float*)(F.ws + WS_IGLF);
    float* CHS = (float*)(F.ws + WS_CTL + CTL_CHS);
    const bf16* MLK = (const bf16*)(F.ws + WS_MLK); const bf16* MLV = (const bf16*)(F.ws + WS_MLV);
    float* Dg = F.out + (size_t)item * 16384; float* NDg = (float*)(F.ws + WS_ND) + (size_t)item * 128;
    const int t0 = c * 64; const size_t row0 = (size_t)b * SEQ + t0;
    __syncthreads();
    if (w == 0) {
        const float lf = IGLF[(row0 + lane) * 8 + 4 + h], ig = IGLF[(row0 + lane) * 8 + h];
        float bs = lf;
#pragma unroll
        for (int o = 1; o < 64; o <<= 1) { const float v = __shfl_up(bs, o); if (lane >= o) bs += v; }
        const float blast = __shfl(bs, 63);
        const float a = blast - bs + ig; const float mu = wave_max(a);
        wsm[lane] = __expf(a - mu);
        if (lane == 0) { CHS[2 * item] = blast; CHS[2 * item + 1] = mu; }
    }
    __syncthreads();
    { const int s = tid >> 3, part = tid & 7; float y[16];
      conv16(MLK, h * 128 + part * 16, F.in[6], F.in[7], 512 + h * 128 + part * 16, b, t0 + s, y);
      const float sc = wsm[s] * 0.08838834764831845f;
      v4u k0, k1; k0.x = pk2(y[0] * sc, y[1] * sc); k0.y = pk2(y[2] * sc, y[3] * sc); k0.z = pk2(y[4] * sc, y[5] * sc); k0.w = pk2(y[6] * sc, y[7] * sc);
      k1.x = pk2(y[8] * sc, y[9] * sc); k1.y = pk2(y[10] * sc, y[11] * sc); k1.z = pk2(y[12] * sc, y[13] * sc); k1.w = pk2(y[14] * sc, y[15] * sc);
      lds_store_tr8(WKT, 144, part * 16, s, k0); lds_store_tr8(WKT, 144, part * 16 + 8, s, k1);
      const bf16* vp = MLV + (row0 + s) * 512 + h * 128 + part * 16; const v4u v0 = *(const GAS v4u*)vp, v1 = *(const GAS v4u*)(vp + 8);
      lds_store_tr8(VT, 144, part * 16, s, v0); lds_store_tr8(VT, 144, part * 16 + 8, s, v1); }
    __syncthreads();
    { f32x4 acc[8];
#pragma unroll
      for (int j = 0; j < 8; ++j) acc[j] = (f32x4){0.f, 0.f, 0.f, 0.f};
      wave_mma<8, 2>(acc, VT, 144, 16 * w, WKT, 144, 0, lane);
#pragma unroll
      for (int j = 0; j < 8; ++j)
#pragma unroll
          for (int rg = 0; rg < 4; ++rg) Dg[(16 * w + 4 * (lane >> 4) + rg) * 128 + 16 * j + (lane & 15)] = acc[j][rg]; }
    if (tid < 128) { float s = 0.f;
#pragma unroll
        for (int i = 0; i < 8; ++i) { const v4u v = *(const LAS v4u*)(WKT + tid * 144 + i * 16); s += (bflo(v.x) + bfhi(v.x)) + (bflo(v.y) + bfhi(v.y)) + (bflo(v.z) + bfhi(v.z)) + (bflo(v.w) + bfhi(v.w)); }
        NDg[tid] = s; }
}

__device__ __forceinline__ void mlstm_scan(Frame& F) {
    const float* CHS = (const float*)(F.ws + WS_CTL + CTL_CHS); float* MS = (float*)(F.ws + WS_CTL + CTL_MS);
    const float* Dg = F.out; bf16* CT = (bf16*)(F.ws + WS_CT);
    const float* NDg = (const float*)(F.ws + WS_ND); float* NS = (float*)(F.ws + WS_NS);
    LAS float* chs = (LAS float*)F.lds;
    __syncthreads();
    for (int i = F.tid; i < 2048; i += 512) chs[i] = CHS[i];
    __syncthreads();
    if (F.tid < 8) { float m = 0.f;
        for (int c = 0; c < 128; ++c) { const int item = F.tid * 128 + c; const float blast = chs[2 * item], mu = chs[2 * item + 1];
            if (blockIdx.x == 0) MS[item] = m;
            const float mn = fmaxf(blast + m, mu); chs[2 * item] = __expf(blast + m - mn); chs[2 * item + 1] = __expf(mu - mn); m = mn; } }
    __syncthreads();
    for (int g = blockIdx.x * 512 + F.tid; g < 8 * 16384; g += F.G * 512) {
        const int bh = g >> 14, e = g & 16383; float st = 0.f;
        const float* dp = Dg + (size_t)bh * 128 * 16384 + e; bf16* cp = CT + (size_t)bh * 128 * 16384 + e;
        for (int c0 = 0; c0 < 128; c0 += 16) { float d[16];
#pragma unroll
            for (int k = 0; k < 16; ++k) d[k] = __builtin_nontemporal_load(dp + (size_t)(c0 + k) * 16384);
#pragma unroll
            for (int k = 0; k < 16; ++k) { cp[(size_t)(c0 + k) * 16384] = (bf16)f2bf(st); st = chs[2 * (bh * 128 + c0 + k)] * st + chs[2 * (bh * 128 + c0 + k) + 1] * d[k]; } }
    }
    for (int g = blockIdx.x * 512 + F.tid; g < 8 * 128; g += F.G * 512) {
        const int bh = g >> 7, e = g & 127; float st = 0.f;
        for (int c = 0; c < 128; ++c) { const int item = bh * 128 + c; NS[(size_t)item * 128 + e] = st; st = chs[2 * item] * st + chs[2 * item + 1] * NDg[(size_t)item * 128 + e]; }
    }
}

__device__ __forceinline__ void mem_attn_item(Frame& F, int item, bf16* outp, size_t rmask) {
    const int tile = item & 63, h = (item >> 6) & 3, b = item >> 8;
    const int tid = F.tid, lane = F.lane, w = F.wave;
    LAS unsigned char* Qs = F.lds;
    LAS unsigned char* KVs = F.lds + 34816;
    LAS unsigned char* Pw = F.lds + 34816 + 69632 + w * 2304;
    bf16* MEMQ = (bf16*)(F.ws + WS_MEMQ); const bf16* KV = (const bf16*)(F.ws + WS_KVMEM);
    const float* qg = F.in[11]; const float* kg = F.in[12];
    const size_t row0 = (size_t)b * SEQ + (size_t)tile * 128;
    __syncthreads();
    { const int r = tid >> 2, part = tid & 3; const bf16* p = MEMQ + (row0 + r) * 512 + h * 128 + part * 32;
      v4u x[4]; float s = 0.f;
#pragma unroll
      for (int i = 0; i < 4; ++i) { x[i] = *(const GAS v4u*)(p + 8 * i);
          s += (bflo(x[i].x) * bflo(x[i].x) + bfhi(x[i].x) * bfhi(x[i].x)) + (bflo(x[i].y) * bflo(x[i].y) + bfhi(x[i].y) * bfhi(x[i].y)) + (bflo(x[i].z) * bflo(x[i].z) + bfhi(x[i].z) * bfhi(x[i].z)) + (bflo(x[i].w) * bflo(x[i].w) + bfhi(x[i].w) * bfhi(x[i].w)); }
      s += __shfl_xor(s, 1); s += __shfl_xor(s, 2);
      const float rs = 0.08838834764831845f / sqrtf(s * (1.f / 128.f) + EPS);
#pragma unroll
      for (int i = 0; i < 4; ++i) { const f32x4 g0 = *(const GAS f32x4*)(qg + part * 32 + 8 * i), g1 = *(const GAS f32x4*)(qg + part * 32 + 8 * i + 4);
          v4u o; o.x = pk2(bflo(x[i].x) * rs * g0.x, bfhi(x[i].x) * rs * g0.y); o.y = pk2(bflo(x[i].y) * rs * g0.z, bfhi(x[i].y) * rs * g0.w);
          o.z = pk2(bflo(x[i].z) * rs * g1.x, bfhi(x[i].z) * rs * g1.y); o.w = pk2(bflo(x[i].w) * rs * g1.z, bfhi(x[i].w) * rs * g1.w);
          *(LAS v4u*)(Qs + r * 272 + part * 64 + i * 16) = o; } }
    { const int key = tid >> 1, half = tid & 1; const bf16* p = KV + ((size_t)b * 256 + key) * 1024 + h * 128 + half * 64;
      v4u x[8]; float s = 0.f;
#pragma unroll
      for (int i = 0; i < 8; ++i) { x[i] = *(const GAS v4u*)(p + 8 * i);
          s += (bflo(x[i].x) * bflo(x[i].x) + bfhi(x[i].x) * bfhi(x[i].x)) + (bflo(x[i].y) * bflo(x[i].y) + bfhi(x[i].y) * bfhi(x[i].y)) + (bflo(x[i].z) * bflo(x[i].z) + bfhi(x[i].z) * bfhi(x[i].z)) + (bflo(x[i].w) * bflo(x[i].w) + bfhi(x[i].w) * bfhi(x[i].w)); }
      s += __shfl_xor(s, 1);
      const float rs = 1.0f / sqrtf(s * (1.f / 128.f) + EPS);
#pragma unroll
      for (int i = 0; i < 8; ++i) { const f32x4 g0 = *(const GAS f32x4*)(kg + half * 64 + 8 * i), g1 = *(const GAS f32x4*)(kg + half * 64 + 8 * i + 4);
          v4u o; o.x = pk2(bflo(x[i].x) * rs * g0.x, bfhi(x[i].x) * rs * g0.y); o.y = pk2(bflo(x[i].y) * rs * g0.z, bfhi(x[i].y) * rs * g0.w);
          o.z = pk2(bflo(x[i].z) * rs * g1.x, bfhi(x[i].z) * rs * g1.y); o.w = pk2(bflo(x[i].w) * rs * g1.z, bfhi(x[i].w) * rs * g1.w);
          *(LAS v4u*)(KVs + key * 272 + half * 128 + i * 16) = o; } }
    __syncthreads();
    f32x4 sacc[16];
#pragma unroll
    for (int j = 0; j < 16; ++j) sacc[j] = (f32x4){0.f, 0.f, 0.f, 0.f};
    wave_mma<16, 4>(sacc, Qs, 272, 16 * w, KVs, 272, 0, lane);
    float rsum[4];
#pragma unroll
    for (int rg = 0; rg < 4; ++rg) { float mx = sacc[0][rg];
#pragma unroll
        for (int j = 1; j < 16; ++j) mx = fmaxf(mx, sacc[j][rg]);
        mx = fmaxf(mx, __shfl_xor(mx, 1)); mx = fmaxf(mx, __shfl_xor(mx, 2)); mx = fmaxf(mx, __shfl_xor(mx, 4)); mx = fmaxf(mx, __shfl_xor(mx, 8));
        float sm = 0.f;
#pragma unroll
        for (int j = 0; j < 16; ++j) { const float p = __expf(sacc[j][rg] - mx); sacc[j][rg] = p; sm += p; }
        sm += __shfl_xor(sm, 1); sm += __shfl_xor(sm, 2); sm += __shfl_xor(sm, 4); sm += __shfl_xor(sm, 8);
        rsum[rg] = 1.0f / sm; }
    __syncthreads();
#pragma unroll
    for (int i = 0; i < 8; ++i) { const int p = tid + 512 * i, key = p >> 4, c = p & 15;
        const v4u v = *(const GAS v4u*)(KV + ((size_t)b * 256 + key) * 1024 + 512 + h * 128 + c * 8); lds_store_tr8(KVs, 528, c * 8, key, v); }
    __syncthreads();
    f32x4 oacc[8];
#pragma unroll
    for (int j = 0; j < 8; ++j) oacc[j] = (f32x4){0.f, 0.f, 0.f, 0.f};
#pragma unroll
    for (int kc = 0; kc < 4; ++kc) {
        LDS_WAIT();
#pragma unroll
        for (int jj = 0; jj < 4; ++jj)
#pragma unroll
            for (int rg = 0; rg < 4; ++rg) *(LAS unsigned short*)(Pw + (4 * (lane >> 4) + rg) * 144 + (16 * jj + (lane & 15)) * 2) = (unsigned short)f2bf(sacc[4 * kc + jj][rg]);
        LDS_WAIT();
        wave_mma<8, 2>(oacc, Pw, 144, 0, KVs, 528, 0, lane, 0, 64 * kc);
    }
    LDS_WAIT();
#pragma unroll
    for (int j = 0; j < 8; ++j)
#pragma unroll
        for (int rg = 0; rg < 4; ++rg) *(LAS unsigned short*)(Qs + (16 * w + 4 * (lane >> 4) + rg) * 272 + (16 * j + (lane & 15)) * 2) = (unsigned short)f2bf(oacc[j][rg] * rsum[rg]);
    LDS_WAIT();
#pragma unroll
    for (int i = 0; i < 4; ++i) { const int p = lane + 64 * i, rr = 16 * w + (p >> 4), c = p & 15;
        const v4u v = *(const LAS v4u*)(Qs + rr * 272 + c * 16); *(GAS v4u*)(outp + ((row0 + rr) & rmask) * 512 + h * 128 + c * 8) = v; }
}

__device__ __forceinline__ void mlstm_out_item(Frame& F, int item, bf16* outp, size_t rmask) {
    const int bh = item >> 7, c = item & 127, b = bh >> 2, h = bh & 3;
    const int tid = F.tid, lane = F.lane, w = F.wave;
    LAS unsigned char* Qs = F.lds;
    LAS unsigned char* Ks = F.lds + 17408;
    LAS unsigned char* VT = F.lds + 34816;
    LAS unsigned char* CTs = F.lds + 53248;
    LAS unsigned char* Ss = F.lds + 88064;
    LAS unsigned char* Ws = F.lds + 105472;
    LAS float* bcum = (LAS float*)(F.lds + 114688);
    LAS float* igs = bcum + 64;
    LAS float* nsv = bcum + 128;
    LAS float* rden = bcum + 256;
    const float* IGLF = (const float*)(F.ws + WS_IGLF);
    const bf16* MLQ = (const bf16*)(F.ws + WS_MLQ); const bf16* MLK = (const bf16*)(F.ws + WS_MLK); bf16* MLV = (bf16*)(F.ws + WS_MLV); const bf16* MLO = (const bf16*)(F.ws + WS_MLO);
    const bf16* CT = (const bf16*)(F.ws + WS_CT) + (size_t)item * 16384;
    const float* NS = (const float*)(F.ws + WS_NS) + (size_t)item * 128;
    const float mc = ((const float*)(F.ws + WS_CTL + CTL_MS))[item];
    const int t0 = c * 64; const size_t row0 = (size_t)b * SEQ + t0;
    __syncthreads();
    if (w == 0) {
        const float lf = IGLF[(row0 + lane) * 8 + 4 + h], ig = IGLF[(row0 + lane) * 8 + h];
        float bs = lf;
#pragma unroll
        for (int o = 1; o < 64; o <<= 1) { const float v = __shfl_up(bs, o); if (lane >= o) bs += v; }
        bcum[lane] = bs; igs[lane] = ig;
    } else if (w == 1 || w == 2) { const int i = tid - 64; nsv[i] = NS[i]; }
    { const int s = tid >> 3, part = tid & 7; float y[16];
      conv16(MLQ, h * 128 + part * 16, F.in[6], F.in[7], h * 128 + part * 16, b, t0 + s, y);
      v4u q0, q1; q0.x = pk2(y[0], y[1]); q0.y = pk2(y[2], y[3]); q0.z = pk2(y[4], y[5]); q0.w = pk2(y[6], y[7]); q1.x = pk2(y[8], y[9]); q1.y = pk2(y[10], y[11]); q1.z = pk2(y[12], y[13]); q1.w = pk2(y[14], y[15]);
      *(LAS v4u*)(Qs + s * 272 + part * 32) = q0; *(LAS v4u*)(Qs + s * 272 + part * 32 + 16) = q1;
      conv16(MLK, h * 128 + part * 16, F.in[6], F.in[7], 512 + h * 128 + part * 16, b, t0 + s, y);
      const float sc = 0.08838834764831845f;
      q0.x = pk2(y[0] * sc, y[1] * sc); q0.y = pk2(y[2] * sc, y[3] * sc); q0.z = pk2(y[4] * sc, y[5] * sc); q0.w = pk2(y[6] * sc, y[7] * sc);
      q1.x = pk2(y[8] * sc, y[9] * sc); q1.y = pk2(y[10] * sc, y[11] * sc); q1.z = pk2(y[12] * sc, y[13] * sc); q1.w = pk2(y[14] * sc, y[15] * sc);
      *(LAS v4u*)(Ks + s * 272 + part * 32) = q0; *(LAS v4u*)(Ks + s * 272 + part * 32 + 16) = q1;
      const bf16* vp = MLV + (row0 + s) * 512 + h * 128 + part * 16; const v4u v0 = *(const GAS v4u*)vp, v1 = *(const GAS v4u*)(vp + 8);
      lds_store_tr8(VT, 144, part * 16, s, v0); lds_store_tr8(VT, 144, part * 16 + 8, s, v1); }
#pragma unroll
    for (int i = 0; i < 4; ++i) { const int p = tid + 512 * i, rr = p >> 4, cc = p & 15; const v4u v = *(const GAS v4u*)(CT + rr * 128 + cc * 8); *(LAS v4u*)(CTs + rr * 272 + cc * 16) = v; }
    __syncthreads();
    { f32x4 sacc[2];
      sacc[0] = (f32x4){0.f, 0.f, 0.f, 0.f}; sacc[1] = (f32x4){0.f, 0.f, 0.f, 0.f};
      wave_mma<2, 4>(sacc, Qs, 272, 16 * (w >> 1), Ks, 272, 32 * (w & 1), lane);
#pragma unroll
      for (int j = 0; j < 2; ++j)
#pragma unroll
          for (int rg = 0; rg < 4; ++rg) *(LAS float*)(Ss + (16 * (w >> 1) + 4 * (lane >> 4) + rg) * 272 + (32 * (w & 1) + 16 * j + (lane & 15)) * 4) = sacc[j][rg]; }
    __syncthreads();
    { const int t = tid >> 3, seg = tid & 7;
      const float bt = bcum[t];
      const f32x4 s0 = *(const LAS f32x4*)(Ss + t * 272 + seg * 32), s1 = *(const LAS f32x4*)(Ss + t * 272 + seg * 32 + 16);
      const float sv[8] = {s0.x, s0.y, s0.z, s0.w, s1.x, s1.y, s1.z, s1.w};
      float dm[8]; float mx = -3.0e38f;
#pragma unroll
      for (int i = 0; i < 8; ++i) { const int s = seg * 8 + i; dm[i] = bt - bcum[s] + igs[s]; if (s <= t) mx = fmaxf(mx, dm[i]); }
      mx = fmaxf(mx, __shfl_xor(mx, 1)); mx = fmaxf(mx, __shfl_xor(mx, 2)); mx = fmaxf(mx, __shfl_xor(mx, 4));
      const float minter = bt + mc; const float mt = fmaxf(minter, mx);
      float wv[8]; float den = 0.f;
#pragma unroll
      for (int i = 0; i < 8; ++i) { const int s = seg * 8 + i; wv[i] = (s <= t) ? sv[i] * __expf(dm[i] - mt) : 0.f; den += wv[i]; }
      *(LAS v4u*)(Ws + t * 144 + seg * 16) = (v4u){pk2(wv[0], wv[1]), pk2(wv[2], wv[3]), pk2(wv[4], wv[5]), pk2(wv[6], wv[7])};
      const float inter = __expf(minter - mt);
      v4u qa = *(const LAS v4u*)(Qs + t * 272 + seg * 32), qb2 = *(const LAS v4u*)(Qs + t * 272 + seg * 32 + 16);
      const float qf[16] = {bflo(qa.x), bfhi(qa.x), bflo(qa.y), bfhi(qa.y), bflo(qa.z), bfhi(qa.z), bflo(qa.w), bfhi(qa.w), bflo(qb2.x), bfhi(qb2.x), bflo(qb2.y), bfhi(qb2.y), bflo(qb2.z), bfhi(qb2.z), bflo(qb2.w), bfhi(qb2.w)};
      float qn = 0.f;
#pragma unroll
      for (int i = 0; i < 16; ++i) qn += qf[i] * nsv[seg * 16 + i];
      den += inter * qn;
      den += __shfl_xor(den, 1); den += __shfl_xor(den, 2); den += __shfl_xor(den, 4);
      qa.x = pk2(qf[0] * inter, qf[1] * inter); qa.y = pk2(qf[2] * inter, qf[3] * inter); qa.z = pk2(qf[4] * inter, qf[5] * inter); qa.w = pk2(qf[6] * inter, qf[7] * inter);
      qb2.x = pk2(qf[8] * inter, qf[9] * inter); qb2.y = pk2(qf[10] * inter, qf[11] * inter); qb2.z = pk2(qf[12] * inter, qf[13] * inter); qb2.w = pk2(qf[14] * inter, qf[15] * inter);
      *(LAS v4u*)(Qs + t * 272 + seg * 32) = qa; *(LAS v4u*)(Qs + t * 272 + seg * 32 + 16) = qb2;
      if (seg == 0) rden[t] = 1.0f / fmaxf(fabsf(den), __expf(-mt)); }
    __syncthreads();
    f32x4 acc[4];
#pragma unroll
    for (int j = 0; j < 4; ++j) acc[j] = (f32x4){0.f, 0.f, 0.f, 0.f};
    wave_mma<4, 2>(acc, Ws, 144, 16 * (w >> 1), VT, 144, 64 * (w & 1), lane);
    wave_mma<4, 4>(acc, Qs, 272, 16 * (w >> 1), CTs, 272, 64 * (w & 1), lane);
    __syncthreads();
    LAS unsigned char* Hs = CTs;
#pragma unroll
    for (int j = 0; j < 4; ++j)
#pragma unroll
        for (int rg = 0; rg < 4; ++rg) { const int row = 16 * (w >> 1) + 4 * (lane >> 4) + rg; *(LAS float*)(Hs + row * 528 + (64 * (w & 1) + 16 * j + (lane & 15)) * 4) = acc[j][rg] * rden[row]; }
    __syncthreads();
    { const int t = tid >> 3, seg = tid & 7; float hv[16]; float ss = 0.f;
#pragma unroll
      for (int i4 = 0; i4 < 4; ++i4) { const f32x4 v = *(const LAS f32x4*)(Hs + t * 528 + seg * 64 + i4 * 16); hv[4 * i4] = v.x; hv[4 * i4 + 1] = v.y; hv[4 * i4 + 2] = v.z; hv[4 * i4 + 3] = v.w; ss += (v.x * v.x + v.y * v.y) + (v.z * v.z + v.w * v.w); }
      ss += __shfl_xor(ss, 1); ss += __shfl_xor(ss, 2); ss += __shfl_xor(ss, 4);
      const float rs = 1.0f / sqrtf(ss * (1.f / 128.f) + EPS);
      const float* mg = F.in[8] + seg * 16;
      const bf16* op = MLO + (row0 + t) * 512 + h * 128 + seg * 16; const v4u o0 = *(const GAS v4u*)op, o1 = *(const GAS v4u*)(op + 8);
      const float og[16] = {bflo(o0.x), bfhi(o0.x), bflo(o0.y), bfhi(o0.y), bflo(o0.z), bfhi(o0.z), bflo(o0.w), bfhi(o0.w), bflo(o1.x), bfhi(o1.x), bflo(o1.y), bfhi(o1.y), bflo(o1.z), bfhi(o1.z), bflo(o1.w), bfhi(o1.w)};
      float yv[16];
#pragma unroll
      for (int i = 0; i < 16; ++i) yv[i] = hv[i] * rs * mg[i] * og[i];
      v4u y0, y1; y0.x = pk2(yv[0], yv[1]); y0.y = pk2(yv[2], yv[3]); y0.z = pk2(yv[4], yv[5]); y0.w = pk2(yv[6], yv[7]); y1.x = pk2(yv[8], yv[9]); y1.y = pk2(yv[10], yv[11]); y1.z = pk2(yv[12], yv[13]); y1.w = pk2(yv[14], yv[15]);
      bf16* yp = outp + ((row0 + t) & rmask) * 512 + h * 128 + seg * 16; *(GAS v4u*)yp = y0; *(GAS v4u*)(yp + 8) = y1; }
}

#define PEER_INS(L, v) do { L[15] = __builtin_amdgcn_fmed3f(L[14], L[15], v); L[14] = __builtin_amdgcn_fmed3f(L[13], L[14], v); L[13] = __builtin_amdgcn_fmed3f(L[12], L[13], v); \
    L[12] = __builtin_amdgcn_fmed3f(L[11], L[12], v); L[11] = __builtin_amdgcn_fmed3f(L[10], L[11], v); L[10] = __builtin_amdgcn_fmed3f(L[9], L[10], v); L[9] = __builtin_amdgcn_fmed3f(L[8], L[9], v); \
    L[8] = __builtin_amdgcn_fmed3f(L[7], L[8], v); L[7] = __builtin_amdgcn_fmed3f(L[6], L[7], v); L[6] = __builtin_amdgcn_fmed3f(L[5], L[6], v); L[5] = __builtin_amdgcn_fmed3f(L[4], L[5], v); \
    L[4] = __builtin_amdgcn_fmed3f(L[3], L[4], v); L[3] = __builtin_amdgcn_fmed3f(L[2], L[3], v); L[2] = __builtin_amdgcn_fmed3f(L[1], L[2], v); L[1] = __builtin_amdgcn_fmed3f(L[0], L[1], v); L[0] = fmaxf(L[0], v); } while (0)

constexpr int PEER_IDX_OFF = 0, PEER_GW_OFF = 33024, PEER_LST_OFF = 69632;
__device__ __forceinline__ void peer_route_tile(Frame& F, int tile) {
    const int tid = F.tid, lane = F.lane, w = F.wave;
    LAS unsigned char* K1s = F.lds;
    LAS float* LST = (LAS float*)(F.lds + PEER_LST_OFF);
    const bf16* QRY = (const bf16*)(F.ws + WS_QRY); const bf16* PK = (const bf16*)(F.ws + WS_PK);
    const size_t row0 = (size_t)tile * 64;
    const int mt = w & 3, half = w >> 2;
    for (int h = 0; h < 8; ++h) {
        __syncthreads();
#pragma unroll
        for (int i = 0; i < 8; ++i) { const int p = tid + 512 * i, kr = p >> 4, c = p & 15, hf = kr >> 7, key = kr & 127;
            const v4u v = *(const GAS v4u*)(PK + ((size_t)(hf * 8 + h) * 128 + key) * 128 + c * 8); *(LAS v4u*)(K1s + kr * 272 + c * 16) = v; }
        __syncthreads();
        f32x4 acc[8];
#pragma unroll
        for (int j = 0; j < 8; ++j) acc[j] = (f32x4){0.f, 0.f, 0.f, 0.f};
        const bf16* qp = QRY + (row0 + 16 * mt + (lane & 15)) * 2048 + h * 256 + half * 128 + (lane >> 4) * 8;
#pragma unroll
        for (int ks = 0; ks < 4; ++ks) { const bf16x8 q = *(const GAS bf16x8*)(qp + ks * 32);
#pragma unroll
            for (int j = 0; j < 8; ++j) { const bf16x8 kf = *(const LAS bf16x8*)(K1s + (half * 128 + 16 * j + (lane & 15)) * 272 + (ks * 32 + (lane >> 4) * 8) * 2);
                acc[j] = __builtin_amdgcn_mfma_f32_16x16x32_bf16(kf, q, acc[j], 0, 0, 0); } }
        float L[16];
#pragma unroll
        for (int i = 0; i < 16; ++i) L[i] = -3.0e38f;
#pragma unroll
        for (int j = 0; j < 8; ++j)
#pragma unroll
            for (int rg = 0; rg < 4; ++rg) { const float v = __uint_as_float((__float_as_uint(acc[j][rg]) & 0xFFFFFF80u) | (unsigned)(16 * j + 4 * (lane >> 4) + rg)); PEER_INS(L, v); }
#pragma unroll
        for (int step = 16; step <= 32; step <<= 1) { float P[16];
#pragma unroll
            for (int i = 0; i < 16; ++i) P[i] = __shfl_xor(L[i], step);
#pragma unroll
            for (int i = 0; i < 16; ++i) PEER_INS(L, P[i]); }
        if (lane < 16) {
#pragma unroll
            for (int i = 0; i < 16; ++i) LST[((h * 2 + half) * 16 + i) * 64 + 16 * mt + lane] = L[i]; }
    }
    __syncthreads();
    {
        const int h = w;
        float A1[16], A2[16];
#pragma unroll
        for (int i = 0; i < 16; ++i) { A1[i] = LST[((h * 2) * 16 + i) * 64 + lane]; A2[i] = LST[((h * 2 + 1) * 16 + i) * 64 + lane]; }
        float Tt[16];
#pragma unroll
        for (int i = 0; i < 16; ++i) Tt[i] = -3.0e38f;
#pragma unroll
        for (int i = 0; i < 16; ++i)
#pragma unroll
            for (int j = 0; j < 16; ++j) if ((i + 1) * (j + 1) <= 16) { const float cv = __uint_as_float((__float_as_uint(A1[i] + A2[j]) & 0xFFFFFF00u) | (unsigned)(i * 16 + j)); PEER_INS(Tt, cv); }
        float ex[16]; float sm = 0.f;
#pragma unroll
        for (int i = 0; i < 16; ++i) { ex[i] = __expf(Tt[i] - Tt[0]); sm += ex[i]; }
        const float inv = 1.0f / sm;
        int* ip = (int*)(F.ws + WS_IDX) + (row0 + lane) * 128 + h * 16; float* gp = (float*)(F.ws + WS_GW) + (row0 + lane) * 128 + h * 16;
#pragma unroll
        for (int i4 = 0; i4 < 4; ++i4) { unsigned ev[4]; float gv[4];
#pragma unroll
            for (int e = 0; e < 4; ++e) { const int i = 4 * i4 + e; const unsigned code = __float_as_uint(Tt[i]) & 0xFFu; const unsigned i1 = code >> 4, i2 = code & 15u;
                const unsigned e1 = __float_as_uint(LST[((h * 2) * 16 + i1) * 64 + lane]) & 0x7Fu, e2 = __float_as_uint(LST[((h * 2 + 1) * 16 + i2) * 64 + lane]) & 0x7Fu;
                ev[e] = e1 * 128u + e2; gv[e] = ex[i] * inv; }
            *(GAS v4u*)(ip + 4 * i4) = (v4u){ev[0], ev[1], ev[2], ev[3]}; *(GAS f32x4*)(gp + 4 * i4) = (f32x4){gv[0], gv[1], gv[2], gv[3]}; }
    }
}

typedef float f32x2 __attribute__((ext_vector_type(2)));
__device__ __forceinline__ void peer_u_sweep(Frame& F) {
    const int lane = F.lane, eg = lane >> 3, c = lane & 7;
    const int x = blockIdx.x & 7, rb = blockIdx.x >> 3, nrb = F.G >> 3, tper = T_TOK / nrb;
    const bf16* H1B = (const bf16*)(F.ws + WS_H1B); const unsigned char* UT8 = F.ws + WS_UT8 + 128 * x + 16 * c;
    const int* IDX = (const int*)(F.ws + WS_IDX); float* PD = (float*)(F.ws + WS_PD) + (size_t)x * T_TOK * 128;
    const float* SUMSQ = (const float*)(F.ws + WS_CTL + CTL_SUMSQ); const float* gf = F.in[18] + 128 * x + 16 * c;
    const f32x4 g0 = *(const GAS f32x4*)(gf), g1 = *(const GAS f32x4*)(gf + 4), g2 = *(const GAS f32x4*)(gf + 8), g3 = *(const GAS f32x4*)(gf + 12);
    for (int t = rb * tper + F.wave; t < (rb + 1) * tper; t += NWAVES) {
        const float rs = 1.0f / sqrtf(SUMSQ[t] * (1.f / 1024.f) + EPS);
        const v4u h0 = *(const GAS v4u*)(H1B + (size_t)t * 1024 + 128 * x + 16 * c), h1 = *(const GAS v4u*)(H1B + (size_t)t * 1024 + 128 * x + 16 * c + 8);
        f32x2 xh[8];
        xh[0] = (f32x2){bflo(h0.x) * rs * g0.x, bfhi(h0.x) * rs * g0.y}; xh[1] = (f32x2){bflo(h0.y) * rs * g0.z, bfhi(h0.y) * rs * g0.w};
        xh[2] = (f32x2){bflo(h0.z) * rs * g1.x, bfhi(h0.z) * rs * g1.y}; xh[3] = (f32x2){bflo(h0.w) * rs * g1.z, bfhi(h0.w) * rs * g1.w};
        xh[4] = (f32x2){bflo(h1.x) * rs * g2.x, bfhi(h1.x) * rs * g2.y}; xh[5] = (f32x2){bflo(h1.y) * rs * g2.z, bfhi(h1.y) * rs * g2.w};
        xh[6] = (f32x2){bflo(h1.z) * rs * g3.x, bfhi(h1.z) * rs * g3.y}; xh[7] = (f32x2){bflo(h1.w) * rs * g3.z, bfhi(h1.w) * rs * g3.w};
        int ee[16];
#pragma unroll
        for (int i = 0; i < 16; ++i) ee[i] = IDX[(size_t)t * 128 + 8 * i + eg];
        v4u ur[16];
#pragma unroll
        for (int i = 0; i < 16; ++i) ur[i] = *(const GAS v4u*)(UT8 + (size_t)ee[i] * 1024);
        float pd[16];
#pragma unroll
        for (int i = 0; i < 16; ++i) { f32x2 d2 = (f32x2){0.f, 0.f}; const unsigned uw[4] = {ur[i].x, ur[i].y, ur[i].z, ur[i].w};
#pragma unroll
            for (int q = 0; q < 4; ++q) { const f32x2 lo = __builtin_amdgcn_cvt_pk_f32_fp8((int)uw[q], false), hi = __builtin_amdgcn_cvt_pk_f32_fp8((int)uw[q], true);
                d2 = __builtin_elementwise_fma(lo, xh[2 * q], d2); d2 = __builtin_elementwise_fma(hi, xh[2 * q + 1], d2); }
            pd[i] = d2.x + d2.y; }
#pragma unroll
        for (int i = 0; i < 8; ++i) { const bool up = (c & 4) != 0; const float send = up ? pd[i] : pd[i + 8]; const float keep = up ? pd[i + 8] : pd[i]; pd[i] = keep + __shfl_xor(send, 4); }
#pragma unroll
        for (int i = 0; i < 4; ++i) { const bool up = (c & 2) != 0; const float send = up ? pd[i] : pd[i + 4]; const float keep = up ? pd[i + 4] : pd[i]; pd[i] = keep + __shfl_xor(send, 2); }
#pragma unroll
        for (int i = 0; i < 2; ++i) { const bool up = (c & 1) != 0; const float send = up ? pd[i] : pd[i + 2]; const float keep = up ? pd[i + 2] : pd[i]; pd[i] = keep + __shfl_xor(send, 1); }
        float* pp = PD + (size_t)t * 128 + 16 * c + eg;
        pp[0] = pd[0]; pp[8] = pd[1];
    }
}
__device__ __forceinline__ void peer_combine(Frame& F) {
    const int* IDX = (const int*)(F.ws + WS_IDX); float* GW = (float*)(F.ws + WS_GW); const float* PD = (const float*)(F.ws + WS_PD);
    const float* USC = (const float*)(F.ws + WS_USC); const float* VSC = (const float*)(F.ws + WS_VSC);
    for (size_t g = (size_t)blockIdx.x * 512 + F.tid; g < (size_t)T_TOK * 128; g += (size_t)F.G * 512) {
        float d = 0.f;
#pragma unroll
        for (int xx = 0; xx < 8; ++xx) d += PD[(size_t)xx * T_TOK * 128 + g];
        const int e = IDX[g]; const float dt = d * USC[e];
        GW[g] = GW[g] * VSC[e] * 0.5f * dt * (1.0f + erff(dt * 0.70710678118654752f));
    }
}
__device__ __forceinline__ void peer_v_sweep(Frame& F) {
    const int lane = F.lane, eg = lane >> 3, c = lane & 7;
    const int x = blockIdx.x & 7, rb = blockIdx.x >> 3, nrb = F.G >> 3, tper = T_TOK / nrb;
    const unsigned char* VT8 = F.ws + WS_VT8 + 128 * x + 16 * c;
    const int* IDX = (const int*)(F.ws + WS_IDX); const float* GW = (const float*)(F.ws + WS_GW);
    for (int t = rb * tper + F.wave; t < (rb + 1) * tper; t += NWAVES) {
        int ee[16]; float ww[16];
#pragma unroll
        for (int i = 0; i < 16; ++i) { ee[i] = IDX[(size_t)t * 128 + 8 * i + eg]; ww[i] = GW[(size_t)t * 128 + 8 * i + eg]; }
        v4u vr[16];
#pragma unroll
        for (int i = 0; i < 16; ++i) vr[i] = *(const GAS v4u*)(VT8 + (size_t)ee[i] * 1024);
        f32x2 oa[8];
#pragma unroll
        for (int q = 0; q < 8; ++q) oa[q] = (f32x2){0.f, 0.f};
#pragma unroll
        for (int i = 0; i < 16; ++i) { const f32x2 w2 = (f32x2){ww[i], ww[i]}; const unsigned vw[4] = {vr[i].x, vr[i].y, vr[i].z, vr[i].w};
#pragma unroll
            for (int q = 0; q < 4; ++q) { const f32x2 lo = __builtin_amdgcn_cvt_pk_f32_fp8((int)vw[q], false), hi = __builtin_amdgcn_cvt_pk_f32_fp8((int)vw[q], true);
                oa[2 * q] = __builtin_elementwise_fma(lo, w2, oa[2 * q]); oa[2 * q + 1] = __builtin_elementwise_fma(hi, w2, oa[2 * q + 1]); } }
        float pd[16];
#pragma unroll
        for (int q = 0; q < 8; ++q) { pd[2 * q] = oa[q].x; pd[2 * q + 1] = oa[q].y; }
#pragma unroll
        for (int i = 0; i < 8; ++i) { const bool up = (eg & 4) != 0; const float send = up ? pd[i] : pd[i + 8]; const float keep = up ? pd[i + 8] : pd[i]; pd[i] = keep + __shfl_xor(send, 32); }
#pragma unroll
        for (int i = 0; i < 4; ++i) { const bool up = (eg & 2) != 0; const float send = up ? pd[i] : pd[i + 4]; const float keep = up ? pd[i + 4] : pd[i]; pd[i] = keep + __shfl_xor(send, 16); }
#pragma unroll
        for (int i = 0; i < 2; ++i) { const bool up = (eg & 1) != 0; const float send = up ? pd[i] : pd[i + 2]; const float keep = up ? pd[i + 2] : pd[i]; pd[i] = keep + __shfl_xor(send, 8); }
        float* op = F.out + (size_t)t * 1024 + 128 * x + 16 * c + 2 * eg;
        f32x2 o = *(GAS f32x2*)op; o.x += pd[0]; o.y += pd[1]; *(GAS f32x2*)op = o;
    }
}

__device__ __forceinline__ void peer_table_row_fp8(const float* src, unsigned char* dst, float* sc, int lane) {
    f32x4 v[4]; float am = 0.f;
#pragma unroll
    for (int j = 0; j < 4; ++j) { v[j] = __builtin_nontemporal_load((const GAS f32x4*)(src + 256 * j + 4 * lane)); am = fmaxf(am, fmaxf(fmaxf(fabsf(v[j].x), fabsf(v[j].y)), fmaxf(fabsf(v[j].z), fabsf(v[j].w)))); }
    am = fmaxf(wave_max(am), 1e-30f);
    const float s = 224.0f / am;
#pragma unroll
    for (int j = 0; j < 4; ++j) { int p = 0; p = __builtin_amdgcn_cvt_pk_fp8_f32(v[j].x * s, v[j].y * s, p, false); p = __builtin_amdgcn_cvt_pk_fp8_f32(v[j].z * s, v[j].w * s, p, true);
        *(GAS unsigned*)(dst + 256 * j + 4 * lane) = (unsigned)p; }
    if (lane == 0) *sc = am * (1.0f / 224.0f);
}

struct Args { const float* in[24]; float* out; unsigned char* ws; int ph_lo, ph_hi, li, pad; };
__global__ void __launch_bounds__(NWAVES * 64, 2) hybrid_fwd(Args args) {
    extern __shared__ __attribute__((aligned(16))) unsigned char lds[];
    Frame F;
    F.lds = (LAS unsigned char*)lds;
    F.MISC = (volatile LAS unsigned*)(F.lds + MISC_OFF);
    F.tid = threadIdx.x; F.lane = F.tid & 63; F.wave = __builtin_amdgcn_readfirstlane(F.tid >> 6);
    F.G = gridDim.x; F.ws = args.ws; F.out = args.out;
#pragma unroll
    for (int i = 0; i < 24; ++i) F.in[i] = args.in[i];
    for (int u = F.tid; u < (LDS_BYTES - LDSCTL_OFF) / 4; u += NWAVES * 64) ((LAS unsigned*)(F.lds + LDSCTL_OFF))[u] = 0u;
    __syncthreads();
    unsigned* ctl = (unsigned*)(F.ws + WS_CTL);
    XcdBarrier bar; bar.bar = ctl + CW_BAR; bar.x = 0; bar.st = nullptr;
    if (N_LAUNCHES != PER_PHASE) bar = xcd_barrier_post(ctl + CW_BAR, F.MISC + 8);
#define REP(k) for (int rep_ = ((PROBE_PH == (k)) ? 0 : 1); rep_ < 2; ++rep_)
#define DUMMY (rep_ == 0)
#define GRID_BAR() do { if (N_LAUNCHES != PER_PHASE) xcd_barrier(bar); } while (0)
    const int lo = args.ph_lo, hi = args.ph_hi;
#define IN(k) (lo <= (k) && (k) < hi)
#define BOTH(k) (IN(k) && IN((k) + 1))
    const int bx = blockIdx.x;

    if (IN(0)) { REP(0) { p0_prologue(F); __syncthreads(); } if (BOTH(0)) GRID_BAR(); }

    if (IN(1)) {
        pg8::Gemm g{(const bf16*)F.out, (const bf16*)(F.ws + WS_WIN), 1024, 1024, 1024}; pg8::StaticOrder S; S.init(T_TOK, 7168, F.G, bx);
        pg8::EpiProj E{(bf16*)(F.ws + WS_GATES), 512, F.in[16], 512, SPLIT_STRIDE, 12, 22, 24};
        REP(1) pg8::gemm_phase<pg8::EpiProj, pg8::StaticOrder, true, true>(F.lds, g, S, E);
        if (BOTH(1)) GRID_BAR();
    }

    if (IN(2)) {
        { pg8::Gemm g{(const bf16*)(F.ws + WS_MEMN), (const bf16*)(F.ws + WS_WKV), 1024, 1024, 1024}; pg8::FewOrder S{4, 8, bx};
          pg8::EpiProj E{(bf16*)(F.ws + WS_KVMEM), 1024, nullptr, 0, 0, 0, 0, 0};
          pg8::gemm_phase<pg8::EpiProj, pg8::FewOrder, false, true>(F.lds, g, S, E); }
        for (;;) {
            __syncthreads();
            if (F.tid == 0) F.MISC[16] = __hip_atomic_fetch_add(ctl + 1024, 1u, __ATOMIC_RELAXED, __HIP_MEMORY_SCOPE_AGENT);
            __syncthreads();
            const int it = (int)F.MISC[16];
            if (it >= 2048) break;
            if (it < 1024) sb_attn_item(F, it, (bf16*)(F.ws + WS_SBQ), ~(size_t)0); else mlstm_local_item(F, it - 1024);
        }
        if (BOTH(2)) GRID_BAR();
    }

    if (IN(3)) {
        REP(3) mlstm_scan(F);
        REP(13) for (int it = bx; it < 512; it += F.G) mem_attn_item(F, it, DUMMY ? (bf16*)(F.ws + WS_END) : (bf16*)(F.ws + WS_MEMQ), DUMMY ? (size_t)1023 : ~(size_t)0);
        if (BOTH(3)) GRID_BAR();
    }

    if (IN(4)) {
        REP(4) for (int it = bx; it < 1024; it += F.G) mlstm_out_item(F, it, DUMMY ? (bf16*)(F.ws + WS_END) : (bf16*)(F.ws + WS_MLV), DUMMY ? (size_t)1023 : ~(size_t)0);
        if (BOTH(4)) GRID_BAR();
    }

    if (IN(5)) {
        pg8::Gemm g{(const bf16*)(F.ws + WS_SBQ), (const bf16*)(F.ws + WS_WBR), 512, 512, 512};
        pg8::GroupOrder S; S.so.init(T_TOK, 1024, F.G, bx); S.ng = 3; S.a_gstride = 16 * MiB; S.b_gstride = (size_t)1024 * 512 * 2;
        pg8::EpiBranch E{(const bf16*)(F.ws + WS_GATES), SPLIT_STRIDE, (bf16*)(F.ws + WS_MERGED)};
        REP(5) pg8::gemm_phase<pg8::EpiBranch, pg8::GroupOrder, false, true>(F.lds, g, S, E);
        if (BOTH(5)) GRID_BAR();
    }

    if (IN(6)) {
        { pg8::Gemm g{(const bf16*)(F.ws + WS_MERGED), (const bf16*)(F.ws + WS_WOUT), 1024, 1024, 1024}; pg8::StaticOrder S; S.init(T_TOK, 1024, F.G, bx);
          REP(6) { pg8::EpiOut E{F.in[0], F.out, (bf16*)(F.ws + WS_H1B), (float*)(F.ws + WS_CTL + (DUMMY ? 768 * 1024 : CTL_SUMSQ))};
          pg8::gemm_phase<pg8::EpiOut, pg8::StaticOrder, false, true>(F.lds, g, S, E); } }
        REP(16) for (int r = bx * NWAVES + F.wave; r < 2 * 16384; r += F.G * NWAVES) { const bool second = r >= 16384; const int rr = second ? r - 16384 : r;
            peer_table_row_fp8((second ? F.in[23] : F.in[22]) + (size_t)rr * 1024, F.ws + (second ? WS_VT8 : WS_UT8) + (size_t)rr * 1024, (float*)(F.ws + (second ? WS_VSC : WS_USC)) + rr, F.lane); }
        if (BOTH(6)) GRID_BAR();
    }

    if (IN(7)) {
        pg8::Gemm g{(const bf16*)(F.ws + WS_H1B), (const bf16*)(F.ws + WS_WPQ), 1024, 1024, 1024}; pg8::StaticOrder S; S.init(T_TOK, 2048, F.G, bx);
        pg8::EpiQry E{(const float*)(F.ws + WS_CTL + CTL_SUMSQ), (bf16*)(F.ws + WS_QRY), EPS};
        REP(7) pg8::gemm_phase<pg8::EpiQry, pg8::StaticOrder, true, true>(F.lds, g, S, E);
        if (BOTH(7)) GRID_BAR();
    }

    if (IN(8)) { for (int tile = bx; tile < 256; tile += F.G) peer_route_tile(F, tile); if (BOTH(8)) GRID_BAR(); }
    if (IN(9)) { REP(9) peer_u_sweep(F); if (BOTH(9)) GRID_BAR(); }
    if (IN(10)) { peer_combine(F); if (BOTH(10)) GRID_BAR(); }
    if (IN(11)) { peer_v_sweep(F); }
#undef IN
#undef BOTH
#undef GRID_BAR
#undef REP
#undef DUMMY
}

extern "C" void kernel_launch(void* const* d_in, const int* in_sizes, int n_in, void* d_out, int out_size, void* d_ws, size_t ws_size, hipStream_t stream) {
    static int grid = 0;
    if (grid == 0) {
        if (n_in != 24 || out_size != T_TOK * DM || ws_size < WS_END) { fprintf(stderr, "kernel_launch: unexpected problem (n_in %d, out %d, ws %zu); nothing launched\n", n_in, out_size, ws_size); grid = -1; return; }
        int dev = 0, cus = 0, per_cu = 0;
        if (hipGetDevice(&dev) != hipSuccess || hipDeviceGetAttribute(&cus, hipDeviceAttributeMultiprocessorCount, dev) != hipSuccess) { grid = -1; return; }
        if (hipFuncSetAttribute((const void*)hybrid_fwd, hipFuncAttributeMaxDynamicSharedMemorySize, LDS_BYTES) != hipSuccess) { fprintf(stderr, "kernel_launch: hipFuncSetAttribute failed\n"); grid = -1; return; }
        if (hipOccupancyMaxActiveBlocksPerMultiprocessor(&per_cu, (const void*)hybrid_fwd, NWAVES * 64, LDS_BYTES) != hipSuccess || per_cu < 1)
            fprintf(stderr, "kernel_launch: note: occupancy query reports %d workgroups per CU\n", per_cu);
        (void)hipGetLastError();
        grid = cus;
    }
    if (grid < 0) return;
    if (hipMemsetAsync((char*)d_ws + WS_CTL, 0, CTL_ZERO_BYTES, stream) != hipSuccess) { fprintf(stderr, "kernel_launch: memset failed\n"); return; }
    Args a{};
    for (int i = 0; i < 24; ++i) a.in[i] = (const float*)d_in[i];
    a.out = (float*)d_out; a.ws = (unsigned char*)d_ws;
    for (int li = 0; li < N_LAUNCHES; ++li) {
        a.ph_lo = (N_LAUNCHES == PER_PHASE) ? li : 0; a.ph_hi = (N_LAUNCHES == PER_PHASE) ? li + 1 : PER_PHASE; a.li = li;
        hipLaunchKernelGGL(hybrid_fwd, dim3(grid), dim3(NWAVES * 64), LDS_BYTES, stream, a);
        const hipError_t le = hipPeekAtLastError();
        if (le != hipSuccess) { fprintf(stderr, "kernel_launch: launch %d failed: %s\n", li, hipGetErrorName(le)); break; }
    }
}
```

```cpp
#include <hip/hip_runtime.h>
#include <cstdio>
#include <cstdint>

#ifndef MK_N_LAUNCHES
#define MK_N_LAUNCHES 1
#endif

namespace pg8 {
#define PG8_LAS __attribute__((address_space(3)))
typedef unsigned short bf16_t;
typedef short bf16x8 __attribute__((ext_vector_type(8)));
typedef float f32x4 __attribute__((ext_vector_type(4)));
typedef unsigned u32x4 __attribute__((ext_vector_type(4)));
constexpr int BM = 256, BK = 64, HALF = 128, HTB = HALF * BK * 2  , STAGE_BYTES = 8 * HTB, NXCD = 8, WGM = 8;

__host__ __device__ __forceinline__ int lds_byte(int r, int c) { const int st = (r >> 4) * 2 + (c >> 5), rr = r & 15, cc = c & 31, ob = rr * 64 + cc * 2; return st * 1024 + (ob ^ (((ob >> 9) & 1) << 5)); }
__host__ __device__ __forceinline__ void stage_rc(int b, int& R, int& C) { const int st = b / 1024, sb = b % 1024, swz = sb ^ (((sb >> 9) & 1) << 5); R = (st >> 1) * 16 + swz / 64; C = (st & 1) * 32 + (swz % 64) / 2; }
__host__ __device__ __forceinline__ int perm32(int rho) { const int n = rho >> 4, i = rho & 15; return 8 * (i >> 2) + 4 * n + (i & 3); }

struct Unit { int pm, pn, g; };
struct Gemm { const bf16_t* A; const bf16_t* Bt; int lda, ldb, K; };

struct StaticOrder {
    int nM, nN, nwg, G, c;
    __host__ __device__ void init(int M, int N, int G_, int c_) { nM = M / BM; nN = N / BM; nwg = nM * nN; G = G_; c = c_; }
    __host__ __device__ bool next(int i, Unit& u) const {
        const long L = (long)i * G + c; if (L >= nwg) return false;
        int wgid = (int)L; { const int q = nwg / NXCD, r = nwg % NXCD, xcd = wgid % NXCD, off = wgid / NXCD; wgid = (xcd < r ? xcd * (q + 1) : r * (q + 1) + (xcd - r) * q) + off; }
        const int nig = WGM * nN, gid = wgid / nig, fm = gid * WGM, gsz = (nM - fm) < WGM ? (nM - fm) : WGM;
        u.pm = fm + ((wgid % nig) % gsz); u.pn = (wgid % nig) / gsz; u.g = 0; return true;
    }
    __device__ __forceinline__ const char* aptr(const Gemm& g, const Unit& u) const { return (const char*)g.A + (size_t)u.pm * BM * g.lda * 2; }
    __device__ __forceinline__ const char* bptr(const Gemm& g, const Unit& u) const { return (const char*)g.Bt + (size_t)u.pn * BM * g.ldb * 2; }
    __device__ __forceinline__ void a_ready(const Unit&) const {}
    __device__ __forceinline__ void done(const Unit&) const {}
};
struct FewOrder {
    int nN, n, c;
    __device__ bool next(int i, Unit& u) const { if (i > 0 || c >= n) return false; u.pm = c / nN; u.pn = c % nN; u.g = 0; return true; }
    __device__ __forceinline__ const char* aptr(const Gemm& g, const Unit& u) const { return (const char*)g.A + (size_t)u.pm * BM * g.lda * 2; }
    __device__ __forceinline__ const char* bptr(const Gemm& g, const Unit& u) const { return (const char*)g.Bt + (size_t)u.pn * BM * g.ldb * 2; }
    __device__ __forceinline__ void a_ready(const Unit&) const {}
    __device__ __forceinline__ void done(const Unit&) const {}
};
struct GroupOrder {
    StaticOrder so; int ng; size_t a_gstride, b_gstride;
    __device__ bool next(int i, Unit& u) const { if (i >= ng) return false; if (!so.next(0, u)) return false; u.g = i; return true; }
    __device__ __forceinline__ const char* aptr(const Gemm& g, const Unit& u) const { return (const char*)g.A + (size_t)u.g * a_gstride + (size_t)u.pm * BM * g.lda * 2; }
    __device__ __forceinline__ const char* bptr(const Gemm& g, const Unit& u) const { return (const char*)g.Bt + (size_t)u.g * b_gstride + (size_t)u.pn * BM * g.ldb * 2; }
    __device__ __forceinline__ void a_ready(const Unit&) const {}
    __device__ __forceinline__ void done(const Unit&) const {}
};

__device__ __forceinline__ unsigned cvt_pk_bf16(float lo, float hi) { unsigned r; asm volatile("v_cvt_pk_bf16_f32 %0, %1, %2" : "=v"(r) : "v"(lo), "v"(hi)); return r; }
__device__ __forceinline__ float bf_lo(unsigned x) { return __uint_as_float(x << 16); }
__device__ __forceinline__ float bf_hi(unsigned x) { return __uint_as_float(x & 0xffff0000u); }
__device__ __forceinline__ float sigmoidf_(float x) { return 1.0f / (1.0f + __expf(-x)); }

struct EpiProj {
    static constexpr bool PERM = true, AFTER_DRAIN = false;
    bf16_t* O; int ldc; const float* bias; int split_cols; size_t split_stride; int n_sig_bias, sig_lo, sig_hi;
    __device__ __forceinline__ void operator()(const f32x4 (&acc)[2][2][4][2], const Unit& u, int wr, int wc, int fr, int fq) const {
        const int row0 = u.pm * BM + wr * 64 + fr; int colt = u.pn * BM; bf16_t* base = O;
        if (split_cols) { const int t = colt / split_cols; base += (size_t)t * split_stride; colt -= t * split_cols; }
        const int col0 = colt + wc * 32 + 8 * fq, bcol0 = u.pn * BM + wc * 32 + 8 * fq;
        const int mode = (u.pn < n_sig_bias) ? 1 : ((u.pn >= sig_lo && u.pn < sig_hi) ? 2 : 0);
        f32x4 bv[2][2];
#pragma unroll
        for (int bj = 0; bj < 2; ++bj)
#pragma unroll
            for (int n = 0; n < 2; ++n) bv[bj][n] = (mode == 1) ? *(const f32x4*)(bias + bcol0 + bj * HALF + 4 * n) : (f32x4){0.f, 0.f, 0.f, 0.f};
#pragma unroll
        for (int ai = 0; ai < 2; ++ai)
#pragma unroll
            for (int m = 0; m < 4; ++m) { bf16_t* rowp = base + (size_t)(row0 + ai * HALF + m * 16) * ldc + col0;
#pragma unroll
                for (int bj = 0; bj < 2; ++bj) { f32x4 v0 = acc[ai][bj][m][0] + bv[bj][0], v1 = acc[ai][bj][m][1] + bv[bj][1];
                    if (mode != 0) {
#pragma unroll
                        for (int e = 0; e < 4; ++e) { v0[e] = sigmoidf_(v0[e]); v1[e] = sigmoidf_(v1[e]); } }
                    u32x4 w; w.x = cvt_pk_bf16(v0[0], v0[1]); w.y = cvt_pk_bf16(v0[2], v0[3]); w.z = cvt_pk_bf16(v1[0], v1[1]); w.w = cvt_pk_bf16(v1[2], v1[3]);
                    *(u32x4*)(rowp + bj * HALF) = w; } }
    }
};

struct EpiBranch {
    static constexpr bool PERM = true, AFTER_DRAIN = false;
    const bf16_t* gates; size_t gate_stride; bf16_t* merged;
    __device__ __forceinline__ void operator()(const f32x4 (&acc)[2][2][4][2], const Unit& u, int wr, int wc, int fr, int fq) const {
        const int row0 = u.pm * BM + wr * 64 + fr; const int col0 = u.pn * BM + wc * 32 + 8 * fq;
#pragma unroll
        for (int ai = 0; ai < 2; ++ai)
#pragma unroll
            for (int m = 0; m < 4; ++m) { const size_t row = (size_t)(row0 + ai * HALF + m * 16);
#pragma unroll
                for (int bj = 0; bj < 2; ++bj) { const int c = col0 + bj * HALF; const int gc = u.g * 1024 + c;
                    const u32x4 gw = *(const u32x4*)(gates + (size_t)(gc >> 9) * gate_stride + row * 512 + (gc & 511));
                    bf16_t* mp = merged + row * 1024 + c;
                    f32x4 v0 = acc[ai][bj][m][0], v1 = acc[ai][bj][m][1];
                    v0[0] *= bf_lo(gw.x); v0[1] *= bf_hi(gw.x); v0[2] *= bf_lo(gw.y); v0[3] *= bf_hi(gw.y);
                    v1[0] *= bf_lo(gw.z); v1[1] *= bf_hi(gw.z); v1[2] *= bf_lo(gw.w); v1[3] *= bf_hi(gw.w);
                    if (u.g > 0) { const u32x4 pv = *(const u32x4*)mp;
                        v0[0] += bf_lo(pv.x); v0[1] += bf_hi(pv.x); v0[2] += bf_lo(pv.y); v0[3] += bf_hi(pv.y);
                        v1[0] += bf_lo(pv.z); v1[1] += bf_hi(pv.z); v1[2] += bf_lo(pv.w); v1[3] += bf_hi(pv.w); }
                    u32x4 w; w.x = cvt_pk_bf16(v0[0], v0[1]); w.y = cvt_pk_bf16(v0[2], v0[3]); w.z = cvt_pk_bf16(v1[0], v1[1]); w.w = cvt_pk_bf16(v1[2], v1[3]);
                    *(u32x4*)mp = w; } }
    }
};

struct EpiOut {
    static constexpr bool PERM = true, AFTER_DRAIN = false;
    const float* x; float* out; bf16_t* h1b; float* sumsq;
    __device__ __forceinline__ void operator()(const f32x4 (&acc)[2][2][4][2], const Unit& u, int wr, int wc, int fr, int fq) const {
        const int row0 = u.pm * BM + wr * 64 + fr; const int col0 = u.pn * BM + wc * 32 + 8 * fq;
#pragma unroll
        for (int ai = 0; ai < 2; ++ai)
#pragma unroll
            for (int m = 0; m < 4; ++m) { const size_t row = (size_t)(row0 + ai * HALF + m * 16); float ss = 0.f;
#pragma unroll
                for (int bj = 0; bj < 2; ++bj) { const size_t off = row * 1024 + col0 + bj * HALF;
                    const f32x4 x0 = *(const f32x4*)(x + off), x1 = *(const f32x4*)(x + off + 4);
                    const f32x4 v0 = acc[ai][bj][m][0] + x0, v1 = acc[ai][bj][m][1] + x1;
                    *(f32x4*)(out + off) = v0; *(f32x4*)(out + off + 4) = v1;
                    ss += (v0[0] * v0[0] + v0[1] * v0[1]) + (v0[2] * v0[2] + v0[3] * v0[3]) + (v1[0] * v1[0] + v1[1] * v1[1]) + (v1[2] * v1[2] + v1[3] * v1[3]);
                    u32x4 w; w.x = cvt_pk_bf16(v0[0], v0[1]); w.y = cvt_pk_bf16(v0[2], v0[3]); w.z = cvt_pk_bf16(v1[0], v1[1]); w.w = cvt_pk_bf16(v1[2], v1[3]);
                    *(u32x4*)(h1b + off) = w; }
                ss += __shfl_xor(ss, 16); ss += __shfl_xor(ss, 32);
                if (fq == 0) atomicAdd(sumsq + row, ss); }
    }
};

struct EpiQry {
    static constexpr bool PERM = true, AFTER_DRAIN = false;
    const float* sumsq; bf16_t* qry; float eps;
    __device__ __forceinline__ void operator()(const f32x4 (&acc)[2][2][4][2], const Unit& u, int wr, int wc, int fr, int fq) const {
        const int row0 = u.pm * BM + wr * 64 + fr; const int col0 = u.pn * BM + wc * 32 + 8 * fq;
#pragma unroll
        for (int ai = 0; ai < 2; ++ai)
#pragma unroll
            for (int m = 0; m < 4; ++m) { const size_t row = (size_t)(row0 + ai * HALF + m * 16);
                const float rs = __builtin_amdgcn_rsqf(__hip_atomic_load(sumsq + row, __ATOMIC_RELAXED, __HIP_MEMORY_SCOPE_AGENT) * (1.0f / 1024.0f) + eps);
#pragma unroll
                for (int bj = 0; bj < 2; ++bj) { const f32x4 v0 = acc[ai][bj][m][0] * rs, v1 = acc[ai][bj][m][1] * rs;
                    u32x4 w; w.x = cvt_pk_bf16(v0[0], v0[1]); w.y = cvt_pk_bf16(v0[2], v0[3]); w.z = cvt_pk_bf16(v1[0], v1[1]); w.w = cvt_pk_bf16(v1[2], v1[3]);
                    *(u32x4*)(qry + row * 2048 + col0 + bj * HALF) = w; } }
    }
};

template <class Epi, class Sched, bool ALIGN_EPI = false, bool SP2 = false>
__device__ __forceinline__ void gemm_phase(PG8_LAS unsigned char* lds, const Gemm g, const Sched& S, const Epi& E) {
    const int tid = threadIdx.x, wid = __builtin_amdgcn_readfirstlane(tid >> 6), lane = tid & 63, wr = wid >> 2, wc = wid & 3, fr = lane & 15, fq = lane >> 4;
    const int K = g.K, nt = K / BK;
    unsigned voffA[2], voffB[2];
#pragma unroll
    for (int i = 0; i < 2; ++i) { int R, C; stage_rc(tid * 16 + i * 8192, R, C); const int Rb = Epi::PERM ? ((R & ~31) + perm32(R & 31)) : R;
        voffA[i] = (unsigned)(R * g.lda + C) * 2u; voffB[i] = (unsigned)(Rb * g.ldb + C) * 2u; }
    const size_t kstep = (size_t)(BK * 2);
    const size_t hstepA = (size_t)HALF * g.lda * 2, hstepB = (size_t)HALF * g.ldb * 2;
    const unsigned ldsw = (unsigned)wid * 1024u;
    const int aoff = lds_byte(wr * 64 + fr, fq * 8), boff = lds_byte(wc * 32 + fr, fq * 8);
#define PG8_SA(b, h) (((b) * 2 + (h)) * HTB)
#define PG8_SB(b, h) ((4 + (b) * 2 + (h)) * HTB)
#define PG8_STAGE(bufoff, gbase, voff) do { _Pragma("unroll") for (int _i = 0; _i < 2; ++_i) \
        __builtin_amdgcn_global_load_lds((const unsigned*)((const char*)(gbase) + (voff)[_i]), (PG8_LAS unsigned*)(lds + (bufoff) + ldsw + _i * 8192), 16, 0, 0); } while (0)
#define PG8_LDA(dst, b, h) do { _Pragma("unroll") for (int m = 0; m < 4; ++m) _Pragma("unroll") for (int k = 0; k < 2; ++k) dst[m][k] = *(const PG8_LAS bf16x8*)(lds + PG8_SA(b, h) + aoff + m * 2048 + k * 1024); } while (0)
#define PG8_LDB(dst, b, h) do { _Pragma("unroll") for (int n = 0; n < 2; ++n) _Pragma("unroll") for (int k = 0; k < 2; ++k) dst[n][k] = *(const PG8_LAS bf16x8*)(lds + PG8_SB(b, h) + boff + n * 2048 + k * 1024); } while (0)
#define PG8_MMA(ai, bj, At, Bt) do { __builtin_amdgcn_s_setprio(1); _Pragma("unroll") for (int m = 0; m < 4; ++m) _Pragma("unroll") for (int n = 0; n < 2; ++n) _Pragma("unroll") for (int k = 0; k < 2; ++k) \
        acc[ai][bj][m][n] = __builtin_amdgcn_mfma_f32_16x16x32_bf16(Bt[n][k], At[m][k], acc[ai][bj][m][n], 0, 0, 0); __builtin_amdgcn_s_setprio(0); } while (0)
#define PG8_WAIT_V(n) asm volatile("s_waitcnt vmcnt(" #n ")" ::: "memory")
#define PG8_WAIT_L(n) asm volatile("s_waitcnt lgkmcnt(" #n ")" ::: "memory")
#define PG8_BAR __builtin_amdgcn_s_barrier()
#define PG8_SCHED __builtin_amdgcn_sched_barrier(0)
    Unit cur, nxt; int ui = 0;
    if (!S.next(0, cur)) return;
    f32x4 acc[2][2][4][2];
#pragma unroll
    for (int a = 0; a < 2; ++a)
#pragma unroll
        for (int b = 0; b < 2; ++b)
#pragma unroll
            for (int m = 0; m < 4; ++m)
#pragma unroll
                for (int n = 0; n < 2; ++n) acc[a][b][m][n] = (f32x4){0.f, 0.f, 0.f, 0.f};
    bf16x8 At[4][2], B0[2][2], B1[2][2];
    const char* cA = S.aptr(g, cur); const char* cB = S.bptr(g, cur);
    S.a_ready(cur);
    if constexpr (SP2) {
        PG8_STAGE(PG8_SB(0, 0), cB, voffB); PG8_STAGE(PG8_SB(0, 1), cB + hstepB, voffB); PG8_STAGE(PG8_SA(0, 0), cA, voffA); PG8_STAGE(PG8_SA(0, 1), cA + hstepA, voffA);
        if (wr == 1) PG8_BAR;
        PG8_WAIT_V(2); PG8_BAR;
        PG8_STAGE(PG8_SB(1, 0), cB + kstep, voffB); PG8_STAGE(PG8_SA(1, 0), cA + kstep, voffA); PG8_STAGE(PG8_SB(1, 1), cB + hstepB + kstep, voffB);
        PG8_WAIT_V(6); PG8_BAR;
    } else {
        PG8_STAGE(PG8_SB(0, 0), cB, voffB); PG8_STAGE(PG8_SA(0, 0), cA, voffA); PG8_STAGE(PG8_SB(0, 1), cB + hstepB, voffB); PG8_STAGE(PG8_SA(0, 1), cA + hstepA, voffA);
        if (wr == 1) PG8_BAR;
        PG8_WAIT_V(4); PG8_BAR;
        PG8_STAGE(PG8_SB(1, 0), cB + kstep, voffB); PG8_STAGE(PG8_SA(1, 0), cA + kstep, voffA); PG8_STAGE(PG8_SB(1, 1), cB + hstepB + kstep, voffB);
        PG8_WAIT_V(6); PG8_BAR;
    }
    for (;;) {
        const bool has_next = S.next(ui + 1, nxt);
        const char* nA = has_next ? S.aptr(g, nxt) : cA; const char* nB = has_next ? S.bptr(g, nxt) : cB;
        for (int t = 0; t < nt; t += 2) {
            const bool last = (t == nt - 2);
            const char* a1 = cA + (size_t)(t + 1) * kstep;
            const char* a2 = last ? nA : cA + (size_t)(t + 2) * kstep; const char* b2 = last ? nB : cB + (size_t)(t + 2) * kstep;
            const char* a3 = a2 + kstep; const char* b3 = b2 + kstep;
            if (last && has_next) S.a_ready(nxt);
            if constexpr (SP2) {
            PG8_LDB(B0, 0, 0); PG8_LDB(B1, 0, 1); PG8_SCHED; PG8_LDA(At, 0, 0); PG8_STAGE(PG8_SA(1, 1), a1 + hstepA, voffA);
            PG8_WAIT_V(8); PG8_WAIT_L(0); PG8_BAR; PG8_MMA(0, 0, At, B0); PG8_MMA(0, 1, At, B1); PG8_BAR; PG8_SCHED;
            PG8_LDA(At, 0, 1); PG8_STAGE(PG8_SB(0, 0), b2, voffB); PG8_STAGE(PG8_SB(0, 1), b2 + hstepB, voffB); PG8_STAGE(PG8_SA(0, 0), a2, voffA);
            PG8_WAIT_V(8); PG8_WAIT_L(0); PG8_BAR; PG8_MMA(1, 0, At, B0); PG8_MMA(1, 1, At, B1); PG8_BAR; PG8_SCHED;
            PG8_LDB(B0, 1, 0); PG8_LDB(B1, 1, 1); PG8_SCHED; PG8_LDA(At, 1, 0); PG8_STAGE(PG8_SA(0, 1), a2 + hstepA, voffA);
            PG8_WAIT_V(8); PG8_WAIT_L(0); PG8_BAR; PG8_MMA(0, 0, At, B0); PG8_MMA(0, 1, At, B1); PG8_BAR; PG8_SCHED;
            PG8_LDA(At, 1, 1); PG8_STAGE(PG8_SB(1, 0), b3, voffB); PG8_STAGE(PG8_SB(1, 1), b3 + hstepB, voffB); PG8_STAGE(PG8_SA(1, 0), a3, voffA);
            PG8_WAIT_V(8); PG8_WAIT_L(0); PG8_BAR; PG8_MMA(1, 0, At, B0); PG8_MMA(1, 1, At, B1); PG8_BAR; PG8_SCHED;
            } else {
            PG8_LDB(B0, 0, 0); PG8_SCHED; PG8_LDA(At, 0, 0); PG8_STAGE(PG8_SA(1, 1), a1 + hstepA, voffA);
            PG8_WAIT_L(8); PG8_BAR; PG8_WAIT_L(0); PG8_MMA(0, 0, At, B0); PG8_BAR; PG8_SCHED;
            PG8_LDB(B1, 0, 1); PG8_STAGE(PG8_SB(0, 0), b2, voffB);
            PG8_BAR; PG8_WAIT_L(0); PG8_MMA(0, 1, At, B1); PG8_BAR;
            PG8_LDA(At, 0, 1); PG8_STAGE(PG8_SA(0, 0), a2, voffA);
            PG8_BAR; PG8_WAIT_L(0); PG8_MMA(1, 0, At, B0); PG8_BAR; PG8_SCHED;
            PG8_STAGE(PG8_SB(0, 1), b2 + hstepB, voffB);
            PG8_WAIT_V(6); PG8_BAR; PG8_MMA(1, 1, At, B1); PG8_BAR;
            PG8_LDB(B0, 1, 0); PG8_SCHED; PG8_LDA(At, 1, 0); PG8_STAGE(PG8_SA(0, 1), a2 + hstepA, voffA);
            PG8_WAIT_L(8); PG8_BAR; PG8_WAIT_L(0); PG8_MMA(0, 0, At, B0); PG8_BAR; PG8_SCHED;
            PG8_LDB(B1, 1, 1); PG8_STAGE(PG8_SB(1, 0), b3, voffB);
            PG8_BAR; PG8_WAIT_L(0); PG8_MMA(0, 1, At, B1); PG8_BAR;
            PG8_LDA(At, 1, 1); PG8_STAGE(PG8_SA(1, 0), a3, voffA);
            PG8_BAR; PG8_WAIT_L(0); PG8_MMA(1, 0, At, B0); PG8_BAR; PG8_SCHED;
            PG8_STAGE(PG8_SB(1, 1), b3 + hstepB, voffB);
            PG8_WAIT_V(6); PG8_BAR; PG8_MMA(1, 1, At, B1); PG8_BAR;
            }
        }
        if constexpr (ALIGN_EPI) { if (wr == 0) PG8_BAR; }
        if constexpr (!Epi::AFTER_DRAIN) { E(acc, cur, wr, wc, fr, fq); S.done(cur); }
        if (!has_next) break;
#pragma unroll
        for (int a = 0; a < 2; ++a)
#pragma unroll
            for (int b = 0; b < 2; ++b)
#pragma unroll
                for (int m = 0; m < 4; ++m)
#pragma unroll
                    for (int n = 0; n < 2; ++n) acc[a][b][m][n] = (f32x4){0.f, 0.f, 0.f, 0.f};
        cur = nxt; cA = nA; cB = nB; ++ui;
        if constexpr (ALIGN_EPI) { if (wr == 1) PG8_BAR; }
    }
    PG8_WAIT_V(0);
    if constexpr (!ALIGN_EPI) { if (wr == 0) PG8_BAR; }
    PG8_BAR;
    if constexpr (Epi::AFTER_DRAIN) { E.fused(acc, cur, wr, wc, fr, fq, lds, wid, lane); S.done(cur); }
#undef PG8_SA
#undef PG8_SB
#undef PG8_STAGE
#undef PG8_LDA
#undef PG8_LDB
#undef PG8_MMA
#undef PG8_WAIT_V
#undef PG8_WAIT_L
#undef PG8_BAR
#undef PG8_SCHED
}
}

#ifndef PROBE_PH
#define PROBE_PH -1
#endif
constexpr int NWAVES = 8;
constexpr int N_LAUNCHES = MK_N_LAUNCHES;
constexpr int PER_PHASE = 12;

constexpr int T_TOK = 16384, DM = 1024, SEQ = 8192;
constexpr float EPS = 1e-6f;
constexpr int W_IN_COLS = 7176;

constexpr size_t MiB = 1u << 20;
constexpr size_t WS_CTL = 0, CTL_ZERO_BYTES = 1 * MiB;
constexpr size_t WS_WIN = 1 * MiB, WS_WKV = 15 * MiB, WS_WBR = 17 * MiB, WS_WOUT = 20 * MiB, WS_WPQ = 22 * MiB, WS_PK = 26 * MiB;
constexpr size_t WS_KVMEM = 26 * MiB + 512 * 1024, WS_MEMN = 27 * MiB + 512 * 1024, WS_IGLF = 28 * MiB + 512 * 1024, WS_ND = 29 * MiB, WS_NS = 29 * MiB + 512 * 1024;
constexpr size_t WS_GATES = 30 * MiB;
constexpr size_t WS_MLQ = 126 * MiB, WS_MLK = 142 * MiB, WS_SBQ = 158 * MiB, WS_MLV = 174 * MiB, WS_MEMQ = 190 * MiB, WS_MLO = 206 * MiB, WS_SBK = 222 * MiB, WS_SBV = 238 * MiB;
constexpr size_t WS_UT8 = 30 * MiB, WS_VT8 = 46 * MiB, WS_USC = 94 * MiB, WS_VSC = 94 * MiB + 65536;
constexpr size_t WS_H1B = 126 * MiB;
constexpr size_t WS_QRY = 158 * MiB;
constexpr size_t WS_CT = 222 * MiB;
constexpr size_t WS_MERGED = 222 * MiB;
constexpr size_t WS_IDX = 222 * MiB, WS_GW = 230 * MiB;
constexpr size_t WS_PD = 158 * MiB;
constexpr size_t WS_END = 254 * MiB;
constexpr size_t SPLIT_STRIDE = (size_t)T_TOK * 512;
constexpr size_t CTL_CHS = 256 * 1024, CTL_MS = 272 * 1024, CTL_SUMSQ = 512 * 1024;
constexpr int CW_BAR = 4096;

constexpr int RING_BYTES = 131072;
constexpr int LDSCTL_OFF = 155648, MISC_OFF = LDSCTL_OFF + 320;
constexpr int LDS_BYTES = 163840;

#define GAS __attribute__((address_space(1)))
#define LAS __attribute__((address_space(3)))
typedef unsigned short bf16;
typedef unsigned v4u __attribute__((ext_vector_type(4)));
typedef unsigned v2u __attribute__((ext_vector_type(2)));
typedef float f32x4 __attribute__((ext_vector_type(4)));
typedef short bf16x8 __attribute__((ext_vector_type(8)));
typedef GAS unsigned gu32;
#define RLX_AGENT __ATOMIC_RELAXED, __HIP_MEMORY_SCOPE_AGENT
#define LDS_WAIT() asm volatile("s_waitcnt lgkmcnt(0)" ::: "memory")
#define VM_WAIT() asm volatile("s_waitcnt vmcnt(0)" ::: "memory")
__device__ __forceinline__ unsigned f2bf(float f) { unsigned u = __builtin_bit_cast(unsigned, f); return (u + 0x7fffu + ((u >> 16) & 1u)) >> 16; }
__device__ __forceinline__ unsigned pk2(float lo, float hi) { return f2bf(lo) | (f2bf(hi) << 16); }
__device__ __forceinline__ float bflo(unsigned x) { return __uint_as_float(x << 16); }
__device__ __forceinline__ float bfhi(unsigned x) { return __uint_as_float(x & 0xffff0000u); }
__device__ __forceinline__ float sigm(float x) { return 1.0f / (1.0f + __expf(-x)); }
__device__ __forceinline__ float softplusf_(float z) { return fmaxf(z, 0.f) + __logf(1.0f + __expf(-fabsf(z))); }

#define XB_TMO      128
#define XB_XCNT(j)  (256  + 64 * (j))
#define XB_XSUB(j)  (1280 + 64 * (j))
#define XB_XGEN(j)  (2304 + 64 * (j))
#define XB_TOP      3328
#define XB_TOPGEN   3392
#define XCD_BAR_WORDS 3456
#define XB_SPIN_CAP (1u << 18)
__device__ __forceinline__ unsigned xb_ld(unsigned* p)              { return __hip_atomic_load(p, __ATOMIC_RELAXED, __HIP_MEMORY_SCOPE_AGENT); }
__device__ __forceinline__ unsigned xb_add(unsigned* p, unsigned v) { return __hip_atomic_fetch_add(p, v, __ATOMIC_RELAXED, __HIP_MEMORY_SCOPE_AGENT); }
__device__ __forceinline__ unsigned xb_xcc_id() { return (unsigned)__builtin_amdgcn_s_getreg((3 << 11) | 20) & 0xFu; }
#define XB_SPIN(cond, bar) do { unsigned _sp = 0; while (cond) { __builtin_amdgcn_s_sleep(1); \
    if ((++_sp & 255u) == 0u) { if (xb_ld(&(bar)[XB_TMO])) break; if (_sp > XB_SPIN_CAP) { atomicAdd(&(bar)[XB_TMO], 1u); break; } } } } while (0)
struct XcdBarrier { unsigned* bar; unsigned x; volatile LAS unsigned* st; };
__device__ __forceinline__ XcdBarrier xcd_barrier_post(unsigned* bar, volatile LAS unsigned* st) {
    XcdBarrier b; b.bar = bar; b.x = xb_xcc_id(); b.st = st;
    if (threadIdx.x == 0) (void)xb_add(&bar[XB_XCNT(b.x)], 1u);
    return b;
}
__device__ __forceinline__ void xcd_barrier_complete(unsigned* bar, unsigned x, unsigned& nloc, unsigned& nx) {
    const unsigned G = gridDim.x * gridDim.y * gridDim.z;
    unsigned sum, cnt, mine, sp = 0u;
    for (;;) {
        sum = 0u; cnt = 0u; mine = 0u;
#pragma unroll
        for (unsigned j = 0; j < 16; ++j) { const unsigned c = xb_ld(&bar[XB_XCNT(j)]); sum += c; cnt += (c > 0u) ? 1u : 0u; mine = (j == x) ? c : mine; }
        if (sum == G) break;
        __builtin_amdgcn_s_sleep(1);
        if ((++sp & 255u) == 0u) { if (xb_ld(&bar[XB_TMO])) break; if (sp > XB_SPIN_CAP) { atomicAdd(&bar[XB_TMO], 1u); break; } }
    }
    nloc = mine > 0u ? mine : 1u; nx = cnt > 0u ? cnt : 1u;
}
__device__ __forceinline__ void xcd_barrier(const XcdBarrier& b) {
    asm volatile("s_waitcnt vmcnt(0)" ::: "memory");
    __syncthreads();
    if (threadIdx.x == 0) {
        unsigned* bar = b.bar;
        __builtin_amdgcn_s_waitcnt(0);
        unsigned nloc = b.st[0], nx = b.st[1];
        if (nloc == 0u) { xcd_barrier_complete(bar, b.x, nloc, nx); b.st[0] = nloc; b.st[1] = nx; }
        const unsigned old = xb_add(&bar[XB_XSUB(b.x)], 1u);
        const unsigned gen = old / nloc;
        if (old + 1u == (gen + 1u) * nloc) {
            __builtin_amdgcn_fence(__ATOMIC_RELEASE, "agent");
            asm volatile("s_waitcnt vmcnt(0)" ::: "memory");
            const unsigned og = xb_add(&bar[XB_TOP], 1u);
            const unsigned tg = og / nx;
            if (og + 1u == (tg + 1u) * nx) xb_add(&bar[XB_TOPGEN], 1u);
            else XB_SPIN(xb_ld(&bar[XB_TOPGEN]) == tg, bar);
            __builtin_amdgcn_fence(__ATOMIC_ACQUIRE, "agent");
            xb_add(&bar[XB_XGEN(b.x)], 1u);
            asm volatile("s_waitcnt vmcnt(0)" ::: "memory");
        } else {
            XB_SPIN(xb_ld(&bar[XB_XGEN(b.x)]) == gen, bar);
            __builtin_amdgcn_fence(__ATOMIC_ACQUIRE, "agent");
            asm volatile("s_waitcnt vmcnt(0)" ::: "memory");
        }
    }
    __syncthreads();
}

struct Frame {
    LAS unsigned char* lds;
    volatile LAS unsigned* MISC;
    int tid, lane, wave, G;
    unsigned char* ws; float* out;
    const float* in[24];
};
__device__ __forceinline__ float wave_sum(float v) {
#pragma unroll
    for (int o = 1; o < 64; o <<= 1) v += __shfl_xor(v, o);
    return v;
}
__device__ __forceinline__ float wave_max(float v) {
#pragma unroll
    for (int o = 1; o < 64; o <<= 1) v = fmaxf(v, __shfl_xor(v, o));
    return v;
}

template <int NT, int KS>
__device__ __forceinline__ void wave_mma(f32x4 (&acc)[NT], const LAS unsigned char* A, int pitchA, int m0, const LAS unsigned char* Bt, int pitchB, int n0, int lane, int koffA = 0, int koffB = 0) {
    const int r = lane & 15, q = lane >> 4;
#pragma unroll
    for (int ks = 0; ks < KS; ++ks) {
        const bf16x8 a = *(const LAS bf16x8*)(A + (m0 + r) * pitchA + (koffA + ks * 32 + q * 8) * 2);
#pragma unroll
        for (int j = 0; j < NT; ++j) {
            const bf16x8 b = *(const LAS bf16x8*)(Bt + (n0 + 16 * j + r) * pitchB + (koffB + ks * 32 + q * 8) * 2);
            acc[j] = __builtin_amdgcn_mfma_f32_16x16x32_bf16(a, b, acc[j], 0, 0, 0);
        }
    }
}
__device__ __forceinline__ void lds_store_tr8(LAS unsigned char* base, int pitch, int d0, int col, v4u v) {
    *(LAS unsigned short*)(base + (d0 + 0) * pitch + col * 2) = (unsigned short)(v.x & 0xffffu); *(LAS unsigned short*)(base + (d0 + 1) * pitch + col * 2) = (unsigned short)(v.x >> 16);
    *(LAS unsigned short*)(base + (d0 + 2) * pitch + col * 2) = (unsigned short)(v.y & 0xffffu); *(LAS unsigned short*)(base + (d0 + 3) * pitch + col * 2) = (unsigned short)(v.y >> 16);
    *(LAS unsigned short*)(base + (d0 + 4) * pitch + col * 2) = (unsigned short)(v.z & 0xffffu); *(LAS unsigned short*)(base + (d0 + 5) * pitch + col * 2) = (unsigned short)(v.z >> 16);
    *(LAS unsigned short*)(base + (d0 + 6) * pitch + col * 2) = (unsigned short)(v.w & 0xffffu); *(LAS unsigned short*)(base + (d0 + 7) * pitch + col * 2) = (unsigned short)(v.w >> 16);
}

__device__ __forceinline__ void p0_transpose_item(const float* W, int ldsrc, int src_off, int K, int ncols, bf16* WT, int row_off, const float* kscale, LAS float* scr, int item, int lane) {
    const int nblk = ncols / 32, kb = item / nblk, nb = item % nblk, k0 = 64 * kb, n0 = 32 * nb;
#pragma unroll 8
    for (int i = 0; i < 32; ++i) { const int kk = 2 * i + (lane >> 5); float v = W[(size_t)(k0 + kk) * ldsrc + src_off + n0 + (lane & 31)]; if (kscale) v *= kscale[k0 + kk]; scr[kk * 33 + (lane & 31)] = v; }
    LDS_WAIT(); asm volatile("" ::: "memory");
    const int c = lane & 7;
#pragma unroll
    for (int j = 0; j < 4; ++j) { const int n = (lane >> 3) + 8 * j; const LAS float* s = scr + (8 * c) * 33 + n;
        v4u o; o.x = pk2(s[0 * 33], s[1 * 33]); o.y = pk2(s[2 * 33], s[3 * 33]); o.z = pk2(s[4 * 33], s[5 * 33]); o.w = pk2(s[6 * 33], s[7 * 33]);
        *(GAS v4u*)(WT + (size_t)(row_off + n0 + n) * K + k0 + 8 * c) = o; }
    LDS_WAIT(); asm volatile("" ::: "memory");
}

__device__ __forceinline__ void p0_prologue(Frame& F) {
    const float* x = F.in[0]; const float* mem = F.in[1]; const float* g_mix = F.in[2]; const float* w_in = F.in[3];
    const float* b_ig = F.in[4]; const float* b_fg = F.in[5]; const float* mem_g = F.in[9];
    bf16* XN = (bf16*)F.out;
    bf16* MEMN = (bf16*)(F.ws + WS_MEMN);
    float* IGLF = (float*)(F.ws + WS_IGLF);
    LAS float* gws = (LAS float*)(F.lds + 69632);
    for (int e = F.tid; e < 8192; e += 512) { const int c = e & 7, k = e >> 3; gws[c * 1024 + k] = w_in[(size_t)k * W_IN_COLS + 3072 + c]; }
    __syncthreads();
    const int gw = blockIdx.x * NWAVES + F.wave, NGW = F.G * NWAVES;
    for (int m = gw; m < T_TOK + 512; m += NGW) {
        const bool is_mem = m >= T_TOK;
        const float* src = is_mem ? mem + (size_t)(m - T_TOK) * DM : x + (size_t)m * DM;
        const float* gsrc = is_mem ? mem_g : g_mix;
        bf16* dst = is_mem ? MEMN + (size_t)(m - T_TOK) * DM : XN + (size_t)m * DM;
        const GAS f32x4* xr = (const GAS f32x4*)src + F.lane;
        f32x4 v[4]; float s = 0.f;
#pragma unroll
        for (int j = 0; j < 4; ++j) { v[j] = xr[64 * j]; s += (v[j].x * v[j].x + v[j].y * v[j].y) + (v[j].z * v[j].z + v[j].w * v[j].w); }
        const float rstd = 1.0f / sqrtf(wave_sum(s) * (1.f / DM) + EPS);
#pragma unroll
        for (int j = 0; j < 4; ++j) { const f32x4 gg = *((const GAS f32x4*)gsrc + F.lane + 64 * j); v[j] = v[j] * rstd * gg; }
        GAS unsigned long long* o8 = (GAS unsigned long long*)dst + F.lane;
#pragma unroll
        for (int j = 0; j < 4; ++j) o8[64 * j] = (unsigned long long)pk2(v[j].x, v[j].y) | ((unsigned long long)pk2(v[j].z, v[j].w) << 32);
        if (!is_mem) {
            float dots[8];
#pragma unroll
            for (int c = 0; c < 8; ++c) { float d = 0.f;
#pragma unroll
                for (int j = 0; j < 4; ++j) { const f32x4 wv = *(const LAS f32x4*)(gws + c * 1024 + 256 * j + 4 * F.lane); d += (v[j].x * wv.x + v[j].y * wv.y) + (v[j].z * wv.z + v[j].w * wv.w); }
                dots[c] = wave_sum(d); }
            if (F.lane == 0) {
                f32x4 o0, o1;
#pragma unroll
                for (int h = 0; h < 4; ++h) { o0[h] = dots[h] + b_ig[h]; const float fp = dots[4 + h] + b_fg[h]; o1[h] = fminf(fp, 0.f) - __logf(1.0f + __expf(-fabsf(fp))); }
                *(GAS f32x4*)(IGLF + (size_t)m * 8) = o0; *(GAS f32x4*)(IGLF + (size_t)m * 8 + 4) = o1;
            }
        }
    }
    { const float* k1 = F.in[20]; const float* k2 = F.in[21]; bf16* PK = (bf16*)(F.ws + WS_PK);
      for (int e = (blockIdx.x * 512 + F.tid) * 4; e < 2 * 131072; e += F.G * 512 * 4) {
          const f32x4 vv = (e < 131072) ? *(const GAS f32x4*)(k1 + e) : *(const GAS f32x4*)(k2 + e - 131072);
          v2u o; o.x = pk2(vv.x, vv.y); o.y = pk2(vv.z, vv.w); *(GAS v2u*)(PK + e) = o; } }
    __syncthreads();
    LAS float* scr = (LAS float*)(F.lds + F.wave * 8448);
    bf16* WIN = (bf16*)(F.ws + WS_WIN); bf16* WKV = (bf16*)(F.ws + WS_WKV); bf16* WBR = (bf16*)(F.ws + WS_WBR); bf16* WOUT = (bf16*)(F.ws + WS_WOUT); bf16* WPQ = (bf16*)(F.ws + WS_WPQ);
    constexpr int I_G = 16 * 96, I_5 = 16 * 16, I_KV = 16 * 32, I_BR = 8 * 32, I_OUT = 16 * 32, I_PQ = 16 * 64;
    constexpr int NITEMS = I_G + 8 * I_5 + I_KV + 3 * I_BR + I_OUT + I_PQ;
    for (int it = gw; it < NITEMS; it += NGW) {
        int r = it;
        if (r < I_G) { p0_transpose_item(w_in, W_IN_COLS, 4104, 1024, 3072, WIN, 0, nullptr, scr, r, F.lane); continue; } r -= I_G;
        if (r < I_5) { p0_transpose_item(w_in, W_IN_COLS, 1536, 1024, 512, WIN, 3072, nullptr, scr, r, F.lane); continue; } r -= I_5;
        if (r < I_5) { p0_transpose_item(w_in, W_IN_COLS, 2048, 1024, 512, WIN, 3584, nullptr, scr, r, F.lane); continue; } r -= I_5;
        if (r < I_5) { p0_transpose_item(w_in, W_IN_COLS, 0, 1024, 512, WIN, 4096, nullptr, scr, r, F.lane); continue; } r -= I_5;
        if (r < I_5) { p0_transpose_item(w_in, W_IN_COLS, 2560, 1024, 512, WIN, 4608, nullptr, scr, r, F.lane); continue; } r -= I_5;
        if (r < I_5) { p0_transpose_item(w_in, W_IN_COLS, 3592, 1024, 512, WIN, 5120, nullptr, scr, r, F.lane); continue; } r -= I_5;
        if (r < I_5) { p0_transpose_item(w_in, W_IN_COLS, 3080, 1024, 512, WIN, 5632, nullptr, scr, r, F.lane); continue; } r -= I_5;
        if (r < I_5) { p0_transpose_item(w_in, W_IN_COLS, 512, 1024, 512, WIN, 6144, nullptr, scr, r, F.lane); continue; } r -= I_5;
        if (r < I_5) { p0_transpose_item(w_in, W_IN_COLS, 1024, 1024, 512, WIN, 6656, nullptr, scr, r, F.lane); continue; } r -= I_5;
        if (r < I_KV) { p0_transpose_item(F.in[10], 1024, 0, 1024, 1024, WKV, 0, nullptr, scr, r, F.lane); continue; } r -= I_KV;
        if (r < I_BR) { p0_transpose_item(F.in[13], 1024, 0, 512, 1024, WBR, 0, nullptr, scr, r, F.lane); continue; } r -= I_BR;
        if (r < I_BR) { p0_transpose_item(F.in[14], 1024, 0, 512, 1024, WBR, 1024, nullptr, scr, r, F.lane); continue; } r -= I_BR;
        if (r < I_BR) { p0_transpose_item(F.in[15], 1024, 0, 512, 1024, WBR, 2048, nullptr, scr, r, F.lane); continue; } r -= I_BR;
        if (r < I_OUT) { p0_transpose_item(F.in[17], 1024, 0, 1024, 1024, WOUT, 0, nullptr, scr, r, F.lane); continue; } r -= I_OUT;
        p0_transpose_item(F.in[19], 2048, 0, 1024, 2048, WPQ, 0, F.in[18], scr, r, F.lane);
    }
}

__device__ __forceinline__ void sb_attn_item(Frame& F, int item, bf16* outp, size_t rmask) {
    const int bh = item >> 6, qb = item & 63, b = bh >> 3, h = bh & 7;
    const int tid = F.tid, lane = F.lane, w = F.wave;
    LAS unsigned char* Qs = F.lds;
    LAS unsigned char* Ks = F.lds + 18432;
    LAS unsigned char* VTs = F.lds + 27648;
    LAS unsigned char* Ss = F.lds + 36864;
    LAS unsigned char* Ps = F.lds + 71680;
    LAS float* red = (LAS float*)(F.lds + 90112);
    bf16* SBQ = (bf16*)(F.ws + WS_SBQ); const bf16* SBK = (const bf16*)(F.ws + WS_SBK); const bf16* SBV = (const bf16*)(F.ws + WS_SBV);
    const size_t row0 = (size_t)b * SEQ + (size_t)qb * 128;
    __syncthreads();
#pragma unroll
    for (int i = 0; i < 2; ++i) { const int p = tid + 512 * i, r = p >> 3, c = p & 7;
        const v4u v = *(const GAS v4u*)(SBQ + (row0 + r) * 512 + h * 64 + c * 8); *(LAS v4u*)(Qs + r * 144 + c * 16) = v; }
    f32x4 oacc[4];
#pragma unroll
    for (int j = 0; j < 4; ++j) oacc[j] = (f32x4){0.f, 0.f, 0.f, 0.f};
    float R = 0.f;
    const int r = tid >> 2, qd = tid & 3;
    const int tq = qb * 128 + r;
    const int skey = tid >> 3, sc8 = tid & 7;
    v4u kv, vv;
    { const size_t grow = (size_t)b * SEQ + (size_t)(2 * qb + 1) * 64 + skey; kv = *(const GAS v4u*)(SBK + grow * 512 + h * 64 + sc8 * 8); vv = *(const GAS v4u*)(SBV + grow * 512 + h * 64 + sc8 * 8); }
    for (int jb = 2 * qb + 1; jb >= 0; --jb) {
        __syncthreads();
        *(LAS v4u*)(Ks + skey * 144 + sc8 * 16) = kv; lds_store_tr8(VTs, 144, sc8 * 8, skey, vv);
        if (jb > 0) { const size_t grow = (size_t)b * SEQ + (size_t)(jb - 1) * 64 + skey; kv = *(const GAS v4u*)(SBK + grow * 512 + h * 64 + sc8 * 8); vv = *(const GAS v4u*)(SBV + grow * 512 + h * 64 + sc8 * 8); }
        __syncthreads();
        { f32x4 sacc[4];
#pragma unroll
          for (int j = 0; j < 4; ++j) sacc[j] = (f32x4){0.f, 0.f, 0.f, 0.f};
          wave_mma<4, 2>(sacc, Qs, 144, 16 * w, Ks, 144, 0, lane);
#pragma unroll
          for (int j = 0; j < 4; ++j)
#pragma unroll
              for (int rg = 0; rg < 4; ++rg) *(LAS float*)(Ss + (16 * w + 4 * (lane >> 4) + rg) * 272 + (16 * j + (lane & 15)) * 4) = sacc[j][rg]; }
        __syncthreads();
        { float z[16];
#pragma unroll
          for (int i4 = 0; i4 < 4; ++i4) { const f32x4 t4 = *(const LAS f32x4*)(Ss + r * 272 + qd * 64 + i4 * 16); z[4 * i4] = t4.x; z[4 * i4 + 1] = t4.y; z[4 * i4 + 2] = t4.z; z[4 * i4 + 3] = t4.w; }
          const int s0 = jb * 64 + qd * 16;
          float suf[16], lb[16]; float run = 0.f;
#pragma unroll
          for (int i = 15; i >= 0; --i) { const float zz = z[i] * 0.125f; const bool mk = (s0 + i) < tq; const float sp = softplusf_(zz); lb[i] = zz - sp; suf[i] = run; run += mk ? -sp : 0.f; }
          const float a1 = __shfl_xor(run, 1), a2 = __shfl_xor(run, 2), a3 = __shfl_xor(run, 3);
          const float off = ((qd & 1) == 0 ? a1 : 0.f) + ((qd & 2) == 0 ? a2 : 0.f) + (qd < 2 ? a3 : 0.f);
          const float base = R + off;
          unsigned pw[8];
#pragma unroll
          for (int i = 0; i < 16; i += 2) { const float p0 = ((s0 + i) < tq) ? __expf(lb[i] + base + suf[i]) : 0.f; const float p1 = ((s0 + i + 1) < tq) ? __expf(lb[i + 1] + base + suf[i + 1]) : 0.f; pw[i >> 1] = pk2(p0, p1); }
          *(LAS v4u*)(Ps + r * 144 + qd * 32) = (v4u){pw[0], pw[1], pw[2], pw[3]}; *(LAS v4u*)(Ps + r * 144 + qd * 32 + 16) = (v4u){pw[4], pw[5], pw[6], pw[7]};
          R += run + a1 + a2 + a3; }
        const float rm = wave_max(R);
        if (lane == 0) red[w] = rm;
        __syncthreads();
        wave_mma<4, 2>(oacc, Ps, 144, 16 * w, VTs, 144, 0, lane);
        float rmax = red[0];
#pragma unroll
        for (int i = 1; i < 8; ++i) rmax = fmaxf(rmax, red[i]);
        if (rmax < -110.f) break;
    }
    LDS_WAIT();
#pragma unroll
    for (int j = 0; j < 4; ++j)
#pragma unroll
        for (int rg = 0; rg < 4; ++rg) *(LAS unsigned short*)(Ps + (16 * w + 4 * (lane >> 4) + rg) * 144 + (16 * j + (lane & 15)) * 2) = (unsigned short)f2bf(oacc[j][rg]);
    LDS_WAIT();
#pragma unroll
    for (int i = 0; i < 2; ++i) { const int p = lane + 64 * i, rr = 16 * w + (p >> 3), c = p & 7;
        const v4u v = *(const LAS v4u*)(Ps + rr * 144 + c * 16); *(GAS v4u*)(outp + ((row0 + rr) & rmask) * 512 + h * 64 + c * 8) = v; }
}

__device__ __forceinline__ void conv16(const bf16* src, int col, const float* cw, const float* cb, int ch, int b, int t, float (&y)[16]) {
#pragma unroll
    for (int i4 = 0; i4 < 4; ++i4) { const f32x4 bb = *(const GAS f32x4*)(cb + ch + 4 * i4); y[4 * i4] = bb.x; y[4 * i4 + 1] = bb.y; y[4 * i4 + 2] = bb.z; y[4 * i4 + 3] = bb.w; }
#pragma unroll
    for (int kk = 0; kk < 4; ++kk) { const int tt = t - 3 + kk;
        if (tt >= 0) { const bf16* p = src + ((size_t)b * SEQ + tt) * 512 + col; const v4u x0 = *(const GAS v4u*)p, x1 = *(const GAS v4u*)(p + 8);
            const float xs[16] = {bflo(x0.x), bfhi(x0.x), bflo(x0.y), bfhi(x0.y), bflo(x0.z), bfhi(x0.z), bflo(x0.w), bfhi(x0.w), bflo(x1.x), bfhi(x1.x), bflo(x1.y), bfhi(x1.y), bflo(x1.z), bfhi(x1.z), bflo(x1.w), bfhi(x1.w)};
#pragma unroll
            for (int i4 = 0; i4 < 4; ++i4) { const f32x4 wv = *(const GAS f32x4*)(cw + kk * 1024 + ch + 4 * i4);
                y[4 * i4] += wv.x * xs[4 * i4]; y[4 * i4 + 1] += wv.y * xs[4 * i4 + 1]; y[4 * i4 + 2] += wv.z * xs[4 * i4 + 2]; y[4 * i4 + 3] += wv.w * xs[4 * i4 + 3]; } } }
#pragma unroll
    for (int i = 0; i < 16; ++i) y[i] = y[i] * sigm(y[i]);
}

__device__ __forceinline__ void mlstm_local_item(Frame& F, int item) {
    const int bh = item >> 7, c = item & 127, b = bh >> 2, h = bh & 3;
    const int tid = F.tid, lane = F.lane, w = F.wave;
    LAS float* wsm = (LAS float*)F.lds;
    LAS unsigned char* WKT = F.lds + 256;
    LAS unsigned char* VT = F.lds + 256 + 18432;
    const float* IGLF = (const float*)(F.ws + WS_IGLF);
    float* CHS = (float*)(F.ws + WS_CTL + CTL_CHS);
    const bf16* MLK = (const bf16*)(F.ws + WS_MLK); const bf16* MLV = (const bf16*)(F.ws + WS_MLV);
    float* Dg = F.out + (size_t)item * 16384; float* NDg = (float*)(F.ws + WS_ND) + (size_t)item * 128;
    const int t0 = c * 64; const size_t row0 = (size_t)b * SEQ + t0;
    __syncthreads();
    if (w == 0) {
        const float lf = IGLF[(row0 + lane) * 8 + 4 + h], ig = IGLF[(row0 + lane) * 8 + h];
        float bs = lf;
#pragma unroll
        for (int o = 1; o < 64; o <<= 1) { const float v = __shfl_up(bs, o); if (lane >= o) bs += v; }
        const float blast = __shfl(bs, 63);
        const float a = blast - bs + ig; const float mu = wave_max(a);
        wsm[lane] = __expf(a - mu);
        if (lane == 0) { CHS[2 * item] = blast; CHS[2 * item + 1] = mu; }
    }
    __syncthreads();
    { const int s = tid >> 3, part = tid & 7; float y[16];
      conv16(MLK, h * 128 + part * 16, F.in[6], F.in[7], 512 + h * 128 + part * 16, b, t0 + s, y);
      const float sc = wsm[s] * 0.08838834764831845f;
      v4u k0, k1; k0.x = pk2(y[0] * sc, y[1] * sc); k0.y = pk2(y[2] * sc, y[3] * sc); k0.z = pk2(y[4] * sc, y[5] * sc); k0.w = pk2(y[6] * sc, y[7] * sc);
      k1.x = pk2(y[8] * sc, y[9] * sc); k1.y = pk2(y[10] * sc, y[11] * sc); k1.z = pk2(y[12] * sc, y[13] * sc); k1.w = pk2(y[14] * sc, y[15] * sc);
      lds_store_tr8(WKT, 144, part * 16, s, k0); lds_store_tr8(WKT, 144, part * 16 + 8, s, k1);
      const bf16* vp = MLV + (row0 + s) * 512 + h * 128 + part * 16; const v4u v0 = *(const GAS v4u*)vp, v1 = *(const GAS v4u*)(vp + 8);
      lds_store_tr8(VT, 144, part * 16, s, v0); lds_store_tr8(VT, 144, part * 16 + 8, s, v1); }
    __syncthreads();
    { f32x4 acc[8];
#pragma unroll
      for (int j = 0; j < 8; ++j) acc[j] = (f32x4){0.f, 0.f, 0.f, 0.f};
      wave_mma<8, 2>(acc, VT, 144, 16 * w, WKT, 144, 0, lane);
#pragma unroll
      for (int j = 0; j < 8; ++j)
#pragma unroll
          for (int rg = 0; rg < 4; ++rg) Dg[(16 * w + 4 * (lane >> 4) + rg) * 128 + 16 * j + (lane & 15)] = acc[j][rg]; }
    if (tid < 128) { float s = 0.f;
#pragma unroll
        for (int i = 0; i < 8; ++i) { const v4u v = *(const LAS v4u*)(WKT + tid * 144 + i * 16); s += (bflo(v.x) + bfhi(v.x)) + (bflo(v.y) + bfhi(v.y)) + (bflo(v.z) + bfhi(v.z)) + (bflo(v.w) + bfhi(v.w)); }
        NDg[tid] = s; }
}

__device__ __forceinline__ void mlstm_scan(Frame& F) {
    const float* CHS = (const float*)(F.ws + WS_CTL + CTL_CHS); float* MS = (float*)(F.ws + WS_CTL + CTL_MS);
    const float* Dg = F.out; bf16* CT = (bf16*)(F.ws + WS_CT);
    const float* NDg = (const float*)(F.ws + WS_ND); float* NS = (float*)(F.ws + WS_NS);
    LAS float* chs = (LAS float*)F.lds;
    __syncthreads();
    for (int i = F.tid; i < 2048; i += 512) chs[i] = CHS[i];
    __syncthreads();
    if (F.tid < 8) { float m = 0.f;
        for (int c = 0; c < 128; ++c) { const int item = F.tid * 128 + c; const float blast = chs[2 * item], mu = chs[2 * item + 1];
            if (blockIdx.x == 0) MS[item] = m;
            const float mn = fmaxf(blast + m, mu); chs[2 * item] = __expf(blast + m - mn); chs[2 * item + 1] = __expf(mu - mn); m = mn; } }
    __syncthreads();
    for (int g = blockIdx.x * 512 + F.tid; g < 8 * 16384; g += F.G * 512) {
        const int bh = g >> 14, e = g & 16383; float st = 0.f;
        const float* dp = Dg + (size_t)bh * 128 * 16384 + e; bf16* cp = CT + (size_t)bh * 128 * 16384 + e;
        for (int c0 = 0; c0 < 128; c0 += 16) { float d[16];
#pragma unroll
            for (int k = 0; k < 16; ++k) d[k] = __builtin_nontemporal_load(dp + (size_t)(c0 + k) * 16384);
#pragma unroll
            for (int k = 0; k < 16; ++k) { cp[(size_t)(c0 + k) * 16384] = (bf16)f2bf(st); st = chs[2 * (bh * 128 + c0 + k)] * st + chs[2 * (bh * 128 + c0 + k) + 1] * d[k]; } }
    }
    for (int g = blockIdx.x * 512 + F.tid; g < 8 * 128; g += F.G * 512) {
        const int bh = g >> 7, e = g & 127; float st = 0.f;
        for (int c = 0; c < 128; ++c) { const int item = bh * 128 + c; NS[(size_t)item * 128 + e] = st; st = chs[2 * item] * st + chs[2 * item + 1] * NDg[(size_t)item * 128 + e]; }
    }
}

__device__ __forceinline__ void mem_attn_item(Frame& F, int item, bf16* outp, size_t rmask) {
    const int tile = item & 63, h = (item >> 6) & 3, b = item >> 8;
    const int tid = F.tid, lane = F.lane, w = F.wave;
    LAS unsigned char* Qs = F.lds;
    LAS unsigned char* KVs = F.lds + 34816;
    LAS unsigned char* Pw = F.lds + 34816 + 69632 + w * 2304;
    bf16* MEMQ = (bf16*)(F.ws + WS_MEMQ); const bf16* KV = (const bf16*)(F.ws + WS_KVMEM);
    const float* qg = F.in[11]; const float* kg = F.in[12];
    const size_t row0 = (size_t)b * SEQ + (size_t)tile * 128;
    __syncthreads();
    { const int r = tid >> 2, part = tid & 3; const bf16* p = MEMQ + (row0 + r) * 512 + h * 128 + part * 32;
      v4u x[4]; float s = 0.f;
#pragma unroll
      for (int i = 0; i < 4; ++i) { x[i] = *(const GAS v4u*)(p + 8 * i);
          s += (bflo(x[i].x) * bflo(x[i].x) + bfhi(x[i].x) * bfhi(x[i].x)) + (bflo(x[i].y) * bflo(x[i].y) + bfhi(x[i].y) * bfhi(x[i].y)) + (bflo(x[i].z) * bflo(x[i].z) + bfhi(x[i].z) * bfhi(x[i].z)) + (bflo(x[i].w) * bflo(x[i].w) + bfhi(x[i].w) * bfhi(x[i].w)); }
      s += __shfl_xor(s, 1); s += __shfl_xor(s, 2);
      const float rs = 0.08838834764831845f / sqrtf(s * (1.f / 128.f) + EPS);
#pragma unroll
      for (int i = 0; i < 4; ++i) { const f32x4 g0 = *(const GAS f32x4*)(qg + part * 32 + 8 * i), g1 = *(const GAS f32x4*)(qg + part * 32 + 8 * i + 4);
          v4u o; o.x = pk2(bflo(x[i].x) * rs * g0.x, bfhi(x[i].x) * rs * g0.y); o.y = pk2(bflo(x[i].y) * rs * g0.z, bfhi(x[i].y) * rs * g0.w);
          o.z = pk2(bflo(x[i].z) * rs * g1.x, bfhi(x[i].z) * rs * g1.y); o.w = pk2(bflo(x[i].w) * rs * g1.z, bfhi(x[i].w) * rs * g1.w);
          *(LAS v4u*)(Qs + r * 272 + part * 64 + i * 16) = o; } }
    { const int key = tid >> 1, half = tid & 1; const bf16* p = KV + ((size_t)b * 256 + key) * 1024 + h * 128 + half * 64;
      v4u x[8]; float s = 0.f;
#pragma unroll
      for (int i = 0; i < 8; ++i) { x[i] = *(const GAS v4u*)(p + 8 * i);
          s += (bflo(x[i].x) * bflo(x[i].x) + bfhi(x[i].x) * bfhi(x[i].x)) + (bflo(x[i].y) * bflo(x[i].y) + bfhi(x[i].y) * bfhi(x[i].y)) + (bflo(x[i].z) * bflo(x[i].z) + bfhi(x[i].z) * bfhi(x[i].z)) + (bflo(x[i].w) * bflo(x[i].w) + bfhi(x[i].w) * bfhi(x[i].w)); }
      s += __shfl_xor(s, 1);
      const float rs = 1.0f / sqrtf(s * (1.f / 128.f) + EPS);
#pragma unroll
      for (int i = 0; i < 8; ++i) { const f32x4 g0 = *(const GAS f32x4*)(kg + half * 64 + 8 * i), g1 = *(const GAS f32x4*)(kg + half * 64 + 8 * i + 4);
          v4u o; o.x = pk2(bflo(x[i].x) * rs * g0.x, bfhi(x[i].x) * rs * g0.y); o.y = pk2(bflo(x[i].y) * rs * g0.z, bfhi(x[i].y) * rs * g0.w);
          o.z = pk2(bflo(x[i].z) * rs * g1.x, bfhi(x[i].z) * rs * g1.y); o.w = pk2(bflo(x[i].w) * rs * g1.z, bfhi(x[i].w) * rs * g1.w);
          *(LAS v4u*)(KVs + key * 272 + half * 128 + i * 16) = o; } }
    __syncthreads();
    f32x4 sacc[16];
#pragma unroll
    for (int j = 0; j < 16; ++j) sacc[j] = (f32x4){0.f, 0.f, 0.f, 0.f};
    wave_mma<16, 4>(sacc, Qs, 272, 16 * w, KVs, 272, 0, lane);
    float rsum[4];
#pragma unroll
    for (int rg = 0; rg < 4; ++rg) { float mx = sacc[0][rg];
#pragma unroll
        for (int j = 1; j < 16; ++j) mx = fmaxf(mx, sacc[j][rg]);
        mx = fmaxf(mx, __shfl_xor(mx, 1)); mx = fmaxf(mx, __shfl_xor(mx, 2)); mx = fmaxf(mx, __shfl_xor(mx, 4)); mx = fmaxf(mx, __shfl_xor(mx, 8));
        float sm = 0.f;
#pragma unroll
        for (int j = 0; j < 16; ++j) { const float p = __expf(sacc[j][rg] - mx); sacc[j][rg] = p; sm += p; }
        sm += __shfl_xor(sm, 1); sm += __shfl_xor(sm, 2); sm += __shfl_xor(sm, 4); sm += __shfl_xor(sm, 8);
        rsum[rg] = 1.0f / sm; }
    __syncthreads();
#pragma unroll
    for (int i = 0; i < 8; ++i) { const int p = tid + 512 * i, key = p >> 4, c = p & 15;
        const v4u v = *(const GAS v4u*)(KV + ((size_t)b * 256 + key) * 1024 + 512 + h * 128 + c * 8); lds_store_tr8(KVs, 528, c * 8, key, v); }
    __syncthreads();
    f32x4 oacc[8];
#pragma unroll
    for (int j = 0; j < 8; ++j) oacc[j] = (f32x4){0.f, 0.f, 0.f, 0.f};
#pragma unroll
    for (int kc = 0; kc < 4; ++kc) {
        LDS_WAIT();
#pragma unroll
        for (int jj = 0; jj < 4; ++jj)
#pragma unroll
            for (int rg = 0; rg < 4; ++rg) *(LAS unsigned short*)(Pw + (4 * (lane >> 4) + rg) * 144 + (16 * jj + (lane & 15)) * 2) = (unsigned short)f2bf(sacc[4 * kc + jj][rg]);
        LDS_WAIT();
        wave_mma<8, 2>(oacc, Pw, 144, 0, KVs, 528, 0, lane, 0, 64 * kc);
    }
    LDS_WAIT();
#pragma unroll
    for (int j = 0; j < 8; ++j)
#pragma unroll
        for (int rg = 0; rg < 4; ++rg) *(LAS unsigned short*)(Qs + (16 * w + 4 * (lane >> 4) + rg) * 272 + (16 * j + (lane & 15)) * 2) = (unsigned short)f2bf(oacc[j][rg] * rsum[rg]);
    LDS_WAIT();
#pragma unroll
    for (int i = 0; i < 4; ++i) { const int p = lane + 64 * i, rr = 16 * w + (p >> 4), c = p & 15;
        const v4u v = *(const LAS v4u*)(Qs + rr * 272 + c * 16); *(GAS v4u*)(outp + ((row0 + rr) & rmask) * 512 + h * 128 + c * 8) = v; }
}

__device__ __forceinline__ void mlstm_out_item(Frame& F, int item, bf16* outp, size_t rmask) {
    const int bh = item >> 7, c = item & 127, b = bh >> 2, h = bh & 3;
    const int tid = F.tid, lane = F.lane, w = F.wave;
    LAS unsigned char* Qs = F.lds;
    LAS unsigned char* Ks = F.lds + 17408;
    LAS unsigned char* VT = F.lds + 34816;
    LAS unsigned char* CTs = F.lds + 53248;
    LAS unsigned char* Ss = F.lds + 88064;
    LAS unsigned char* Ws = F.lds + 105472;
    LAS float* bcum = (LAS float*)(F.lds + 114688);
    LAS float* igs = bcum + 64;
    LAS float* nsv = bcum + 128;
    LAS float* rden = bcum + 256;
    const float* IGLF = (const float*)(F.ws + WS_IGLF);
    const bf16* MLQ = (const bf16*)(F.ws + WS_MLQ); const bf16* MLK = (const bf16*)(F.ws + WS_MLK); bf16* MLV = (bf16*)(F.ws + WS_MLV); const bf16* MLO = (const bf16*)(F.ws + WS_MLO);
    const bf16* CT = (const bf16*)(F.ws + WS_CT) + (size_t)item * 16384;
    const float* NS = (const float*)(F.ws + WS_NS) + (size_t)item * 128;
    const float mc = ((const float*)(F.ws + WS_CTL + CTL_MS))[item];
    const int t0 = c * 64; const size_t row0 = (size_t)b * SEQ + t0;
    __syncthreads();
    if (w == 0) {
        const float lf = IGLF[(row0 + lane) * 8 + 4 + h], ig = IGLF[(row0 + lane) * 8 + h];
        float bs = lf;
#pragma unroll
        for (int o = 1; o < 64; o <<= 1) { const float v = __shfl_up(bs, o); if (lane >= o) bs += v; }
        bcum[lane] = bs; igs[lane] = ig;
    } else if (w == 1 || w == 2) { const int i = tid - 64; nsv[i] = NS[i]; }
    { const int s = tid >> 3, part = tid & 7; float y[16];
      conv16(MLQ, h * 128 + part * 16, F.in[6], F.in[7], h * 128 + part * 16, b, t0 + s, y);
      v4u q0, q1; q0.x = pk2(y[0], y[1]); q0.y = pk2(y[2], y[3]); q0.z = pk2(y[4], y[5]); q0.w = pk2(y[6], y[7]); q1.x = pk2(y[8], y[9]); q1.y = pk2(y[10], y[11]); q1.z = pk2(y[12], y[13]); q1.w = pk2(y[14], y[15]);
      *(LAS v4u*)(Qs + s * 272 + part * 32) = q0; *(LAS v4u*)(Qs + s * 272 + part * 32 + 16) = q1;
      conv16(MLK, h * 128 + part * 16, F.in[6], F.in[7], 512 + h * 128 + part * 16, b, t0 + s, y);
      const float sc = 0.08838834764831845f;
      q0.x = pk2(y[0] * sc, y[1] * sc); q0.y = pk2(y[2] * sc, y[3] * sc); q0.z = pk2(y[4] * sc, y[5] * sc); q0.w = pk2(y[6] * sc, y[7] * sc);
      q1.x = pk2(y[8] * sc, y[9] * sc); q1.y = pk2(y[10] * sc, y[11] * sc); q1.z = pk2(y[12] * sc, y[13] * sc); q1.w = pk2(y[14] * sc, y[15] * sc);
      *(LAS v4u*)(Ks + s * 272 + part * 32) = q0; *(LAS v4u*)(Ks + s * 272 + part * 32 + 16) = q1;
      const bf16* vp = MLV + (row0 + s) * 512 + h * 128 + part * 16; const v4u v0 = *(const GAS v4u*)vp, v1 = *(const GAS v4u*)(vp + 8);
      lds_store_tr8(VT, 144, part * 16, s, v0); lds_store_tr8(VT, 144, part * 16 + 8, s, v1); }
#pragma unroll
    for (int i = 0; i < 4; ++i) { const int p = tid + 512 * i, rr = p >> 4, cc = p & 15; const v4u v = *(const GAS v4u*)(CT + rr * 128 + cc * 8); *(LAS v4u*)(CTs + rr * 272 + cc * 16) = v; }
    __syncthreads();
    { f32x4 sacc[2];
      sacc[0] = (f32x4){0.f, 0.f, 0.f, 0.f}; sacc[1] = (f32x4){0.f, 0.f, 0.f, 0.f};
      wave_mma<2, 4>(sacc, Qs, 272, 16 * (w >> 1), Ks, 272, 32 * (w & 1), lane);
#pragma unroll
      for (int j = 0; j < 2; ++j)
#pragma unroll
          for (int rg = 0; rg < 4; ++rg) *(LAS float*)(Ss + (16 * (w >> 1) + 4 * (lane >> 4) + rg) * 272 + (32 * (w & 1) + 16 * j + (lane & 15)) * 4) = sacc[j][rg]; }
    __syncthreads();
    { const int t = tid >> 3, seg = tid & 7;
      const float bt = bcum[t];
      const f32x4 s0 = *(const LAS f32x4*)(Ss + t * 272 + seg * 32), s1 = *(const LAS f32x4*)(Ss + t * 272 + seg * 32 + 16);
      const float sv[8] = {s0.x, s0.y, s0.z, s0.w, s1.x, s1.y, s1.z, s1.w};
      float dm[8]; float mx = -3.0e38f;
#pragma unroll
      for (int i = 0; i < 8; ++i) { const int s = seg * 8 + i; dm[i] = bt - bcum[s] + igs[s]; if (s <= t) mx = fmaxf(mx, dm[i]); }
      mx = fmaxf(mx, __shfl_xor(mx, 1)); mx = fmaxf(mx, __shfl_xor(mx, 2)); mx = fmaxf(mx, __shfl_xor(mx, 4));
      const float minter = bt + mc; const float mt = fmaxf(minter, mx);
      float wv[8]; float den = 0.f;
#pragma unroll
      for (int i = 0; i < 8; ++i) { const int s = seg * 8 + i; wv[i] = (s <= t) ? sv[i] * __expf(dm[i] - mt) : 0.f; den += wv[i]; }
      *(LAS v4u*)(Ws + t * 144 + seg * 16) = (v4u){pk2(wv[0], wv[1]), pk2(wv[2], wv[3]), pk2(wv[4], wv[5]), pk2(wv[6], wv[7])};
      const float inter = __expf(minter - mt);
      v4u qa = *(const LAS v4u*)(Qs + t * 272 + seg * 32), qb2 = *(const LAS v4u*)(Qs + t * 272 + seg * 32 + 16);
      const float qf[16] = {bflo(qa.x), bfhi(qa.x), bflo(qa.y), bfhi(qa.y), bflo(qa.z), bfhi(qa.z), bflo(qa.w), bfhi(qa.w), bflo(qb2.x), bfhi(qb2.x), bflo(qb2.y), bfhi(qb2.y), bflo(qb2.z), bfhi(qb2.z), bflo(qb2.w), bfhi(qb2.w)};
      float qn = 0.f;
#pragma unroll
      for (int i = 0; i < 16; ++i) qn += qf[i] * nsv[seg * 16 + i];
      den += inter * qn;
      den += __shfl_xor(den, 1); den += __shfl_xor(den, 2); den += __shfl_xor(den, 4);
      qa.x = pk2(qf[0] * inter, qf[1] * inter); qa.y = pk2(qf[2] * inter, qf[3] * inter); qa.z = pk2(qf[4] * inter, qf[5] * inter); qa.w = pk2(qf[6] * inter, qf[7] * inter);
      qb2.x = pk2(qf[8] * inter, qf[9] * inter); qb2.y = pk2(qf[10] * inter, qf[11] * inter); qb2.z = pk2(qf[12] * inter, qf[13] * inter); qb2.w = pk2(qf[14] * inter, qf[15] * inter);
      *(LAS v4u*)(Qs + t * 272 + seg * 32) = qa; *(LAS v4u*)(Qs + t * 272 + seg * 32 + 16) = qb2;
      if (seg == 0) rden[t] = 1.0f / fmaxf(fabsf(den), __expf(-mt)); }
    __syncthreads();
    f32x4 acc[4];
#pragma unroll
    for (int j = 0; j < 4; ++j) acc[j] = (f32x4){0.f, 0.f, 0.f, 0.f};
    wave_mma<4, 2>(acc, Ws, 144, 16 * (w >> 1), VT, 144, 64 * (w & 1), lane);
    wave_mma<4, 4>(acc, Qs, 272, 16 * (w >> 1), CTs, 272, 64 * (w & 1), lane);
    __syncthreads();
    LAS unsigned char* Hs = CTs;
#pragma unroll
    for (int j = 0; j < 4; ++j)
#pragma unroll
        for (int rg = 0; rg < 4; ++rg) { const int row = 16 * (w >> 1) + 4 * (lane >> 4) + rg; *(LAS float*)(Hs + row * 528 + (64 * (w & 1) + 16 * j + (lane & 15)) * 4) = acc[j][rg] * rden[row]; }
    __syncthreads();
    { const int t = tid >> 3, seg = tid & 7; float hv[16]; float ss = 0.f;
#pragma unroll
      for (int i4 = 0; i4 < 4; ++i4) { const f32x4 v = *(const LAS f32x4*)(Hs + t * 528 + seg * 64 + i4 * 16); hv[4 * i4] = v.x; hv[4 * i4 + 1] = v.y; hv[4 * i4 + 2] = v.z; hv[4 * i4 + 3] = v.w; ss += (v.x * v.x + v.y * v.y) + (v.z * v.z + v.w * v.w); }
      ss += __shfl_xor(ss, 1); ss += __shfl_xor(ss, 2); ss += __shfl_xor(ss, 4);
      const float rs = 1.0f / sqrtf(ss * (1.f / 128.f) + EPS);
      const float* mg = F.in[8] + seg * 16;
      const bf16* op = MLO + (row0 + t) * 512 + h * 128 + seg * 16; const v4u o0 = *(const GAS v4u*)op, o1 = *(const GAS v4u*)(op + 8);
      const float og[16] = {bflo(o0.x), bfhi(o0.x), bflo(o0.y), bfhi(o0.y), bflo(o0.z), bfhi(o0.z), bflo(o0.w), bfhi(o0.w), bflo(o1.x), bfhi(o1.x), bflo(o1.y), bfhi(o1.y), bflo(o1.z), bfhi(o1.z), bflo(o1.w), bfhi(o1.w)};
      float yv[16];
#pragma unroll
      for (int i = 0; i < 16; ++i) yv[i] = hv[i] * rs * mg[i] * og[i];
      v4u y0, y1; y0.x = pk2(yv[0], yv[1]); y0.y = pk2(yv[2], yv[3]); y0.z = pk2(yv[4], yv[5]); y0.w = pk2(yv[6], yv[7]); y1.x = pk2(yv[8], yv[9]); y1.y = pk2(yv[10], yv[11]); y1.z = pk2(yv[12], yv[13]); y1.w = pk2(yv[14], yv[15]);
      bf16* yp = outp + ((row0 + t) & rmask) * 512 + h * 128 + seg * 16; *(GAS v4u*)yp = y0; *(GAS v4u*)(yp + 8) = y1; }
}

#define PEER_INS(L, v) do { L[15] = __builtin_amdgcn_fmed3f(L[14], L[15], v); L[14] = __builtin_amdgcn_fmed3f(L[13], L[14], v); L[13] = __builtin_amdgcn_fmed3f(L[12], L[13], v); \
    L[12] = __builtin_amdgcn_fmed3f(L[11], L[12], v); L[11] = __builtin_amdgcn_fmed3f(L[10], L[11], v); L[10] = __builtin_amdgcn_fmed3f(L[9], L[10], v); L[9] = __builtin_amdgcn_fmed3f(L[8], L[9], v); \
    L[8] = __builtin_amdgcn_fmed3f(L[7], L[8], v); L[7] = __builtin_amdgcn_fmed3f(L[6], L[7], v); L[6] = __builtin_amdgcn_fmed3f(L[5], L[6], v); L[5] = __builtin_amdgcn_fmed3f(L[4], L[5], v); \
    L[4] = __builtin_amdgcn_fmed3f(L[3], L[4], v); L[3] = __builtin_amdgcn_fmed3f(L[2], L[3], v); L[2] = __builtin_amdgcn_fmed3f(L[1], L[2], v); L[1] = __builtin_amdgcn_fmed3f(L[0], L[1], v); L[0] = fmaxf(L[0], v); } while (0)

constexpr int PEER_IDX_OFF = 0, PEER_GW_OFF = 33024, PEER_LST_OFF = 69632;
__device__ __forceinline__ void peer_route_tile(Frame& F, int tile) {
    const int tid = F.tid, lane = F.lane, w = F.wave;
    LAS unsigned char* K1s = F.lds;
    LAS float* LST = (LAS float*)(F.lds + PEER_LST_OFF);
    const bf16* QRY = (const bf16*)(F.ws + WS_QRY); const bf16* PK = (const bf16*)(F.ws + WS_PK);
    const size_t row0 = (size_t)tile * 64;
    const int mt = w & 3, half = w >> 2;
    for (int h = 0; h < 8; ++h) {
        __syncthreads();
#pragma unroll
        for (int i = 0; i < 8; ++i) { const int p = tid + 512 * i, kr = p >> 4, c = p & 15, hf = kr >> 7, key = kr & 127;
            const v4u v = *(const GAS v4u*)(PK + ((size_t)(hf * 8 + h) * 128 + key) * 128 + c * 8); *(LAS v4u*)(K1s + kr * 272 + c * 16) = v; }
        __syncthreads();
        f32x4 acc[8];
#pragma unroll
        for (int j = 0; j < 8; ++j) acc[j] = (f32x4){0.f, 0.f, 0.f, 0.f};
        const bf16* qp = QRY + (row0 + 16 * mt + (lane & 15)) * 2048 + h * 256 + half * 128 + (lane >> 4) * 8;
#pragma unroll
        for (int ks = 0; ks < 4; ++ks) { const bf16x8 q = *(const GAS bf16x8*)(qp + ks * 32);
#pragma unroll
            for (int j = 0; j < 8; ++j) { const bf16x8 kf = *(const LAS bf16x8*)(K1s + (half * 128 + 16 * j + (lane & 15)) * 272 + (ks * 32 + (lane >> 4) * 8) * 2);
                acc[j] = __builtin_amdgcn_mfma_f32_16x16x32_bf16(kf, q, acc[j], 0, 0, 0); } }
        float L[16];
#pragma unroll
        for (int i = 0; i < 16; ++i) L[i] = -3.0e38f;
#pragma unroll
        for (int j = 0; j < 8; ++j)
#pragma unroll
            for (int rg = 0; rg < 4; ++rg) { const float v = __uint_as_float((__float_as_uint(acc[j][rg]) & 0xFFFFFF80u) | (unsigned)(16 * j + 4 * (lane >> 4) + rg)); PEER_INS(L, v); }
#pragma unroll
        for (int step = 16; step <= 32; step <<= 1) { float P[16];
#pragma unroll
            for (int i = 0; i < 16; ++i) P[i] = __shfl_xor(L[i], step);
#pragma unroll
            for (int i = 0; i < 16; ++i) PEER_INS(L, P[i]); }
        if (lane < 16) {
#pragma unroll
            for (int i = 0; i < 16; ++i) LST[((h * 2 + half) * 16 + i) * 64 + 16 * mt + lane] = L[i]; }
    }
    __syncthreads();
    {
        const int h = w;
        float A1[16], A2[16];
#pragma unroll
        for (int i = 0; i < 16; ++i) { A1[i] = LST[((h * 2) * 16 + i) * 64 + lane]; A2[i] = LST[((h * 2 + 1) * 16 + i) * 64 + lane]; }
        float Tt[16];
#pragma unroll
        for (int i = 0; i < 16; ++i) Tt[i] = -3.0e38f;
#pragma unroll
        for (int i = 0; i < 16; ++i)
#pragma unroll
            for (int j = 0; j < 16; ++j) if ((i + 1) * (j + 1) <= 16) { const float cv = __uint_as_float((__float_as_uint(A1[i] + A2[j]) & 0xFFFFFF00u) | (unsigned)(i * 16 + j)); PEER_INS(Tt, cv); }
        float ex[16]; float sm = 0.f;
#pragma unroll
        for (int i = 0; i < 16; ++i) { ex[i] = __expf(Tt[i] - Tt[0]); sm += ex[i]; }
        const float inv = 1.0f / sm;
        int* ip = (int*)(F.ws + WS_IDX) + (row0 + lane) * 128 + h * 16; float* gp = (float*)(F.ws + WS_GW) + (row0 + lane) * 128 + h * 16;
#pragma unroll
        for (int i4 = 0; i4 < 4; ++i4) { unsigned ev[4]; float gv[4];
#pragma unroll
            for (int e = 0; e < 4; ++e) { const int i = 4 * i4 + e; const unsigned code = __float_as_uint(Tt[i]) & 0xFFu; const unsigned i1 = code >> 4, i2 = code & 15u;
                const unsigned e1 = __float_as_uint(LST[((h * 2) * 16 + i1) * 64 + lane]) & 0x7Fu, e2 = __float_as_uint(LST[((h * 2 + 1) * 16 + i2) * 64 + lane]) & 0x7Fu;
                ev[e] = e1 * 128u + e2; gv[e] = ex[i] * inv; }
            *(GAS v4u*)(ip + 4 * i4) = (v4u){ev[0], ev[1], ev[2], ev[3]}; *(GAS f32x4*)(gp + 4 * i4) = (f32x4){gv[0], gv[1], gv[2], gv[3]}; }
    }
}

typedef float f32x2 __attribute__((ext_vector_type(2)));
#define PEER_LOAD_IDX8(ee, s_) do { const size_t b_ = (size_t)TOK((s_) >> 1) * 128 + 64 * ((s_) & 1) + eg; _Pragma("unroll") for (int i_ = 0; i_ < 8; ++i_) ee[i_] = IDX[b_ + 8 * i_]; } while (0)
#define PEER_LOAD_W8(ww, s_) do { const size_t b_ = (size_t)TOK((s_) >> 1) * 128 + 64 * ((s_) & 1) + eg; _Pragma("unroll") for (int i_ = 0; i_ < 8; ++i_) ww[i_] = GW[b_ + 8 * i_]; } while (0)
#define PEER_GATHER8(rr, tab, ee) do { _Pragma("unroll") for (int i_ = 0; i_ < 8; ++i_) rr[i_] = *(const GAS v4u*)((tab) + (size_t)ee[i_] * 128); } while (0)
__device__ __forceinline__ void peer_u_half(const v4u (&ur)[8], const f32x2 (&xh)[8], float* pd) {
#pragma unroll
    for (int i = 0; i < 8; ++i) { f32x2 d2 = (f32x2){0.f, 0.f}; const unsigned uw[4] = {ur[i].x, ur[i].y, ur[i].z, ur[i].w};
#pragma unroll
        for (int q = 0; q < 4; ++q) { const f32x2 lo = __builtin_amdgcn_cvt_pk_f32_fp8((int)uw[q], false), hi = __builtin_amdgcn_cvt_pk_f32_fp8((int)uw[q], true);
            d2 = __builtin_elementwise_fma(lo, xh[2 * q], d2); d2 = __builtin_elementwise_fma(hi, xh[2 * q + 1], d2); }
        pd[i] = d2.x + d2.y; }
}
__device__ __forceinline__ void peer_u_sweep(Frame& F) {
    const int lane = F.lane, eg = lane >> 3, c = lane & 7;
    const int x = blockIdx.x & 7, rb = blockIdx.x >> 3, nrb = F.G >> 3, tper = T_TOK / nrb;
    const bf16* H1B = (const bf16*)(F.ws + WS_H1B) + 128 * x + 16 * c; const unsigned char* UT8 = F.ws + WS_UT8 + (size_t)x * (16384 * 128) + 16 * c;
    const int* IDX = (const int*)(F.ws + WS_IDX); float* PD = (float*)(F.ws + WS_PD) + (size_t)x * T_TOK * 128 + 16 * c + eg;
    const float* SUMSQ = (const float*)(F.ws + WS_CTL + CTL_SUMSQ); const float* gf = F.in[18] + 128 * x + 16 * c;
    const f32x4 g0 = *(const GAS f32x4*)(gf), g1 = *(const GAS f32x4*)(gf + 4), g2 = *(const GAS f32x4*)(gf + 8), g3 = *(const GAS f32x4*)(gf + 12);
    const int n = tper / NWAVES, t0 = rb * tper + F.wave;
#define TOK(k) (t0 + NWAVES * ((k) < n ? (k) : n - 1))
    int ee[8]; v4u urA[8], urB[8]; v4u h0, h1; float ssq;
    PEER_LOAD_IDX8(ee, 0); h0 = *(const GAS v4u*)(H1B + (size_t)TOK(0) * 1024); h1 = *(const GAS v4u*)(H1B + (size_t)TOK(0) * 1024 + 8); ssq = SUMSQ[TOK(0)];
    PEER_GATHER8(urA, UT8, ee);
    PEER_LOAD_IDX8(ee, 1);
    for (int k = 0; k < n; ++k) {
        PEER_GATHER8(urB, UT8, ee);
        PEER_LOAD_IDX8(ee, 2 * k + 2);
        const float rs = 1.0f / sqrtf(ssq * (1.f / 1024.f) + EPS);
        f32x2 xh[8];
        xh[0] = (f32x2){bflo(h0.x) * rs * g0.x, bfhi(h0.x) * rs * g0.y}; xh[1] = (f32x2){bflo(h0.y) * rs * g0.z, bfhi(h0.y) * rs * g0.w};
        xh[2] = (f32x2){bflo(h0.z) * rs * g1.x, bfhi(h0.z) * rs * g1.y}; xh[3] = (f32x2){bflo(h0.w) * rs * g1.z, bfhi(h0.w) * rs * g1.w};
        xh[4] = (f32x2){bflo(h1.x) * rs * g2.x, bfhi(h1.x) * rs * g2.y}; xh[5] = (f32x2){bflo(h1.y) * rs * g2.z, bfhi(h1.y) * rs * g2.w};
        xh[6] = (f32x2){bflo(h1.z) * rs * g3.x, bfhi(h1.z) * rs * g3.y}; xh[7] = (f32x2){bflo(h1.w) * rs * g3.z, bfhi(h1.w) * rs * g3.w};
        h0 = *(const GAS v4u*)(H1B + (size_t)TOK(k + 1) * 1024); h1 = *(const GAS v4u*)(H1B + (size_t)TOK(k + 1) * 1024 + 8); ssq = SUMSQ[TOK(k + 1)];
        float pd[16];
        peer_u_half(urA, xh, pd);
        PEER_GATHER8(urA, UT8, ee);
        PEER_LOAD_IDX8(ee, 2 * k + 3);
        peer_u_half(urB, xh, pd + 8);
#pragma unroll
        for (int i = 0; i < 8; ++i) { const bool up = (c & 4) != 0; const float send = up ? pd[i] : pd[i + 8]; const float keep = up ? pd[i + 8] : pd[i]; pd[i] = keep + __shfl_xor(send, 4); }
#pragma unroll
        for (int i = 0; i < 4; ++i) { const bool up = (c & 2) != 0; const float send = up ? pd[i] : pd[i + 4]; const float keep = up ? pd[i + 4] : pd[i]; pd[i] = keep + __shfl_xor(send, 2); }
#pragma unroll
        for (int i = 0; i < 2; ++i) { const bool up = (c & 1) != 0; const float send = up ? pd[i] : pd[i + 2]; const float keep = up ? pd[i + 2] : pd[i]; pd[i] = keep + __shfl_xor(send, 1); }
        float* pp = PD + (size_t)TOK(k) * 128;
        pp[0] = pd[0]; pp[8] = pd[1];
    }
}
__device__ __forceinline__ void peer_combine(Frame& F) {
    const int* IDX = (const int*)(F.ws + WS_IDX); float* GW = (float*)(F.ws + WS_GW); const float* PD = (const float*)(F.ws + WS_PD);
    const float* USC = (const float*)(F.ws + WS_USC); const float* VSC = (const float*)(F.ws + WS_VSC);
    for (size_t g = (size_t)blockIdx.x * 512 + F.tid; g < (size_t)T_TOK * 128; g += (size_t)F.G * 512) {
        float d = 0.f;
#pragma unroll
        for (int xx = 0; xx < 8; ++xx) d += PD[(size_t)xx * T_TOK * 128 + g];
        const int e = IDX[g]; const float dt = d * USC[e];
        GW[g] = GW[g] * VSC[e] * 0.5f * dt * (1.0f + erff(dt * 0.70710678118654752f));
    }
}
__device__ __forceinline__ void peer_v_half(const v4u (&vr)[8], const float (&ww)[8], f32x2 (&oa)[8]) {
#pragma unroll
    for (int i = 0; i < 8; ++i) { const f32x2 w2 = (f32x2){ww[i], ww[i]}; const unsigned vw[4] = {vr[i].x, vr[i].y, vr[i].z, vr[i].w};
#pragma unroll
        for (int q = 0; q < 4; ++q) { const f32x2 lo = __builtin_amdgcn_cvt_pk_f32_fp8((int)vw[q], false), hi = __builtin_amdgcn_cvt_pk_f32_fp8((int)vw[q], true);
            oa[2 * q] = __builtin_elementwise_fma(lo, w2, oa[2 * q]); oa[2 * q + 1] = __builtin_elementwise_fma(hi, w2, oa[2 * q + 1]); } }
}
__device__ __forceinline__ void peer_v_sweep(Frame& F) {
    const int lane = F.lane, eg = lane >> 3, c = lane & 7;
    const int x = blockIdx.x & 7, rb = blockIdx.x >> 3, nrb = F.G >> 3, tper = T_TOK / nrb;
    const unsigned char* VT8 = F.ws + WS_VT8 + (size_t)x * (16384 * 128) + 16 * c;
    const int* IDX = (const int*)(F.ws + WS_IDX); const float* GW = (const float*)(F.ws + WS_GW);
    float* outp = F.out + 128 * x + 16 * c + 2 * eg;
    const int n = tper / NWAVES, t0 = rb * tper + F.wave;
    int ee[8]; float wwA[8], wwB[8]; v4u vrA[8], vrB[8];
    PEER_LOAD_IDX8(ee, 0); PEER_LOAD_W8(wwA, 0);
    PEER_GATHER8(vrA, VT8, ee);
    PEER_LOAD_IDX8(ee, 1); PEER_LOAD_W8(wwB, 1);
    for (int k = 0; k < n; ++k) {
        PEER_GATHER8(vrB, VT8, ee);
        PEER_LOAD_IDX8(ee, 2 * k + 2);
        float* op = outp + (size_t)TOK(k) * 1024;
        const f32x2 oin = *(GAS f32x2*)op;
        f32x2 oa[8];
#pragma unroll
        for (int q = 0; q < 8; ++q) oa[q] = (f32x2){0.f, 0.f};
        peer_v_half(vrA, wwA, oa);
        PEER_LOAD_W8(wwA, 2 * k + 2);
        PEER_GATHER8(vrA, VT8, ee);
        PEER_LOAD_IDX8(ee, 2 * k + 3);
        peer_v_half(vrB, wwB, oa);
        PEER_LOAD_W8(wwB, 2 * k + 3);
        float pd[16];
#pragma unroll
        for (int q = 0; q < 8; ++q) { pd[2 * q] = oa[q].x; pd[2 * q + 1] = oa[q].y; }
#pragma unroll
        for (int i = 0; i < 8; ++i) { const bool up = (eg & 4) != 0; const float send = up ? pd[i] : pd[i + 8]; const float keep = up ? pd[i + 8] : pd[i]; pd[i] = keep + __shfl_xor(send, 32); }
#pragma unroll
        for (int i = 0; i < 4; ++i) { const bool up = (eg & 2) != 0; const float send = up ? pd[i] : pd[i + 4]; const float keep = up ? pd[i + 4] : pd[i]; pd[i] = keep + __shfl_xor(send, 16); }
#pragma unroll
        for (int i = 0; i < 2; ++i) { const bool up = (eg & 1) != 0; const float send = up ? pd[i] : pd[i + 2]; const float keep = up ? pd[i + 2] : pd[i]; pd[i] = keep + __shfl_xor(send, 8); }
        f32x2 o = oin; o.x += pd[0]; o.y += pd[1]; *(GAS f32x2*)op = o;
    }
#undef TOK
}

__device__ __forceinline__ void peer_table_row_fp8(const float* src, unsigned char* dst  , float* sc, int lane) {
    f32x4 v[4]; float am = 0.f;
#pragma unroll
    for (int j = 0; j < 4; ++j) { v[j] = __builtin_nontemporal_load((const GAS f32x4*)(src + 256 * j + 4 * lane)); am = fmaxf(am, fmaxf(fmaxf(fabsf(v[j].x), fabsf(v[j].y)), fmaxf(fabsf(v[j].z), fabsf(v[j].w)))); }
    am = fmaxf(wave_max(am), 1e-30f);
    const float s = 224.0f / am;
#pragma unroll
    for (int j = 0; j < 4; ++j) { int p = 0; p = __builtin_amdgcn_cvt_pk_fp8_f32(v[j].x * s, v[j].y * s, p, false); p = __builtin_amdgcn_cvt_pk_fp8_f32(v[j].z * s, v[j].w * s, p, true);
        *(GAS unsigned*)(dst + (size_t)(2 * j + (lane >> 5)) * (16384 * 128) + 4 * (lane & 31)) = (unsigned)p; }
    if (lane == 0) *sc = am * (1.0f / 224.0f);
}

struct Args { const float* in[24]; float* out; unsigned char* ws; int ph_lo, ph_hi, li, pad; };
__global__ void __launch_bounds__(NWAVES * 64, 2) hybrid_fwd(Args args) {
    extern __shared__ __attribute__((aligned(16))) unsigned char lds[];
    Frame F;
    F.lds = (LAS unsigned char*)lds;
    F.MISC = (volatile LAS unsigned*)(F.lds + MISC_OFF);
    F.tid = threadIdx.x; F.lane = F.tid & 63; F.wave = __builtin_amdgcn_readfirstlane(F.tid >> 6);
    F.G = gridDim.x; F.ws = args.ws; F.out = args.out;
#pragma unroll
    for (int i = 0; i < 24; ++i) F.in[i] = args.in[i];
    for (int u = F.tid; u < (LDS_BYTES - LDSCTL_OFF) / 4; u += NWAVES * 64) ((LAS unsigned*)(F.lds + LDSCTL_OFF))[u] = 0u;
    __syncthreads();
    unsigned* ctl = (unsigned*)(F.ws + WS_CTL);
    XcdBarrier bar; bar.bar = ctl + CW_BAR; bar.x = 0; bar.st = nullptr;
    if (N_LAUNCHES != PER_PHASE) bar = xcd_barrier_post(ctl + CW_BAR, F.MISC + 8);
#define REP(k) for (int rep_ = ((PROBE_PH == (k)) ? 0 : 1); rep_ < 2; ++rep_)
#define DUMMY (rep_ == 0)
#define GRID_BAR() do { if (N_LAUNCHES != PER_PHASE) xcd_barrier(bar); } while (0)
    const int lo = args.ph_lo, hi = args.ph_hi;
#define IN(k) (lo <= (k) && (k) < hi)
#define BOTH(k) (IN(k) && IN((k) + 1))
    const int bx = blockIdx.x;

    if (IN(0)) { REP(0) { p0_prologue(F); __syncthreads(); } if (BOTH(0)) GRID_BAR(); }

    if (IN(1)) {
        pg8::Gemm g{(const bf16*)F.out, (const bf16*)(F.ws + WS_WIN), 1024, 1024, 1024}; pg8::StaticOrder S; S.init(T_TOK, 7168, F.G, bx);
        pg8::EpiProj E{(bf16*)(F.ws + WS_GATES), 512, F.in[16], 512, SPLIT_STRIDE, 12, 22, 24};
        REP(1) pg8::gemm_phase<pg8::EpiProj, pg8::StaticOrder, true, true>(F.lds, g, S, E);
        if (BOTH(1)) GRID_BAR();
    }

    if (IN(2)) {
        { pg8::Gemm g{(const bf16*)(F.ws + WS_MEMN), (const bf16*)(F.ws + WS_WKV), 1024, 1024, 1024}; pg8::FewOrder S{4, 8, bx};
          pg8::EpiProj E{(bf16*)(F.ws + WS_KVMEM), 1024, nullptr, 0, 0, 0, 0, 0};
          pg8::gemm_phase<pg8::EpiProj, pg8::FewOrder, false, true>(F.lds, g, S, E); }
        for (;;) {
            __syncthreads();
            if (F.tid == 0) F.MISC[16] = __hip_atomic_fetch_add(ctl + 1024, 1u, __ATOMIC_RELAXED, __HIP_MEMORY_SCOPE_AGENT);
            __syncthreads();
            const int it = (int)F.MISC[16];
            if (it >= 2048) break;
            if (it < 1024) sb_attn_item(F, it, (bf16*)(F.ws + WS_SBQ), ~(size_t)0); else mlstm_local_item(F, it - 1024);
        }
        if (BOTH(2)) GRID_BAR();
    }

    if (IN(3)) {
        REP(3) mlstm_scan(F);
        REP(13) for (int it = bx; it < 512; it += F.G) mem_attn_item(F, it, DUMMY ? (bf16*)(F.ws + WS_END) : (bf16*)(F.ws + WS_MEMQ), DUMMY ? (size_t)1023 : ~(size_t)0);
        if (BOTH(3)) GRID_BAR();
    }

    if (IN(4)) {
        REP(4) for (int it = bx; it < 1024; it += F.G) mlstm_out_item(F, it, DUMMY ? (bf16*)(F.ws + WS_END) : (bf16*)(F.ws + WS_MLV), DUMMY ? (size_t)1023 : ~(size_t)0);
        if (BOTH(4)) GRID_BAR();
    }

    if (IN(5)) {
        pg8::Gemm g{(const bf16*)(F.ws + WS_SBQ), (const bf16*)(F.ws + WS_WBR), 512, 512, 512};
        pg8::GroupOrder S; S.so.init(T_TOK, 1024, F.G, bx); S.ng = 3; S.a_gstride = 16 * MiB; S.b_gstride = (size_t)1024 * 512 * 2;
        pg8::EpiBranch E{(const bf16*)(F.ws + WS_GATES), SPLIT_STRIDE, (bf16*)(F.ws + WS_MERGED)};
        REP(5) pg8::gemm_phase<pg8::EpiBranch, pg8::GroupOrder, false, true>(F.lds, g, S, E);
        if (BOTH(5)) GRID_BAR();
    }

    if (IN(6)) {
        { pg8::Gemm g{(const bf16*)(F.ws + WS_MERGED), (const bf16*)(F.ws + WS_WOUT), 1024, 1024, 1024}; pg8::StaticOrder S; S.init(T_TOK, 1024, F.G, bx);
          REP(6) { pg8::EpiOut E{F.in[0], F.out, (bf16*)(F.ws + WS_H1B), (float*)(F.ws + WS_CTL + (DUMMY ? 768 * 1024 : CTL_SUMSQ))};
          pg8::gemm_phase<pg8::EpiOut, pg8::StaticOrder, false, true>(F.lds, g, S, E); } }
        REP(16) for (int r = bx * NWAVES + F.wave; r < 2 * 16384; r += F.G * NWAVES) { const bool second = r >= 16384; const int rr = second ? r - 16384 : r;
            peer_table_row_fp8((second ? F.in[23] : F.in[22]) + (size_t)rr * 1024, F.ws + (second ? WS_VT8 : WS_UT8) + (size_t)rr * 128, (float*)(F.ws + (second ? WS_VSC : WS_USC)) + rr, F.lane); }
        if (BOTH(6)) GRID_BAR();
    }

    if (IN(7)) {
        pg8::Gemm g{(const bf16*)(F.ws + WS_H1B), (const bf16*)(F.ws + WS_WPQ), 1024, 1024, 1024}; pg8::StaticOrder S; S.init(T_TOK, 2048, F.G, bx);
        pg8::EpiQry E{(const float*)(F.ws + WS_CTL + CTL_SUMSQ), (bf16*)(F.ws + WS_QRY), EPS};
        REP(7) pg8::gemm_phase<pg8::EpiQry, pg8::StaticOrder, true, true>(F.lds, g, S, E);
        if (BOTH(7)) GRID_BAR();
    }

    if (IN(8)) { for (int tile = bx; tile < 256; tile += F.G) peer_route_tile(F, tile); if (BOTH(8)) GRID_BAR(); }
    if (IN(9)) { REP(9) peer_u_sweep(F); if (BOTH(9)) GRID_BAR(); }
    if (IN(10)) { peer_combine(F); if (BOTH(10)) GRID_BAR(); }
    if (IN(11)) { peer_v_sweep(F); }
#undef IN
#undef BOTH
#undef GRID_BAR
#undef REP
#undef DUMMY
}

extern "C" void kernel_launch(void* const* d_in, const int* in_sizes, int n_in, void* d_out, int out_size, void* d_ws, size_t ws_size, hipStream_t stream) {
    static int grid = 0;
    if (grid == 0) {
        if (n_in != 24 || out_size != T_TOK * DM || ws_size < WS_END) { fprintf(stderr, "kernel_launch: unexpected problem (n_in %d, out %d, ws %zu); nothing launched\n", n_in, out_size, ws_size); grid = -1; return; }
        int dev = 0, cus = 0, per_cu = 0;
        if (hipGetDevice(&dev) != hipSuccess || hipDeviceGetAttribute(&cus, hipDeviceAttributeMultiprocessorCount, dev) != hipSuccess) { grid = -1; return; }
        if (hipFuncSetAttribute((const void*)hybrid_fwd, hipFuncAttributeMaxDynamicSharedMemorySize, LDS_BYTES) != hipSuccess) { fprintf(stderr, "kernel_launch: hipFuncSetAttribute failed\n"); grid = -1; return; }
        if (hipOccupancyMaxActiveBlocksPerMultiprocessor(&per_cu, (const void*)hybrid_fwd, NWAVES * 64, LDS_BYTES) != hipSuccess || per_cu < 1)
            fprintf(stderr, "kernel_launch: note: occupancy query reports %d workgroups per CU\n", per_cu);
        (void)hipGetLastError();
        grid = cus;
    }
    if (grid < 0) return;
    if (hipMemsetAsync((char*)d_ws + WS_CTL, 0, CTL_ZERO_BYTES, stream) != hipSuccess) { fprintf(stderr, "kernel_launch: memset failed\n"); return; }
    Args a{};
    for (int i = 0; i < 24; ++i) a.in[i] = (const float*)d_in[i];
    a.out = (float*)d_out; a.ws = (unsigned char*)d_ws;
    for (int li = 0; li < N_LAUNCHES; ++li) {
        a.ph_lo = (N_LAUNCHES == PER_PHASE) ? li : 0; a.ph_hi = (N_LAUNCHES == PER_PHASE) ? li + 1 : PER_PHASE; a.li = li;
        hipLaunchKernelGGL(hybrid_fwd, dim3(grid), dim3(NWAVES * 64), LDS_BYTES, stream, a);
        const hipError_t le = hipPeekAtLastError();
        if (le != hipSuccess) { fprintf(stderr, "kernel_launch: launch %d failed: %s\n", li, hipGetErrorName(le)); break; }
    }
}
```

```cpp
#include <hip/hip_runtime.h>
#include <cstdio>
#include <cstdint>

#ifndef MK_N_LAUNCHES
#define MK_N_LAUNCHES 1
#endif

namespace pg8 {
#define PG8_LAS __attribute__((address_space(3)))
typedef unsigned short bf16_t;
typedef short bf16x8 __attribute__((ext_vector_type(8)));
typedef float f32x4 __attribute__((ext_vector_type(4)));
typedef unsigned u32x4 __attribute__((ext_vector_type(4)));
constexpr int BM = 256, BK = 64, HALF = 128, HTB = HALF * BK * 2  , STAGE_BYTES = 8 * HTB, NXCD = 8, WGM = 4;

__host__ __device__ __forceinline__ int lds_byte(int r, int c) { const int st = (r >> 4) * 2 + (c >> 5), rr = r & 15, cc = c & 31, ob = rr * 64 + cc * 2; return st * 1024 + (ob ^ (((ob >> 9) & 1) << 5)); }
__host__ __device__ __forceinline__ void stage_rc(int b, int& R, int& C) { const int st = b / 1024, sb = b % 1024, swz = sb ^ (((sb >> 9) & 1) << 5); R = (st >> 1) * 16 + swz / 64; C = (st & 1) * 32 + (swz % 64) / 2; }
__host__ __device__ __forceinline__ int perm32(int rho) { const int n = rho >> 4, i = rho & 15; return 8 * (i >> 2) + 4 * n + (i & 3); }

struct Unit { int pm, pn, g; };
struct Gemm { const bf16_t* A; const bf16_t* Bt; int lda, ldb, K; };

struct StaticOrder {
    int nM, nN, nwg, G, c;
    __host__ __device__ void init(int M, int N, int G_, int c_) { nM = M / BM; nN = N / BM; nwg = nM * nN; G = G_; c = c_; }
    __host__ __device__ bool next(int i, Unit& u) const {
        const long L = (long)i * G + c; if (L >= nwg) return false;
        int wgid = (int)L; { const int q = nwg / NXCD, r = nwg % NXCD, xcd = wgid % NXCD, off = wgid / NXCD; wgid = (xcd < r ? xcd * (q + 1) : r * (q + 1) + (xcd - r) * q) + off; }
        const int nig = WGM * nN, gid = wgid / nig, fm = gid * WGM, gsz = (nM - fm) < WGM ? (nM - fm) : WGM;
        u.pm = fm + ((wgid % nig) % gsz); u.pn = (wgid % nig) / gsz; u.g = 0; return true;
    }
    __device__ __forceinline__ const char* aptr(const Gemm& g, const Unit& u) const { return (const char*)g.A + (size_t)u.pm * BM * g.lda * 2; }
    __device__ __forceinline__ const char* bptr(const Gemm& g, const Unit& u) const { return (const char*)g.Bt + (size_t)u.pn * BM * g.ldb * 2; }
    __device__ __forceinline__ void a_ready(const Unit&) const {}
    __device__ __forceinline__ void done(const Unit&) const {}
};
struct FewOrder {
    int nN, n, c;
    __device__ bool next(int i, Unit& u) const { if (i > 0 || c >= n) return false; u.pm = c / nN; u.pn = c % nN; u.g = 0; return true; }
    __device__ __forceinline__ const char* aptr(const Gemm& g, const Unit& u) const { return (const char*)g.A + (size_t)u.pm * BM * g.lda * 2; }
    __device__ __forceinline__ const char* bptr(const Gemm& g, const Unit& u) const { return (const char*)g.Bt + (size_t)u.pn * BM * g.ldb * 2; }
    __device__ __forceinline__ void a_ready(const Unit&) const {}
    __device__ __forceinline__ void done(const Unit&) const {}
};
struct GroupOrder {
    StaticOrder so; int ng; size_t a_gstride, b_gstride;
    __device__ bool next(int i, Unit& u) const { if (i >= ng) return false; if (!so.next(0, u)) return false; u.g = i; return true; }
    __device__ __forceinline__ const char* aptr(const Gemm& g, const Unit& u) const { return (const char*)g.A + (size_t)u.g * a_gstride + (size_t)u.pm * BM * g.lda * 2; }
    __device__ __forceinline__ const char* bptr(const Gemm& g, const Unit& u) const { return (const char*)g.Bt + (size_t)u.g * b_gstride + (size_t)u.pn * BM * g.ldb * 2; }
    __device__ __forceinline__ void a_ready(const Unit&) const {}
    __device__ __forceinline__ void done(const Unit&) const {}
};

typedef __bf16 bf16x2_t_ __attribute__((ext_vector_type(2)));
typedef float f32x2_t_ __attribute__((ext_vector_type(2)));
__device__ __forceinline__ unsigned cvt_pk_bf16_c(float lo, float hi) { const bf16x2_t_ r = __builtin_convertvector((f32x2_t_){lo, hi}, bf16x2_t_); return __builtin_bit_cast(unsigned, r); }
__device__ __forceinline__ unsigned cvt_pk_bf16(float lo, float hi) { unsigned r; asm volatile("s_nop 0\n\tv_cvt_pk_bf16_f32 %0, %1, %2" : "=v"(r) : "v"(lo), "v"(hi)); return r; }
__device__ __forceinline__ float bf_lo(unsigned x) { return __uint_as_float(x << 16); }
__device__ __forceinline__ float bf_hi(unsigned x) { return __uint_as_float(x & 0xffff0000u); }
__device__ __forceinline__ float sigmoidf_(float x) { return 1.0f / (1.0f + __expf(-x)); }

struct EpiProj {
    static constexpr bool PERM = true, AFTER_DRAIN = false, KEEP_ACC = false;
    bf16_t* O; int ldc; const float* bias; int split_cols; size_t split_stride; int n_sig_bias, sig_lo, sig_hi;
    __device__ __forceinline__ void operator()(const f32x4 (&acc)[2][2][4][2], const Unit& u, int wr, int wc, int fr, int fq) const {
        const int row0 = u.pm * BM + wr * 64 + fr; int colt = u.pn * BM; bf16_t* base = O;
        if (split_cols) { const int t = colt / split_cols; base += (size_t)t * split_stride; colt -= t * split_cols; }
        const int col0 = colt + wc * 32 + 8 * fq, bcol0 = u.pn * BM + wc * 32 + 8 * fq;
        const int mode = (u.pn < n_sig_bias) ? 1 : ((u.pn >= sig_lo && u.pn < sig_hi) ? 2 : 0);
        f32x4 bv[2][2];
#pragma unroll
        for (int bj = 0; bj < 2; ++bj)
#pragma unroll
            for (int n = 0; n < 2; ++n) bv[bj][n] = (mode == 1) ? *(const f32x4*)(bias + bcol0 + bj * HALF + 4 * n) : (f32x4){0.f, 0.f, 0.f, 0.f};
#pragma unroll
        for (int ai = 0; ai < 2; ++ai)
#pragma unroll
            for (int m = 0; m < 4; ++m) { bf16_t* rowp = base + (size_t)(row0 + ai * HALF + m * 16) * ldc + col0;
#pragma unroll
                for (int bj = 0; bj < 2; ++bj) { f32x4 v0 = acc[ai][bj][m][0] + bv[bj][0], v1 = acc[ai][bj][m][1] + bv[bj][1];
                    if (mode != 0) {
#pragma unroll
                        for (int e = 0; e < 4; ++e) { v0[e] = sigmoidf_(v0[e]); v1[e] = sigmoidf_(v1[e]); } }
                    u32x4 w; w.x = cvt_pk_bf16(v0[0], v0[1]); w.y = cvt_pk_bf16(v0[2], v0[3]); w.z = cvt_pk_bf16(v1[0], v1[1]); w.w = cvt_pk_bf16(v1[2], v1[3]);
                    *(u32x4*)(rowp + bj * HALF) = w; } }
    }
};

struct EpiBranch {
    static constexpr bool PERM = true, AFTER_DRAIN = false, KEEP_ACC = true;
    const bf16_t* gates; size_t gate_stride; bf16_t* merged;
    __device__ __forceinline__ void operator()(f32x4 (&acc)[2][2][4][2], const Unit& u, int wr, int wc, int fr, int fq) const {
        const int row0 = u.pm * BM + wr * 64 + fr; const int col0 = u.pn * BM + wc * 32 + 8 * fq;
        const bool last = u.g == 2;
#pragma unroll
        for (int ai = 0; ai < 2; ++ai) {
            u32x4 gw[4][2], gn[4][2];
#pragma unroll
            for (int m = 0; m < 4; ++m) { const size_t row = (size_t)(row0 + ai * HALF + m * 16);
#pragma unroll
                for (int bj = 0; bj < 2; ++bj) { const int c = col0 + bj * HALF; const int gc = u.g * 1024 + c, gc2 = gc + 1024;
                    gw[m][bj] = *(const u32x4*)(gates + (size_t)(gc >> 9) * gate_stride + row * 512 + (gc & 511));
                    if (!last) gn[m][bj] = *(const u32x4*)(gates + (size_t)(gc2 >> 9) * gate_stride + row * 512 + (gc2 & 511)); else gn[m][bj] = (u32x4){0x3f803f80u, 0x3f803f80u, 0x3f803f80u, 0x3f803f80u}; } }
#pragma unroll
            for (int m = 0; m < 4; ++m) { const size_t row = (size_t)(row0 + ai * HALF + m * 16);
#pragma unroll
                for (int bj = 0; bj < 2; ++bj) { const int c = col0 + bj * HALF;
                    const u32x4 g4 = gw[m][bj], n4 = gn[m][bj];
                    const unsigned gws_[4] = {g4.x, g4.y, g4.z, g4.w}, gns_[4] = {n4.x, n4.y, n4.z, n4.w};
                    f32x4 v0 = acc[ai][bj][m][0], v1 = acc[ai][bj][m][1];
#pragma unroll
                    for (int e = 0; e < 2; ++e) { const float r0 = fmaxf(bf_lo(gws_[e]), 1e-4f) * __builtin_amdgcn_rcpf(fmaxf(bf_lo(gns_[e]), 1e-4f)), r1 = fmaxf(bf_hi(gws_[e]), 1e-4f) * __builtin_amdgcn_rcpf(fmaxf(bf_hi(gns_[e]), 1e-4f));
                        v0[2 * e] *= r0; v0[2 * e + 1] *= r1; }
#pragma unroll
                    for (int e = 0; e < 2; ++e) { const float r0 = fmaxf(bf_lo(gws_[2 + e]), 1e-4f) * __builtin_amdgcn_rcpf(fmaxf(bf_lo(gns_[2 + e]), 1e-4f)), r1 = fmaxf(bf_hi(gws_[2 + e]), 1e-4f) * __builtin_amdgcn_rcpf(fmaxf(bf_hi(gns_[2 + e]), 1e-4f));
                        v1[2 * e] *= r0; v1[2 * e + 1] *= r1; }
                    if (last) { u32x4 w; w.x = cvt_pk_bf16(v0[0], v0[1]); w.y = cvt_pk_bf16(v0[2], v0[3]); w.z = cvt_pk_bf16(v1[0], v1[1]); w.w = cvt_pk_bf16(v1[2], v1[3]);
                        *(u32x4*)(merged + row * 1024 + c) = w; }
                    else { acc[ai][bj][m][0] = v0; acc[ai][bj][m][1] = v1; } } }
        }
    }
};

struct EpiOut {
    static constexpr bool PERM = true, AFTER_DRAIN = false, KEEP_ACC = false;
    const float* x; float* out; bf16_t* h1b; float* sumsq;
    __device__ __forceinline__ void operator()(const f32x4 (&acc)[2][2][4][2], const Unit& u, int wr, int wc, int fr, int fq) const {
        const int row0 = u.pm * BM + wr * 64 + fr; const int col0 = u.pn * BM + wc * 32 + 8 * fq;
#pragma unroll
        for (int ai = 0; ai < 2; ++ai)
#pragma unroll
            for (int mp = 0; mp < 4; mp += 2) {
                f32x4 xv[2][2][2];
#pragma unroll
                for (int mm = 0; mm < 2; ++mm) { const size_t row = (size_t)(row0 + ai * HALF + (mp + mm) * 16);
#pragma unroll
                    for (int bj = 0; bj < 2; ++bj) { const size_t off = row * 1024 + col0 + bj * HALF; xv[mm][bj][0] = *(const f32x4*)(x + off); xv[mm][bj][1] = *(const f32x4*)(x + off + 4); } }
#pragma unroll
                for (int mm = 0; mm < 2; ++mm) { const int m = mp + mm; const size_t row = (size_t)(row0 + ai * HALF + m * 16); float ss = 0.f;
#pragma unroll
                    for (int bj = 0; bj < 2; ++bj) { const size_t off = row * 1024 + col0 + bj * HALF;
                        const f32x4 v0 = acc[ai][bj][m][0] + xv[mm][bj][0], v1 = acc[ai][bj][m][1] + xv[mm][bj][1];
                        ss += (v0[0] * v0[0] + v0[1] * v0[1]) + (v0[2] * v0[2] + v0[3] * v0[3]) + (v1[0] * v1[0] + v1[1] * v1[1]) + (v1[2] * v1[2] + v1[3] * v1[3]);
                        u32x4 w; w.x = cvt_pk_bf16(v0[0], v0[1]); w.y = cvt_pk_bf16(v0[2], v0[3]); w.z = cvt_pk_bf16(v1[0], v1[1]); w.w = cvt_pk_bf16(v1[2], v1[3]);
                        *(u32x4*)(h1b + off) = w; }
                    ss += __shfl_xor(ss, 16); ss += __shfl_xor(ss, 32);
                    if (fq == 0) atomicAdd(sumsq + row, ss); } }
    }
};

struct EpiQry {
    static constexpr bool PERM = true, AFTER_DRAIN = false, KEEP_ACC = false;
    const float* sumsq; bf16_t* qry; float eps;
    __device__ __forceinline__ void operator()(const f32x4 (&acc)[2][2][4][2], const Unit& u, int wr, int wc, int fr, int fq) const {
        const int row0 = u.pm * BM + wr * 64 + fr; const int col0 = u.pn * BM + wc * 32 + 8 * fq;
#pragma unroll
        for (int ai = 0; ai < 2; ++ai)
#pragma unroll
            for (int m = 0; m < 4; ++m) { const size_t row = (size_t)(row0 + ai * HALF + m * 16);
                const float rs = __builtin_amdgcn_rsqf(__hip_atomic_load(sumsq + row, __ATOMIC_RELAXED, __HIP_MEMORY_SCOPE_AGENT) * (1.0f / 1024.0f) + eps);
#pragma unroll
                for (int bj = 0; bj < 2; ++bj) { const f32x4 v0 = acc[ai][bj][m][0] * rs, v1 = acc[ai][bj][m][1] * rs;
                    u32x4 w; w.x = cvt_pk_bf16(v0[0], v0[1]); w.y = cvt_pk_bf16(v0[2], v0[3]); w.z = cvt_pk_bf16(v1[0], v1[1]); w.w = cvt_pk_bf16(v1[2], v1[3]);
                    *(u32x4*)(qry + row * 2048 + col0 + bj * HALF) = w; } }
    }
};

template <class Epi, class Sched, bool ALIGN_EPI = false, bool SP2 = false>
__device__ __forceinline__ void gemm_phase(PG8_LAS unsigned char* lds, const Gemm g, const Sched& S, const Epi& E) {
    const int tid = threadIdx.x, wid = __builtin_amdgcn_readfirstlane(tid >> 6), lane = tid & 63, wr = wid >> 2, wc = wid & 3, fr = lane & 15, fq = lane >> 4;
    const int K = g.K, nt = K / BK;
    unsigned voffA[2], voffB[2];
#pragma unroll
    for (int i = 0; i < 2; ++i) { int R, C; stage_rc(tid * 16 + i * 8192, R, C); const int Rb = Epi::PERM ? ((R & ~31) + perm32(R & 31)) : R;
        voffA[i] = (unsigned)(R * g.lda + C) * 2u; voffB[i] = (unsigned)(Rb * g.ldb + C) * 2u; }
    const size_t kstep = (size_t)(BK * 2);
    const size_t hstepA = (size_t)HALF * g.lda * 2, hstepB = (size_t)HALF * g.ldb * 2;
    const unsigned ldsw = (unsigned)wid * 1024u;
    const int aoff = lds_byte(wr * 64 + fr, fq * 8), boff = lds_byte(wc * 32 + fr, fq * 8);
#define PG8_SA(b, h) (((b) * 2 + (h)) * HTB)
#define PG8_SB(b, h) ((4 + (b) * 2 + (h)) * HTB)
#define PG8_STAGE(bufoff, gbase, voff) do { _Pragma("unroll") for (int _i = 0; _i < 2; ++_i) \
        __builtin_amdgcn_global_load_lds((const unsigned*)((const char*)(gbase) + (voff)[_i]), (PG8_LAS unsigned*)(lds + (bufoff) + ldsw + _i * 8192), 16, 0, 0); } while (0)
#define PG8_LDA(dst, b, h) do { _Pragma("unroll") for (int m = 0; m < 4; ++m) _Pragma("unroll") for (int k = 0; k < 2; ++k) dst[m][k] = *(const PG8_LAS bf16x8*)(lds + PG8_SA(b, h) + aoff + m * 2048 + k * 1024); } while (0)
#define PG8_LDB(dst, b, h) do { _Pragma("unroll") for (int n = 0; n < 2; ++n) _Pragma("unroll") for (int k = 0; k < 2; ++k) dst[n][k] = *(const PG8_LAS bf16x8*)(lds + PG8_SB(b, h) + boff + n * 2048 + k * 1024); } while (0)
#define PG8_MMA(ai, bj, At, Bt) do { __builtin_amdgcn_s_setprio(1); _Pragma("unroll") for (int m = 0; m < 4; ++m) _Pragma("unroll") for (int n = 0; n < 2; ++n) _Pragma("unroll") for (int k = 0; k < 2; ++k) \
        acc[ai][bj][m][n] = __builtin_amdgcn_mfma_f32_16x16x32_bf16(Bt[n][k], At[m][k], acc[ai][bj][m][n], 0, 0, 0); __builtin_amdgcn_s_setprio(0); } while (0)
#define PG8_WAIT_V(n) asm volatile("s_waitcnt vmcnt(" #n ")" ::: "memory")
#define PG8_WAIT_L(n) asm volatile("s_waitcnt lgkmcnt(" #n ")" ::: "memory")
#define PG8_BAR __builtin_amdgcn_s_barrier()
#define PG8_SCHED __builtin_amdgcn_sched_barrier(0)
    Unit cur, nxt; int ui = 0;
    if (!S.next(0, cur)) return;
    f32x4 acc[2][2][4][2];
#pragma unroll
    for (int a = 0; a < 2; ++a)
#pragma unroll
        for (int b = 0; b < 2; ++b)
#pragma unroll
            for (int m = 0; m < 4; ++m)
#pragma unroll
                for (int n = 0; n < 2; ++n) acc[a][b][m][n] = (f32x4){0.f, 0.f, 0.f, 0.f};
    bf16x8 At[4][2], B0[2][2], B1[2][2];
    const char* cA = S.aptr(g, cur); const char* cB = S.bptr(g, cur);
    S.a_ready(cur);
    if constexpr (SP2) {
        PG8_STAGE(PG8_SB(0, 0), cB, voffB); PG8_STAGE(PG8_SB(0, 1), cB + hstepB, voffB); PG8_STAGE(PG8_SA(0, 0), cA, voffA); PG8_STAGE(PG8_SA(0, 1), cA + hstepA, voffA);
        if (wr == 1) PG8_BAR;
        PG8_WAIT_V(2); PG8_BAR;
        PG8_STAGE(PG8_SB(1, 0), cB + kstep, voffB); PG8_STAGE(PG8_SA(1, 0), cA + kstep, voffA); PG8_STAGE(PG8_SB(1, 1), cB + hstepB + kstep, voffB);
        PG8_WAIT_V(6); PG8_BAR;
    } else {
        PG8_STAGE(PG8_SB(0, 0), cB, voffB); PG8_STAGE(PG8_SA(0, 0), cA, voffA); PG8_STAGE(PG8_SB(0, 1), cB + hstepB, voffB); PG8_STAGE(PG8_SA(0, 1), cA + hstepA, voffA);
        if (wr == 1) PG8_BAR;
        PG8_WAIT_V(4); PG8_BAR;
        PG8_STAGE(PG8_SB(1, 0), cB + kstep, voffB); PG8_STAGE(PG8_SA(1, 0), cA + kstep, voffA); PG8_STAGE(PG8_SB(1, 1), cB + hstepB + kstep, voffB);
        PG8_WAIT_V(6); PG8_BAR;
    }
    for (;;) {
        const bool has_next = S.next(ui + 1, nxt);
        const char* nA = has_next ? S.aptr(g, nxt) : cA; const char* nB = has_next ? S.bptr(g, nxt) : cB;
        for (int t = 0; t < nt; t += 2) {
            const bool last = (t == nt - 2);
            const char* a1 = cA + (size_t)(t + 1) * kstep;
            const char* a2 = last ? nA : cA + (size_t)(t + 2) * kstep; const char* b2 = last ? nB : cB + (size_t)(t + 2) * kstep;
            const char* a3 = a2 + kstep; const char* b3 = b2 + kstep;
            if (last && has_next) S.a_ready(nxt);
            if constexpr (SP2) {
            PG8_LDB(B0, 0, 0); PG8_LDB(B1, 0, 1); PG8_SCHED; PG8_LDA(At, 0, 0); PG8_STAGE(PG8_SA(1, 1), a1 + hstepA, voffA);
            PG8_WAIT_V(8); PG8_WAIT_L(0); PG8_BAR; PG8_MMA(0, 0, At, B0); PG8_MMA(0, 1, At, B1); PG8_BAR; PG8_SCHED;
            PG8_LDA(At, 0, 1); PG8_STAGE(PG8_SB(0, 0), b2, voffB); PG8_STAGE(PG8_SB(0, 1), b2 + hstepB, voffB); PG8_STAGE(PG8_SA(0, 0), a2, voffA);
            PG8_WAIT_V(8); PG8_WAIT_L(0); PG8_BAR; PG8_MMA(1, 0, At, B0); PG8_MMA(1, 1, At, B1); PG8_BAR; PG8_SCHED;
            PG8_LDB(B0, 1, 0); PG8_LDB(B1, 1, 1); PG8_SCHED; PG8_LDA(At, 1, 0); PG8_STAGE(PG8_SA(0, 1), a2 + hstepA, voffA);
            PG8_WAIT_V(8); PG8_WAIT_L(0); PG8_BAR; PG8_MMA(0, 0, At, B0); PG8_MMA(0, 1, At, B1); PG8_BAR; PG8_SCHED;
            PG8_LDA(At, 1, 1); PG8_STAGE(PG8_SB(1, 0), b3, voffB); PG8_STAGE(PG8_SB(1, 1), b3 + hstepB, voffB); PG8_STAGE(PG8_SA(1, 0), a3, voffA);
            PG8_WAIT_V(8); PG8_WAIT_L(0); PG8_BAR; PG8_MMA(1, 0, At, B0); PG8_MMA(1, 1, At, B1); PG8_BAR; PG8_SCHED;
            } else {
            PG8_LDB(B0, 0, 0); PG8_SCHED; PG8_LDA(At, 0, 0); PG8_STAGE(PG8_SA(1, 1), a1 + hstepA, voffA);
            PG8_WAIT_L(8); PG8_BAR; PG8_WAIT_L(0); PG8_MMA(0, 0, At, B0); PG8_BAR; PG8_SCHED;
            PG8_LDB(B1, 0, 1); PG8_STAGE(PG8_SB(0, 0), b2, voffB);
            PG8_BAR; PG8_WAIT_L(0); PG8_MMA(0, 1, At, B1); PG8_BAR;
            PG8_LDA(At, 0, 1); PG8_STAGE(PG8_SA(0, 0), a2, voffA);
            PG8_BAR; PG8_WAIT_L(0); PG8_MMA(1, 0, At, B0); PG8_BAR; PG8_SCHED;
            PG8_STAGE(PG8_SB(0, 1), b2 + hstepB, voffB);
            PG8_WAIT_V(6); PG8_BAR; PG8_MMA(1, 1, At, B1); PG8_BAR;
            PG8_LDB(B0, 1, 0); PG8_SCHED; PG8_LDA(At, 1, 0); PG8_STAGE(PG8_SA(0, 1), a2 + hstepA, voffA);
            PG8_WAIT_L(8); PG8_BAR; PG8_WAIT_L(0); PG8_MMA(0, 0, At, B0); PG8_BAR; PG8_SCHED;
            PG8_LDB(B1, 1, 1); PG8_STAGE(PG8_SB(1, 0), b3, voffB);
            PG8_BAR; PG8_WAIT_L(0); PG8_MMA(0, 1, At, B1); PG8_BAR;
            PG8_LDA(At, 1, 1); PG8_STAGE(PG8_SA(1, 0), a3, voffA);
            PG8_BAR; PG8_WAIT_L(0); PG8_MMA(1, 0, At, B0); PG8_BAR; PG8_SCHED;
            PG8_STAGE(PG8_SB(1, 1), b3 + hstepB, voffB);
            PG8_WAIT_V(6); PG8_BAR; PG8_MMA(1, 1, At, B1); PG8_BAR;
            }
        }
        if constexpr (ALIGN_EPI) { if (wr == 0) PG8_BAR; }
        if constexpr (!Epi::AFTER_DRAIN) { E(acc, cur, wr, wc, fr, fq); S.done(cur); }
        if (!has_next) break;
        if constexpr (!Epi::KEEP_ACC) {
#pragma unroll
        for (int a = 0; a < 2; ++a)
#pragma unroll
            for (int b = 0; b < 2; ++b)
#pragma unroll
                for (int m = 0; m < 4; ++m)
#pragma unroll
                    for (int n = 0; n < 2; ++n) acc[a][b][m][n] = (f32x4){0.f, 0.f, 0.f, 0.f};
        }
        cur = nxt; cA = nA; cB = nB; ++ui;
        if constexpr (ALIGN_EPI) { if (wr == 1) PG8_BAR; }
    }
    PG8_WAIT_V(0);
    if constexpr (!ALIGN_EPI) { if (wr == 0) PG8_BAR; }
    PG8_BAR;
    if constexpr (Epi::AFTER_DRAIN) { E.fused(acc, cur, wr, wc, fr, fq, lds, wid, lane); S.done(cur); }
#undef PG8_SA
#undef PG8_SB
#undef PG8_STAGE
#undef PG8_LDA
#undef PG8_LDB
#undef PG8_MMA
#undef PG8_WAIT_V
#undef PG8_WAIT_L
#undef PG8_BAR
#undef PG8_SCHED
}
}

#ifndef PROBE_PH
#define PROBE_PH -1
#endif
#ifndef PROBE_TS
#define PROBE_TS -1
#endif
#ifndef PROBE_MULT
#define PROBE_MULT 8
#endif
#ifndef PROBE_BX
#define PROBE_BX 100
#endif
constexpr int NWAVES = 8;
constexpr int N_LAUNCHES = MK_N_LAUNCHES;
constexpr int PER_PHASE = 10;

constexpr int T_TOK = 16384, DM = 1024, SEQ = 8192;
constexpr float EPS = 1e-6f;
constexpr int W_IN_COLS = 7176;

constexpr size_t MiB = 1u << 20;
constexpr size_t WS_CTL = 0, CTL_ZERO_BYTES = 1 * MiB;
constexpr size_t WS_WIN = 1 * MiB, WS_WKV = 15 * MiB, WS_WBR = 17 * MiB, WS_WOUT = 20 * MiB, WS_WPQ = 22 * MiB, WS_PK = 26 * MiB;
constexpr size_t WS_KVMEM = 26 * MiB + 512 * 1024, WS_MEMN = 27 * MiB + 512 * 1024, WS_IGLF = 28 * MiB + 512 * 1024, WS_ND = 29 * MiB, WS_NS = 29 * MiB + 512 * 1024;
constexpr size_t WS_GATES = 30 * MiB;
constexpr size_t WS_MLQ = 126 * MiB, WS_MLK = 142 * MiB, WS_SBQ = 158 * MiB, WS_MLV = 174 * MiB, WS_MEMQ = 190 * MiB, WS_MLO = 206 * MiB, WS_SBK = 222 * MiB, WS_SBV = 238 * MiB;
constexpr size_t WS_UT8 = 30 * MiB, WS_VT8 = 46 * MiB, WS_USC = 94 * MiB, WS_VSC = 94 * MiB + 65536;
constexpr size_t WS_H1B = 126 * MiB;
constexpr size_t WS_QRY = 158 * MiB;
constexpr size_t WS_CT = 222 * MiB;
constexpr size_t WS_MERGED = 222 * MiB;
constexpr size_t WS_IDX = 222 * MiB, WS_GW = 230 * MiB;
constexpr size_t WS_PD = 158 * MiB;
constexpr size_t WS_END = 254 * MiB;
constexpr size_t SPLIT_STRIDE = (size_t)T_TOK * 512;
constexpr size_t CTL_CHS = 256 * 1024, CTL_MS = 272 * 1024, CTL_SUMSQ = 512 * 1024;
constexpr int CW_BAR = 4096;

constexpr int RING_BYTES = 131072;
constexpr int LDSCTL_OFF = 155648, MISC_OFF = LDSCTL_OFF + 320;
constexpr int LDS_BYTES = 163840;

#define GAS __attribute__((address_space(1)))
#define LAS __attribute__((address_space(3)))
typedef unsigned short bf16;
typedef unsigned v4u __attribute__((ext_vector_type(4)));
typedef unsigned v2u __attribute__((ext_vector_type(2)));
typedef float f32x4 __attribute__((ext_vector_type(4)));
typedef short bf16x8 __attribute__((ext_vector_type(8)));
typedef GAS unsigned gu32;
#define RLX_AGENT __ATOMIC_RELAXED, __HIP_MEMORY_SCOPE_AGENT
#define LDS_WAIT() asm volatile("s_waitcnt lgkmcnt(0)" ::: "memory")
#define VM_WAIT() asm volatile("s_waitcnt vmcnt(0)" ::: "memory")
__device__ __forceinline__ unsigned f2bf(float f) { unsigned u = __builtin_bit_cast(unsigned, f); return (u + 0x7fffu + ((u >> 16) & 1u)) >> 16; }
__device__ __forceinline__ unsigned pk2(float lo, float hi) { return pg8::cvt_pk_bf16_c(lo, hi); }
__device__ __forceinline__ unsigned pk2s(float lo, float hi) { return f2bf(lo) | (f2bf(hi) << 16); }
__device__ __forceinline__ float bflo(unsigned x) { return __uint_as_float(x << 16); }
__device__ __forceinline__ float bfhi(unsigned x) { return __uint_as_float(x & 0xffff0000u); }
__device__ __forceinline__ float sigm(float x) { return 1.0f / (1.0f + __expf(-x)); }
__device__ __forceinline__ float softplusf_(float z) { return fmaxf(z, 0.f) + __logf(1.0f + __expf(-fabsf(z))); }

#define XB_TMO      128
#define XB_XCNT(j)  (256  + 64 * (j))
#define XB_XSUB(j)  (1280 + 64 * (j))
#define XB_XGEN(j)  (2304 + 64 * (j))
#define XB_TOP      3328
#define XB_TOPGEN   3392
#define XCD_BAR_WORDS 3456
#define XB_SPIN_CAP (1u << 18)
__device__ __forceinline__ unsigned xb_ld(unsigned* p)              { return __hip_atomic_load(p, __ATOMIC_RELAXED, __HIP_MEMORY_SCOPE_AGENT); }
__device__ __forceinline__ unsigned xb_add(unsigned* p, unsigned v) { return __hip_atomic_fetch_add(p, v, __ATOMIC_RELAXED, __HIP_MEMORY_SCOPE_AGENT); }
__device__ __forceinline__ unsigned xb_xcc_id() { return (unsigned)__builtin_amdgcn_s_getreg((3 << 11) | 20) & 0xFu; }
#define XB_SPIN(cond, bar) do { unsigned _sp = 0; while (cond) { __builtin_amdgcn_s_sleep(1); \
    if ((++_sp & 255u) == 0u) { if (xb_ld(&(bar)[XB_TMO])) break; if (_sp > XB_SPIN_CAP) { atomicAdd(&(bar)[XB_TMO], 1u); break; } } } } while (0)
struct XcdBarrier { unsigned* bar; unsigned x; volatile LAS unsigned* st; };
__device__ __forceinline__ XcdBarrier xcd_barrier_post(unsigned* bar, volatile LAS unsigned* st) {
    XcdBarrier b; b.bar = bar; b.x = xb_xcc_id(); b.st = st;
    if (threadIdx.x == 0) (void)xb_add(&bar[XB_XCNT(b.x)], 1u);
    return b;
}
__device__ __forceinline__ void xcd_barrier_complete(unsigned* bar, unsigned x, unsigned& nloc, unsigned& nx) {
    const unsigned G = gridDim.x * gridDim.y * gridDim.z;
    unsigned sum, cnt, mine, sp = 0u;
    for (;;) {
        sum = 0u; cnt = 0u; mine = 0u;
#pragma unroll
        for (unsigned j = 0; j < 16; ++j) { const unsigned c = xb_ld(&bar[XB_XCNT(j)]); sum += c; cnt += (c > 0u) ? 1u : 0u; mine = (j == x) ? c : mine; }
        if (sum == G) break;
        __builtin_amdgcn_s_sleep(1);
        if ((++sp & 255u) == 0u) { if (xb_ld(&bar[XB_TMO])) break; if (sp > XB_SPIN_CAP) { atomicAdd(&bar[XB_TMO], 1u); break; } }
    }
    nloc = mine > 0u ? mine : 1u; nx = cnt > 0u ? cnt : 1u;
}
__device__ __forceinline__ void xcd_barrier(const XcdBarrier& b) {
    asm volatile("s_waitcnt vmcnt(0)" ::: "memory");
    __syncthreads();
    if (threadIdx.x == 0) {
        unsigned* bar = b.bar;
        __builtin_amdgcn_s_waitcnt(0);
        unsigned nloc = b.st[0], nx = b.st[1];
        if (nloc == 0u) { xcd_barrier_complete(bar, b.x, nloc, nx); b.st[0] = nloc; b.st[1] = nx; }
        const unsigned old = xb_add(&bar[XB_XSUB(b.x)], 1u);
        const unsigned gen = old / nloc;
        if (old + 1u == (gen + 1u) * nloc) {
            __builtin_amdgcn_fence(__ATOMIC_RELEASE, "agent");
            asm volatile("s_waitcnt vmcnt(0)" ::: "memory");
            const unsigned og = xb_add(&bar[XB_TOP], 1u);
            const unsigned tg = og / nx;
            if (og + 1u == (tg + 1u) * nx) xb_add(&bar[XB_TOPGEN], 1u);
            else XB_SPIN(xb_ld(&bar[XB_TOPGEN]) == tg, bar);
            __builtin_amdgcn_fence(__ATOMIC_ACQUIRE, "agent");
            xb_add(&bar[XB_XGEN(b.x)], 1u);
            asm volatile("s_waitcnt vmcnt(0)" ::: "memory");
        } else {
            XB_SPIN(xb_ld(&bar[XB_XGEN(b.x)]) == gen, bar);
            __builtin_amdgcn_fence(__ATOMIC_ACQUIRE, "agent");
            asm volatile("s_waitcnt vmcnt(0)" ::: "memory");
        }
    }
    __syncthreads();
}

struct Frame {
    LAS unsigned char* lds;
    volatile LAS unsigned* MISC;
    int tid, lane, wave, G;
    unsigned char* ws; float* out;
    const float* in[24];
};
__device__ __forceinline__ float wave_sum(float v) {
#pragma unroll
    for (int o = 1; o < 64; o <<= 1) v += __shfl_xor(v, o);
    return v;
}
__device__ __forceinline__ float wave_max(float v) {
#pragma unroll
    for (int o = 1; o < 64; o <<= 1) v = fmaxf(v, __shfl_xor(v, o));
    return v;
}

template <int NT, int KS>
__device__ __forceinline__ void wave_mma(f32x4 (&acc)[NT], const LAS unsigned char* A, int pitchA, int m0, const LAS unsigned char* Bt, int pitchB, int n0, int lane, int koffA = 0, int koffB = 0) {
    const int r = lane & 15, q = lane >> 4;
#pragma unroll
    for (int ks = 0; ks < KS; ++ks) {
        const bf16x8 a = *(const LAS bf16x8*)(A + (m0 + r) * pitchA + (koffA + ks * 32 + q * 8) * 2);
#pragma unroll
        for (int j = 0; j < NT; ++j) {
            const bf16x8 b = *(const LAS bf16x8*)(Bt + (n0 + 16 * j + r) * pitchB + (koffB + ks * 32 + q * 8) * 2);
            acc[j] = __builtin_amdgcn_mfma_f32_16x16x32_bf16(a, b, acc[j], 0, 0, 0);
        }
    }
}
typedef short s16x4 __attribute__((ext_vector_type(4)));
__device__ __forceinline__ bf16x8 lds_tr_frag(const LAS unsigned char* T, int pitch, int k0, int n0, int lane) {
    const int g = lane >> 4, q = (lane & 15) >> 2, p = lane & 3;
    const LAS unsigned char* a = T + (k0 + 8 * g + q) * pitch + (n0 + 4 * p) * 2;
    const s16x4 lo = __builtin_amdgcn_ds_read_tr16_b64_v4i16((LAS s16x4*)a);
    const s16x4 hi = __builtin_amdgcn_ds_read_tr16_b64_v4i16((LAS s16x4*)(a + 4 * pitch));
    return (bf16x8){lo[0], lo[1], lo[2], lo[3], hi[0], hi[1], hi[2], hi[3]};
}
template <int NT, int KS>
__device__ __forceinline__ void wave_mma_kn(f32x4 (&acc)[NT], const LAS unsigned char* A, int pitchA, int m0, const LAS unsigned char* Bkn, int pitchB, int n0, int lane, int koffA = 0, int k0B = 0) {
    const int r = lane & 15, q = lane >> 4;
#pragma unroll
    for (int ks = 0; ks < KS; ++ks) {
        const bf16x8 a = *(const LAS bf16x8*)(A + (m0 + r) * pitchA + (koffA + ks * 32 + q * 8) * 2);
#pragma unroll
        for (int j = 0; j < NT; ++j) { const bf16x8 b = lds_tr_frag(Bkn, pitchB, k0B + ks * 32, n0 + 16 * j, lane); acc[j] = __builtin_amdgcn_mfma_f32_16x16x32_bf16(a, b, acc[j], 0, 0, 0); }
    }
}
__device__ __forceinline__ void lds_store_tr8(LAS unsigned char* base, int pitch, int d0, int col, v4u v) {
    *(LAS unsigned short*)(base + (d0 + 0) * pitch + col * 2) = (unsigned short)(v.x & 0xffffu); *(LAS unsigned short*)(base + (d0 + 1) * pitch + col * 2) = (unsigned short)(v.x >> 16);
    *(LAS unsigned short*)(base + (d0 + 2) * pitch + col * 2) = (unsigned short)(v.y & 0xffffu); *(LAS unsigned short*)(base + (d0 + 3) * pitch + col * 2) = (unsigned short)(v.y >> 16);
    *(LAS unsigned short*)(base + (d0 + 4) * pitch + col * 2) = (unsigned short)(v.z & 0xffffu); *(LAS unsigned short*)(base + (d0 + 5) * pitch + col * 2) = (unsigned short)(v.z >> 16);
    *(LAS unsigned short*)(base + (d0 + 6) * pitch + col * 2) = (unsigned short)(v.w & 0xffffu); *(LAS unsigned short*)(base + (d0 + 7) * pitch + col * 2) = (unsigned short)(v.w >> 16);
}

__device__ __forceinline__ void p0_transpose_item(const float* W, int ldsrc, int src_off, int K, int ncols, bf16* WT, int row_off, const float* kscale, LAS float* scr, int item, int lane) {
    const int nblk = ncols / 64, kb = item / nblk, nb = item % nblk, k0 = 64 * kb, n0 = 64 * nb;
    const int kk = lane >> 4, n4 = lane & 15;
    f32x4 v[16];
#pragma unroll
    for (int i = 0; i < 16; ++i) v[i] = *(const GAS f32x4*)(W + (size_t)(k0 + 4 * i + kk) * ldsrc + src_off + n0 + 4 * n4);
#pragma unroll
    for (int i = 0; i < 16; ++i) { const int k = 4 * i + kk; const float sc = kscale ? kscale[k0 + k] : 1.0f; LAS float* p = scr + k * 65 + 4 * n4;
        p[0] = v[i].x * sc; p[1] = v[i].y * sc; p[2] = v[i].z * sc; p[3] = v[i].w * sc; }
    LDS_WAIT(); asm volatile("" ::: "memory");
    const int c = lane & 7;
#pragma unroll
    for (int j = 0; j < 8; ++j) { const int n = (lane >> 3) + 8 * j; const LAS float* sp = scr + (8 * c) * 65 + n;
        v4u o; o.x = pk2(sp[0 * 65], sp[1 * 65]); o.y = pk2(sp[2 * 65], sp[3 * 65]); o.z = pk2(sp[4 * 65], sp[5 * 65]); o.w = pk2(sp[6 * 65], sp[7 * 65]);
        *(GAS v4u*)(WT + (size_t)(row_off + n0 + n) * K + k0 + 8 * c) = o; }
    LDS_WAIT(); asm volatile("" ::: "memory");
}

__device__ __forceinline__ void p0_prologue(Frame& F) {
    const float* x = F.in[0]; const float* mem = F.in[1]; const float* g_mix = F.in[2]; const float* w_in = F.in[3];
    const float* b_ig = F.in[4]; const float* b_fg = F.in[5]; const float* mem_g = F.in[9];
    bf16* XN = (bf16*)F.out;
    bf16* MEMN = (bf16*)(F.ws + WS_MEMN);
    float* IGLF = (float*)(F.ws + WS_IGLF);
    LAS float* gws = (LAS float*)(F.lds + 69632);
    for (int e = F.tid; e < 8192; e += 512) { const int c = e & 7, k = e >> 3; gws[c * 1024 + k] = w_in[(size_t)k * W_IN_COLS + 3072 + c]; }
    __syncthreads();
    const int gw = blockIdx.x * NWAVES + F.wave, NGW = F.G * NWAVES;
#define P0_SRC(m_) (((m_) >= T_TOK ? mem + (size_t)((m_) - T_TOK) * DM : x + (size_t)(m_) * DM))
    f32x4 v[4], vn[4];
    if (gw < T_TOK + 512) {
#pragma unroll
        for (int j = 0; j < 4; ++j) v[j] = *((const GAS f32x4*)P0_SRC(gw) + F.lane + 64 * j); }
    for (int m = gw; m < T_TOK + 512; m += NGW) {
        const bool is_mem = m >= T_TOK;
        const int mn = (m + NGW < T_TOK + 512) ? m + NGW : m;
#pragma unroll
        for (int j = 0; j < 4; ++j) vn[j] = *((const GAS f32x4*)P0_SRC(mn) + F.lane + 64 * j);
        const float* gsrc = is_mem ? mem_g : g_mix;
        bf16* dst = is_mem ? MEMN + (size_t)(m - T_TOK) * DM : XN + (size_t)m * DM;
        float s = 0.f;
#pragma unroll
        for (int j = 0; j < 4; ++j) s += (v[j].x * v[j].x + v[j].y * v[j].y) + (v[j].z * v[j].z + v[j].w * v[j].w);
        const float rstd = 1.0f / sqrtf(wave_sum(s) * (1.f / DM) + EPS);
#pragma unroll
        for (int j = 0; j < 4; ++j) { const f32x4 gg = *((const GAS f32x4*)gsrc + F.lane + 64 * j); v[j] = v[j] * rstd * gg; }
        GAS unsigned long long* o8 = (GAS unsigned long long*)dst + F.lane;
#pragma unroll
        for (int j = 0; j < 4; ++j) o8[64 * j] = (unsigned long long)pk2(v[j].x, v[j].y) | ((unsigned long long)pk2(v[j].z, v[j].w) << 32);
        if (!is_mem) {
            float dots[8];
#pragma unroll
            for (int c = 0; c < 8; ++c) { float d = 0.f;
#pragma unroll
                for (int j = 0; j < 4; ++j) { const f32x4 wv = *(const LAS f32x4*)(gws + c * 1024 + 256 * j + 4 * F.lane); d += (v[j].x * wv.x + v[j].y * wv.y) + (v[j].z * wv.z + v[j].w * wv.w); }
                dots[c] = d; }
#pragma unroll
            for (int i = 0; i < 4; ++i) { const bool up = (F.lane & 4) != 0; const float send = up ? dots[i] : dots[i + 4]; const float keep = up ? dots[i + 4] : dots[i]; dots[i] = keep + __shfl_xor(send, 4); }
#pragma unroll
            for (int i = 0; i < 2; ++i) { const bool up = (F.lane & 2) != 0; const float send = up ? dots[i] : dots[i + 2]; const float keep = up ? dots[i + 2] : dots[i]; dots[i] = keep + __shfl_xor(send, 2); }
            { const bool up = (F.lane & 1) != 0; const float send = up ? dots[0] : dots[1]; const float keep = up ? dots[1] : dots[0]; dots[0] = keep + __shfl_xor(send, 1); }
            float dt = dots[0]; dt += __shfl_xor(dt, 8); dt += __shfl_xor(dt, 16); dt += __shfl_xor(dt, 32);
            if (F.lane < 8) { const int c = F.lane;
                float o;
                if (c < 4) o = dt + b_ig[c]; else { const float fp = dt + b_fg[c - 4]; o = fminf(fp, 0.f) - __logf(1.0f + __expf(-fabsf(fp))); }
                IGLF[(size_t)m * 8 + c] = o; }
        }
#pragma unroll
        for (int j = 0; j < 4; ++j) v[j] = vn[j];
    }
#undef P0_SRC
    { const float* k1 = F.in[20]; const float* k2 = F.in[21]; bf16* PK = (bf16*)(F.ws + WS_PK);
      for (int e = (blockIdx.x * 512 + F.tid) * 4; e < 2 * 131072; e += F.G * 512 * 4) {
          const f32x4 vv = (e < 131072) ? *(const GAS f32x4*)(k1 + e) : *(const GAS f32x4*)(k2 + e - 131072);
          v2u o; o.x = pk2(vv.x, vv.y); o.y = pk2(vv.z, vv.w); *(GAS v2u*)(PK + e) = o; } }
    __syncthreads();
    LAS float* scr = (LAS float*)(F.lds + F.wave * 16640);
    bf16* WIN = (bf16*)(F.ws + WS_WIN); bf16* WKV = (bf16*)(F.ws + WS_WKV); bf16* WBR = (bf16*)(F.ws + WS_WBR); bf16* WOUT = (bf16*)(F.ws + WS_WOUT); bf16* WPQ = (bf16*)(F.ws + WS_WPQ);
    constexpr int I_G = 16 * 48, I_5 = 16 * 8, I_KV = 16 * 16, I_BR = 8 * 16, I_OUT = 16 * 16, I_PQ = 16 * 32;
    constexpr int NITEMS = I_G + 8 * I_5 + I_KV + 3 * I_BR + I_OUT + I_PQ;
    for (int it = gw; it < NITEMS; it += NGW) {
        int r = it;
        if (r < I_G) { p0_transpose_item(w_in, W_IN_COLS, 4104, 1024, 3072, WIN, 0, nullptr, scr, r, F.lane); continue; } r -= I_G;
        if (r < I_5) { p0_transpose_item(w_in, W_IN_COLS, 1536, 1024, 512, WIN, 3072, nullptr, scr, r, F.lane); continue; } r -= I_5;
        if (r < I_5) { p0_transpose_item(w_in, W_IN_COLS, 2048, 1024, 512, WIN, 3584, nullptr, scr, r, F.lane); continue; } r -= I_5;
        if (r < I_5) { p0_transpose_item(w_in, W_IN_COLS, 0, 1024, 512, WIN, 4096, nullptr, scr, r, F.lane); continue; } r -= I_5;
        if (r < I_5) { p0_transpose_item(w_in, W_IN_COLS, 2560, 1024, 512, WIN, 4608, nullptr, scr, r, F.lane); continue; } r -= I_5;
        if (r < I_5) { p0_transpose_item(w_in, W_IN_COLS, 3592, 1024, 512, WIN, 5120, nullptr, scr, r, F.lane); continue; } r -= I_5;
        if (r < I_5) { p0_transpose_item(w_in, W_IN_COLS, 3080, 1024, 512, WIN, 5632, nullptr, scr, r, F.lane); continue; } r -= I_5;
        if (r < I_5) { p0_transpose_item(w_in, W_IN_COLS, 512, 1024, 512, WIN, 6144, nullptr, scr, r, F.lane); continue; } r -= I_5;
        if (r < I_5) { p0_transpose_item(w_in, W_IN_COLS, 1024, 1024, 512, WIN, 6656, nullptr, scr, r, F.lane); continue; } r -= I_5;
        if (r < I_KV) { p0_transpose_item(F.in[10], 1024, 0, 1024, 1024, WKV, 0, nullptr, scr, r, F.lane); continue; } r -= I_KV;
        if (r < I_BR) { p0_transpose_item(F.in[13], 1024, 0, 512, 1024, WBR, 0, nullptr, scr, r, F.lane); continue; } r -= I_BR;
        if (r < I_BR) { p0_transpose_item(F.in[14], 1024, 0, 512, 1024, WBR, 1024, nullptr, scr, r, F.lane); continue; } r -= I_BR;
        if (r < I_BR) { p0_transpose_item(F.in[15], 1024, 0, 512, 1024, WBR, 2048, nullptr, scr, r, F.lane); continue; } r -= I_BR;
        if (r < I_OUT) { p0_transpose_item(F.in[17], 1024, 0, 1024, 1024, WOUT, 0, nullptr, scr, r, F.lane); continue; } r -= I_OUT;
        p0_transpose_item(F.in[19], 2048, 0, 1024, 2048, WPQ, 0, F.in[18], scr, r, F.lane);
    }
}

template <bool DIAG>
__device__ __forceinline__ void sb_elementwise(const LAS unsigned char* Ss, LAS unsigned char* Ps, int r, int qd, int rel, float& R) {
    float z[16];
#pragma unroll
    for (int i4 = 0; i4 < 4; ++i4) { const f32x4 t4 = *(const LAS f32x4*)(Ss + r * 272 + qd * 64 + i4 * 16); z[4 * i4] = t4.x; z[4 * i4 + 1] = t4.y; z[4 * i4 + 2] = t4.z; z[4 * i4 + 3] = t4.w; }
    float suf[16], lb[16]; float run = 0.f;
#pragma unroll
    for (int i = 15; i >= 0; --i) { const float zz = z[i] * 0.18033688011112042f;
        const float sp = fmaxf(zz, 0.f) + __builtin_amdgcn_logf(1.0f + __builtin_amdgcn_exp2f(-fabsf(zz)));
        const bool mk = DIAG ? (i < rel) : true;
        lb[i] = zz - sp; suf[i] = run; run += mk ? -sp : 0.f; }
    const float a1 = __shfl_xor(run, 1), a2 = __shfl_xor(run, 2), a3 = __shfl_xor(run, 3);
    const float off = ((qd & 1) == 0 ? a1 : 0.f) + ((qd & 2) == 0 ? a2 : 0.f) + (qd < 2 ? a3 : 0.f);
    const float base = R + off;
    unsigned pw[8];
#pragma unroll
    for (int i = 0; i < 16; i += 2) { float p0 = __builtin_amdgcn_exp2f(lb[i] + base + suf[i]), p1 = __builtin_amdgcn_exp2f(lb[i + 1] + base + suf[i + 1]);
        if (DIAG) { if (!(i < rel)) p0 = 0.f; if (!(i + 1 < rel)) p1 = 0.f; }
        pw[i >> 1] = pk2(p0, p1); }
    *(LAS v4u*)(Ps + r * 144 + qd * 32) = (v4u){pw[0], pw[1], pw[2], pw[3]}; *(LAS v4u*)(Ps + r * 144 + qd * 32 + 16) = (v4u){pw[4], pw[5], pw[6], pw[7]};
    R += run + a1 + a2 + a3;
}
__device__ __forceinline__ void sb_attn_item(Frame& F, int item, bf16* outp, size_t rmask) {
    const int bh = item >> 6, qb = 63 - (item & 63), b = bh >> 3, h = bh & 7;
    const int tid = F.tid, lane = F.lane, w = F.wave, hf = w >> 2;
    LAS unsigned char* Qs = F.lds;
    LAS unsigned char* Ks = F.lds + 18432;
    LAS unsigned char* Vs = F.lds + 36864;
    LAS unsigned char* Ss = F.lds + 55296;
    LAS unsigned char* Ps = F.lds + 90112;
    LAS unsigned* alive = (LAS unsigned*)(F.lds + 108544);
    const bf16* SBQ = (const bf16*)(F.ws + WS_SBQ); const bf16* SBK = (const bf16*)(F.ws + WS_SBK); const bf16* SBV = (const bf16*)(F.ws + WS_SBV);
    const size_t row0 = (size_t)b * SEQ + (size_t)qb * 128;
    const int skey = tid >> 3, sc8 = tid & 7;
    v4u kl, vl, ku, vu;
    { const size_t gu = (size_t)b * SEQ + (size_t)(2 * qb + 1) * 64 + skey, gl = gu - 64;
      ku = *(const GAS v4u*)(SBK + gu * 512 + h * 64 + sc8 * 8); vu = *(const GAS v4u*)(SBV + gu * 512 + h * 64 + sc8 * 8);
      kl = *(const GAS v4u*)(SBK + gl * 512 + h * 64 + sc8 * 8); vl = *(const GAS v4u*)(SBV + gl * 512 + h * 64 + sc8 * 8); }
    __syncthreads();
#pragma unroll
    for (int i = 0; i < 2; ++i) { const int p = tid + 512 * i, rr = p >> 3, c = p & 7;
        const v4u v = *(const GAS v4u*)(SBQ + (row0 + rr) * 512 + h * 64 + c * 8); *(LAS v4u*)(Qs + rr * 144 + c * 16) = v; }
    if (tid < 16) alive[tid] = 1u;
    f32x4 oacc[4];
#pragma unroll
    for (int j = 0; j < 4; ++j) oacc[j] = (f32x4){0.f, 0.f, 0.f, 0.f};
    float R = 0.f;
    const int r = tid >> 2, qd = tid & 3;
    int par = 0;
    for (int ju = 2 * qb + 1; ju >= 0; --ju, par ^= 1) {
        __syncthreads();
        if (ju < 2 * qb) { unsigned any = 0u;
#pragma unroll
            for (int i = 0; i < 8; ++i) any |= alive[(par ^ 1) * 8 + i];
            if (any == 0u) break; }
        *(LAS v4u*)(Ks + 9216 + skey * 144 + sc8 * 16) = ku; *(LAS v4u*)(Vs + 9216 + skey * 144 + sc8 * 16) = vu;
        *(LAS v4u*)(Ks + skey * 144 + sc8 * 16) = kl; *(LAS v4u*)(Vs + skey * 144 + sc8 * 16) = vl;
        if (ju > 0) { const size_t gu = (size_t)b * SEQ + (size_t)(ju - 1) * 64 + skey;
            ku = *(const GAS v4u*)(SBK + gu * 512 + h * 64 + sc8 * 8); vu = *(const GAS v4u*)(SBV + gu * 512 + h * 64 + sc8 * 8);
            if (ju > 1) { const size_t gl = gu - 64; kl = *(const GAS v4u*)(SBK + gl * 512 + h * 64 + sc8 * 8); vl = *(const GAS v4u*)(SBV + gl * 512 + h * 64 + sc8 * 8); } }
        __syncthreads();
        const int jb = ju - 1 + hf;
        if (jb >= 0) {
            const int rel0 = 128 * qb + 16 * w - 64 * jb;
            f32x4 sacc[4];
#pragma unroll
            for (int j = 0; j < 4; ++j) sacc[j] = (f32x4){0.f, 0.f, 0.f, 0.f};
            wave_mma<4, 2>(sacc, Qs, 144, 16 * w, Ks + 9216 * hf, 144, 0, lane);
#pragma unroll
            for (int j = 0; j < 4; ++j)
#pragma unroll
                for (int rg = 0; rg < 4; ++rg) *(LAS float*)(Ss + (16 * w + 4 * (lane >> 4) + rg) * 272 + (16 * j + (lane & 15)) * 4) = sacc[j][rg];
            LDS_WAIT();
            const int rel = 128 * qb + r - 64 * jb - 16 * qd;
            if (rel0 < 64) sb_elementwise<true>(Ss, Ps, r, qd, rel, R); else sb_elementwise<false>(Ss, Ps, r, qd, rel, R);
            LDS_WAIT();
            wave_mma_kn<4, 2>(oacc, Ps, 144, 16 * w, Vs + 9216 * hf, 144, 0, lane);
        }
        const bool al = (jb > 0) && (__builtin_amdgcn_ballot_w64(R >= -160.f) != 0ull);
        if (lane == 0) alive[par * 8 + w] = al ? 1u : 0u;
    }
    LDS_WAIT();
#pragma unroll
    for (int j = 0; j < 4; ++j)
#pragma unroll
        for (int rg = 0; rg < 4; ++rg) *(LAS unsigned short*)(Ps + (16 * w + 4 * (lane >> 4) + rg) * 144 + (16 * j + (lane & 15)) * 2) = (unsigned short)f2bf(oacc[j][rg]);
    LDS_WAIT();
#pragma unroll
    for (int i = 0; i < 2; ++i) { const int p = lane + 64 * i, rr = 16 * w + (p >> 3), c = p & 7;
        const v4u v = *(const LAS v4u*)(Ps + rr * 144 + c * 16); *(GAS v4u*)(outp + ((row0 + rr) & rmask) * 512 + h * 64 + c * 8) = v; }
}

__device__ __forceinline__ void conv16(const bf16* src, int col, const float* cw, const float* cb, int ch, int b, int t, float (&y)[16]) {
#pragma unroll
    for (int i4 = 0; i4 < 4; ++i4) { const f32x4 bb = *(const GAS f32x4*)(cb + ch + 4 * i4); y[4 * i4] = bb.x; y[4 * i4 + 1] = bb.y; y[4 * i4 + 2] = bb.z; y[4 * i4 + 3] = bb.w; }
#pragma unroll
    for (int kk = 0; kk < 4; ++kk) { const int tt = t - 3 + kk;
        if (tt >= 0) { const bf16* p = src + ((size_t)b * SEQ + tt) * 512 + col; const v4u x0 = *(const GAS v4u*)p, x1 = *(const GAS v4u*)(p + 8);
            const float xs[16] = {bflo(x0.x), bfhi(x0.x), bflo(x0.y), bfhi(x0.y), bflo(x0.z), bfhi(x0.z), bflo(x0.w), bfhi(x0.w), bflo(x1.x), bfhi(x1.x), bflo(x1.y), bfhi(x1.y), bflo(x1.z), bfhi(x1.z), bflo(x1.w), bfhi(x1.w)};
#pragma unroll
            for (int i4 = 0; i4 < 4; ++i4) { const f32x4 wv = *(const GAS f32x4*)(cw + kk * 1024 + ch + 4 * i4);
                y[4 * i4] += wv.x * xs[4 * i4]; y[4 * i4 + 1] += wv.y * xs[4 * i4 + 1]; y[4 * i4 + 2] += wv.z * xs[4 * i4 + 2]; y[4 * i4 + 3] += wv.w * xs[4 * i4 + 3]; } } }
#pragma unroll
    for (int i = 0; i < 16; ++i) y[i] = y[i] * sigm(y[i]);
}

constexpr int CONVW_OFF = 122880, CONVW_SET = 5 * 128 * 4;
__device__ __forceinline__ void conv_weights_to_lds(Frame& F, int h) {
    LAS float* wl = (LAS float*)(F.lds + CONVW_OFF);
    for (int e = F.tid; e < 2 * 5 * 128; e += NWAVES * 64) { const int set = e / 640, r = e % 640, kk = r >> 7, ch = r & 127; const int gch = set * 512 + h * 128 + ch;
        wl[e] = (kk < 4) ? F.in[6][kk * 1024 + gch] : F.in[7][gch]; }
}
__device__ __forceinline__ void conv16_lds(const bf16* src, int col, const LAS float* wl, int chl, int b, int t, float (&y)[16]) {
#pragma unroll
    for (int i4 = 0; i4 < 4; ++i4) { const f32x4 bb = *(const LAS f32x4*)(wl + 4 * 128 + chl + 4 * i4); y[4 * i4] = bb.x; y[4 * i4 + 1] = bb.y; y[4 * i4 + 2] = bb.z; y[4 * i4 + 3] = bb.w; }
#pragma unroll
    for (int kk = 0; kk < 4; ++kk) { const int tt = t - 3 + kk;
        if (tt >= 0) { const bf16* p = src + ((size_t)b * SEQ + tt) * 512 + col; const v4u x0 = *(const GAS v4u*)p, x1 = *(const GAS v4u*)(p + 8);
            const float xs[16] = {bflo(x0.x), bfhi(x0.x), bflo(x0.y), bfhi(x0.y), bflo(x0.z), bfhi(x0.z), bflo(x0.w), bfhi(x0.w), bflo(x1.x), bfhi(x1.x), bflo(x1.y), bfhi(x1.y), bflo(x1.z), bfhi(x1.z), bflo(x1.w), bfhi(x1.w)};
#pragma unroll
            for (int i4 = 0; i4 < 4; ++i4) { const f32x4 wv = *(const LAS f32x4*)(wl + kk * 128 + chl + 4 * i4);
                y[4 * i4] += wv.x * xs[4 * i4]; y[4 * i4 + 1] += wv.y * xs[4 * i4 + 1]; y[4 * i4 + 2] += wv.z * xs[4 * i4 + 2]; y[4 * i4 + 3] += wv.w * xs[4 * i4 + 3]; } } }
#pragma unroll
    for (int i = 0; i < 16; ++i) y[i] = y[i] * sigm(y[i]);
}
__device__ __forceinline__ void conv16_regs(const v4u (&x)[8], const LAS float* wl, int chl, float (&y)[16]) {
#pragma unroll
    for (int i4 = 0; i4 < 4; ++i4) { const f32x4 bb = *(const LAS f32x4*)(wl + 4 * 128 + chl + 4 * i4); y[4 * i4] = bb.x; y[4 * i4 + 1] = bb.y; y[4 * i4 + 2] = bb.z; y[4 * i4 + 3] = bb.w; }
#pragma unroll
    for (int kk = 0; kk < 4; ++kk) { const v4u x0 = x[2 * kk], x1 = x[2 * kk + 1];
        const float xs[16] = {bflo(x0.x), bfhi(x0.x), bflo(x0.y), bfhi(x0.y), bflo(x0.z), bfhi(x0.z), bflo(x0.w), bfhi(x0.w), bflo(x1.x), bfhi(x1.x), bflo(x1.y), bfhi(x1.y), bflo(x1.z), bfhi(x1.z), bflo(x1.w), bfhi(x1.w)};
#pragma unroll
        for (int i4 = 0; i4 < 4; ++i4) { const f32x4 wv = *(const LAS f32x4*)(wl + kk * 128 + chl + 4 * i4);
            y[4 * i4] += wv.x * xs[4 * i4]; y[4 * i4 + 1] += wv.y * xs[4 * i4 + 1]; y[4 * i4 + 2] += wv.z * xs[4 * i4 + 2]; y[4 * i4 + 3] += wv.w * xs[4 * i4 + 3]; } }
#pragma unroll
    for (int i = 0; i < 16; ++i) y[i] = y[i] * sigm(y[i]);
}
__device__ __forceinline__ void mlstm_store_wk(LAS unsigned char* p, const float (&y)[16], float sc) {
    v4u k0, k1; k0.x = pk2(y[0] * sc, y[1] * sc); k0.y = pk2(y[2] * sc, y[3] * sc); k0.z = pk2(y[4] * sc, y[5] * sc); k0.w = pk2(y[6] * sc, y[7] * sc);
    k1.x = pk2(y[8] * sc, y[9] * sc); k1.y = pk2(y[10] * sc, y[11] * sc); k1.z = pk2(y[12] * sc, y[13] * sc); k1.w = pk2(y[14] * sc, y[15] * sc);
    *(LAS v4u*)p = k0; *(LAS v4u*)(p + 16) = k1;
}
struct MlstmLocalRaw { v4u xk[8], vv[2]; float lf, ig; };
__device__ __forceinline__ void mlstm_local_load(Frame& F, int item, MlstmLocalRaw& R) {
    const int bh = item >> 7, c = item & 127, b = bh >> 2, h = bh & 3;
    const int tid = F.tid, lane = F.lane;
    const float* IGLF = (const float*)(F.ws + WS_IGLF);
    const bf16* MLK = (const bf16*)(F.ws + WS_MLK); const bf16* MLV = (const bf16*)(F.ws + WS_MLV);
    const int t0 = c * 64; const size_t row0 = (size_t)b * SEQ + t0;
    const int s = tid >> 3, part = tid & 7;
#pragma unroll
    for (int kk = 0; kk < 4; ++kk) { const int tt = t0 + s - 3 + kk;
        if (tt >= 0) { const size_t off = ((size_t)b * SEQ + tt) * 512 + h * 128 + part * 16; R.xk[2 * kk] = *(const GAS v4u*)(MLK + off); R.xk[2 * kk + 1] = *(const GAS v4u*)(MLK + off + 8); }
        else { R.xk[2 * kk] = (v4u){0u, 0u, 0u, 0u}; R.xk[2 * kk + 1] = (v4u){0u, 0u, 0u, 0u}; } }
    { const bf16* vp = MLV + (row0 + s) * 512 + h * 128 + part * 16; R.vv[0] = *(const GAS v4u*)vp; R.vv[1] = *(const GAS v4u*)(vp + 8); }
    R.lf = 0.f; R.ig = 0.f;
    if (F.wave == 0) { R.lf = IGLF[(row0 + lane) * 8 + 4 + h]; R.ig = IGLF[(row0 + lane) * 8 + h]; }
}
__device__ __forceinline__ void mlstm_local_item(Frame& F, int item, int next, MlstmLocalRaw& R) {
    const int tid = F.tid, lane = F.lane, w = F.wave;
    LAS float* wsm = (LAS float*)F.lds;
    LAS unsigned char* WKs = F.lds + 256;
    LAS unsigned char* Vs = F.lds + 256 + 17408;
    float* CHS = (float*)(F.ws + WS_CTL + CTL_CHS);
    bf16* Dg = (bf16*)F.out + (size_t)item * 16384; float* NDg = (float*)(F.ws + WS_ND) + (size_t)item * 128;
    LAS unsigned char* Dst = F.lds + 36864 + w * 4352;
    __syncthreads();
    if (w == 0) {
        float bs = R.lf;
#pragma unroll
        for (int o = 1; o < 64; o <<= 1) { const float v = __shfl_up(bs, o); if (lane >= o) bs += v; }
        const float blast = __shfl(bs, 63);
        const float a = blast - bs + R.ig; const float mu = wave_max(a);
        wsm[lane] = __expf(a - mu);
        if (lane == 0) { CHS[2 * item] = blast; CHS[2 * item + 1] = mu; }
    }
    const int s = tid >> 3, part = tid & 7; float y[16];
    conv16_regs(R.xk, (const LAS float*)(F.lds + CONVW_OFF + CONVW_SET), part * 16, y);
    *(LAS v4u*)(Vs + s * 272 + part * 32) = R.vv[0]; *(LAS v4u*)(Vs + s * 272 + part * 32 + 16) = R.vv[1];
    if (next >= 0) mlstm_local_load(F, next, R);
    __syncthreads();
    mlstm_store_wk(WKs + s * 272 + part * 32, y, wsm[s] * 0.08838834764831845f);
    __syncthreads();
    { f32x4 acc[8];
#pragma unroll
      for (int j = 0; j < 8; ++j) acc[j] = (f32x4){0.f, 0.f, 0.f, 0.f};
#pragma unroll
      for (int ks = 0; ks < 2; ++ks) { const bf16x8 a = lds_tr_frag(Vs, 272, 32 * ks, 16 * w, lane);
#pragma unroll
          for (int j = 0; j < 8; ++j) { const bf16x8 bb = lds_tr_frag(WKs, 272, 32 * ks, 16 * j, lane); acc[j] = __builtin_amdgcn_mfma_f32_16x16x32_bf16(a, bb, acc[j], 0, 0, 0); } }
#pragma unroll
      for (int j = 0; j < 8; ++j)
#pragma unroll
          for (int rg = 0; rg < 4; ++rg) *(LAS unsigned short*)(Dst + (4 * (lane >> 4) + rg) * 272 + (16 * j + (lane & 15)) * 2) = (unsigned short)f2bf(acc[j][rg]);
      LDS_WAIT();
#pragma unroll
      for (int i = 0; i < 4; ++i) { const int p = lane + 64 * i, rr = p >> 4, cc = p & 15;
          const v4u v = *(const LAS v4u*)(Dst + rr * 272 + cc * 16); *(GAS v4u*)(Dg + (16 * w + rr) * 128 + cc * 8) = v; } }
    if (tid < 128) { float sacc = 0.f;
#pragma unroll 8
        for (int i = 0; i < 64; ++i) sacc += __uint_as_float((unsigned)(*(const LAS unsigned short*)(WKs + i * 272 + tid * 2)) << 16);
        NDg[tid] = sacc; }
}

__device__ __forceinline__ void mlstm_scan(Frame& F) {
    const float* CHS = (const float*)(F.ws + WS_CTL + CTL_CHS); float* MS = (float*)(F.ws + WS_CTL + CTL_MS);
    const float* NDg = (const float*)(F.ws + WS_ND); float* NS = (float*)(F.ws + WS_NS);
    LAS float* chs = (LAS float*)F.lds;
    __syncthreads();
    for (int i = F.tid; i < 2048; i += 512) chs[i] = CHS[i];
    __syncthreads();
    if (F.tid < 8) { float m = 0.f;
        for (int c = 0; c < 128; ++c) { const int item = F.tid * 128 + c; const float blast = chs[2 * item], mu = chs[2 * item + 1];
            if (blockIdx.x == 0) MS[item] = m;
            const float mn = fmaxf(blast + m, mu); chs[2 * item] = __expf(blast + m - mn); chs[2 * item + 1] = __expf(mu - mn); m = mn; } }
    __syncthreads();
    for (int g = blockIdx.x * 512 + F.tid; g < 8 * 8192; g += F.G * 512) {
        const int bh = g >> 13, e2 = g & 8191; float st0 = 0.f, st1 = 0.f;
        const unsigned* dp = (const unsigned*)F.out + (size_t)bh * 128 * 8192 + e2; unsigned* cp = (unsigned*)(F.ws + WS_CT) + (size_t)bh * 128 * 8192 + e2;
        for (int c0 = 0; c0 < 128; c0 += 8) { unsigned d[8];
#pragma unroll
            for (int k = 0; k < 8; ++k) d[k] = __builtin_nontemporal_load(dp + (size_t)(c0 + k) * 8192);
#pragma unroll
            for (int k = 0; k < 8; ++k) { cp[(size_t)(c0 + k) * 8192] = pk2(st0, st1); const float al = chs[2 * (bh * 128 + c0 + k)], be = chs[2 * (bh * 128 + c0 + k) + 1];
                st0 = al * st0 + be * bflo(d[k]); st1 = al * st1 + be * bfhi(d[k]); } }
    }
    for (int g = blockIdx.x * 512 + F.tid; g < 8 * 128; g += F.G * 512) {
        const int bh = g >> 7, e = g & 127; float st = 0.f;
        for (int c = 0; c < 128; ++c) { const int item = bh * 128 + c; NS[(size_t)item * 128 + e] = st; st = chs[2 * item] * st + chs[2 * item + 1] * NDg[(size_t)item * 128 + e]; }
    }
}

__device__ __forceinline__ void mem_attn_item(Frame& F, int item, bf16* outp, size_t rmask) {
    const int tile = item & 63, h = (item >> 6) & 3, b = item >> 8;
    const int tid = F.tid, lane = F.lane, w = F.wave;
    LAS unsigned char* Qs = F.lds;
    LAS unsigned char* KVs = F.lds + 34816;
    LAS unsigned char* Pw = F.lds + 34816 + 69632 + w * 2304;
    bf16* MEMQ = (bf16*)(F.ws + WS_MEMQ); const bf16* KV = (const bf16*)(F.ws + WS_KVMEM);
    const float* qg = F.in[11]; const float* kg = F.in[12];
    const size_t row0 = (size_t)b * SEQ + (size_t)tile * 128;
    __syncthreads();
    { const int r = tid >> 2, part = tid & 3; const bf16* p = MEMQ + (row0 + r) * 512 + h * 128 + part * 32;
      v4u x[4]; float s = 0.f;
#pragma unroll
      for (int i = 0; i < 4; ++i) { x[i] = *(const GAS v4u*)(p + 8 * i);
          s += (bflo(x[i].x) * bflo(x[i].x) + bfhi(x[i].x) * bfhi(x[i].x)) + (bflo(x[i].y) * bflo(x[i].y) + bfhi(x[i].y) * bfhi(x[i].y)) + (bflo(x[i].z) * bflo(x[i].z) + bfhi(x[i].z) * bfhi(x[i].z)) + (bflo(x[i].w) * bflo(x[i].w) + bfhi(x[i].w) * bfhi(x[i].w)); }
      s += __shfl_xor(s, 1); s += __shfl_xor(s, 2);
      const float rs = 0.08838834764831845f / sqrtf(s * (1.f / 128.f) + EPS);
#pragma unroll
      for (int i = 0; i < 4; ++i) { const f32x4 g0 = *(const GAS f32x4*)(qg + part * 32 + 8 * i), g1 = *(const GAS f32x4*)(qg + part * 32 + 8 * i + 4);
          v4u o; o.x = pk2s(bflo(x[i].x) * rs * g0.x, bfhi(x[i].x) * rs * g0.y); o.y = pk2s(bflo(x[i].y) * rs * g0.z, bfhi(x[i].y) * rs * g0.w);
          o.z = pk2s(bflo(x[i].z) * rs * g1.x, bfhi(x[i].z) * rs * g1.y); o.w = pk2s(bflo(x[i].w) * rs * g1.z, bfhi(x[i].w) * rs * g1.w);
          *(LAS v4u*)(Qs + r * 272 + part * 64 + i * 16) = o; } }
    { const int key = tid >> 1, half = tid & 1; const bf16* p = KV + ((size_t)b * 256 + key) * 1024 + h * 128 + half * 64;
      v4u x[8]; float s = 0.f;
#pragma unroll
      for (int i = 0; i < 8; ++i) { x[i] = *(const GAS v4u*)(p + 8 * i);
          s += (bflo(x[i].x) * bflo(x[i].x) + bfhi(x[i].x) * bfhi(x[i].x)) + (bflo(x[i].y) * bflo(x[i].y) + bfhi(x[i].y) * bfhi(x[i].y)) + (bflo(x[i].z) * bflo(x[i].z) + bfhi(x[i].z) * bfhi(x[i].z)) + (bflo(x[i].w) * bflo(x[i].w) + bfhi(x[i].w) * bfhi(x[i].w)); }
      s += __shfl_xor(s, 1);
      const float rs = 1.0f / sqrtf(s * (1.f / 128.f) + EPS);
#pragma unroll
      for (int i = 0; i < 8; ++i) { const f32x4 g0 = *(const GAS f32x4*)(kg + half * 64 + 8 * i), g1 = *(const GAS f32x4*)(kg + half * 64 + 8 * i + 4);
          v4u o; o.x = pk2s(bflo(x[i].x) * rs * g0.x, bfhi(x[i].x) * rs * g0.y); o.y = pk2s(bflo(x[i].y) * rs * g0.z, bfhi(x[i].y) * rs * g0.w);
          o.z = pk2s(bflo(x[i].z) * rs * g1.x, bfhi(x[i].z) * rs * g1.y); o.w = pk2s(bflo(x[i].w) * rs * g1.z, bfhi(x[i].w) * rs * g1.w);
          *(LAS v4u*)(KVs + key * 272 + half * 128 + i * 16) = o; } }
    __syncthreads();
    f32x4 sacc[16];
#pragma unroll
    for (int j = 0; j < 16; ++j) sacc[j] = (f32x4){0.f, 0.f, 0.f, 0.f};
    wave_mma<16, 4>(sacc, Qs, 272, 16 * w, KVs, 272, 0, lane);
    float rsum[4];
#pragma unroll
    for (int rg = 0; rg < 4; ++rg) { float mx = sacc[0][rg];
#pragma unroll
        for (int j = 1; j < 16; ++j) mx = fmaxf(mx, sacc[j][rg]);
        mx = fmaxf(mx, __shfl_xor(mx, 1)); mx = fmaxf(mx, __shfl_xor(mx, 2)); mx = fmaxf(mx, __shfl_xor(mx, 4)); mx = fmaxf(mx, __shfl_xor(mx, 8));
        float sm = 0.f;
#pragma unroll
        for (int j = 0; j < 16; ++j) { const float p = __expf(sacc[j][rg] - mx); sacc[j][rg] = p; sm += p; }
        sm += __shfl_xor(sm, 1); sm += __shfl_xor(sm, 2); sm += __shfl_xor(sm, 4); sm += __shfl_xor(sm, 8);
        rsum[rg] = 1.0f / sm; }
    __syncthreads();
#pragma unroll
    for (int i = 0; i < 8; ++i) { const int p = tid + 512 * i, key = p >> 4, c = p & 15;
        const v4u v = *(const GAS v4u*)(KV + ((size_t)b * 256 + key) * 1024 + 512 + h * 128 + c * 8); *(LAS v4u*)(KVs + key * 272 + c * 16) = v; }
    __syncthreads();
    f32x4 oacc[8];
#pragma unroll
    for (int j = 0; j < 8; ++j) oacc[j] = (f32x4){0.f, 0.f, 0.f, 0.f};
#pragma unroll
    for (int kc = 0; kc < 4; ++kc) {
        LDS_WAIT();
#pragma unroll
        for (int jj = 0; jj < 4; ++jj)
#pragma unroll
            for (int rg = 0; rg < 4; ++rg) *(LAS unsigned short*)(Pw + (4 * (lane >> 4) + rg) * 144 + (16 * jj + (lane & 15)) * 2) = (unsigned short)f2bf(sacc[4 * kc + jj][rg]);
        LDS_WAIT();
        wave_mma_kn<8, 2>(oacc, Pw, 144, 0, KVs, 272, 0, lane, 0, 64 * kc);
    }
    LDS_WAIT();
#pragma unroll
    for (int j = 0; j < 8; ++j)
#pragma unroll
        for (int rg = 0; rg < 4; ++rg) *(LAS unsigned short*)(Qs + (16 * w + 4 * (lane >> 4) + rg) * 272 + (16 * j + (lane & 15)) * 2) = (unsigned short)f2bf(oacc[j][rg] * rsum[rg]);
    LDS_WAIT();
#pragma unroll
    for (int i = 0; i < 4; ++i) { const int p = lane + 64 * i, rr = 16 * w + (p >> 4), c = p & 15;
        const v4u v = *(const LAS v4u*)(Qs + rr * 272 + c * 16); *(GAS v4u*)(outp + ((row0 + rr) & rmask) * 512 + h * 128 + c * 8) = v; }
}

struct MlstmRaw { v4u xq[8], xk[8], vv[2], ct[4], mo[2]; float g0, g1, mc; };
__device__ __forceinline__ void mlstm_out_load(Frame& F, int item, MlstmRaw& R) {
    const int bh = item >> 7, c = item & 127, b = bh >> 2, h = bh & 3;
    const int tid = F.tid, lane = F.lane, w = F.wave;
    const float* IGLF = (const float*)(F.ws + WS_IGLF);
    const bf16* MLQ = (const bf16*)(F.ws + WS_MLQ); const bf16* MLK = (const bf16*)(F.ws + WS_MLK); const bf16* MLV = (const bf16*)(F.ws + WS_MLV); const bf16* MLO = (const bf16*)(F.ws + WS_MLO);
    const bf16* CT = (const bf16*)(F.ws + WS_CT) + (size_t)item * 16384;
    const int t0 = c * 64; const size_t row0 = (size_t)b * SEQ + t0;
    const int s = tid >> 3, part = tid & 7;
#pragma unroll
    for (int kk = 0; kk < 4; ++kk) { const int tt = t0 + s - 3 + kk;
        if (tt >= 0) { const size_t off = ((size_t)b * SEQ + tt) * 512 + h * 128 + part * 16;
            R.xq[2 * kk] = *(const GAS v4u*)(MLQ + off); R.xq[2 * kk + 1] = *(const GAS v4u*)(MLQ + off + 8); R.xk[2 * kk] = *(const GAS v4u*)(MLK + off); R.xk[2 * kk + 1] = *(const GAS v4u*)(MLK + off + 8); }
        else { R.xq[2 * kk] = (v4u){0u, 0u, 0u, 0u}; R.xq[2 * kk + 1] = (v4u){0u, 0u, 0u, 0u}; R.xk[2 * kk] = (v4u){0u, 0u, 0u, 0u}; R.xk[2 * kk + 1] = (v4u){0u, 0u, 0u, 0u}; } }
    { const bf16* vp = MLV + (row0 + s) * 512 + h * 128 + part * 16; R.vv[0] = *(const GAS v4u*)vp; R.vv[1] = *(const GAS v4u*)(vp + 8);
      const bf16* op = MLO + (row0 + s) * 512 + h * 128 + part * 16; R.mo[0] = *(const GAS v4u*)op; R.mo[1] = *(const GAS v4u*)(op + 8); }
#pragma unroll
    for (int i = 0; i < 4; ++i) { const int p = tid + 512 * i, rr = p >> 4, cc = p & 15; R.ct[i] = *(const GAS v4u*)(CT + rr * 128 + cc * 8); }
    R.g0 = 0.f; R.g1 = 0.f;
    if (w == 0) { R.g0 = IGLF[(row0 + lane) * 8 + 4 + h]; R.g1 = IGLF[(row0 + lane) * 8 + h]; }
    else if (w == 1 || w == 2) R.g0 = ((const float*)(F.ws + WS_NS))[(size_t)item * 128 + tid - 64];
    R.mc = ((const float*)(F.ws + WS_CTL + CTL_MS))[item];
}
__device__ __forceinline__ void mlstm_out_item(Frame& F, int item, int next, MlstmRaw& R, bf16* outp, size_t rmask) {
    const int bh = item >> 7, c = item & 127, b = bh >> 2, h = bh & 3;
    const int tid = F.tid, lane = F.lane, w = F.wave;
    LAS unsigned char* Qs = F.lds;
    LAS unsigned char* Ks = F.lds + 17408;
    LAS unsigned char* Vs = F.lds + 34816;
    LAS unsigned char* CTs = F.lds + 53248;
    LAS unsigned char* Ss = F.lds + 88064;
    LAS unsigned char* Ws = F.lds + 105472;
    LAS float* bcum = (LAS float*)(F.lds + 114688);
    LAS float* igs = bcum + 64;
    LAS float* nsv = bcum + 128;
    LAS float* rden = bcum + 256;
    const float mc = R.mc;
    const int t0 = c * 64; const size_t row0 = (size_t)b * SEQ + t0;
    const v4u mo0 = R.mo[0], mo1 = R.mo[1];
    __syncthreads();
    if (w == 0) {
        float bs = R.g0;
#pragma unroll
        for (int o = 1; o < 64; o <<= 1) { const float v = __shfl_up(bs, o); if (lane >= o) bs += v; }
        bcum[lane] = bs; igs[lane] = R.g1;
    } else if (w == 1 || w == 2) nsv[tid - 64] = R.g0;
    { const int s = tid >> 3, part = tid & 7; float y[16];
      conv16_regs(R.xq, (const LAS float*)(F.lds + CONVW_OFF), part * 16, y);
      v4u q0, q1; q0.x = pk2(y[0], y[1]); q0.y = pk2(y[2], y[3]); q0.z = pk2(y[4], y[5]); q0.w = pk2(y[6], y[7]); q1.x = pk2(y[8], y[9]); q1.y = pk2(y[10], y[11]); q1.z = pk2(y[12], y[13]); q1.w = pk2(y[14], y[15]);
      *(LAS v4u*)(Qs + s * 272 + part * 32) = q0; *(LAS v4u*)(Qs + s * 272 + part * 32 + 16) = q1;
      conv16_regs(R.xk, (const LAS float*)(F.lds + CONVW_OFF + CONVW_SET), part * 16, y);
      const float sc = 0.08838834764831845f;
      q0.x = pk2(y[0] * sc, y[1] * sc); q0.y = pk2(y[2] * sc, y[3] * sc); q0.z = pk2(y[4] * sc, y[5] * sc); q0.w = pk2(y[6] * sc, y[7] * sc);
      q1.x = pk2(y[8] * sc, y[9] * sc); q1.y = pk2(y[10] * sc, y[11] * sc); q1.z = pk2(y[12] * sc, y[13] * sc); q1.w = pk2(y[14] * sc, y[15] * sc);
      *(LAS v4u*)(Ks + s * 272 + part * 32) = q0; *(LAS v4u*)(Ks + s * 272 + part * 32 + 16) = q1;
      *(LAS v4u*)(Vs + s * 272 + part * 32) = R.vv[0]; *(LAS v4u*)(Vs + s * 272 + part * 32 + 16) = R.vv[1]; }
#pragma unroll
    for (int i = 0; i < 4; ++i) { const int p = tid + 512 * i, rr = p >> 4, cc = p & 15; *(LAS v4u*)(CTs + rr * 272 + cc * 16) = R.ct[i]; }
    if (next >= 0) mlstm_out_load(F, next, R);
    __syncthreads();
    { f32x4 sacc[2];
      sacc[0] = (f32x4){0.f, 0.f, 0.f, 0.f}; sacc[1] = (f32x4){0.f, 0.f, 0.f, 0.f};
      wave_mma<2, 4>(sacc, Qs, 272, 16 * (w >> 1), Ks, 272, 32 * (w & 1), lane);
#pragma unroll
      for (int j = 0; j < 2; ++j)
#pragma unroll
          for (int rg = 0; rg < 4; ++rg) *(LAS float*)(Ss + (16 * (w >> 1) + 4 * (lane >> 4) + rg) * 272 + (32 * (w & 1) + 16 * j + (lane & 15)) * 4) = sacc[j][rg]; }
    __syncthreads();
    { const int t = tid >> 3, seg = tid & 7;
      const float bt = bcum[t];
      const f32x4 s0 = *(const LAS f32x4*)(Ss + t * 272 + seg * 32), s1 = *(const LAS f32x4*)(Ss + t * 272 + seg * 32 + 16);
      const float sv[8] = {s0.x, s0.y, s0.z, s0.w, s1.x, s1.y, s1.z, s1.w};
      float dm[8]; float mx = -3.0e38f;
#pragma unroll
      for (int i = 0; i < 8; ++i) { const int s = seg * 8 + i; dm[i] = bt - bcum[s] + igs[s]; if (s <= t) mx = fmaxf(mx, dm[i]); }
      mx = fmaxf(mx, __shfl_xor(mx, 1)); mx = fmaxf(mx, __shfl_xor(mx, 2)); mx = fmaxf(mx, __shfl_xor(mx, 4));
      const float minter = bt + mc; const float mt = fmaxf(minter, mx);
      float wv[8]; float den = 0.f;
#pragma unroll
      for (int i = 0; i < 8; ++i) { const int s = seg * 8 + i; wv[i] = (s <= t) ? sv[i] * __expf(dm[i] - mt) : 0.f; den += wv[i]; }
      *(LAS v4u*)(Ws + t * 144 + seg * 16) = (v4u){pk2(wv[0], wv[1]), pk2(wv[2], wv[3]), pk2(wv[4], wv[5]), pk2(wv[6], wv[7])};
      const float inter = __expf(minter - mt);
      v4u qa = *(const LAS v4u*)(Qs + t * 272 + seg * 32), qb2 = *(const LAS v4u*)(Qs + t * 272 + seg * 32 + 16);
      const float qf[16] = {bflo(qa.x), bfhi(qa.x), bflo(qa.y), bfhi(qa.y), bflo(qa.z), bfhi(qa.z), bflo(qa.w), bfhi(qa.w), bflo(qb2.x), bfhi(qb2.x), bflo(qb2.y), bfhi(qb2.y), bflo(qb2.z), bfhi(qb2.z), bflo(qb2.w), bfhi(qb2.w)};
      float qn = 0.f;
#pragma unroll
      for (int i = 0; i < 16; ++i) qn += qf[i] * nsv[seg * 16 + i];
      den += inter * qn;
      den += __shfl_xor(den, 1); den += __shfl_xor(den, 2); den += __shfl_xor(den, 4);
      qa.x = pk2(qf[0] * inter, qf[1] * inter); qa.y = pk2(qf[2] * inter, qf[3] * inter); qa.z = pk2(qf[4] * inter, qf[5] * inter); qa.w = pk2(qf[6] * inter, qf[7] * inter);
      qb2.x = pk2(qf[8] * inter, qf[9] * inter); qb2.y = pk2(qf[10] * inter, qf[11] * inter); qb2.z = pk2(qf[12] * inter, qf[13] * inter); qb2.w = pk2(qf[14] * inter, qf[15] * inter);
      *(LAS v4u*)(Qs + t * 272 + seg * 32) = qa; *(LAS v4u*)(Qs + t * 272 + seg * 32 + 16) = qb2;
      if (seg == 0) rden[t] = 1.0f / fmaxf(fabsf(den), __expf(-mt)); }
    __syncthreads();
    f32x4 acc[4];
#pragma unroll
    for (int j = 0; j < 4; ++j) acc[j] = (f32x4){0.f, 0.f, 0.f, 0.f};
    wave_mma_kn<4, 2>(acc, Ws, 144, 16 * (w >> 1), Vs, 272, 64 * (w & 1), lane);
    wave_mma<4, 4>(acc, Qs, 272, 16 * (w >> 1), CTs, 272, 64 * (w & 1), lane);
    __syncthreads();
    LAS unsigned char* Hs = CTs;
#pragma unroll
    for (int j = 0; j < 4; ++j)
#pragma unroll
        for (int rg = 0; rg < 4; ++rg) { const int row = 16 * (w >> 1) + 4 * (lane >> 4) + rg; *(LAS float*)(Hs + row * 528 + (64 * (w & 1) + 16 * j + (lane & 15)) * 4) = acc[j][rg] * rden[row]; }
    __syncthreads();
    { const int t = tid >> 3, seg = tid & 7; float hv[16]; float ss = 0.f;
#pragma unroll
      for (int i4 = 0; i4 < 4; ++i4) { const f32x4 v = *(const LAS f32x4*)(Hs + t * 528 + seg * 64 + i4 * 16); hv[4 * i4] = v.x; hv[4 * i4 + 1] = v.y; hv[4 * i4 + 2] = v.z; hv[4 * i4 + 3] = v.w; ss += (v.x * v.x + v.y * v.y) + (v.z * v.z + v.w * v.w); }
      ss += __shfl_xor(ss, 1); ss += __shfl_xor(ss, 2); ss += __shfl_xor(ss, 4);
      const float rs = 1.0f / sqrtf(ss * (1.f / 128.f) + EPS);
      const float* mg = F.in[8] + seg * 16;
      const float og[16] = {bflo(mo0.x), bfhi(mo0.x), bflo(mo0.y), bfhi(mo0.y), bflo(mo0.z), bfhi(mo0.z), bflo(mo0.w), bfhi(mo0.w), bflo(mo1.x), bfhi(mo1.x), bflo(mo1.y), bfhi(mo1.y), bflo(mo1.z), bfhi(mo1.z), bflo(mo1.w), bfhi(mo1.w)};
      float yv[16];
#pragma unroll
      for (int i = 0; i < 16; ++i) yv[i] = hv[i] * rs * mg[i] * og[i];
      v4u y0, y1; y0.x = pk2(yv[0], yv[1]); y0.y = pk2(yv[2], yv[3]); y0.z = pk2(yv[4], yv[5]); y0.w = pk2(yv[6], yv[7]); y1.x = pk2(yv[8], yv[9]); y1.y = pk2(yv[10], yv[11]); y1.z = pk2(yv[12], yv[13]); y1.w = pk2(yv[14], yv[15]);
      bf16* yp = outp + ((row0 + t) & rmask) * 512 + h * 128 + seg * 16; *(GAS v4u*)yp = y0; *(GAS v4u*)(yp + 8) = y1; }
}

#define PEER_INS(L, v) do { L[15] = __builtin_amdgcn_fmed3f(L[14], L[15], v); L[14] = __builtin_amdgcn_fmed3f(L[13], L[14], v); L[13] = __builtin_amdgcn_fmed3f(L[12], L[13], v); \
    L[12] = __builtin_amdgcn_fmed3f(L[11], L[12], v); L[11] = __builtin_amdgcn_fmed3f(L[10], L[11], v); L[10] = __builtin_amdgcn_fmed3f(L[9], L[10], v); L[9] = __builtin_amdgcn_fmed3f(L[8], L[9], v); \
    L[8] = __builtin_amdgcn_fmed3f(L[7], L[8], v); L[7] = __builtin_amdgcn_fmed3f(L[6], L[7], v); L[6] = __builtin_amdgcn_fmed3f(L[5], L[6], v); L[5] = __builtin_amdgcn_fmed3f(L[4], L[5], v); \
    L[4] = __builtin_amdgcn_fmed3f(L[3], L[4], v); L[3] = __builtin_amdgcn_fmed3f(L[2], L[3], v); L[2] = __builtin_amdgcn_fmed3f(L[1], L[2], v); L[1] = __builtin_amdgcn_fmed3f(L[0], L[1], v); L[0] = fmaxf(L[0], v); } while (0)

__device__ __forceinline__ void sort16_desc(float (&a)[16]) {
#pragma unroll
    for (int k = 2; k <= 16; k <<= 1)
#pragma unroll
        for (int j = k >> 1; j > 0; j >>= 1)
#pragma unroll
            for (int i = 0; i < 16; ++i) { const int l = i ^ j;
                if (l > i) { const float x = a[i], y = a[l]; const bool desc = (i & k) == 0;
                    a[i] = desc ? fmaxf(x, y) : fminf(x, y); a[l] = desc ? fminf(x, y) : fmaxf(x, y); } }
}
__device__ __forceinline__ void merge16_desc(float (&L)[16], const float (&Brev)[16]) {
#pragma unroll
    for (int i = 0; i < 16; ++i) L[i] = fmaxf(L[i], Brev[i]);
#pragma unroll
    for (int j = 8; j > 0; j >>= 1)
#pragma unroll
        for (int i = 0; i < 16; ++i) { const int l = i ^ j; if (l > i) { const float x = L[i], y = L[l]; L[i] = fmaxf(x, y); L[l] = fminf(x, y); } }
}
constexpr int PEER_IDX_OFF = 0, PEER_GW_OFF = 33024, PEER_LST_OFF = 69632;
__device__ __forceinline__ void peer_route_tile(Frame& F, int tile) {
    const int tid = F.tid, lane = F.lane, w = F.wave;
    LAS unsigned char* K1s = F.lds;
    LAS float* LST = (LAS float*)(F.lds + PEER_LST_OFF);
    const bf16* QRY = (const bf16*)(F.ws + WS_QRY); const bf16* PK = (const bf16*)(F.ws + WS_PK);
    const size_t row0 = (size_t)tile * 64;
    const int mt = w & 3, half = w >> 2;
    v4u kreg[8]; bf16x8 qf[4];
    const bf16* qp0 = QRY + (row0 + 16 * mt + (lane & 15)) * 2048 + half * 128 + (lane >> 4) * 8;
#pragma unroll
    for (int i = 0; i < 8; ++i) { const int p = tid + 512 * i, kr = p >> 4, c = p & 15, hf = kr >> 7, key = kr & 127; kreg[i] = *(const GAS v4u*)(PK + ((size_t)(hf * 8 + 0) * 128 + key) * 128 + c * 8); }
#pragma unroll
    for (int ks = 0; ks < 4; ++ks) qf[ks] = *(const GAS bf16x8*)(qp0 + ks * 32);
    for (int h = 0; h < 8; ++h) {
        __syncthreads();
#pragma unroll
        for (int i = 0; i < 8; ++i) { const int p = tid + 512 * i, kr = p >> 4, c = p & 15; *(LAS v4u*)(K1s + kr * 272 + c * 16) = kreg[i]; }
        if (h < 7) {
#pragma unroll
            for (int i = 0; i < 8; ++i) { const int p = tid + 512 * i, kr = p >> 4, c = p & 15, hf = kr >> 7, key = kr & 127; kreg[i] = *(const GAS v4u*)(PK + ((size_t)(hf * 8 + h + 1) * 128 + key) * 128 + c * 8); } }
        __syncthreads();
        f32x4 acc[8];
#pragma unroll
        for (int j = 0; j < 8; ++j) acc[j] = (f32x4){0.f, 0.f, 0.f, 0.f};
#pragma unroll
        for (int ks = 0; ks < 4; ++ks) {
#pragma unroll
            for (int j = 0; j < 8; ++j) { const bf16x8 kf = *(const LAS bf16x8*)(K1s + (half * 128 + 16 * j + (lane & 15)) * 272 + (ks * 32 + (lane >> 4) * 8) * 2);
                acc[j] = __builtin_amdgcn_mfma_f32_16x16x32_bf16(kf, qf[ks], acc[j], 0, 0, 0); } }
        if (h < 7) {
#pragma unroll
            for (int ks = 0; ks < 4; ++ks) qf[ks] = *(const GAS bf16x8*)(qp0 + (h + 1) * 256 + ks * 32); }
        float L[16], L2[16];
#pragma unroll
        for (int j = 0; j < 4; ++j)
#pragma unroll
            for (int rg = 0; rg < 4; ++rg) { L[4 * j + rg] = __uint_as_float((__float_as_uint(acc[j][rg]) & 0xFFFFFF80u) | (unsigned)(16 * j + 4 * (lane >> 4) + rg));
                L2[15 - (4 * j + rg)] = __uint_as_float((__float_as_uint(acc[4 + j][rg]) & 0xFFFFFF80u) | (unsigned)(16 * (4 + j) + 4 * (lane >> 4) + rg)); }
        sort16_desc(L);
        { float T2[16];
#pragma unroll
          for (int i = 0; i < 16; ++i) T2[i] = L2[15 - i];
          sort16_desc(T2);
#pragma unroll
          for (int i = 0; i < 16; ++i) L2[i] = T2[15 - i]; }
        merge16_desc(L, L2);
#pragma unroll
        for (int step = 16; step <= 32; step <<= 1) { float P[16];
#pragma unroll
            for (int i = 0; i < 16; ++i) P[i] = __shfl_xor(L[15 - i], step);
            merge16_desc(L, P); }
        if (lane < 16) {
#pragma unroll
            for (int i = 0; i < 16; ++i) LST[((h * 2 + half) * 16 + i) * 64 + 16 * mt + lane] = L[i]; }
    }
    __syncthreads();
    {
        const int h = w;
        float A1[16], A2[16];
#pragma unroll
        for (int i = 0; i < 16; ++i) { A1[i] = LST[((h * 2) * 16 + i) * 64 + lane]; A2[i] = LST[((h * 2 + 1) * 16 + i) * 64 + lane]; }
        float Tt[16];
#pragma unroll
        for (int i = 0; i < 16; ++i) Tt[i] = -3.0e38f;
#pragma unroll
        for (int i = 0; i < 16; ++i)
#pragma unroll
            for (int j = 0; j < 16; ++j) if ((i + 1) * (j + 1) <= 16) { const float cv = __uint_as_float((__float_as_uint(A1[i] + A2[j]) & 0xFFFFFF00u) | (unsigned)(i * 16 + j)); PEER_INS(Tt, cv); }
        float ex[16]; float sm = 0.f;
#pragma unroll
        for (int i = 0; i < 16; ++i) { ex[i] = __expf(Tt[i] - Tt[0]); sm += ex[i]; }
        const float inv = 1.0f / sm;
        unsigned short* ip = (unsigned short*)(F.ws + WS_IDX) + (row0 + lane) * 128 + h * 16; bf16* gp = (bf16*)(F.ws + WS_GW) + (row0 + lane) * 128 + h * 16;
        unsigned ew[8], gwp[8];
#pragma unroll
        for (int i2 = 0; i2 < 8; ++i2) { unsigned ev[2]; float gv[2];
#pragma unroll
            for (int e = 0; e < 2; ++e) { const int i = 2 * i2 + e; const unsigned code = __float_as_uint(Tt[i]) & 0xFFu; const unsigned i1 = code >> 4, i2b = code & 15u;
                const unsigned e1 = __float_as_uint(LST[((h * 2) * 16 + i1) * 64 + lane]) & 0x7Fu, e2 = __float_as_uint(LST[((h * 2 + 1) * 16 + i2b) * 64 + lane]) & 0x7Fu;
                ev[e] = e1 * 128u + e2; gv[e] = ex[i] * inv; }
            ew[i2] = ev[0] | (ev[1] << 16); gwp[i2] = pk2(gv[0], gv[1]); }
        *(GAS v4u*)ip = (v4u){ew[0], ew[1], ew[2], ew[3]}; *(GAS v4u*)(ip + 8) = (v4u){ew[4], ew[5], ew[6], ew[7]};
        *(GAS v4u*)gp = (v4u){gwp[0], gwp[1], gwp[2], gwp[3]}; *(GAS v4u*)(gp + 8) = (v4u){gwp[4], gwp[5], gwp[6], gwp[7]};
    }
}

typedef float f32x2 __attribute__((ext_vector_type(2)));
#define PEER_LOAD_IDX8(ee, s_) do { const size_t b_ = (size_t)TOK((s_) >> 1) * 64 + 32 * ((s_) & 1) + eg; _Pragma("unroll") for (int i_ = 0; i_ < 4; ++i_) { const unsigned w_ = IDX[b_ + 8 * i_]; ee[2 * i_] = (int)(w_ & 0xffffu); ee[2 * i_ + 1] = (int)(w_ >> 16); } } while (0)
#define PEER_LOAD_W8(ww, s_) do { const size_t b_ = (size_t)TOK((s_) >> 1) * 64 + 32 * ((s_) & 1) + eg; _Pragma("unroll") for (int i_ = 0; i_ < 4; ++i_) { const unsigned w_ = GW[b_ + 8 * i_]; ww[2 * i_] = bflo(w_); ww[2 * i_ + 1] = bfhi(w_); } } while (0)
#define PEER_GATHER8(rr, tab, ee) do { _Pragma("unroll") for (int i_ = 0; i_ < 8; ++i_) rr[i_] = *(const GAS v4u*)((tab) + (size_t)ee[i_] * 128); } while (0)
template <bool DRY>
__device__ __forceinline__ void peer_u_half(const v4u (&ur)[8], const int (&xq)[4], float inv_sx, float* pd) {
    if (DRY) {
#pragma unroll
        for (int i = 0; i < 8; ++i) pd[i] = __uint_as_float((ur[i].x ^ ur[i].y ^ ur[i].z ^ ur[i].w) & 0x3fffffffu) + inv_sx;
        return; }
#pragma unroll
    for (int i = 0; i < 8; ++i) { int a = __builtin_amdgcn_sdot4((int)ur[i].x, xq[0], 0, false); a = __builtin_amdgcn_sdot4((int)ur[i].y, xq[1], a, false);
        a = __builtin_amdgcn_sdot4((int)ur[i].z, xq[2], a, false); a = __builtin_amdgcn_sdot4((int)ur[i].w, xq[3], a, false); pd[i] = (float)a * inv_sx; }
}
template <bool DRY>
__device__ __forceinline__ void peer_u_sweep(Frame& F) {
    const int lane = F.lane, eg = lane >> 3, c = lane & 7;
    const int x = blockIdx.x & 7, rb = blockIdx.x >> 3, nrb = F.G >> 3, tper = T_TOK / nrb;
    const bf16* H1B = (const bf16*)(F.ws + WS_H1B) + 128 * x + 16 * c; const unsigned char* UT8 = F.ws + WS_UT8 + (size_t)x * (16384 * 128) + 16 * c;
    const unsigned* IDX = (const unsigned*)(F.ws + WS_IDX); unsigned* PD = DRY ? (unsigned*)(F.ws + WS_END) + 8 * c + eg : (unsigned*)(F.ws + WS_PD) + (size_t)x * T_TOK * 64 + 8 * c + eg;
    const float* SUMSQ = (const float*)(F.ws + WS_CTL + CTL_SUMSQ); const float* gf = F.in[18] + 128 * x + 16 * c;
    const f32x4 g0 = *(const GAS f32x4*)(gf), g1 = *(const GAS f32x4*)(gf + 4), g2 = *(const GAS f32x4*)(gf + 8), g3 = *(const GAS f32x4*)(gf + 12);
    const int n = tper / NWAVES, t0 = rb * tper + F.wave;
#define TOK(k) (t0 + NWAVES * ((k) < n ? (k) : n - 1))
    int ee[8]; v4u urA[8], urB[8]; v4u h0, h1; float ssq;
    PEER_LOAD_IDX8(ee, 0); h0 = *(const GAS v4u*)(H1B + (size_t)TOK(0) * 1024); h1 = *(const GAS v4u*)(H1B + (size_t)TOK(0) * 1024 + 8); ssq = SUMSQ[TOK(0)];
    PEER_GATHER8(urA, UT8, ee);
    PEER_LOAD_IDX8(ee, 1);
    for (int k = 0; k < n; ++k) {
        PEER_GATHER8(urB, UT8, ee);
        PEER_LOAD_IDX8(ee, 2 * k + 2);
        const float rs = 1.0f / sqrtf(ssq * (1.f / 1024.f) + EPS);
        float xf[16];
        xf[0] = bflo(h0.x) * rs * g0.x; xf[1] = bfhi(h0.x) * rs * g0.y; xf[2] = bflo(h0.y) * rs * g0.z; xf[3] = bfhi(h0.y) * rs * g0.w;
        xf[4] = bflo(h0.z) * rs * g1.x; xf[5] = bfhi(h0.z) * rs * g1.y; xf[6] = bflo(h0.w) * rs * g1.z; xf[7] = bfhi(h0.w) * rs * g1.w;
        xf[8] = bflo(h1.x) * rs * g2.x; xf[9] = bfhi(h1.x) * rs * g2.y; xf[10] = bflo(h1.y) * rs * g2.z; xf[11] = bfhi(h1.y) * rs * g2.w;
        xf[12] = bflo(h1.z) * rs * g3.x; xf[13] = bfhi(h1.z) * rs * g3.y; xf[14] = bflo(h1.w) * rs * g3.z; xf[15] = bfhi(h1.w) * rs * g3.w;
        float am = 1e-20f;
#pragma unroll
        for (int i = 0; i < 16; ++i) am = fmaxf(am, fabsf(xf[i]));
        am = fmaxf(am, __shfl_xor(am, 1)); am = fmaxf(am, __shfl_xor(am, 2)); am = fmaxf(am, __shfl_xor(am, 4));
        const float sx = 127.0f / am, inv_sx = am * (1.0f / 127.0f);
        int xq[4];
#pragma unroll
        for (int q = 0; q < 4; ++q) { const int b0 = __float2int_rn(xf[4 * q] * sx), b1 = __float2int_rn(xf[4 * q + 1] * sx), b2 = __float2int_rn(xf[4 * q + 2] * sx), b3 = __float2int_rn(xf[4 * q + 3] * sx);
            xq[q] = (b0 & 0xff) | ((b1 & 0xff) << 8) | ((b2 & 0xff) << 16) | (b3 << 24); }
        h0 = *(const GAS v4u*)(H1B + (size_t)TOK(k + 1) * 1024); h1 = *(const GAS v4u*)(H1B + (size_t)TOK(k + 1) * 1024 + 8); ssq = SUMSQ[TOK(k + 1)];
        float pd[16];
        peer_u_half<DRY>(urA, xq, inv_sx, pd);
        PEER_GATHER8(urA, UT8, ee);
        PEER_LOAD_IDX8(ee, 2 * k + 3);
        peer_u_half<DRY>(urB, xq, inv_sx, pd + 8);
#pragma unroll
        for (int i = 0; i < 8; ++i) { const bool up = (c & 4) != 0; const float send = up ? pd[i] : pd[i + 8]; const float keep = up ? pd[i + 8] : pd[i]; pd[i] = keep + __shfl_xor(send, 4); }
#pragma unroll
        for (int i = 0; i < 4; ++i) { const bool up = (c & 2) != 0; const float send = up ? pd[i] : pd[i + 4]; const float keep = up ? pd[i + 4] : pd[i]; pd[i] = keep + __shfl_xor(send, 2); }
#pragma unroll
        for (int i = 0; i < 2; ++i) { const bool up = (c & 1) != 0; const float send = up ? pd[i] : pd[i + 2]; const float keep = up ? pd[i + 2] : pd[i]; pd[i] = keep + __shfl_xor(send, 1); }
        __hip_atomic_store(PD + (size_t)(DRY ? (TOK(k) & 63) : TOK(k)) * 64, pk2(pd[0], pd[1]), __ATOMIC_RELAXED, __HIP_MEMORY_SCOPE_AGENT);
    }
}
__device__ __forceinline__ void peer_combine_group(Frame& F, int tok0, int ntok) {
    const unsigned* IDX = (const unsigned*)(F.ws + WS_IDX); unsigned* GW = (unsigned*)(F.ws + WS_GW); const unsigned* PD = (const unsigned*)(F.ws + WS_PD);
    const float* USC = (const float*)(F.ws + WS_USC); const float* VSC = (const float*)(F.ws + WS_VSC);
    for (int i = F.tid; i < ntok * 64; i += 2 * NWAVES * 64) {
        float d0[2], d1[2]; unsigned gwv[2], ev[2];
#pragma unroll
        for (int u = 0; u < 2; ++u) { const size_t g = (size_t)tok0 * 64 + i + u * NWAVES * 64; ev[u] = IDX[g]; gwv[u] = GW[g]; float a0 = 0.f, a1 = 0.f;
#pragma unroll
            for (int xx = 0; xx < 8; ++xx) { const unsigned p = PD[(size_t)xx * T_TOK * 64 + g]; a0 += bflo(p); a1 += bfhi(p); }
            d0[u] = a0; d1[u] = a1; }
#pragma unroll
        for (int u = 0; u < 2; ++u) { const size_t g = (size_t)tok0 * 64 + i + u * NWAVES * 64; const unsigned e0 = ev[u] & 0xffffu, e1 = ev[u] >> 16;
            const float t0 = d0[u] * USC[e0], t1 = d1[u] * USC[e1];
            const float w0 = bflo(gwv[u]) * VSC[e0] * 0.5f * t0 * (1.0f + erff(t0 * 0.70710678118654752f)), w1 = bfhi(gwv[u]) * VSC[e1] * 0.5f * t1 * (1.0f + erff(t1 * 0.70710678118654752f));
            __hip_atomic_store(GW + g, pk2(w0, w1), __ATOMIC_RELAXED, __HIP_MEMORY_SCOPE_AGENT); }
    }
}
__device__ __forceinline__ void peer_group_sync(Frame& F, int rb, unsigned target) {
    asm volatile("s_waitcnt vmcnt(0)" ::: "memory");
    __syncthreads();
    if (F.tid == 0) {
        unsigned* cnt = (unsigned*)(F.ws + WS_CTL) + 1280 + 64 * rb;
        (void)__hip_atomic_fetch_add(cnt, 1u, __ATOMIC_RELAXED, __HIP_MEMORY_SCOPE_AGENT);
        unsigned sp = 0;
        while (__hip_atomic_load(cnt, __ATOMIC_RELAXED, __HIP_MEMORY_SCOPE_AGENT) < target) { __builtin_amdgcn_s_sleep(2); if (++sp > (1u << 22)) break; }
        __builtin_amdgcn_fence(__ATOMIC_ACQUIRE, "agent"); asm volatile("s_waitcnt vmcnt(0)" ::: "memory");
    }
    __syncthreads();
}
__device__ __forceinline__ void peer_v_half(const v4u (&vr)[8], const float (&ww)[8], f32x2 (&oa)[8]) {
#pragma unroll
    for (int i = 0; i < 8; ++i) { const f32x2 w2 = (f32x2){ww[i], ww[i]}; const unsigned vw[4] = {vr[i].x, vr[i].y, vr[i].z, vr[i].w};
#pragma unroll
        for (int q = 0; q < 4; ++q) { const f32x2 lo = __builtin_amdgcn_cvt_pk_f32_fp8((int)vw[q], false), hi = __builtin_amdgcn_cvt_pk_f32_fp8((int)vw[q], true);
            oa[2 * q] = __builtin_elementwise_fma(lo, w2, oa[2 * q]); oa[2 * q + 1] = __builtin_elementwise_fma(hi, w2, oa[2 * q + 1]); } }
}
__device__ __forceinline__ void peer_v_sweep(Frame& F) {
    const int lane = F.lane, eg = lane >> 3, c = lane & 7;
    const int x = blockIdx.x & 7, rb = blockIdx.x >> 3, nrb = F.G >> 3, tper = T_TOK / nrb;
    const unsigned char* VT8 = F.ws + WS_VT8 + (size_t)x * (16384 * 128) + 16 * c;
    const unsigned* IDX = (const unsigned*)(F.ws + WS_IDX); const unsigned* GW = (const unsigned*)(F.ws + WS_GW);
    float* outp = F.out + 128 * x + 16 * c + 2 * eg; const bf16* h1p = (const bf16*)(F.ws + WS_H1B) + 128 * x + 16 * c + 2 * eg;
    const int n = tper / NWAVES, t0 = rb * tper + F.wave;
    int ee[8]; float wwA[8], wwB[8]; v4u vrA[8], vrB[8];
    PEER_LOAD_IDX8(ee, 0); PEER_LOAD_W8(wwA, 0);
    PEER_GATHER8(vrA, VT8, ee);
    PEER_LOAD_IDX8(ee, 1); PEER_LOAD_W8(wwB, 1);
    for (int k = 0; k < n; ++k) {
        PEER_GATHER8(vrB, VT8, ee);
        PEER_LOAD_IDX8(ee, 2 * k + 2);
        float* op = outp + (size_t)TOK(k) * 1024;
        const unsigned hin = *(const GAS unsigned*)(h1p + (size_t)TOK(k) * 1024);
        f32x2 oa[8];
#pragma unroll
        for (int q = 0; q < 8; ++q) oa[q] = (f32x2){0.f, 0.f};
        peer_v_half(vrA, wwA, oa);
        PEER_LOAD_W8(wwA, 2 * k + 2);
        PEER_GATHER8(vrA, VT8, ee);
        PEER_LOAD_IDX8(ee, 2 * k + 3);
        peer_v_half(vrB, wwB, oa);
        PEER_LOAD_W8(wwB, 2 * k + 3);
        float pd[16];
#pragma unroll
        for (int q = 0; q < 8; ++q) { pd[2 * q] = oa[q].x; pd[2 * q + 1] = oa[q].y; }
#pragma unroll
        for (int i = 0; i < 8; ++i) { const bool up = (eg & 4) != 0; const float send = up ? pd[i] : pd[i + 8]; const float keep = up ? pd[i + 8] : pd[i]; pd[i] = keep + __shfl_xor(send, 32); }
#pragma unroll
        for (int i = 0; i < 4; ++i) { const bool up = (eg & 2) != 0; const float send = up ? pd[i] : pd[i + 4]; const float keep = up ? pd[i + 4] : pd[i]; pd[i] = keep + __shfl_xor(send, 16); }
#pragma unroll
        for (int i = 0; i < 2; ++i) { const bool up = (eg & 1) != 0; const float send = up ? pd[i] : pd[i + 2]; const float keep = up ? pd[i + 2] : pd[i]; pd[i] = keep + __shfl_xor(send, 8); }
        f32x2 o; o.x = bflo(hin) + pd[0]; o.y = bfhi(hin) + pd[1]; *(GAS f32x2*)op = o;
    }
#undef TOK
}

__device__ __forceinline__ void peer_table_row_i8(const f32x4 (&v)[4], unsigned char* dst, float* sc, int lane) {
    float am = 0.f;
#pragma unroll
    for (int j = 0; j < 4; ++j) am = fmaxf(am, fmaxf(fmaxf(fabsf(v[j].x), fabsf(v[j].y)), fmaxf(fabsf(v[j].z), fabsf(v[j].w))));
    am = fmaxf(wave_max(am), 1e-30f);
    const float s = 127.0f / am;
#pragma unroll
    for (int j = 0; j < 4; ++j) { const int b0 = __float2int_rn(v[j].x * s), b1 = __float2int_rn(v[j].y * s), b2 = __float2int_rn(v[j].z * s), b3 = __float2int_rn(v[j].w * s);
        *(GAS unsigned*)(dst + (size_t)(2 * j + (lane >> 5)) * (16384 * 128) + 4 * (lane & 31)) = (unsigned)((b0 & 0xff) | ((b1 & 0xff) << 8) | ((b2 & 0xff) << 16) | (b3 << 24)); }
    if (lane == 0) *sc = am * (1.0f / 127.0f);
}
__device__ __forceinline__ void peer_table_row_fp8(const f32x4 (&v)[4], unsigned char* dst  , float* sc, int lane) {
    float am = 0.f;
#pragma unroll
    for (int j = 0; j < 4; ++j) am = fmaxf(am, fmaxf(fmaxf(fabsf(v[j].x), fabsf(v[j].y)), fmaxf(fabsf(v[j].z), fabsf(v[j].w))));
    am = fmaxf(wave_max(am), 1e-30f);
    const float s = 224.0f / am;
#pragma unroll
    for (int j = 0; j < 4; ++j) { int p = 0; p = __builtin_amdgcn_cvt_pk_fp8_f32(v[j].x * s, v[j].y * s, p, false); p = __builtin_amdgcn_cvt_pk_fp8_f32(v[j].z * s, v[j].w * s, p, true);
        *(GAS unsigned*)(dst + (size_t)(2 * j + (lane >> 5)) * (16384 * 128) + 4 * (lane & 31)) = (unsigned)p; }
    if (lane == 0) *sc = am * (1.0f / 224.0f);
}

struct Args { const float* in[24]; float* out; unsigned char* ws; int ph_lo, ph_hi, li, pad; };
__global__ void __launch_bounds__(NWAVES * 64, 2) hybrid_fwd(Args args) {
    extern __shared__ __attribute__((aligned(16))) unsigned char lds[];
    Frame F;
    F.lds = (LAS unsigned char*)lds;
    F.MISC = (volatile LAS unsigned*)(F.lds + MISC_OFF);
    F.tid = threadIdx.x; F.lane = F.tid & 63; F.wave = __builtin_amdgcn_readfirstlane(F.tid >> 6);
    F.G = gridDim.x; F.ws = args.ws; F.out = args.out;
#pragma unroll
    for (int i = 0; i < 24; ++i) F.in[i] = args.in[i];
    for (int u = F.tid; u < (LDS_BYTES - LDSCTL_OFF) / 4; u += NWAVES * 64) ((LAS unsigned*)(F.lds + LDSCTL_OFF))[u] = 0u;
    __syncthreads();
    unsigned* ctl = (unsigned*)(F.ws + WS_CTL);
    XcdBarrier bar; bar.bar = ctl + CW_BAR; bar.x = 0; bar.st = nullptr;
    if (N_LAUNCHES != PER_PHASE) bar = xcd_barrier_post(ctl + CW_BAR, F.MISC + 8);
#define REP(k) for (int rep_ = ((PROBE_PH == (k)) ? 0 : 1); rep_ < 2; ++rep_)
#define DUMMY (rep_ == 0)
#define STAMP(k) do { if (PROBE_TS >= 0 && F.tid == 0 && blockIdx.x == PROBE_BX) { const unsigned long long t_ = __builtin_amdgcn_s_memrealtime(); F.MISC[32 + 2 * (k)] = (unsigned)t_; F.MISC[33 + 2 * (k)] = (unsigned)(t_ >> 32); } } while (0)
#define TIC() do { if (PROBE_TS >= 100 && F.tid == 0) { const unsigned long long t_ = __builtin_amdgcn_s_memrealtime(); F.MISC[28] = (unsigned)t_; F.MISC[29] = (unsigned)(t_ >> 32); } } while (0)
#define TOC(j) do { if (PROBE_TS == 100 + (j) && F.tid == 0) { const unsigned long long t_ = __builtin_amdgcn_s_memrealtime(); const unsigned long long a_ = ((unsigned long long)F.MISC[29] << 32) | F.MISC[28]; \
    unsigned long long acc_ = ((unsigned long long)F.MISC[31] << 32) | F.MISC[30]; acc_ += t_ - a_; F.MISC[30] = (unsigned)acc_; F.MISC[31] = (unsigned)(acc_ >> 32); } } while (0)
#define GRID_BAR() do { if (N_LAUNCHES != PER_PHASE) xcd_barrier(bar); } while (0)
    const int lo = args.ph_lo, hi = args.ph_hi;
#define IN(k) (lo <= (k) && (k) < hi)
#define BOTH(k) (IN(k) && IN((k) + 1))
    const int bx = blockIdx.x;

    STAMP(0);
    if (IN(0)) { REP(0) { p0_prologue(F); __syncthreads(); } if (BOTH(0)) GRID_BAR(); STAMP(1); }

    if (IN(1)) {
        pg8::Gemm g{(const bf16*)F.out, (const bf16*)(F.ws + WS_WIN), 1024, 1024, 1024}; pg8::StaticOrder S; S.init(T_TOK, 7168, F.G, bx);
        pg8::EpiProj E{(bf16*)(F.ws + WS_GATES), 512, F.in[16], 512, SPLIT_STRIDE, 12, 22, 24};
        REP(1) pg8::gemm_phase<pg8::EpiProj, pg8::StaticOrder, true, true>(F.lds, g, S, E);
        if (BOTH(1)) GRID_BAR(); STAMP(2);
    }

    if (IN(2)) {
        { pg8::Gemm g{(const bf16*)(F.ws + WS_MEMN), (const bf16*)(F.ws + WS_WKV), 1024, 1024, 1024}; pg8::FewOrder S{4, 8, bx};
          pg8::EpiProj E{(bf16*)(F.ws + WS_KVMEM), 1024, nullptr, 0, 0, 0, 0, 0};
          TIC(); pg8::gemm_phase<pg8::EpiProj, pg8::FewOrder, false, true>(F.lds, g, S, E); TOC(3); }
        for (;;) {
            TIC();
            __syncthreads();
            if (F.tid == 0) F.MISC[16] = __hip_atomic_fetch_add(ctl + 1024, 1u, __ATOMIC_RELAXED, __HIP_MEMORY_SCOPE_AGENT);
            __syncthreads();
            const int it = __builtin_amdgcn_readfirstlane((int)F.MISC[16]);
            TOC(2);
            if (it >= 1024) break;
            TIC();
            sb_attn_item(F, it, (bf16*)(F.ws + WS_SBQ), ~(size_t)0);
            if (PROBE_TS == 100) { __syncthreads(); TOC(0); }
        }
        {
            const int bh = bx >> 5;
            __syncthreads();
            conv_weights_to_lds(F, bh & 3);
            TIC();
            const int it0 = bh * 128 + (bx & 31) * 4;
            MlstmLocalRaw lraw; mlstm_local_load(F, it0, lraw);
            for (int k = 0; k < 4; ++k) mlstm_local_item(F, it0 + k, k < 3 ? it0 + k + 1 : -1, lraw);
            if (PROBE_TS == 101) { __syncthreads(); TOC(1); }
        }
        if (BOTH(2)) GRID_BAR(); STAMP(3);
    }

    if (IN(3)) {
        TIC(); REP(3) mlstm_scan(F); __syncthreads(); TOC(4); TIC();
        REP(13) for (int it = bx; it < 512; it += F.G) mem_attn_item(F, it, DUMMY ? (bf16*)(F.ws + WS_END) : (bf16*)(F.ws + WS_MEMQ), DUMMY ? (size_t)1023 : ~(size_t)0);
        __syncthreads(); TOC(5);
        if (BOTH(3)) GRID_BAR(); STAMP(4);
    }

    if (IN(4)) {
        { const int bh = bx >> 5;
          __syncthreads();
          conv_weights_to_lds(F, bh & 3);
          const int it0 = bh * 128 + (bx & 31) * 4;
          MlstmRaw raw; mlstm_out_load(F, it0, raw);
          for (int k = 0; k < 4; ++k) mlstm_out_item(F, it0 + k, k < 3 ? it0 + k + 1 : -1, raw, (bf16*)(F.ws + WS_MLV), ~(size_t)0); }
        if (BOTH(4)) GRID_BAR(); STAMP(5);
    }

    if (IN(5)) {
        pg8::Gemm g{(const bf16*)(F.ws + WS_SBQ), (const bf16*)(F.ws + WS_WBR), 512, 512, 512};
        pg8::GroupOrder S; S.so.init(T_TOK, 1024, F.G, bx); S.ng = 3; S.a_gstride = 16 * MiB; S.b_gstride = (size_t)1024 * 512 * 2;
        pg8::EpiBranch E{(const bf16*)(F.ws + WS_GATES), SPLIT_STRIDE, (bf16*)(F.ws + WS_MERGED)};
        REP(5) pg8::gemm_phase<pg8::EpiBranch, pg8::GroupOrder, true, true>(F.lds, g, S, E);
        if (BOTH(5)) GRID_BAR(); STAMP(6);
    }

    if (IN(6)) {
        { pg8::Gemm g{(const bf16*)(F.ws + WS_MERGED), (const bf16*)(F.ws + WS_WOUT), 1024, 1024, 1024}; pg8::StaticOrder S; S.init(T_TOK, 1024, F.G, bx);
          REP(6) { pg8::EpiOut E{F.in[0], F.out, (bf16*)(F.ws + WS_H1B), (float*)(F.ws + WS_CTL + (DUMMY ? 768 * 1024 : CTL_SUMSQ))};
          pg8::gemm_phase<pg8::EpiOut, pg8::StaticOrder, false, true>(F.lds, g, S, E); } }
        {
            const int nrow = 2 * 16384, stride = F.G * NWAVES;
            int r = bx * NWAVES + F.wave;
            f32x4 cur[4], nxt[4];
#define TABLE_SRC(r_) (((r_) >= 16384 ? F.in[23] + (size_t)((r_) - 16384) * 1024 : F.in[22] + (size_t)(r_) * 1024) + 4 * F.lane)
            if (r < nrow) {
#pragma unroll
                for (int j = 0; j < 4; ++j) cur[j] = __builtin_nontemporal_load((const GAS f32x4*)(TABLE_SRC(r) + 256 * j)); }
            for (; r < nrow; r += stride) {
                const int rn = (r + stride < nrow) ? r + stride : r;
#pragma unroll
                for (int j = 0; j < 4; ++j) nxt[j] = __builtin_nontemporal_load((const GAS f32x4*)(TABLE_SRC(rn) + 256 * j));
                if (r >= 16384) peer_table_row_fp8(cur, F.ws + WS_VT8 + (size_t)(r - 16384) * 128, (float*)(F.ws + WS_VSC) + (r - 16384), F.lane);
                else peer_table_row_i8(cur, F.ws + WS_UT8 + (size_t)r * 128, (float*)(F.ws + WS_USC) + r, F.lane);
#pragma unroll
                for (int j = 0; j < 4; ++j) cur[j] = nxt[j];
            }
#undef TABLE_SRC
        }
        if (BOTH(6)) GRID_BAR(); STAMP(7);
    }

    if (IN(7)) {
        pg8::Gemm g{(const bf16*)(F.ws + WS_H1B), (const bf16*)(F.ws + WS_WPQ), 1024, 1024, 1024}; pg8::StaticOrder S; S.init(T_TOK, 2048, F.G, bx);
        pg8::EpiQry E{(const float*)(F.ws + WS_CTL + CTL_SUMSQ), (bf16*)(F.ws + WS_QRY), EPS};
        REP(7) pg8::gemm_phase<pg8::EpiQry, pg8::StaticOrder, true, true>(F.lds, g, S, E);
        if (BOTH(7)) GRID_BAR(); STAMP(8);
    }

    if (IN(8)) { for (int tile = bx; tile < 256; tile += F.G) peer_route_tile(F, tile); if (BOTH(8)) GRID_BAR(); STAMP(9); }
    if (IN(9)) {
        if (PROBE_PH == 9) peer_u_sweep<true>(F);
        const int x = bx & 7, rb = bx >> 3, tper = T_TOK / (F.G >> 3);
        peer_u_sweep<false>(F);
        peer_group_sync(F, rb, 8u);
        peer_combine_group(F, rb * tper + x * (tper >> 3), tper >> 3);
        peer_group_sync(F, rb, 16u);
        peer_v_sweep(F);
    }
    if (PROBE_TS >= 0) {
        __syncthreads();
        if (bx == PROBE_BX && F.tid == 0) {
            const unsigned long long tend = __builtin_amdgcn_s_memrealtime();
            const int k0 = (PROBE_TS >= 0 && PROBE_TS < 100) ? PROBE_TS : 0;
            const unsigned long long a = ((unsigned long long)F.MISC[33 + 2 * k0] << 32) | F.MISC[32 + 2 * k0];
            const unsigned long long b = (k0 + 1 < 10) ? (((unsigned long long)F.MISC[35 + 2 * k0] << 32) | F.MISC[34 + 2 * k0]) : tend;
            const unsigned long long racc = ((unsigned long long)F.MISC[31] << 32) | F.MISC[30];
            const unsigned long long until = tend + (unsigned long long)PROBE_MULT * (PROBE_TS >= 100 ? racc : (b - a));
            while (__builtin_amdgcn_s_memrealtime() < until) __builtin_amdgcn_s_sleep(32);
        }
    }
#undef IN
#undef BOTH
#undef GRID_BAR
#undef STAMP
#undef REP
#undef DUMMY
}

extern "C" void kernel_launch(void* const* d_in, const int* in_sizes, int n_in, void* d_out, int out_size, void* d_ws, size_t ws_size, hipStream_t stream) {
    static int grid = 0;
    if (grid == 0) {
        if (n_in != 24 || out_size != T_TOK * DM || ws_size < WS_END) { fprintf(stderr, "kernel_launch: unexpected problem (n_in %d, out %d, ws %zu); nothing launched\n", n_in, out_size, ws_size); grid = -1; return; }
        int dev = 0, cus = 0, per_cu = 0;
        if (hipGetDevice(&dev) != hipSuccess || hipDeviceGetAttribute(&cus, hipDeviceAttributeMultiprocessorCount, dev) != hipSuccess) { grid = -1; return; }
        if (hipFuncSetAttribute((const void*)hybrid_fwd, hipFuncAttributeMaxDynamicSharedMemorySize, LDS_BYTES) != hipSuccess) { fprintf(stderr, "kernel_launch: hipFuncSetAttribute failed\n"); grid = -1; return; }
        if (hipOccupancyMaxActiveBlocksPerMultiprocessor(&per_cu, (const void*)hybrid_fwd, NWAVES * 64, LDS_BYTES) != hipSuccess || per_cu < 1)
            fprintf(stderr, "kernel_launch: note: occupancy query reports %d workgroups per CU\n", per_cu);
        (void)hipGetLastError();
        grid = cus;
    }
    if (grid < 0) return;
    if (hipMemsetAsync((char*)d_ws + WS_CTL, 0, CTL_ZERO_BYTES, stream) != hipSuccess) { fprintf(stderr, "kernel_launch: memset failed\n"); return; }
    Args a{};
    for (int i = 0; i < 24; ++i) a.in[i] = (const float*)d_in[i];
    a.out = (float*)d_out; a.ws = (unsigned char*)d_ws;
    for (int li = 0; li < N_LAUNCHES; ++li) {
        a.ph_lo = (N_LAUNCHES == PER_PHASE) ? li : 0; a.ph_hi = (N_LAUNCHES == PER_PHASE) ? li + 1 : PER_PHASE; a.li = li;
        hipLaunchKernelGGL(hybrid_fwd, dim3(grid), dim3(NWAVES * 64), LDS_BYTES, stream, a);
        const hipError_t le = hipPeekAtLastError();
        if (le != hipSuccess) { fprintf(stderr, "kernel_launch: launch %d failed: %s\n", li, hipGetErrorName(le)); break; }
    }
}
```

```cpp
#include <hip/hip_runtime.h>
#include <cstdio>
#include <cstdint>

#ifndef MK_N_LAUNCHES
#define MK_N_LAUNCHES 1
#endif

namespace pg8 {
#define PG8_LAS __attribute__((address_space(3)))
typedef unsigned short bf16_t;
typedef short bf16x8 __attribute__((ext_vector_type(8)));
typedef float f32x4 __attribute__((ext_vector_type(4)));
typedef unsigned u32x4 __attribute__((ext_vector_type(4)));
constexpr int BM = 256, BK = 64, HALF = 128, HTB = HALF * BK * 2  , STAGE_BYTES = 8 * HTB, NXCD = 8, WGM = 4;

__host__ __device__ __forceinline__ int lds_byte(int r, int c) { const int st = (r >> 4) * 2 + (c >> 5), rr = r & 15, cc = c & 31, ob = rr * 64 + cc * 2; return st * 1024 + (ob ^ (((ob >> 9) & 1) << 5)); }
__host__ __device__ __forceinline__ void stage_rc(int b, int& R, int& C) { const int st = b / 1024, sb = b % 1024, swz = sb ^ (((sb >> 9) & 1) << 5); R = (st >> 1) * 16 + swz / 64; C = (st & 1) * 32 + (swz % 64) / 2; }
__host__ __device__ __forceinline__ int perm32(int rho) { const int n = rho >> 4, i = rho & 15; return 8 * (i >> 2) + 4 * n + (i & 3); }

struct Unit { int pm, pn, g; };
struct Gemm { const bf16_t* A; const bf16_t* Bt; int lda, ldb, K; };

struct StaticOrder {
    int nM, nN, nwg, G, c;
    __host__ __device__ void init(int M, int N, int G_, int c_) { nM = M / BM; nN = N / BM; nwg = nM * nN; G = G_; c = c_; }
    __host__ __device__ bool next(int i, Unit& u) const {
        const long L = (long)i * G + c; if (L >= nwg) return false;
        int wgid = (int)L; { const int q = nwg / NXCD, r = nwg % NXCD, xcd = wgid % NXCD, off = wgid / NXCD; wgid = (xcd < r ? xcd * (q + 1) : r * (q + 1) + (xcd - r) * q) + off; }
        const int nig = WGM * nN, gid = wgid / nig, fm = gid * WGM, gsz = (nM - fm) < WGM ? (nM - fm) : WGM;
        u.pm = fm + ((wgid % nig) % gsz); u.pn = (wgid % nig) / gsz; u.g = 0; return true;
    }
    __device__ __forceinline__ const char* aptr(const Gemm& g, const Unit& u) const { return (const char*)g.A + (size_t)u.pm * BM * g.lda * 2; }
    __device__ __forceinline__ const char* bptr(const Gemm& g, const Unit& u) const { return (const char*)g.Bt + (size_t)u.pn * BM * g.ldb * 2; }
    __device__ __forceinline__ void a_ready(const Unit&) const {}
    __device__ __forceinline__ void done(const Unit&) const {}
};
struct FewOrder {
    int nN, n, c;
    __device__ bool next(int i, Unit& u) const { if (i > 0 || c >= n) return false; u.pm = c / nN; u.pn = c % nN; u.g = 0; return true; }
    __device__ __forceinline__ const char* aptr(const Gemm& g, const Unit& u) const { return (const char*)g.A + (size_t)u.pm * BM * g.lda * 2; }
    __device__ __forceinline__ const char* bptr(const Gemm& g, const Unit& u) const { return (const char*)g.Bt + (size_t)u.pn * BM * g.ldb * 2; }
    __device__ __forceinline__ void a_ready(const Unit&) const {}
    __device__ __forceinline__ void done(const Unit&) const {}
};
struct GroupOrder {
    StaticOrder so; int ng; size_t a_gstride, b_gstride;
    __device__ bool next(int i, Unit& u) const { if (i >= ng) return false; if (!so.next(0, u)) return false; u.g = i; return true; }
    __device__ __forceinline__ const char* aptr(const Gemm& g, const Unit& u) const { return (const char*)g.A + (size_t)u.g * a_gstride + (size_t)u.pm * BM * g.lda * 2; }
    __device__ __forceinline__ const char* bptr(const Gemm& g, const Unit& u) const { return (const char*)g.Bt + (size_t)u.g * b_gstride + (size_t)u.pn * BM * g.ldb * 2; }
    __device__ __forceinline__ void a_ready(const Unit&) const {}
    __device__ __forceinline__ void done(const Unit&) const {}
};

typedef __bf16 bf16x2_t_ __attribute__((ext_vector_type(2)));
typedef float f32x2_t_ __attribute__((ext_vector_type(2)));
__device__ __forceinline__ unsigned cvt_pk_bf16_c(float lo, float hi) { const bf16x2_t_ r = __builtin_convertvector((f32x2_t_){lo, hi}, bf16x2_t_); return __builtin_bit_cast(unsigned, r); }
__device__ __forceinline__ unsigned cvt_pk_bf16(float lo, float hi) { unsigned r; asm volatile("s_nop 0\n\tv_cvt_pk_bf16_f32 %0, %1, %2" : "=v"(r) : "v"(lo), "v"(hi)); return r; }
__device__ __forceinline__ float bf_lo(unsigned x) { return __uint_as_float(x << 16); }
__device__ __forceinline__ float bf_hi(unsigned x) { return __uint_as_float(x & 0xffff0000u); }
__device__ __forceinline__ float ubf_(unsigned x, int i) { return (float)((x >> (8 * i)) & 0xffu); }
__device__ __forceinline__ float sigmoidf_(float x) { return 1.0f / (1.0f + __expf(-x)); }

struct EpiProj {
    static constexpr bool PERM = true, AFTER_DRAIN = false, KEEP_ACC = false;
    bf16_t* O; int ldc; const float* bias; int split_cols; size_t split_stride; int n_sig_bias, sig_lo, sig_hi; unsigned char* G8;
    __device__ __forceinline__ void operator()(const f32x4 (&acc)[2][2][4][2], const Unit& u, int wr, int wc, int fr, int fq) const {
        const int row0 = u.pm * BM + wr * 64 + fr; int colt = u.pn * BM; bf16_t* base = O;
        if (split_cols) { const int t = colt / split_cols; base += (size_t)t * split_stride; colt -= t * split_cols; }
        const int col0 = colt + wc * 32 + 8 * fq, bcol0 = u.pn * BM + wc * 32 + 8 * fq;
        const int mode = (u.pn < n_sig_bias) ? 1 : ((u.pn >= sig_lo && u.pn < sig_hi) ? 2 : 0);
        f32x4 bv[2][2];
#pragma unroll
        for (int bj = 0; bj < 2; ++bj)
#pragma unroll
            for (int n = 0; n < 2; ++n) bv[bj][n] = (mode == 1) ? *(const f32x4*)(bias + bcol0 + bj * HALF + 4 * n) : (f32x4){0.f, 0.f, 0.f, 0.f};
#pragma unroll
        for (int ai = 0; ai < 2; ++ai)
#pragma unroll
            for (int m = 0; m < 4; ++m) { bf16_t* rowp = base + (size_t)(row0 + ai * HALF + m * 16) * ldc + col0;
#pragma unroll
                for (int bj = 0; bj < 2; ++bj) { f32x4 v0 = acc[ai][bj][m][0] + bv[bj][0], v1 = acc[ai][bj][m][1] + bv[bj][1];
                    if (mode != 0) {
#pragma unroll
                        for (int e = 0; e < 4; ++e) { v0[e] = sigmoidf_(v0[e]); v1[e] = sigmoidf_(v1[e]); } }
                    if (mode == 1) {
                        const unsigned lo = (unsigned)__float2int_rn(v0[0] * 255.f) | ((unsigned)__float2int_rn(v0[1] * 255.f) << 8) | ((unsigned)__float2int_rn(v0[2] * 255.f) << 16) | ((unsigned)__float2int_rn(v0[3] * 255.f) << 24);
                        const unsigned hi = (unsigned)__float2int_rn(v1[0] * 255.f) | ((unsigned)__float2int_rn(v1[1] * 255.f) << 8) | ((unsigned)__float2int_rn(v1[2] * 255.f) << 16) | ((unsigned)__float2int_rn(v1[3] * 255.f) << 24);
                        typedef unsigned u32x2_ __attribute__((ext_vector_type(2)));
                        *(u32x2_*)(G8 + (size_t)((u.pn * BM) / split_cols) * split_stride + (size_t)(row0 + ai * HALF + m * 16) * 512 + col0 + bj * HALF) = (u32x2_){lo, hi}; }
                    else { u32x4 w; w.x = cvt_pk_bf16(v0[0], v0[1]); w.y = cvt_pk_bf16(v0[2], v0[3]); w.z = cvt_pk_bf16(v1[0], v1[1]); w.w = cvt_pk_bf16(v1[2], v1[3]);
                        *(u32x4*)(rowp + bj * HALF) = w; } } }
    }
};

struct EpiBranch {
    static constexpr bool PERM = true, AFTER_DRAIN = false, KEEP_ACC = true;
    const unsigned char* gates; size_t gate_stride; bf16_t* merged;
    __device__ __forceinline__ void operator()(f32x4 (&acc)[2][2][4][2], const Unit& u, int wr, int wc, int fr, int fq) const {
        typedef unsigned u32x2_ __attribute__((ext_vector_type(2)));
        const int row0 = u.pm * BM + wr * 64 + fr; const int col0 = u.pn * BM + wc * 32 + 8 * fq;
        const bool last = u.g == 2;
#pragma unroll
        for (int ai = 0; ai < 2; ++ai) {
            u32x2_ gw[4][2], gn[4][2];
#pragma unroll
            for (int m = 0; m < 4; ++m) { const size_t row = (size_t)(row0 + ai * HALF + m * 16);
#pragma unroll
                for (int bj = 0; bj < 2; ++bj) { const int c = col0 + bj * HALF; const int gc = u.g * 1024 + c, gc2 = gc + 1024;
                    gw[m][bj] = *(const u32x2_*)(gates + (size_t)(gc >> 9) * gate_stride + row * 512 + (gc & 511));
                    if (!last) gn[m][bj] = *(const u32x2_*)(gates + (size_t)(gc2 >> 9) * gate_stride + row * 512 + (gc2 & 511)); else gn[m][bj] = (u32x2_){0xffffffffu, 0xffffffffu}; } }
#pragma unroll
            for (int m = 0; m < 4; ++m) { const size_t row = (size_t)(row0 + ai * HALF + m * 16);
#pragma unroll
                for (int bj = 0; bj < 2; ++bj) { const int c = col0 + bj * HALF;
                    const u32x2_ g2 = gw[m][bj], n2 = gn[m][bj];
                    f32x4 v0 = acc[ai][bj][m][0], v1 = acc[ai][bj][m][1];
                    const float k = 1.0f / 255.0f;
#pragma unroll
                    for (int e = 0; e < 4; ++e) { v0[e] *= fmaxf(ubf_(g2.x, e) * k, 1e-4f) * __builtin_amdgcn_rcpf(fmaxf(ubf_(n2.x, e) * k, 1e-4f)); v1[e] *= fmaxf(ubf_(g2.y, e) * k, 1e-4f) * __builtin_amdgcn_rcpf(fmaxf(ubf_(n2.y, e) * k, 1e-4f)); }
                    if (last) { u32x4 w; w.x = cvt_pk_bf16(v0[0], v0[1]); w.y = cvt_pk_bf16(v0[2], v0[3]); w.z = cvt_pk_bf16(v1[0], v1[1]); w.w = cvt_pk_bf16(v1[2], v1[3]);
                        *(u32x4*)(merged + row * 1024 + c) = w; }
                    else { acc[ai][bj][m][0] = v0; acc[ai][bj][m][1] = v1; } } }
        }
    }
};

struct EpiOut {
    static constexpr bool PERM = true, AFTER_DRAIN = false, KEEP_ACC = false;
    const float* x; float* out; bf16_t* h1b; float* sumsq;
    __device__ __forceinline__ void operator()(const f32x4 (&acc)[2][2][4][2], const Unit& u, int wr, int wc, int fr, int fq) const {
        const int row0 = u.pm * BM + wr * 64 + fr; const int col0 = u.pn * BM + wc * 32 + 8 * fq;
#pragma unroll
        for (int ai = 0; ai < 2; ++ai)
#pragma unroll
            for (int mp = 0; mp < 4; mp += 2) {
                f32x4 xv[2][2][2];
#pragma unroll
                for (int mm = 0; mm < 2; ++mm) { const size_t row = (size_t)(row0 + ai * HALF + (mp + mm) * 16);
#pragma unroll
                    for (int bj = 0; bj < 2; ++bj) { const size_t off = row * 1024 + col0 + bj * HALF; xv[mm][bj][0] = *(const f32x4*)(x + off); xv[mm][bj][1] = *(const f32x4*)(x + off + 4); } }
#pragma unroll
                for (int mm = 0; mm < 2; ++mm) { const int m = mp + mm; const size_t row = (size_t)(row0 + ai * HALF + m * 16); float ss = 0.f;
#pragma unroll
                    for (int bj = 0; bj < 2; ++bj) { const size_t off = row * 1024 + col0 + bj * HALF;
                        const f32x4 v0 = acc[ai][bj][m][0] + xv[mm][bj][0], v1 = acc[ai][bj][m][1] + xv[mm][bj][1];
                        ss += (v0[0] * v0[0] + v0[1] * v0[1]) + (v0[2] * v0[2] + v0[3] * v0[3]) + (v1[0] * v1[0] + v1[1] * v1[1]) + (v1[2] * v1[2] + v1[3] * v1[3]);
                        u32x4 w; w.x = cvt_pk_bf16(v0[0], v0[1]); w.y = cvt_pk_bf16(v0[2], v0[3]); w.z = cvt_pk_bf16(v1[0], v1[1]); w.w = cvt_pk_bf16(v1[2], v1[3]);
                        *(u32x4*)(h1b + off) = w; }
                    ss += __shfl_xor(ss, 16); ss += __shfl_xor(ss, 32);
                    if (fq == 0) atomicAdd(sumsq + row, ss); } }
    }
};

struct EpiQry {
    static constexpr bool PERM = true, AFTER_DRAIN = false, KEEP_ACC = false;
    const float* sumsq; bf16_t* qry; float eps;
    __device__ __forceinline__ void operator()(const f32x4 (&acc)[2][2][4][2], const Unit& u, int wr, int wc, int fr, int fq) const {
        const int row0 = u.pm * BM + wr * 64 + fr; const int col0 = u.pn * BM + wc * 32 + 8 * fq;
#pragma unroll
        for (int ai = 0; ai < 2; ++ai)
#pragma unroll
            for (int m = 0; m < 4; ++m) { const size_t row = (size_t)(row0 + ai * HALF + m * 16);
                const float rs = __builtin_amdgcn_rsqf(__hip_atomic_load(sumsq + row, __ATOMIC_RELAXED, __HIP_MEMORY_SCOPE_AGENT) * (1.0f / 1024.0f) + eps);
#pragma unroll
                for (int bj = 0; bj < 2; ++bj) { const f32x4 v0 = acc[ai][bj][m][0] * rs, v1 = acc[ai][bj][m][1] * rs;
                    u32x4 w; w.x = cvt_pk_bf16(v0[0], v0[1]); w.y = cvt_pk_bf16(v0[2], v0[3]); w.z = cvt_pk_bf16(v1[0], v1[1]); w.w = cvt_pk_bf16(v1[2], v1[3]);
                    *(u32x4*)(qry + row * 2048 + col0 + bj * HALF) = w; } }
    }
};

template <class Epi, class Sched, bool ALIGN_EPI = false, bool SP2 = false>
__device__ __forceinline__ void gemm_phase(PG8_LAS unsigned char* lds, const Gemm g, const Sched& S, const Epi& E) {
    const int tid = threadIdx.x, wid = __builtin_amdgcn_readfirstlane(tid >> 6), lane = tid & 63, wr = wid >> 2, wc = wid & 3, fr = lane & 15, fq = lane >> 4;
    const int K = g.K, nt = K / BK;
    unsigned voffA[2], voffB[2];
#pragma unroll
    for (int i = 0; i < 2; ++i) { int R, C; stage_rc(tid * 16 + i * 8192, R, C); const int Rb = Epi::PERM ? ((R & ~31) + perm32(R & 31)) : R;
        voffA[i] = (unsigned)(R * g.lda + C) * 2u; voffB[i] = (unsigned)(Rb * g.ldb + C) * 2u; }
    const size_t kstep = (size_t)(BK * 2);
    const size_t hstepA = (size_t)HALF * g.lda * 2, hstepB = (size_t)HALF * g.ldb * 2;
    const unsigned ldsw = (unsigned)wid * 1024u;
    const int aoff = lds_byte(wr * 64 + fr, fq * 8), boff = lds_byte(wc * 32 + fr, fq * 8);
#define PG8_SA(b, h) (((b) * 2 + (h)) * HTB)
#define PG8_SB(b, h) ((4 + (b) * 2 + (h)) * HTB)
#define PG8_STAGE(bufoff, gbase, voff) do { _Pragma("unroll") for (int _i = 0; _i < 2; ++_i) \
        __builtin_amdgcn_global_load_lds((const unsigned*)((const char*)(gbase) + (voff)[_i]), (PG8_LAS unsigned*)(lds + (bufoff) + ldsw + _i * 8192), 16, 0, 0); } while (0)
#define PG8_LDA(dst, b, h) do { _Pragma("unroll") for (int m = 0; m < 4; ++m) _Pragma("unroll") for (int k = 0; k < 2; ++k) dst[m][k] = *(const PG8_LAS bf16x8*)(lds + PG8_SA(b, h) + aoff + m * 2048 + k * 1024); } while (0)
#define PG8_LDB(dst, b, h) do { _Pragma("unroll") for (int n = 0; n < 2; ++n) _Pragma("unroll") for (int k = 0; k < 2; ++k) dst[n][k] = *(const PG8_LAS bf16x8*)(lds + PG8_SB(b, h) + boff + n * 2048 + k * 1024); } while (0)
#define PG8_MMA(ai, bj, At, Bt) do { __builtin_amdgcn_s_setprio(1); _Pragma("unroll") for (int m = 0; m < 4; ++m) _Pragma("unroll") for (int n = 0; n < 2; ++n) _Pragma("unroll") for (int k = 0; k < 2; ++k) \
        acc[ai][bj][m][n] = __builtin_amdgcn_mfma_f32_16x16x32_bf16(Bt[n][k], At[m][k], acc[ai][bj][m][n], 0, 0, 0); __builtin_amdgcn_s_setprio(0); } while (0)
#define PG8_WAIT_V(n) asm volatile("s_waitcnt vmcnt(" #n ")" ::: "memory")
#define PG8_WAIT_L(n) asm volatile("s_waitcnt lgkmcnt(" #n ")" ::: "memory")
#define PG8_BAR __builtin_amdgcn_s_barrier()
#define PG8_SCHED __builtin_amdgcn_sched_barrier(0)
    Unit cur, nxt; int ui = 0;
    if (!S.next(0, cur)) return;
    f32x4 acc[2][2][4][2];
#pragma unroll
    for (int a = 0; a < 2; ++a)
#pragma unroll
        for (int b = 0; b < 2; ++b)
#pragma unroll
            for (int m = 0; m < 4; ++m)
#pragma unroll
                for (int n = 0; n < 2; ++n) acc[a][b][m][n] = (f32x4){0.f, 0.f, 0.f, 0.f};
    bf16x8 At[4][2], B0[2][2], B1[2][2];
    const char* cA = S.aptr(g, cur); const char* cB = S.bptr(g, cur);
    S.a_ready(cur);
    if constexpr (SP2) {
        PG8_STAGE(PG8_SB(0, 0), cB, voffB); PG8_STAGE(PG8_SB(0, 1), cB + hstepB, voffB); PG8_STAGE(PG8_SA(0, 0), cA, voffA); PG8_STAGE(PG8_SA(0, 1), cA + hstepA, voffA);
        if (wr == 1) PG8_BAR;
        PG8_WAIT_V(2); PG8_BAR;
        PG8_STAGE(PG8_SB(1, 0), cB + kstep, voffB); PG8_STAGE(PG8_SA(1, 0), cA + kstep, voffA); PG8_STAGE(PG8_SB(1, 1), cB + hstepB + kstep, voffB);
        PG8_WAIT_V(6); PG8_BAR;
    } else {
        PG8_STAGE(PG8_SB(0, 0), cB, voffB); PG8_STAGE(PG8_SA(0, 0), cA, voffA); PG8_STAGE(PG8_SB(0, 1), cB + hstepB, voffB); PG8_STAGE(PG8_SA(0, 1), cA + hstepA, voffA);
        if (wr == 1) PG8_BAR;
        PG8_WAIT_V(4); PG8_BAR;
        PG8_STAGE(PG8_SB(1, 0), cB + kstep, voffB); PG8_STAGE(PG8_SA(1, 0), cA + kstep, voffA); PG8_STAGE(PG8_SB(1, 1), cB + hstepB + kstep, voffB);
        PG8_WAIT_V(6); PG8_BAR;
    }
    for (;;) {
        const bool has_next = S.next(ui + 1, nxt);
        const char* nA = has_next ? S.aptr(g, nxt) : cA; const char* nB = has_next ? S.bptr(g, nxt) : cB;
        for (int t = 0; t < nt; t += 2) {
            const bool last = (t == nt - 2);
            const char* a1 = cA + (size_t)(t + 1) * kstep;
            const char* a2 = last ? nA : cA + (size_t)(t + 2) * kstep; const char* b2 = last ? nB : cB + (size_t)(t + 2) * kstep;
            const char* a3 = a2 + kstep; const char* b3 = b2 + kstep;
            if (last && has_next) S.a_ready(nxt);
            if constexpr (SP2) {
            PG8_LDB(B0, 0, 0); PG8_LDB(B1, 0, 1); PG8_SCHED; PG8_LDA(At, 0, 0); PG8_STAGE(PG8_SA(1, 1), a1 + hstepA, voffA);
            PG8_WAIT_V(8); PG8_WAIT_L(0); PG8_BAR; PG8_MMA(0, 0, At, B0); PG8_MMA(0, 1, At, B1); PG8_BAR; PG8_SCHED;
            PG8_LDA(At, 0, 1); PG8_STAGE(PG8_SB(0, 0), b2, voffB); PG8_STAGE(PG8_SB(0, 1), b2 + hstepB, voffB); PG8_STAGE(PG8_SA(0, 0), a2, voffA);
            PG8_WAIT_V(8); PG8_WAIT_L(0); PG8_BAR; PG8_MMA(1, 0, At, B0); PG8_MMA(1, 1, At, B1); PG8_BAR; PG8_SCHED;
            PG8_LDB(B0, 1, 0); PG8_LDB(B1, 1, 1); PG8_SCHED; PG8_LDA(At, 1, 0); PG8_STAGE(PG8_SA(0, 1), a2 + hstepA, voffA);
            PG8_WAIT_V(8); PG8_WAIT_L(0); PG8_BAR; PG8_MMA(0, 0, At, B0); PG8_MMA(0, 1, At, B1); PG8_BAR; PG8_SCHED;
            PG8_LDA(At, 1, 1); PG8_STAGE(PG8_SB(1, 0), b3, voffB); PG8_STAGE(PG8_SB(1, 1), b3 + hstepB, voffB); PG8_STAGE(PG8_SA(1, 0), a3, voffA);
            PG8_WAIT_V(8); PG8_WAIT_L(0); PG8_BAR; PG8_MMA(1, 0, At, B0); PG8_MMA(1, 1, At, B1); PG8_BAR; PG8_SCHED;
            } else {
            PG8_LDB(B0, 0, 0); PG8_SCHED; PG8_LDA(At, 0, 0); PG8_STAGE(PG8_SA(1, 1), a1 + hstepA, voffA);
            PG8_WAIT_L(8); PG8_BAR; PG8_WAIT_L(0); PG8_MMA(0, 0, At, B0); PG8_BAR; PG8_SCHED;
            PG8_LDB(B1, 0, 1); PG8_STAGE(PG8_SB(0, 0), b2, voffB);
            PG8_BAR; PG8_WAIT_L(0); PG8_MMA(0, 1, At, B1); PG8_BAR;
            PG8_LDA(At, 0, 1); PG8_STAGE(PG8_SA(0, 0), a2, voffA);
            PG8_BAR; PG8_WAIT_L(0); PG8_MMA(1, 0, At, B0); PG8_BAR; PG8_SCHED;
            PG8_STAGE(PG8_SB(0, 1), b2 + hstepB, voffB);
            PG8_WAIT_V(6); PG8_BAR; PG8_MMA(1, 1, At, B1); PG8_BAR;
            PG8_LDB(B0, 1, 0); PG8_SCHED; PG8_LDA(At, 1, 0); PG8_STAGE(PG8_SA(0, 1), a2 + hstepA, voffA);
            PG8_WAIT_L(8); PG8_BAR; PG8_WAIT_L(0); PG8_MMA(0, 0, At, B0); PG8_BAR; PG8_SCHED;
            PG8_LDB(B1, 1, 1); PG8_STAGE(PG8_SB(1, 0), b3, voffB);
            PG8_BAR; PG8_WAIT_L(0); PG8_MMA(0, 1, At, B1); PG8_BAR;
            PG8_LDA(At, 1, 1); PG8_STAGE(PG8_SA(1, 0), a3, voffA);
            PG8_BAR; PG8_WAIT_L(0); PG8_MMA(1, 0, At, B0); PG8_BAR; PG8_SCHED;
            PG8_STAGE(PG8_SB(1, 1), b3 + hstepB, voffB);
            PG8_WAIT_V(6); PG8_BAR; PG8_MMA(1, 1, At, B1); PG8_BAR;
            }
        }
        if constexpr (ALIGN_EPI) { if (wr == 0) PG8_BAR; }
        if constexpr (!Epi::AFTER_DRAIN) { E(acc, cur, wr, wc, fr, fq); S.done(cur); }
        if (!has_next) break;
        if constexpr (!Epi::KEEP_ACC) {
#pragma unroll
        for (int a = 0; a < 2; ++a)
#pragma unroll
            for (int b = 0; b < 2; ++b)
#pragma unroll
                for (int m = 0; m < 4; ++m)
#pragma unroll
                    for (int n = 0; n < 2; ++n) acc[a][b][m][n] = (f32x4){0.f, 0.f, 0.f, 0.f};
        }
        cur = nxt; cA = nA; cB = nB; ++ui;
        if constexpr (ALIGN_EPI) { if (wr == 1) PG8_BAR; }
    }
    PG8_WAIT_V(0);
    if constexpr (!ALIGN_EPI) { if (wr == 0) PG8_BAR; }
    PG8_BAR;
    if constexpr (Epi::AFTER_DRAIN) { E.fused(acc, cur, wr, wc, fr, fq, lds, wid, lane); S.done(cur); }
#undef PG8_SA
#undef PG8_SB
#undef PG8_STAGE
#undef PG8_LDA
#undef PG8_LDB
#undef PG8_MMA
#undef PG8_WAIT_V
#undef PG8_WAIT_L
#undef PG8_BAR
#undef PG8_SCHED
}
}

#ifndef PROBE_PH
#define PROBE_PH -1
#endif
#ifndef PROBE_TS
#define PROBE_TS -1
#endif
#ifndef PROBE_MULT
#define PROBE_MULT 8
#endif
#ifndef PROBE_BX
#define PROBE_BX 100
#endif
constexpr int NWAVES = 8;
constexpr int N_LAUNCHES = MK_N_LAUNCHES;
constexpr int PER_PHASE = 10;

constexpr int T_TOK = 16384, DM = 1024, SEQ = 8192;
constexpr float EPS = 1e-6f;
constexpr int W_IN_COLS = 7176;

constexpr size_t MiB = 1u << 20;
constexpr size_t WS_CTL = 0, CTL_ZERO_BYTES = 1 * MiB;
constexpr size_t WS_WIN = 1 * MiB, WS_WKV = 15 * MiB, WS_WBR = 17 * MiB, WS_WOUT = 20 * MiB, WS_WPQ = 22 * MiB, WS_PK = 26 * MiB;
constexpr size_t WS_KVMEM = 26 * MiB + 512 * 1024, WS_MEMN = 27 * MiB + 512 * 1024, WS_IGLF = 28 * MiB + 512 * 1024, WS_ND = 29 * MiB, WS_NS = 29 * MiB + 512 * 1024;
constexpr size_t WS_GATES = 30 * MiB;
constexpr size_t WS_MLQ = 126 * MiB, WS_MLK = 142 * MiB, WS_SBQ = 158 * MiB, WS_MLV = 174 * MiB, WS_MEMQ = 190 * MiB, WS_MLO = 206 * MiB, WS_SBK = 222 * MiB, WS_SBV = 238 * MiB;
constexpr size_t WS_UT8 = 78 * MiB, WS_VT8 = 94 * MiB, WS_USC = 110 * MiB, WS_VSC = 110 * MiB + 65536;
constexpr size_t WS_H1B = 126 * MiB;
constexpr size_t WS_QRY = 158 * MiB;
constexpr size_t WS_CT = 222 * MiB;
constexpr size_t WS_MERGED = 222 * MiB;
constexpr size_t WS_IDX = 222 * MiB, WS_GW = 230 * MiB;
constexpr size_t WS_PD = 158 * MiB;
constexpr size_t WS_END = 254 * MiB;
constexpr size_t SPLIT_STRIDE = (size_t)T_TOK * 512;
constexpr size_t CTL_CHS = 256 * 1024, CTL_MS = 272 * 1024, CTL_SUMSQ = 512 * 1024;
constexpr int CW_BAR = 4096;

constexpr int RING_BYTES = 131072;
constexpr int LDSCTL_OFF = 155648, MISC_OFF = LDSCTL_OFF + 320;
constexpr int LDS_BYTES = 163840;

#define GAS __attribute__((address_space(1)))
#define LAS __attribute__((address_space(3)))
typedef unsigned short bf16;
typedef unsigned v4u __attribute__((ext_vector_type(4)));
typedef unsigned v2u __attribute__((ext_vector_type(2)));
typedef float f32x4 __attribute__((ext_vector_type(4)));
typedef short bf16x8 __attribute__((ext_vector_type(8)));
typedef GAS unsigned gu32;
#define RLX_AGENT __ATOMIC_RELAXED, __HIP_MEMORY_SCOPE_AGENT
#define LDS_WAIT() asm volatile("s_waitcnt lgkmcnt(0)" ::: "memory")
#define VM_WAIT() asm volatile("s_waitcnt vmcnt(0)" ::: "memory")
__device__ __forceinline__ unsigned f2bf(float f) { unsigned u = __builtin_bit_cast(unsigned, f); return (u + 0x7fffu + ((u >> 16) & 1u)) >> 16; }
__device__ __forceinline__ unsigned pk2(float lo, float hi) { return pg8::cvt_pk_bf16_c(lo, hi); }
__device__ __forceinline__ unsigned pk2s(float lo, float hi) { return f2bf(lo) | (f2bf(hi) << 16); }
__device__ __forceinline__ float bflo(unsigned x) { return __uint_as_float(x << 16); }
__device__ __forceinline__ float bfhi(unsigned x) { return __uint_as_float(x & 0xffff0000u); }
__device__ __forceinline__ float sigm(float x) { return 1.0f / (1.0f + __expf(-x)); }
__device__ __forceinline__ float softplusf_(float z) { return fmaxf(z, 0.f) + __logf(1.0f + __expf(-fabsf(z))); }

#define XB_TMO      128
#define XB_XCNT(j)  (256  + 64 * (j))
#define XB_XSUB(j)  (1280 + 64 * (j))
#define XB_XGEN(j)  (2304 + 64 * (j))
#define XB_TOP      3328
#define XB_TOPGEN   3392
#define XCD_BAR_WORDS 3456
#define XB_SPIN_CAP (1u << 18)
__device__ __forceinline__ unsigned xb_ld(unsigned* p)              { return __hip_atomic_load(p, __ATOMIC_RELAXED, __HIP_MEMORY_SCOPE_AGENT); }
__device__ __forceinline__ unsigned xb_add(unsigned* p, unsigned v) { return __hip_atomic_fetch_add(p, v, __ATOMIC_RELAXED, __HIP_MEMORY_SCOPE_AGENT); }
__device__ __forceinline__ unsigned xb_xcc_id() { return (unsigned)__builtin_amdgcn_s_getreg((3 << 11) | 20) & 0xFu; }
#define XB_SPIN(cond, bar) do { unsigned _sp = 0; while (cond) { __builtin_amdgcn_s_sleep(1); \
    if ((++_sp & 255u) == 0u) { if (xb_ld(&(bar)[XB_TMO])) break; if (_sp > XB_SPIN_CAP) { atomicAdd(&(bar)[XB_TMO], 1u); break; } } } } while (0)
struct XcdBarrier { unsigned* bar; unsigned x; volatile LAS unsigned* st; };
__device__ __forceinline__ XcdBarrier xcd_barrier_post(unsigned* bar, volatile LAS unsigned* st) {
    XcdBarrier b; b.bar = bar; b.x = xb_xcc_id(); b.st = st;
    if (threadIdx.x == 0) (void)xb_add(&bar[XB_XCNT(b.x)], 1u);
    return b;
}
__device__ __forceinline__ void xcd_barrier_complete(unsigned* bar, unsigned x, unsigned& nloc, unsigned& nx) {
    const unsigned G = gridDim.x * gridDim.y * gridDim.z;
    unsigned sum, cnt, mine, sp = 0u;
    for (;;) {
        sum = 0u; cnt = 0u; mine = 0u;
#pragma unroll
        for (unsigned j = 0; j < 16; ++j) { const unsigned c = xb_ld(&bar[XB_XCNT(j)]); sum += c; cnt += (c > 0u) ? 1u : 0u; mine = (j == x) ? c : mine; }
        if (sum == G) break;
        __builtin_amdgcn_s_sleep(1);
        if ((++sp & 255u) == 0u) { if (xb_ld(&bar[XB_TMO])) break; if (sp > XB_SPIN_CAP) { atomicAdd(&bar[XB_TMO], 1u); break; } }
    }
    nloc = mine > 0u ? mine : 1u; nx = cnt > 0u ? cnt : 1u;
}
__device__ __forceinline__ void xcd_barrier(const XcdBarrier& b) {
    asm volatile("s_waitcnt vmcnt(0)" ::: "memory");
    __syncthreads();
    if (threadIdx.x == 0) {
        unsigned* bar = b.bar;
        __builtin_amdgcn_s_waitcnt(0);
        unsigned nloc = b.st[0], nx = b.st[1];
        if (nloc == 0u) { xcd_barrier_complete(bar, b.x, nloc, nx); b.st[0] = nloc; b.st[1] = nx; }
        const unsigned old = xb_add(&bar[XB_XSUB(b.x)], 1u);
        const unsigned gen = old / nloc;
        if (old + 1u == (gen + 1u) * nloc) {
            __builtin_amdgcn_fence(__ATOMIC_RELEASE, "agent");
            asm volatile("s_waitcnt vmcnt(0)" ::: "memory");
            const unsigned og = xb_add(&bar[XB_TOP], 1u);
            const unsigned tg = og / nx;
            if (og + 1u == (tg + 1u) * nx) xb_add(&bar[XB_TOPGEN], 1u);
            else XB_SPIN(xb_ld(&bar[XB_TOPGEN]) == tg, bar);
            __builtin_amdgcn_fence(__ATOMIC_ACQUIRE, "agent");
            xb_add(&bar[XB_XGEN(b.x)], 1u);
            asm volatile("s_waitcnt vmcnt(0)" ::: "memory");
        } else {
            XB_SPIN(xb_ld(&bar[XB_XGEN(b.x)]) == gen, bar);
            __builtin_amdgcn_fence(__ATOMIC_ACQUIRE, "agent");
            asm volatile("s_waitcnt vmcnt(0)" ::: "memory");
        }
    }
    __syncthreads();
}

struct Frame {
    LAS unsigned char* lds;
    volatile LAS unsigned* MISC;
    int tid, lane, wave, G;
    unsigned char* ws; float* out;
    const float* in[24];
};
__device__ __forceinline__ float wave_sum(float v) {
#pragma unroll
    for (int o = 1; o < 64; o <<= 1) v += __shfl_xor(v, o);
    return v;
}
__device__ __forceinline__ float wave_max(float v) {
#pragma unroll
    for (int o = 1; o < 64; o <<= 1) v = fmaxf(v, __shfl_xor(v, o));
    return v;
}

template <int NT, int KS>
__device__ __forceinline__ void wave_mma(f32x4 (&acc)[NT], const LAS unsigned char* A, int pitchA, int m0, const LAS unsigned char* Bt, int pitchB, int n0, int lane, int koffA = 0, int koffB = 0) {
    const int r = lane & 15, q = lane >> 4;
#pragma unroll
    for (int ks = 0; ks < KS; ++ks) {
        const bf16x8 a = *(const LAS bf16x8*)(A + (m0 + r) * pitchA + (koffA + ks * 32 + q * 8) * 2);
#pragma unroll
        for (int j = 0; j < NT; ++j) {
            const bf16x8 b = *(const LAS bf16x8*)(Bt + (n0 + 16 * j + r) * pitchB + (koffB + ks * 32 + q * 8) * 2);
            acc[j] = __builtin_amdgcn_mfma_f32_16x16x32_bf16(a, b, acc[j], 0, 0, 0);
        }
    }
}
typedef short s16x4 __attribute__((ext_vector_type(4)));
__device__ __forceinline__ bf16x8 lds_tr_frag(const LAS unsigned char* T, int pitch, int k0, int n0, int lane) {
    const int g = lane >> 4, q = (lane & 15) >> 2, p = lane & 3;
    const LAS unsigned char* a = T + (k0 + 8 * g + q) * pitch + (n0 + 4 * p) * 2;
    const s16x4 lo = __builtin_amdgcn_ds_read_tr16_b64_v4i16((LAS s16x4*)a);
    const s16x4 hi = __builtin_amdgcn_ds_read_tr16_b64_v4i16((LAS s16x4*)(a + 4 * pitch));
    return (bf16x8){lo[0], lo[1], lo[2], lo[3], hi[0], hi[1], hi[2], hi[3]};
}
template <int NT, int KS>
__device__ __forceinline__ void wave_mma_kn(f32x4 (&acc)[NT], const LAS unsigned char* A, int pitchA, int m0, const LAS unsigned char* Bkn, int pitchB, int n0, int lane, int koffA = 0, int k0B = 0) {
    const int r = lane & 15, q = lane >> 4;
#pragma unroll
    for (int ks = 0; ks < KS; ++ks) {
        const bf16x8 a = *(const LAS bf16x8*)(A + (m0 + r) * pitchA + (koffA + ks * 32 + q * 8) * 2);
#pragma unroll
        for (int j = 0; j < NT; ++j) { const bf16x8 b = lds_tr_frag(Bkn, pitchB, k0B + ks * 32, n0 + 16 * j, lane); acc[j] = __builtin_amdgcn_mfma_f32_16x16x32_bf16(a, b, acc[j], 0, 0, 0); }
    }
}
__device__ __forceinline__ void lds_store_tr8(LAS unsigned char* base, int pitch, int d0, int col, v4u v) {
    *(LAS unsigned short*)(base + (d0 + 0) * pitch + col * 2) = (unsigned short)(v.x & 0xffffu); *(LAS unsigned short*)(base + (d0 + 1) * pitch + col * 2) = (unsigned short)(v.x >> 16);
    *(LAS unsigned short*)(base + (d0 + 2) * pitch + col * 2) = (unsigned short)(v.y & 0xffffu); *(LAS unsigned short*)(base + (d0 + 3) * pitch + col * 2) = (unsigned short)(v.y >> 16);
    *(LAS unsigned short*)(base + (d0 + 4) * pitch + col * 2) = (unsigned short)(v.z & 0xffffu); *(LAS unsigned short*)(base + (d0 + 5) * pitch + col * 2) = (unsigned short)(v.z >> 16);
    *(LAS unsigned short*)(base + (d0 + 6) * pitch + col * 2) = (unsigned short)(v.w & 0xffffu); *(LAS unsigned short*)(base + (d0 + 7) * pitch + col * 2) = (unsigned short)(v.w >> 16);
}

__device__ __forceinline__ void p0_transpose_item(const float* W, int ldsrc, int src_off, int K, int ncols, bf16* WT, int row_off, const float* kscale, LAS float* scr, int item, int lane) {
    const int nblk = ncols / 64, kb = item / nblk, nb = item % nblk, k0 = 64 * kb, n0 = 64 * nb;
    const int kk = lane >> 4, n4 = lane & 15;
    f32x4 v[16];
#pragma unroll
    for (int i = 0; i < 16; ++i) v[i] = *(const GAS f32x4*)(W + (size_t)(k0 + 4 * i + kk) * ldsrc + src_off + n0 + 4 * n4);
#pragma unroll
    for (int i = 0; i < 16; ++i) { const int k = 4 * i + kk; const float sc = kscale ? kscale[k0 + k] : 1.0f; LAS float* p = scr + k * 65 + 4 * n4;
        p[0] = v[i].x * sc; p[1] = v[i].y * sc; p[2] = v[i].z * sc; p[3] = v[i].w * sc; }
    LDS_WAIT(); asm volatile("" ::: "memory");
    const int c = lane & 7;
#pragma unroll
    for (int j = 0; j < 8; ++j) { const int n = (lane >> 3) + 8 * j; const LAS float* sp = scr + (8 * c) * 65 + n;
        v4u o; o.x = pk2(sp[0 * 65], sp[1 * 65]); o.y = pk2(sp[2 * 65], sp[3 * 65]); o.z = pk2(sp[4 * 65], sp[5 * 65]); o.w = pk2(sp[6 * 65], sp[7 * 65]);
        *(GAS v4u*)(WT + (size_t)(row_off + n0 + n) * K + k0 + 8 * c) = o; }
    LDS_WAIT(); asm volatile("" ::: "memory");
}

__device__ __forceinline__ void p0_prologue(Frame& F) {
    const float* x = F.in[0]; const float* mem = F.in[1]; const float* g_mix = F.in[2]; const float* w_in = F.in[3];
    const float* b_ig = F.in[4]; const float* b_fg = F.in[5]; const float* mem_g = F.in[9];
    bf16* XN = (bf16*)F.out;
    bf16* MEMN = (bf16*)(F.ws + WS_MEMN);
    float* IGLF = (float*)(F.ws + WS_IGLF);
    LAS float* gws = (LAS float*)(F.lds + 69632);
    for (int e = F.tid; e < 8192; e += 512) { const int c = e & 7, k = e >> 3; gws[c * 1024 + k] = w_in[(size_t)k * W_IN_COLS + 3072 + c]; }
    __syncthreads();
    const int gw = blockIdx.x * NWAVES + F.wave, NGW = F.G * NWAVES;
#define P0_SRC(m_) (((m_) >= T_TOK ? mem + (size_t)((m_) - T_TOK) * DM : x + (size_t)(m_) * DM))
    f32x4 v[4], vn[4];
    if (gw < T_TOK + 512) {
#pragma unroll
        for (int j = 0; j < 4; ++j) v[j] = *((const GAS f32x4*)P0_SRC(gw) + F.lane + 64 * j); }
    for (int m = gw; m < T_TOK + 512; m += NGW) {
        const bool is_mem = m >= T_TOK;
        const int mn = (m + NGW < T_TOK + 512) ? m + NGW : m;
#pragma unroll
        for (int j = 0; j < 4; ++j) vn[j] = *((const GAS f32x4*)P0_SRC(mn) + F.lane + 64 * j);
        const float* gsrc = is_mem ? mem_g : g_mix;
        bf16* dst = is_mem ? MEMN + (size_t)(m - T_TOK) * DM : XN + (size_t)m * DM;
        float s = 0.f;
#pragma unroll
        for (int j = 0; j < 4; ++j) s += (v[j].x * v[j].x + v[j].y * v[j].y) + (v[j].z * v[j].z + v[j].w * v[j].w);
        const float rstd = 1.0f / sqrtf(wave_sum(s) * (1.f / DM) + EPS);
#pragma unroll
        for (int j = 0; j < 4; ++j) { const f32x4 gg = *((const GAS f32x4*)gsrc + F.lane + 64 * j); v[j] = v[j] * rstd * gg; }
        GAS unsigned long long* o8 = (GAS unsigned long long*)dst + F.lane;
#pragma unroll
        for (int j = 0; j < 4; ++j) o8[64 * j] = (unsigned long long)pk2(v[j].x, v[j].y) | ((unsigned long long)pk2(v[j].z, v[j].w) << 32);
        if (!is_mem) {
            float dots[8];
#pragma unroll
            for (int c = 0; c < 8; ++c) { float d = 0.f;
#pragma unroll
                for (int j = 0; j < 4; ++j) { const f32x4 wv = *(const LAS f32x4*)(gws + c * 1024 + 256 * j + 4 * F.lane); d += (v[j].x * wv.x + v[j].y * wv.y) + (v[j].z * wv.z + v[j].w * wv.w); }
                dots[c] = d; }
#pragma unroll
            for (int i = 0; i < 4; ++i) { const bool up = (F.lane & 4) != 0; const float send = up ? dots[i] : dots[i + 4]; const float keep = up ? dots[i + 4] : dots[i]; dots[i] = keep + __shfl_xor(send, 4); }
#pragma unroll
            for (int i = 0; i < 2; ++i) { const bool up = (F.lane & 2) != 0; const float send = up ? dots[i] : dots[i + 2]; const float keep = up ? dots[i + 2] : dots[i]; dots[i] = keep + __shfl_xor(send, 2); }
            { const bool up = (F.lane & 1) != 0; const float send = up ? dots[0] : dots[1]; const float keep = up ? dots[1] : dots[0]; dots[0] = keep + __shfl_xor(send, 1); }
            float dt = dots[0]; dt += __shfl_xor(dt, 8); dt += __shfl_xor(dt, 16); dt += __shfl_xor(dt, 32);
            if (F.lane < 8) { const int c = F.lane;
                float o;
                if (c < 4) o = dt + b_ig[c]; else { const float fp = dt + b_fg[c - 4]; o = fminf(fp, 0.f) - __logf(1.0f + __expf(-fabsf(fp))); }
                IGLF[(size_t)m * 8 + c] = o; }
        }
#pragma unroll
        for (int j = 0; j < 4; ++j) v[j] = vn[j];
    }
#undef P0_SRC
    { const float* k1 = F.in[20]; const float* k2 = F.in[21]; bf16* PK = (bf16*)(F.ws + WS_PK);
      for (int e = (blockIdx.x * 512 + F.tid) * 4; e < 2 * 131072; e += F.G * 512 * 4) {
          const f32x4 vv = (e < 131072) ? *(const GAS f32x4*)(k1 + e) : *(const GAS f32x4*)(k2 + e - 131072);
          v2u o; o.x = pk2(vv.x, vv.y); o.y = pk2(vv.z, vv.w); *(GAS v2u*)(PK + e) = o; } }
    __syncthreads();
    LAS float* scr = (LAS float*)(F.lds + F.wave * 16640);
    bf16* WIN = (bf16*)(F.ws + WS_WIN); bf16* WKV = (bf16*)(F.ws + WS_WKV); bf16* WBR = (bf16*)(F.ws + WS_WBR); bf16* WOUT = (bf16*)(F.ws + WS_WOUT); bf16* WPQ = (bf16*)(F.ws + WS_WPQ);
    constexpr int I_G = 16 * 48, I_5 = 16 * 8, I_KV = 16 * 16, I_BR = 8 * 16, I_OUT = 16 * 16, I_PQ = 16 * 32;
    constexpr int NITEMS = I_G + 8 * I_5 + I_KV + 3 * I_BR + I_OUT + I_PQ;
    for (int it = gw; it < NITEMS; it += NGW) {
        int r = it;
        if (r < I_G) { p0_transpose_item(w_in, W_IN_COLS, 4104, 1024, 3072, WIN, 0, nullptr, scr, r, F.lane); continue; } r -= I_G;
        if (r < I_5) { p0_transpose_item(w_in, W_IN_COLS, 1536, 1024, 512, WIN, 3072, nullptr, scr, r, F.lane); continue; } r -= I_5;
        if (r < I_5) { p0_transpose_item(w_in, W_IN_COLS, 2048, 1024, 512, WIN, 3584, nullptr, scr, r, F.lane); continue; } r -= I_5;
        if (r < I_5) { p0_transpose_item(w_in, W_IN_COLS, 0, 1024, 512, WIN, 4096, nullptr, scr, r, F.lane); continue; } r -= I_5;
        if (r < I_5) { p0_transpose_item(w_in, W_IN_COLS, 2560, 1024, 512, WIN, 4608, nullptr, scr, r, F.lane); continue; } r -= I_5;
        if (r < I_5) { p0_transpose_item(w_in, W_IN_COLS, 3592, 1024, 512, WIN, 5120, nullptr, scr, r, F.lane); continue; } r -= I_5;
        if (r < I_5) { p0_transpose_item(w_in, W_IN_COLS, 3080, 1024, 512, WIN, 5632, nullptr, scr, r, F.lane); continue; } r -= I_5;
        if (r < I_5) { p0_transpose_item(w_in, W_IN_COLS, 512, 1024, 512, WIN, 6144, nullptr, scr, r, F.lane); continue; } r -= I_5;
        if (r < I_5) { p0_transpose_item(w_in, W_IN_COLS, 1024, 1024, 512, WIN, 6656, nullptr, scr, r, F.lane); continue; } r -= I_5;
        if (r < I_KV) { p0_transpose_item(F.in[10], 1024, 0, 1024, 1024, WKV, 0, nullptr, scr, r, F.lane); continue; } r -= I_KV;
        if (r < I_BR) { p0_transpose_item(F.in[13], 1024, 0, 512, 1024, WBR, 0, nullptr, scr, r, F.lane); continue; } r -= I_BR;
        if (r < I_BR) { p0_transpose_item(F.in[14], 1024, 0, 512, 1024, WBR, 1024, nullptr, scr, r, F.lane); continue; } r -= I_BR;
        if (r < I_BR) { p0_transpose_item(F.in[15], 1024, 0, 512, 1024, WBR, 2048, nullptr, scr, r, F.lane); continue; } r -= I_BR;
        if (r < I_OUT) { p0_transpose_item(F.in[17], 1024, 0, 1024, 1024, WOUT, 0, nullptr, scr, r, F.lane); continue; } r -= I_OUT;
        p0_transpose_item(F.in[19], 2048, 0, 1024, 2048, WPQ, 0, F.in[18], scr, r, F.lane);
    }
}

template <bool DIAG>
__device__ __forceinline__ void sb_elementwise(const LAS unsigned char* Ss, LAS unsigned char* Ps, int r, int qd, int rel, float& R) {
    float z[16];
#pragma unroll
    for (int i4 = 0; i4 < 4; ++i4) { const f32x4 t4 = *(const LAS f32x4*)(Ss + r * 272 + qd * 64 + i4 * 16); z[4 * i4] = t4.x; z[4 * i4 + 1] = t4.y; z[4 * i4 + 2] = t4.z; z[4 * i4 + 3] = t4.w; }
    float suf[16], lb[16]; float run = 0.f;
#pragma unroll
    for (int i = 15; i >= 0; --i) { const float zz = z[i] * 0.18033688011112042f;
        const float sp = fmaxf(zz, 0.f) + __builtin_amdgcn_logf(1.0f + __builtin_amdgcn_exp2f(-fabsf(zz)));
        const bool mk = DIAG ? (i < rel) : true;
        lb[i] = zz - sp; suf[i] = run; run += mk ? -sp : 0.f; }
    const float a1 = __shfl_xor(run, 1), a2 = __shfl_xor(run, 2), a3 = __shfl_xor(run, 3);
    const float off = ((qd & 1) == 0 ? a1 : 0.f) + ((qd & 2) == 0 ? a2 : 0.f) + (qd < 2 ? a3 : 0.f);
    const float base = R + off;
    unsigned pw[8];
#pragma unroll
    for (int i = 0; i < 16; i += 2) { float p0 = __builtin_amdgcn_exp2f(lb[i] + base + suf[i]), p1 = __builtin_amdgcn_exp2f(lb[i + 1] + base + suf[i + 1]);
        if (DIAG) { if (!(i < rel)) p0 = 0.f; if (!(i + 1 < rel)) p1 = 0.f; }
        pw[i >> 1] = pk2(p0, p1); }
    *(LAS v4u*)(Ps + r * 144 + qd * 32) = (v4u){pw[0], pw[1], pw[2], pw[3]}; *(LAS v4u*)(Ps + r * 144 + qd * 32 + 16) = (v4u){pw[4], pw[5], pw[6], pw[7]};
    R += run + a1 + a2 + a3;
}
__device__ __forceinline__ void sb_attn_item(Frame& F, int item, bf16* outp, size_t rmask) {
    const int bh = item >> 6, qb = 63 - (item & 63), b = bh >> 3, h = bh & 7;
    const int tid = F.tid, lane = F.lane, w = F.wave;
    LAS unsigned char* Qs = F.lds;
    LAS unsigned char* Ks = F.lds + 18432;
    LAS unsigned char* Vs = F.lds + 27648;
    LAS unsigned char* Ss = F.lds + 36864;
    LAS unsigned char* Ps = F.lds + 71680;
    LAS unsigned* alive = (LAS unsigned*)(F.lds + 90112);
    const bf16* SBQ = (const bf16*)(F.ws + WS_SBQ); const bf16* SBK = (const bf16*)(F.ws + WS_SBK); const bf16* SBV = (const bf16*)(F.ws + WS_SBV);
    const size_t row0 = (size_t)b * SEQ + (size_t)qb * 128;
    const int skey = tid >> 3, sc8 = tid & 7;
    v4u kv, vv;
    { const size_t grow = (size_t)b * SEQ + (size_t)(2 * qb + 1) * 64 + skey; kv = *(const GAS v4u*)(SBK + grow * 512 + h * 64 + sc8 * 8); vv = *(const GAS v4u*)(SBV + grow * 512 + h * 64 + sc8 * 8); }
    __syncthreads();
#pragma unroll
    for (int i = 0; i < 2; ++i) { const int p = tid + 512 * i, rr = p >> 3, c = p & 7;
        const v4u v = *(const GAS v4u*)(SBQ + (row0 + rr) * 512 + h * 64 + c * 8); *(LAS v4u*)(Qs + rr * 144 + c * 16) = v; }
    if (tid < 16) alive[tid] = 1u;
    f32x4 oacc[4];
#pragma unroll
    for (int j = 0; j < 4; ++j) oacc[j] = (f32x4){0.f, 0.f, 0.f, 0.f};
    float R = 0.f;
    const int r = tid >> 2, qd = tid & 3;
    int par = 0;
    for (int jb = 2 * qb + 1; jb >= 0; --jb, par ^= 1) {
        __syncthreads();
        if (jb < 2 * qb) { unsigned any = 0u;
#pragma unroll
            for (int i = 0; i < 8; ++i) any |= alive[(par ^ 1) * 8 + i];
            if (any == 0u) break; }
        *(LAS v4u*)(Ks + skey * 144 + sc8 * 16) = kv; *(LAS v4u*)(Vs + skey * 144 + sc8 * 16) = vv;
        if (jb > 0) { const size_t grow = (size_t)b * SEQ + (size_t)(jb - 1) * 64 + skey; kv = *(const GAS v4u*)(SBK + grow * 512 + h * 64 + sc8 * 8); vv = *(const GAS v4u*)(SBV + grow * 512 + h * 64 + sc8 * 8); }
        __syncthreads();
        const int rel0 = 128 * qb + 16 * w - 64 * jb;
        if (rel0 + 15 > 0) {
            f32x4 sacc[4];
#pragma unroll
            for (int j = 0; j < 4; ++j) sacc[j] = (f32x4){0.f, 0.f, 0.f, 0.f};
            wave_mma<4, 2>(sacc, Qs, 144, 16 * w, Ks, 144, 0, lane);
#pragma unroll
            for (int j = 0; j < 4; ++j)
#pragma unroll
                for (int rg = 0; rg < 4; ++rg) *(LAS float*)(Ss + (16 * w + 4 * (lane >> 4) + rg) * 272 + (16 * j + (lane & 15)) * 4) = sacc[j][rg];
            LDS_WAIT();
            const int rel = 128 * qb + r - 64 * jb - 16 * qd;
            if (rel0 < 64) sb_elementwise<true>(Ss, Ps, r, qd, rel, R); else sb_elementwise<false>(Ss, Ps, r, qd, rel, R);
            LDS_WAIT();
            wave_mma_kn<4, 2>(oacc, Ps, 144, 16 * w, Vs, 144, 0, lane);
        }
        const bool al = __builtin_amdgcn_ballot_w64(R >= -160.f) != 0ull;
        if (lane == 0) alive[par * 8 + w] = al ? 1u : 0u;
    }
    LDS_WAIT();
#pragma unroll
    for (int j = 0; j < 4; ++j)
#pragma unroll
        for (int rg = 0; rg < 4; ++rg) *(LAS unsigned short*)(Ps + (16 * w + 4 * (lane >> 4) + rg) * 144 + (16 * j + (lane & 15)) * 2) = (unsigned short)f2bf(oacc[j][rg]);
    LDS_WAIT();
#pragma unroll
    for (int i = 0; i < 2; ++i) { const int p = lane + 64 * i, rr = 16 * w + (p >> 3), c = p & 7;
        const v4u v = *(const LAS v4u*)(Ps + rr * 144 + c * 16); *(GAS v4u*)(outp + ((row0 + rr) & rmask) * 512 + h * 64 + c * 8) = v; }
}

__device__ __forceinline__ void conv16(const bf16* src, int col, const float* cw, const float* cb, int ch, int b, int t, float (&y)[16]) {
#pragma unroll
    for (int i4 = 0; i4 < 4; ++i4) { const f32x4 bb = *(const GAS f32x4*)(cb + ch + 4 * i4); y[4 * i4] = bb.x; y[4 * i4 + 1] = bb.y; y[4 * i4 + 2] = bb.z; y[4 * i4 + 3] = bb.w; }
#pragma unroll
    for (int kk = 0; kk < 4; ++kk) { const int tt = t - 3 + kk;
        if (tt >= 0) { const bf16* p = src + ((size_t)b * SEQ + tt) * 512 + col; const v4u x0 = *(const GAS v4u*)p, x1 = *(const GAS v4u*)(p + 8);
            const float xs[16] = {bflo(x0.x), bfhi(x0.x), bflo(x0.y), bfhi(x0.y), bflo(x0.z), bfhi(x0.z), bflo(x0.w), bfhi(x0.w), bflo(x1.x), bfhi(x1.x), bflo(x1.y), bfhi(x1.y), bflo(x1.z), bfhi(x1.z), bflo(x1.w), bfhi(x1.w)};
#pragma unroll
            for (int i4 = 0; i4 < 4; ++i4) { const f32x4 wv = *(const GAS f32x4*)(cw + kk * 1024 + ch + 4 * i4);
                y[4 * i4] += wv.x * xs[4 * i4]; y[4 * i4 + 1] += wv.y * xs[4 * i4 + 1]; y[4 * i4 + 2] += wv.z * xs[4 * i4 + 2]; y[4 * i4 + 3] += wv.w * xs[4 * i4 + 3]; } } }
#pragma unroll
    for (int i = 0; i < 16; ++i) y[i] = y[i] * sigm(y[i]);
}

constexpr int CONVW_OFF = 122880, CONVW_SET = 5 * 128 * 4;
__device__ __forceinline__ void conv_weights_to_lds(Frame& F, int h) {
    LAS float* wl = (LAS float*)(F.lds + CONVW_OFF);
    for (int e = F.tid; e < 2 * 5 * 128; e += NWAVES * 64) { const int set = e / 640, r = e % 640, kk = r >> 7, ch = r & 127; const int gch = set * 512 + h * 128 + ch;
        wl[e] = (kk < 4) ? F.in[6][kk * 1024 + gch] : F.in[7][gch]; }
}
__device__ __forceinline__ void conv16_lds(const bf16* src, int col, const LAS float* wl, int chl, int b, int t, float (&y)[16]) {
#pragma unroll
    for (int i4 = 0; i4 < 4; ++i4) { const f32x4 bb = *(const LAS f32x4*)(wl + 4 * 128 + chl + 4 * i4); y[4 * i4] = bb.x; y[4 * i4 + 1] = bb.y; y[4 * i4 + 2] = bb.z; y[4 * i4 + 3] = bb.w; }
#pragma unroll
    for (int kk = 0; kk < 4; ++kk) { const int tt = t - 3 + kk;
        if (tt >= 0) { const bf16* p = src + ((size_t)b * SEQ + tt) * 512 + col; const v4u x0 = *(const GAS v4u*)p, x1 = *(const GAS v4u*)(p + 8);
            const float xs[16] = {bflo(x0.x), bfhi(x0.x), bflo(x0.y), bfhi(x0.y), bflo(x0.z), bfhi(x0.z), bflo(x0.w), bfhi(x0.w), bflo(x1.x), bfhi(x1.x), bflo(x1.y), bfhi(x1.y), bflo(x1.z), bfhi(x1.z), bflo(x1.w), bfhi(x1.w)};
#pragma unroll
            for (int i4 = 0; i4 < 4; ++i4) { const f32x4 wv = *(const LAS f32x4*)(wl + kk * 128 + chl + 4 * i4);
                y[4 * i4] += wv.x * xs[4 * i4]; y[4 * i4 + 1] += wv.y * xs[4 * i4 + 1]; y[4 * i4 + 2] += wv.z * xs[4 * i4 + 2]; y[4 * i4 + 3] += wv.w * xs[4 * i4 + 3]; } } }
#pragma unroll
    for (int i = 0; i < 16; ++i) y[i] = y[i] * sigm(y[i]);
}
__device__ __forceinline__ void conv16_regs(const v4u (&x)[8], const LAS float* wl, int chl, float (&y)[16]) {
#pragma unroll
    for (int i4 = 0; i4 < 4; ++i4) { const f32x4 bb = *(const LAS f32x4*)(wl + 4 * 128 + chl + 4 * i4); y[4 * i4] = bb.x; y[4 * i4 + 1] = bb.y; y[4 * i4 + 2] = bb.z; y[4 * i4 + 3] = bb.w; }
#pragma unroll
    for (int kk = 0; kk < 4; ++kk) { const v4u x0 = x[2 * kk], x1 = x[2 * kk + 1];
        const float xs[16] = {bflo(x0.x), bfhi(x0.x), bflo(x0.y), bfhi(x0.y), bflo(x0.z), bfhi(x0.z), bflo(x0.w), bfhi(x0.w), bflo(x1.x), bfhi(x1.x), bflo(x1.y), bfhi(x1.y), bflo(x1.z), bfhi(x1.z), bflo(x1.w), bfhi(x1.w)};
#pragma unroll
        for (int i4 = 0; i4 < 4; ++i4) { const f32x4 wv = *(const LAS f32x4*)(wl + kk * 128 + chl + 4 * i4);
            y[4 * i4] += wv.x * xs[4 * i4]; y[4 * i4 + 1] += wv.y * xs[4 * i4 + 1]; y[4 * i4 + 2] += wv.z * xs[4 * i4 + 2]; y[4 * i4 + 3] += wv.w * xs[4 * i4 + 3]; } }
#pragma unroll
    for (int i = 0; i < 16; ++i) y[i] = y[i] * sigm(y[i]);
}
__device__ __forceinline__ void mlstm_store_wk(LAS unsigned char* p, const float (&y)[16], float sc) {
    v4u k0, k1; k0.x = pk2(y[0] * sc, y[1] * sc); k0.y = pk2(y[2] * sc, y[3] * sc); k0.z = pk2(y[4] * sc, y[5] * sc); k0.w = pk2(y[6] * sc, y[7] * sc);
    k1.x = pk2(y[8] * sc, y[9] * sc); k1.y = pk2(y[10] * sc, y[11] * sc); k1.z = pk2(y[12] * sc, y[13] * sc); k1.w = pk2(y[14] * sc, y[15] * sc);
    *(LAS v4u*)p = k0; *(LAS v4u*)(p + 16) = k1;
}
struct MlstmLocalRaw { v4u xk[8], vv[2]; float lf, ig; };
__device__ __forceinline__ void mlstm_local_load(Frame& F, int item, MlstmLocalRaw& R) {
    const int bh = item >> 7, c = item & 127, b = bh >> 2, h = bh & 3;
    const int tid = F.tid, lane = F.lane;
    const float* IGLF = (const float*)(F.ws + WS_IGLF);
    const bf16* MLK = (const bf16*)(F.ws + WS_MLK); const bf16* MLV = (const bf16*)(F.ws + WS_MLV);
    const int t0 = c * 64; const size_t row0 = (size_t)b * SEQ + t0;
    const int s = tid >> 3, part = tid & 7;
#pragma unroll
    for (int kk = 0; kk < 4; ++kk) { const int tt = t0 + s - 3 + kk;
        if (tt >= 0) { const size_t off = ((size_t)b * SEQ + tt) * 512 + h * 128 + part * 16; R.xk[2 * kk] = *(const GAS v4u*)(MLK + off); R.xk[2 * kk + 1] = *(const GAS v4u*)(MLK + off + 8); }
        else { R.xk[2 * kk] = (v4u){0u, 0u, 0u, 0u}; R.xk[2 * kk + 1] = (v4u){0u, 0u, 0u, 0u}; } }
    { const bf16* vp = MLV + (row0 + s) * 512 + h * 128 + part * 16; R.vv[0] = *(const GAS v4u*)vp; R.vv[1] = *(const GAS v4u*)(vp + 8); }
    R.lf = 0.f; R.ig = 0.f;
    if (F.wave == 0) { R.lf = IGLF[(row0 + lane) * 8 + 4 + h]; R.ig = IGLF[(row0 + lane) * 8 + h]; }
}
__device__ __forceinline__ void mlstm_local_item(Frame& F, int item, int next, MlstmLocalRaw& R) {
    const int tid = F.tid, lane = F.lane, w = F.wave;
    LAS float* wsm = (LAS float*)F.lds;
    LAS unsigned char* WKs = F.lds + 256;
    LAS unsigned char* Vs = F.lds + 256 + 17408;
    float* CHS = (float*)(F.ws + WS_CTL + CTL_CHS);
    bf16* Dg = (bf16*)F.out + (size_t)item * 16384; float* NDg = (float*)(F.ws + WS_ND) + (size_t)item * 128;
    LAS unsigned char* Dst = F.lds + 36864 + w * 4352;
    __syncthreads();
    if (w == 0) {
        float bs = R.lf;
#pragma unroll
        for (int o = 1; o < 64; o <<= 1) { const float v = __shfl_up(bs, o); if (lane >= o) bs += v; }
        const float blast = __shfl(bs, 63);
        const float a = blast - bs + R.ig; const float mu = wave_max(a);
        wsm[lane] = __expf(a - mu);
        if (lane == 0) { CHS[2 * item] = blast; CHS[2 * item + 1] = mu; }
    }
    const int s = tid >> 3, part = tid & 7; float y[16];
    conv16_regs(R.xk, (const LAS float*)(F.lds + CONVW_OFF + CONVW_SET), part * 16, y);
    *(LAS v4u*)(Vs + s * 272 + part * 32) = R.vv[0]; *(LAS v4u*)(Vs + s * 272 + part * 32 + 16) = R.vv[1];
    if (next >= 0) mlstm_local_load(F, next, R);
    __syncthreads();
    mlstm_store_wk(WKs + s * 272 + part * 32, y, wsm[s] * 0.08838834764831845f);
    __syncthreads();
    { f32x4 acc[8];
#pragma unroll
      for (int j = 0; j < 8; ++j) acc[j] = (f32x4){0.f, 0.f, 0.f, 0.f};
#pragma unroll
      for (int ks = 0; ks < 2; ++ks) { const bf16x8 a = lds_tr_frag(Vs, 272, 32 * ks, 16 * w, lane);
#pragma unroll
          for (int j = 0; j < 8; ++j) { const bf16x8 bb = lds_tr_frag(WKs, 272, 32 * ks, 16 * j, lane); acc[j] = __builtin_amdgcn_mfma_f32_16x16x32_bf16(a, bb, acc[j], 0, 0, 0); } }
#pragma unroll
      for (int j = 0; j < 8; ++j)
#pragma unroll
          for (int rg = 0; rg < 4; ++rg) *(LAS unsigned short*)(Dst + (4 * (lane >> 4) + rg) * 272 + (16 * j + (lane & 15)) * 2) = (unsigned short)f2bf(acc[j][rg]);
      LDS_WAIT();
#pragma unroll
      for (int i = 0; i < 4; ++i) { const int p = lane + 64 * i, rr = p >> 4, cc = p & 15;
          const v4u v = *(const LAS v4u*)(Dst + rr * 272 + cc * 16); *(GAS v4u*)(Dg + (16 * w + rr) * 128 + cc * 8) = v; } }
    if (tid < 128) { float sacc = 0.f;
#pragma unroll 8
        for (int i = 0; i < 64; ++i) sacc += __uint_as_float((unsigned)(*(const LAS unsigned short*)(WKs + i * 272 + tid * 2)) << 16);
        NDg[tid] = sacc; }
}

constexpr int SCAN_CHS_OFF = 131072;
struct ScanStream { float st0, st1; unsigned d[8]; int k; };
__device__ __forceinline__ void scan_prepare(Frame& F) {
    const float* CHS = (const float*)(F.ws + WS_CTL + CTL_CHS); float* MS = (float*)(F.ws + WS_CTL + CTL_MS);
    LAS float* chs = (LAS float*)(F.lds + SCAN_CHS_OFF);
    __syncthreads();
    for (int i = F.tid; i < 2048; i += 512) chs[i] = CHS[i];
    __syncthreads();
    if (F.tid < 8) { float m = 0.f;
        for (int c = 0; c < 128; ++c) { const int item = F.tid * 128 + c; const float blast = chs[2 * item], mu = chs[2 * item + 1];
            if (blockIdx.x == 0) MS[item] = m;
            const float mn = fmaxf(blast + m, mu); chs[2 * item] = __expf(blast + m - mn); chs[2 * item + 1] = __expf(mu - mn); m = mn; } }
    __syncthreads();
}
__device__ __forceinline__ void scan_issue(Frame& F, ScanStream& S, int k) {
    S.k = k;
    if (F.tid < 256 && k < 16) { const int g = blockIdx.x * 256 + F.tid; const unsigned* dp = (const unsigned*)F.out + (size_t)(g >> 13) * 128 * 8192 + (g & 8191);
#pragma unroll
        for (int i = 0; i < 8; ++i) S.d[i] = __builtin_nontemporal_load(dp + (size_t)(8 * k + i) * 8192); }
}
__device__ __forceinline__ void scan_step(Frame& F, ScanStream& S) {
    if (S.k >= 16) return;
    if (F.tid < 256) { const int g = blockIdx.x * 256 + F.tid, bh = g >> 13; unsigned* cp = (unsigned*)(F.ws + WS_CT) + (size_t)bh * 128 * 8192 + (g & 8191);
        const LAS float* chs = (const LAS float*)(F.lds + SCAN_CHS_OFF) + 2 * (bh * 128 + 8 * S.k);
#pragma unroll
        for (int i = 0; i < 8; ++i) { cp[(size_t)(8 * S.k + i) * 8192] = pk2(S.st0, S.st1); const float al = chs[2 * i], be = chs[2 * i + 1];
            S.st0 = al * S.st0 + be * bflo(S.d[i]); S.st1 = al * S.st1 + be * bfhi(S.d[i]); } }
    scan_issue(F, S, S.k + 1);
}
__device__ __forceinline__ void scan_nstate(Frame& F) {
    const float* NDg = (const float*)(F.ws + WS_ND); float* NS = (float*)(F.ws + WS_NS);
    const LAS float* chs = (const LAS float*)(F.lds + SCAN_CHS_OFF);
    for (int g = blockIdx.x * 512 + F.tid; g < 8 * 128; g += F.G * 512) {
        const int bh = g >> 7, e = g & 127; float st = 0.f;
        for (int c = 0; c < 128; ++c) { const int item = bh * 128 + c; NS[(size_t)item * 128 + e] = st; st = chs[2 * item] * st + chs[2 * item + 1] * NDg[(size_t)item * 128 + e]; }
    }
}

__device__ __forceinline__ void peer_table_row_i8(const f32x4 (&v)[4], unsigned char* dst, float* sc, int lane);
__device__ __forceinline__ void peer_table_row_fp8(const f32x4 (&v)[4], unsigned char* dst, float* sc, int lane);
struct TabStream { f32x4 v[4]; int k; };
__device__ __forceinline__ const float* tab_src(Frame& F, int r) { return (r >= 16384 ? F.in[23] + (size_t)(r - 16384) * 1024 : F.in[22] + (size_t)r * 1024) + 4 * F.lane; }
__device__ __forceinline__ void tab_issue(Frame& F, TabStream& S, int k) {
    S.k = k;
    if (k < 16) { const float* p = tab_src(F, (blockIdx.x * NWAVES + F.wave) + k * F.G * NWAVES);
#pragma unroll
        for (int j = 0; j < 4; ++j) S.v[j] = __builtin_nontemporal_load((const GAS f32x4*)(p + 256 * j)); }
}
__device__ __forceinline__ void tab_step(Frame& F, TabStream& S) {
    if (S.k < 16) { const int r = (blockIdx.x * NWAVES + F.wave) + S.k * F.G * NWAVES;
        if (r >= 16384) peer_table_row_fp8(S.v, F.ws + WS_VT8 + (size_t)(r - 16384) * 128, (float*)(F.ws + WS_VSC) + (r - 16384), F.lane);
        else peer_table_row_i8(S.v, F.ws + WS_UT8 + (size_t)r * 128, (float*)(F.ws + WS_USC) + r, F.lane);
        tab_issue(F, S, S.k + 1); }
}
__device__ __forceinline__ void mem_attn_item(Frame& F, int item, bf16* outp, size_t rmask, TabStream& TS, ScanStream& SS) {
    const int tile = item & 63, h = (item >> 6) & 3, b = item >> 8;
    const int tid = F.tid, lane = F.lane, w = F.wave;
    LAS unsigned char* Qs = F.lds;
    LAS unsigned char* KVs = F.lds + 34816;
    LAS unsigned char* Pw = F.lds + 34816 + 69632 + w * 2304;
    bf16* MEMQ = (bf16*)(F.ws + WS_MEMQ); const bf16* KV = (const bf16*)(F.ws + WS_KVMEM);
    const float* qg = F.in[11]; const float* kg = F.in[12];
    const size_t row0 = (size_t)b * SEQ + (size_t)tile * 128;
    __syncthreads();
    { const int r = tid >> 2, part = tid & 3; const bf16* p = MEMQ + (row0 + r) * 512 + h * 128 + part * 32;
      v4u x[4]; float s = 0.f;
#pragma unroll
      for (int i = 0; i < 4; ++i) { x[i] = *(const GAS v4u*)(p + 8 * i);
          s += (bflo(x[i].x) * bflo(x[i].x) + bfhi(x[i].x) * bfhi(x[i].x)) + (bflo(x[i].y) * bflo(x[i].y) + bfhi(x[i].y) * bfhi(x[i].y)) + (bflo(x[i].z) * bflo(x[i].z) + bfhi(x[i].z) * bfhi(x[i].z)) + (bflo(x[i].w) * bflo(x[i].w) + bfhi(x[i].w) * bfhi(x[i].w)); }
      s += __shfl_xor(s, 1); s += __shfl_xor(s, 2);
      const float rs = 0.08838834764831845f / sqrtf(s * (1.f / 128.f) + EPS);
#pragma unroll
      for (int i = 0; i < 4; ++i) { const f32x4 g0 = *(const GAS f32x4*)(qg + part * 32 + 8 * i), g1 = *(const GAS f32x4*)(qg + part * 32 + 8 * i + 4);
          v4u o; o.x = pk2s(bflo(x[i].x) * rs * g0.x, bfhi(x[i].x) * rs * g0.y); o.y = pk2s(bflo(x[i].y) * rs * g0.z, bfhi(x[i].y) * rs * g0.w);
          o.z = pk2s(bflo(x[i].z) * rs * g1.x, bfhi(x[i].z) * rs * g1.y); o.w = pk2s(bflo(x[i].w) * rs * g1.z, bfhi(x[i].w) * rs * g1.w);
          *(LAS v4u*)(Qs + r * 272 + part * 64 + i * 16) = o; } }
    { const int key = tid >> 1, half = tid & 1; const bf16* p = KV + ((size_t)b * 256 + key) * 1024 + h * 128 + half * 64;
      v4u x[8]; float s = 0.f;
#pragma unroll
      for (int i = 0; i < 8; ++i) { x[i] = *(const GAS v4u*)(p + 8 * i);
          s += (bflo(x[i].x) * bflo(x[i].x) + bfhi(x[i].x) * bfhi(x[i].x)) + (bflo(x[i].y) * bflo(x[i].y) + bfhi(x[i].y) * bfhi(x[i].y)) + (bflo(x[i].z) * bflo(x[i].z) + bfhi(x[i].z) * bfhi(x[i].z)) + (bflo(x[i].w) * bflo(x[i].w) + bfhi(x[i].w) * bfhi(x[i].w)); }
      s += __shfl_xor(s, 1);
      const float rs = 1.0f / sqrtf(s * (1.f / 128.f) + EPS);
#pragma unroll
      for (int i = 0; i < 8; ++i) { const f32x4 g0 = *(const GAS f32x4*)(kg + half * 64 + 8 * i), g1 = *(const GAS f32x4*)(kg + half * 64 + 8 * i + 4);
          v4u o; o.x = pk2s(bflo(x[i].x) * rs * g0.x, bfhi(x[i].x) * rs * g0.y); o.y = pk2s(bflo(x[i].y) * rs * g0.z, bfhi(x[i].y) * rs * g0.w);
          o.z = pk2s(bflo(x[i].z) * rs * g1.x, bfhi(x[i].z) * rs * g1.y); o.w = pk2s(bflo(x[i].w) * rs * g1.z, bfhi(x[i].w) * rs * g1.w);
          *(LAS v4u*)(KVs + key * 272 + half * 128 + i * 16) = o; } }
    __syncthreads();
    f32x4 sacc[16];
#pragma unroll
    for (int j = 0; j < 16; ++j) sacc[j] = (f32x4){0.f, 0.f, 0.f, 0.f};
    wave_mma<16, 4>(sacc, Qs, 272, 16 * w, KVs, 272, 0, lane);
    tab_step(F, TS); scan_step(F, SS);
    float rsum[4];
#pragma unroll
    for (int rg = 0; rg < 4; ++rg) { float mx = sacc[0][rg];
#pragma unroll
        for (int j = 1; j < 16; ++j) mx = fmaxf(mx, sacc[j][rg]);
        mx = fmaxf(mx, __shfl_xor(mx, 1)); mx = fmaxf(mx, __shfl_xor(mx, 2)); mx = fmaxf(mx, __shfl_xor(mx, 4)); mx = fmaxf(mx, __shfl_xor(mx, 8));
        float sm = 0.f;
#pragma unroll
        for (int j = 0; j < 16; ++j) { const float p = __expf(sacc[j][rg] - mx); sacc[j][rg] = p; sm += p; }
        sm += __shfl_xor(sm, 1); sm += __shfl_xor(sm, 2); sm += __shfl_xor(sm, 4); sm += __shfl_xor(sm, 8);
        rsum[rg] = 1.0f / sm; }
    tab_step(F, TS); scan_step(F, SS);
    __syncthreads();
#pragma unroll
    for (int i = 0; i < 8; ++i) { const int p = tid + 512 * i, key = p >> 4, c = p & 15;
        const v4u v = *(const GAS v4u*)(KV + ((size_t)b * 256 + key) * 1024 + 512 + h * 128 + c * 8); *(LAS v4u*)(KVs + key * 272 + c * 16) = v; }
    __syncthreads();
    f32x4 oacc[8];
#pragma unroll
    for (int j = 0; j < 8; ++j) oacc[j] = (f32x4){0.f, 0.f, 0.f, 0.f};
#pragma unroll
    for (int kc = 0; kc < 4; ++kc) {
        LDS_WAIT();
#pragma unroll
        for (int jj = 0; jj < 4; ++jj)
#pragma unroll
            for (int rg = 0; rg < 4; ++rg) *(LAS unsigned short*)(Pw + (4 * (lane >> 4) + rg) * 144 + (16 * jj + (lane & 15)) * 2) = (unsigned short)f2bf(sacc[4 * kc + jj][rg]);
        LDS_WAIT();
        wave_mma_kn<8, 2>(oacc, Pw, 144, 0, KVs, 272, 0, lane, 0, 64 * kc);
        tab_step(F, TS); scan_step(F, SS);
    }
    LDS_WAIT();
#pragma unroll
    for (int j = 0; j < 8; ++j)
#pragma unroll
        for (int rg = 0; rg < 4; ++rg) *(LAS unsigned short*)(Qs + (16 * w + 4 * (lane >> 4) + rg) * 272 + (16 * j + (lane & 15)) * 2) = (unsigned short)f2bf(oacc[j][rg] * rsum[rg]);
    LDS_WAIT();
#pragma unroll
    for (int i = 0; i < 4; ++i) { const int p = lane + 64 * i, rr = 16 * w + (p >> 4), c = p & 15;
        const v4u v = *(const LAS v4u*)(Qs + rr * 272 + c * 16); *(GAS v4u*)(outp + ((row0 + rr) & rmask) * 512 + h * 128 + c * 8) = v; }
    tab_step(F, TS); scan_step(F, SS); tab_step(F, TS); scan_step(F, SS);
}

struct MlstmRaw { v4u xq[8], xk[8], vv[2], ct[4], mo[2]; float g0, g1, mc; };
__device__ __forceinline__ void mlstm_out_load(Frame& F, int item, MlstmRaw& R) {
    const int bh = item >> 7, c = item & 127, b = bh >> 2, h = bh & 3;
    const int tid = F.tid, lane = F.lane, w = F.wave;
    const float* IGLF = (const float*)(F.ws + WS_IGLF);
    const bf16* MLQ = (const bf16*)(F.ws + WS_MLQ); const bf16* MLK = (const bf16*)(F.ws + WS_MLK); const bf16* MLV = (const bf16*)(F.ws + WS_MLV); const bf16* MLO = (const bf16*)(F.ws + WS_MLO);
    const bf16* CT = (const bf16*)(F.ws + WS_CT) + (size_t)item * 16384;
    const int t0 = c * 64; const size_t row0 = (size_t)b * SEQ + t0;
    const int s = tid >> 3, part = tid & 7;
#pragma unroll
    for (int kk = 0; kk < 4; ++kk) { const int tt = t0 + s - 3 + kk;
        if (tt >= 0) { const size_t off = ((size_t)b * SEQ + tt) * 512 + h * 128 + part * 16;
            R.xq[2 * kk] = *(const GAS v4u*)(MLQ + off); R.xq[2 * kk + 1] = *(const GAS v4u*)(MLQ + off + 8); R.xk[2 * kk] = *(const GAS v4u*)(MLK + off); R.xk[2 * kk + 1] = *(const GAS v4u*)(MLK + off + 8); }
        else { R.xq[2 * kk] = (v4u){0u, 0u, 0u, 0u}; R.xq[2 * kk + 1] = (v4u){0u, 0u, 0u, 0u}; R.xk[2 * kk] = (v4u){0u, 0u, 0u, 0u}; R.xk[2 * kk + 1] = (v4u){0u, 0u, 0u, 0u}; } }
    { const bf16* vp = MLV + (row0 + s) * 512 + h * 128 + part * 16; R.vv[0] = *(const GAS v4u*)vp; R.vv[1] = *(const GAS v4u*)(vp + 8);
      const bf16* op = MLO + (row0 + s) * 512 + h * 128 + part * 16; R.mo[0] = *(const GAS v4u*)op; R.mo[1] = *(const GAS v4u*)(op + 8); }
#pragma unroll
    for (int i = 0; i < 4; ++i) { const int p = tid + 512 * i, rr = p >> 4, cc = p & 15; R.ct[i] = *(const GAS v4u*)(CT + rr * 128 + cc * 8); }
    R.g0 = 0.f; R.g1 = 0.f;
    if (w == 0) { R.g0 = IGLF[(row0 + lane) * 8 + 4 + h]; R.g1 = IGLF[(row0 + lane) * 8 + h]; }
    else if (w == 1 || w == 2) R.g0 = ((const float*)(F.ws + WS_NS))[(size_t)item * 128 + tid - 64];
    R.mc = ((const float*)(F.ws + WS_CTL + CTL_MS))[item];
}
__device__ __forceinline__ void mlstm_out_item(Frame& F, int item, int next, MlstmRaw& R, bf16* outp, size_t rmask) {
    const int bh = item >> 7, c = item & 127, b = bh >> 2, h = bh & 3;
    const int tid = F.tid, lane = F.lane, w = F.wave;
    LAS unsigned char* Qs = F.lds;
    LAS unsigned char* Ks = F.lds + 17408;
    LAS unsigned char* Vs = F.lds + 34816;
    LAS unsigned char* CTs = F.lds + 53248;
    LAS unsigned char* Ss = F.lds + 88064;
    LAS unsigned char* Ws = F.lds + 105472;
    LAS float* bcum = (LAS float*)(F.lds + 114688);
    LAS float* igs = bcum + 64;
    LAS float* nsv = bcum + 128;
    LAS float* rden = bcum + 256;
    const float mc = R.mc;
    const int t0 = c * 64; const size_t row0 = (size_t)b * SEQ + t0;
    const v4u mo0 = R.mo[0], mo1 = R.mo[1];
    __syncthreads();
    if (w == 0) {
        float bs = R.g0;
#pragma unroll
        for (int o = 1; o < 64; o <<= 1) { const float v = __shfl_up(bs, o); if (lane >= o) bs += v; }
        bcum[lane] = bs; igs[lane] = R.g1;
    } else if (w == 1 || w == 2) nsv[tid - 64] = R.g0;
    { const int s = tid >> 3, part = tid & 7; float y[16];
      conv16_regs(R.xq, (const LAS float*)(F.lds + CONVW_OFF), part * 16, y);
      v4u q0, q1; q0.x = pk2(y[0], y[1]); q0.y = pk2(y[2], y[3]); q0.z = pk2(y[4], y[5]); q0.w = pk2(y[6], y[7]); q1.x = pk2(y[8], y[9]); q1.y = pk2(y[10], y[11]); q1.z = pk2(y[12], y[13]); q1.w = pk2(y[14], y[15]);
      *(LAS v4u*)(Qs + s * 272 + part * 32) = q0; *(LAS v4u*)(Qs + s * 272 + part * 32 + 16) = q1;
      conv16_regs(R.xk, (const LAS float*)(F.lds + CONVW_OFF + CONVW_SET), part * 16, y);
      const float sc = 0.08838834764831845f;
      q0.x = pk2(y[0] * sc, y[1] * sc); q0.y = pk2(y[2] * sc, y[3] * sc); q0.z = pk2(y[4] * sc, y[5] * sc); q0.w = pk2(y[6] * sc, y[7] * sc);
      q1.x = pk2(y[8] * sc, y[9] * sc); q1.y = pk2(y[10] * sc, y[11] * sc); q1.z = pk2(y[12] * sc, y[13] * sc); q1.w = pk2(y[14] * sc, y[15] * sc);
      *(LAS v4u*)(Ks + s * 272 + part * 32) = q0; *(LAS v4u*)(Ks + s * 272 + part * 32 + 16) = q1;
      *(LAS v4u*)(Vs + s * 272 + part * 32) = R.vv[0]; *(LAS v4u*)(Vs + s * 272 + part * 32 + 16) = R.vv[1]; }
#pragma unroll
    for (int i = 0; i < 4; ++i) { const int p = tid + 512 * i, rr = p >> 4, cc = p & 15; *(LAS v4u*)(CTs + rr * 272 + cc * 16) = R.ct[i]; }
    if (next >= 0) mlstm_out_load(F, next, R);
    __syncthreads();
    { f32x4 sacc[2];
      sacc[0] = (f32x4){0.f, 0.f, 0.f, 0.f}; sacc[1] = (f32x4){0.f, 0.f, 0.f, 0.f};
      wave_mma<2, 4>(sacc, Qs, 272, 16 * (w >> 1), Ks, 272, 32 * (w & 1), lane);
#pragma unroll
      for (int j = 0; j < 2; ++j)
#pragma unroll
          for (int rg = 0; rg < 4; ++rg) *(LAS float*)(Ss + (16 * (w >> 1) + 4 * (lane >> 4) + rg) * 272 + (32 * (w & 1) + 16 * j + (lane & 15)) * 4) = sacc[j][rg]; }
    __syncthreads();
    { const int t = tid >> 3, seg = tid & 7;
      const float bt = bcum[t];
      const f32x4 s0 = *(const LAS f32x4*)(Ss + t * 272 + seg * 32), s1 = *(const LAS f32x4*)(Ss + t * 272 + seg * 32 + 16);
      const float sv[8] = {s0.x, s0.y, s0.z, s0.w, s1.x, s1.y, s1.z, s1.w};
      float dm[8]; float mx = -3.0e38f;
#pragma unroll
      for (int i = 0; i < 8; ++i) { const int s = seg * 8 + i; dm[i] = bt - bcum[s] + igs[s]; if (s <= t) mx = fmaxf(mx, dm[i]); }
      mx = fmaxf(mx, __shfl_xor(mx, 1)); mx = fmaxf(mx, __shfl_xor(mx, 2)); mx = fmaxf(mx, __shfl_xor(mx, 4));
      const float minter = bt + mc; const float mt = fmaxf(minter, mx);
      float wv[8]; float den = 0.f;
#pragma unroll
      for (int i = 0; i < 8; ++i) { const int s = seg * 8 + i; wv[i] = (s <= t) ? sv[i] * __expf(dm[i] - mt) : 0.f; den += wv[i]; }
      *(LAS v4u*)(Ws + t * 144 + seg * 16) = (v4u){pk2(wv[0], wv[1]), pk2(wv[2], wv[3]), pk2(wv[4], wv[5]), pk2(wv[6], wv[7])};
      const float inter = __expf(minter - mt);
      v4u qa = *(const LAS v4u*)(Qs + t * 272 + seg * 32), qb2 = *(const LAS v4u*)(Qs + t * 272 + seg * 32 + 16);
      const float qf[16] = {bflo(qa.x), bfhi(qa.x), bflo(qa.y), bfhi(qa.y), bflo(qa.z), bfhi(qa.z), bflo(qa.w), bfhi(qa.w), bflo(qb2.x), bfhi(qb2.x), bflo(qb2.y), bfhi(qb2.y), bflo(qb2.z), bfhi(qb2.z), bflo(qb2.w), bfhi(qb2.w)};
      float qn = 0.f;
#pragma unroll
      for (int i = 0; i < 16; ++i) qn += qf[i] * nsv[seg * 16 + i];
      den += inter * qn;
      den += __shfl_xor(den, 1); den += __shfl_xor(den, 2); den += __shfl_xor(den, 4);
      qa.x = pk2(qf[0] * inter, qf[1] * inter); qa.y = pk2(qf[2] * inter, qf[3] * inter); qa.z = pk2(qf[4] * inter, qf[5] * inter); qa.w = pk2(qf[6] * inter, qf[7] * inter);
      qb2.x = pk2(qf[8] * inter, qf[9] * inter); qb2.y = pk2(qf[10] * inter, qf[11] * inter); qb2.z = pk2(qf[12] * inter, qf[13] * inter); qb2.w = pk2(qf[14] * inter, qf[15] * inter);
      *(LAS v4u*)(Qs + t * 272 + seg * 32) = qa; *(LAS v4u*)(Qs + t * 272 + seg * 32 + 16) = qb2;
      if (seg == 0) rden[t] = 1.0f / fmaxf(fabsf(den), __expf(-mt)); }
    __syncthreads();
    f32x4 acc[4];
#pragma unroll
    for (int j = 0; j < 4; ++j) acc[j] = (f32x4){0.f, 0.f, 0.f, 0.f};
    wave_mma_kn<4, 2>(acc, Ws, 144, 16 * (w >> 1), Vs, 272, 64 * (w & 1), lane);
    wave_mma<4, 4>(acc, Qs, 272, 16 * (w >> 1), CTs, 272, 64 * (w & 1), lane);
    __syncthreads();
    LAS unsigned char* Hs = CTs;
#pragma unroll
    for (int j = 0; j < 4; ++j)
#pragma unroll
        for (int rg = 0; rg < 4; ++rg) { const int row = 16 * (w >> 1) + 4 * (lane >> 4) + rg; *(LAS float*)(Hs + row * 528 + (64 * (w & 1) + 16 * j + (lane & 15)) * 4) = acc[j][rg] * rden[row]; }
    __syncthreads();
    { const int t = tid >> 3, seg = tid & 7; float hv[16]; float ss = 0.f;
#pragma unroll
      for (int i4 = 0; i4 < 4; ++i4) { const f32x4 v = *(const LAS f32x4*)(Hs + t * 528 + seg * 64 + i4 * 16); hv[4 * i4] = v.x; hv[4 * i4 + 1] = v.y; hv[4 * i4 + 2] = v.z; hv[4 * i4 + 3] = v.w; ss += (v.x * v.x + v.y * v.y) + (v.z * v.z + v.w * v.w); }
      ss += __shfl_xor(ss, 1); ss += __shfl_xor(ss, 2); ss += __shfl_xor(ss, 4);
      const float rs = 1.0f / sqrtf(ss * (1.f / 128.f) + EPS);
      const float* mg = F.in[8] + seg * 16;
      const float og[16] = {bflo(mo0.x), bfhi(mo0.x), bflo(mo0.y), bfhi(mo0.y), bflo(mo0.z), bfhi(mo0.z), bflo(mo0.w), bfhi(mo0.w), bflo(mo1.x), bfhi(mo1.x), bflo(mo1.y), bfhi(mo1.y), bflo(mo1.z), bfhi(mo1.z), bflo(mo1.w), bfhi(mo1.w)};
      float yv[16];
#pragma unroll
      for (int i = 0; i < 16; ++i) yv[i] = hv[i] * rs * mg[i] * og[i];
      v4u y0, y1; y0.x = pk2(yv[0], yv[1]); y0.y = pk2(yv[2], yv[3]); y0.z = pk2(yv[4], yv[5]); y0.w = pk2(yv[6], yv[7]); y1.x = pk2(yv[8], yv[9]); y1.y = pk2(yv[10], yv[11]); y1.z = pk2(yv[12], yv[13]); y1.w = pk2(yv[14], yv[15]);
      bf16* yp = outp + ((row0 + t) & rmask) * 512 + h * 128 + seg * 16; *(GAS v4u*)yp = y0; *(GAS v4u*)(yp + 8) = y1; }
}

#define PEER_INS(L, v) do { L[15] = __builtin_amdgcn_fmed3f(L[14], L[15], v); L[14] = __builtin_amdgcn_fmed3f(L[13], L[14], v); L[13] = __builtin_amdgcn_fmed3f(L[12], L[13], v); \
    L[12] = __builtin_amdgcn_fmed3f(L[11], L[12], v); L[11] = __builtin_amdgcn_fmed3f(L[10], L[11], v); L[10] = __builtin_amdgcn_fmed3f(L[9], L[10], v); L[9] = __builtin_amdgcn_fmed3f(L[8], L[9], v); \
    L[8] = __builtin_amdgcn_fmed3f(L[7], L[8], v); L[7] = __builtin_amdgcn_fmed3f(L[6], L[7], v); L[6] = __builtin_amdgcn_fmed3f(L[5], L[6], v); L[5] = __builtin_amdgcn_fmed3f(L[4], L[5], v); \
    L[4] = __builtin_amdgcn_fmed3f(L[3], L[4], v); L[3] = __builtin_amdgcn_fmed3f(L[2], L[3], v); L[2] = __builtin_amdgcn_fmed3f(L[1], L[2], v); L[1] = __builtin_amdgcn_fmed3f(L[0], L[1], v); L[0] = fmaxf(L[0], v); } while (0)

__device__ __forceinline__ void sort16_desc(float (&a)[16]) {
#pragma unroll
    for (int k = 2; k <= 16; k <<= 1)
#pragma unroll
        for (int j = k >> 1; j > 0; j >>= 1)
#pragma unroll
            for (int i = 0; i < 16; ++i) { const int l = i ^ j;
                if (l > i) { const float x = a[i], y = a[l]; const bool desc = (i & k) == 0;
                    a[i] = desc ? fmaxf(x, y) : fminf(x, y); a[l] = desc ? fminf(x, y) : fmaxf(x, y); } }
}
__device__ __forceinline__ void merge16_desc(float (&L)[16], const float (&Brev)[16]) {
#pragma unroll
    for (int i = 0; i < 16; ++i) L[i] = fmaxf(L[i], Brev[i]);
#pragma unroll
    for (int j = 8; j > 0; j >>= 1)
#pragma unroll
        for (int i = 0; i < 16; ++i) { const int l = i ^ j; if (l > i) { const float x = L[i], y = L[l]; L[i] = fmaxf(x, y); L[l] = fminf(x, y); } }
}
constexpr int PEER_IDX_OFF = 0, PEER_GW_OFF = 33024, PEER_LST_OFF = 69632;
__device__ __forceinline__ void peer_route_tile(Frame& F, int tile) {
    const int tid = F.tid, lane = F.lane, w = F.wave;
    LAS unsigned char* K1s = F.lds;
    LAS float* LST = (LAS float*)(F.lds + PEER_LST_OFF);
    const bf16* QRY = (const bf16*)(F.ws + WS_QRY); const bf16* PK = (const bf16*)(F.ws + WS_PK);
    const size_t row0 = (size_t)tile * 64;
    const int mt = w & 3, half = w >> 2;
    v4u kreg[8]; bf16x8 qf[4];
    const bf16* qp0 = QRY + (row0 + 16 * mt + (lane & 15)) * 2048 + half * 128 + (lane >> 4) * 8;
#pragma unroll
    for (int i = 0; i < 8; ++i) { const int p = tid + 512 * i, kr = p >> 4, c = p & 15, hf = kr >> 7, key = kr & 127; kreg[i] = *(const GAS v4u*)(PK + ((size_t)(hf * 8 + 0) * 128 + key) * 128 + c * 8); }
#pragma unroll
    for (int ks = 0; ks < 4; ++ks) qf[ks] = *(const GAS bf16x8*)(qp0 + ks * 32);
    for (int h = 0; h < 8; ++h) {
        __syncthreads();
#pragma unroll
        for (int i = 0; i < 8; ++i) { const int p = tid + 512 * i, kr = p >> 4, c = p & 15; *(LAS v4u*)(K1s + kr * 272 + c * 16) = kreg[i]; }
        if (h < 7) {
#pragma unroll
            for (int i = 0; i < 8; ++i) { const int p = tid + 512 * i, kr = p >> 4, c = p & 15, hf = kr >> 7, key = kr & 127; kreg[i] = *(const GAS v4u*)(PK + ((size_t)(hf * 8 + h + 1) * 128 + key) * 128 + c * 8); } }
        __syncthreads();
        f32x4 acc[8];
#pragma unroll
        for (int j = 0; j < 8; ++j) acc[j] = (f32x4){0.f, 0.f, 0.f, 0.f};
#pragma unroll
        for (int ks = 0; ks < 4; ++ks) {
#pragma unroll
            for (int j = 0; j < 8; ++j) { const bf16x8 kf = *(const LAS bf16x8*)(K1s + (half * 128 + 16 * j + (lane & 15)) * 272 + (ks * 32 + (lane >> 4) * 8) * 2);
                acc[j] = __builtin_amdgcn_mfma_f32_16x16x32_bf16(kf, qf[ks], acc[j], 0, 0, 0); } }
        if (h < 7) {
#pragma unroll
            for (int ks = 0; ks < 4; ++ks) qf[ks] = *(const GAS bf16x8*)(qp0 + (h + 1) * 256 + ks * 32); }
        float L[16], L2[16];
#pragma unroll
        for (int j = 0; j < 4; ++j)
#pragma unroll
            for (int rg = 0; rg < 4; ++rg) { L[4 * j + rg] = __uint_as_float((__float_as_uint(acc[j][rg]) & 0xFFFFFF80u) | (unsigned)(16 * j + 4 * (lane >> 4) + rg));
                L2[15 - (4 * j + rg)] = __uint_as_float((__float_as_uint(acc[4 + j][rg]) & 0xFFFFFF80u) | (unsigned)(16 * (4 + j) + 4 * (lane >> 4) + rg)); }
        sort16_desc(L);
        { float T2[16];
#pragma unroll
          for (int i = 0; i < 16; ++i) T2[i] = L2[15 - i];
          sort16_desc(T2);
#pragma unroll
          for (int i = 0; i < 16; ++i) L2[i] = T2[15 - i]; }
        merge16_desc(L, L2);
#pragma unroll
        for (int step = 16; step <= 32; step <<= 1) { float P[16];
#pragma unroll
            for (int i = 0; i < 16; ++i) P[i] = __shfl_xor(L[15 - i], step);
            merge16_desc(L, P); }
        if (lane < 16) {
#pragma unroll
            for (int i = 0; i < 16; ++i) LST[((h * 2 + half) * 16 + i) * 64 + 16 * mt + lane] = L[i]; }
    }
    __syncthreads();
    {
        const int h = w;
        float A1[16], A2[16];
#pragma unroll
        for (int i = 0; i < 16; ++i) { A1[i] = LST[((h * 2) * 16 + i) * 64 + lane]; A2[i] = LST[((h * 2 + 1) * 16 + i) * 64 + lane]; }
        float Tt[16];
#pragma unroll
        for (int i = 0; i < 16; ++i) Tt[i] = -3.0e38f;
#pragma unroll
        for (int i = 0; i < 16; ++i)
#pragma unroll
            for (int j = 0; j < 16; ++j) if ((i + 1) * (j + 1) <= 16) { const float cv = __uint_as_float((__float_as_uint(A1[i] + A2[j]) & 0xFFFFFF00u) | (unsigned)(i * 16 + j)); PEER_INS(Tt, cv); }
        float ex[16]; float sm = 0.f;
#pragma unroll
        for (int i = 0; i < 16; ++i) { ex[i] = __expf(Tt[i] - Tt[0]); sm += ex[i]; }
        const float inv = 1.0f / sm;
        unsigned short* ip = (unsigned short*)(F.ws + WS_IDX) + (row0 + lane) * 128 + h * 16; bf16* gp = (bf16*)(F.ws + WS_GW) + (row0 + lane) * 128 + h * 16;
        unsigned ew[8], gwp[8];
#pragma unroll
        for (int i2 = 0; i2 < 8; ++i2) { unsigned ev[2]; float gv[2];
#pragma unroll
            for (int e = 0; e < 2; ++e) { const int i = 2 * i2 + e; const unsigned code = __float_as_uint(Tt[i]) & 0xFFu; const unsigned i1 = code >> 4, i2b = code & 15u;
                const unsigned e1 = __float_as_uint(LST[((h * 2) * 16 + i1) * 64 + lane]) & 0x7Fu, e2 = __float_as_uint(LST[((h * 2 + 1) * 16 + i2b) * 64 + lane]) & 0x7Fu;
                ev[e] = e1 * 128u + e2; gv[e] = ex[i] * inv; }
            ew[i2] = ev[0] | (ev[1] << 16); gwp[i2] = pk2(gv[0], gv[1]); }
        *(GAS v4u*)ip = (v4u){ew[0], ew[1], ew[2], ew[3]}; *(GAS v4u*)(ip + 8) = (v4u){ew[4], ew[5], ew[6], ew[7]};
        *(GAS v4u*)gp = (v4u){gwp[0], gwp[1], gwp[2], gwp[3]}; *(GAS v4u*)(gp + 8) = (v4u){gwp[4], gwp[5], gwp[6], gwp[7]};
    }
}

typedef float f32x2 __attribute__((ext_vector_type(2)));
#define PEER_LOAD_IDX8(ee, s_) do { const size_t b_ = (size_t)TOK((s_) >> 1) * 64 + 32 * ((s_) & 1) + eg; _Pragma("unroll") for (int i_ = 0; i_ < 4; ++i_) { const unsigned w_ = IDX[b_ + 8 * i_]; ee[2 * i_] = (int)(w_ & 0xffffu); ee[2 * i_ + 1] = (int)(w_ >> 16); } } while (0)
#define PEER_LOAD_W8(ww, s_) do { const size_t b_ = (size_t)TOK((s_) >> 1) * 64 + 32 * ((s_) & 1) + eg; _Pragma("unroll") for (int i_ = 0; i_ < 4; ++i_) { const unsigned w_ = GW[b_ + 8 * i_]; ww[2 * i_] = bflo(w_); ww[2 * i_ + 1] = bfhi(w_); } } while (0)
#define PEER_GATHER8(rr, tab, ee) do { _Pragma("unroll") for (int i_ = 0; i_ < 8; ++i_) rr[i_] = *(const GAS v4u*)((tab) + (size_t)ee[i_] * 128); } while (0)
template <bool DRY>
__device__ __forceinline__ void peer_u_half(const v4u (&ur)[8], const int (&xq)[4], float inv_sx, float* pd) {
    if (DRY) {
#pragma unroll
        for (int i = 0; i < 8; ++i) pd[i] = __uint_as_float((ur[i].x ^ ur[i].y ^ ur[i].z ^ ur[i].w) & 0x3fffffffu) + inv_sx;
        return; }
#pragma unroll
    for (int i = 0; i < 8; ++i) { int a = __builtin_amdgcn_sdot4((int)ur[i].x, xq[0], 0, false); a = __builtin_amdgcn_sdot4((int)ur[i].y, xq[1], a, false);
        a = __builtin_amdgcn_sdot4((int)ur[i].z, xq[2], a, false); a = __builtin_amdgcn_sdot4((int)ur[i].w, xq[3], a, false); pd[i] = (float)a * inv_sx; }
}
template <bool DRY>
__device__ __forceinline__ void peer_u_sweep(Frame& F) {
    const int lane = F.lane, eg = lane >> 3, c = lane & 7;
    const int x = blockIdx.x & 7, rb = blockIdx.x >> 3, nrb = F.G >> 3, tper = T_TOK / nrb;
    const bf16* H1B = (const bf16*)(F.ws + WS_H1B) + 128 * x + 16 * c; const unsigned char* UT8 = F.ws + WS_UT8 + (size_t)x * (16384 * 128) + 16 * c;
    const unsigned* IDX = (const unsigned*)(F.ws + WS_IDX); unsigned* PD = DRY ? (unsigned*)(F.ws + WS_END) + 8 * c + eg : (unsigned*)(F.ws + WS_PD) + (size_t)x * T_TOK * 64 + 8 * c + eg;
    const float* SUMSQ = (const float*)(F.ws + WS_CTL + CTL_SUMSQ); const float* gf = F.in[18] + 128 * x + 16 * c;
    const f32x4 g0 = *(const GAS f32x4*)(gf), g1 = *(const GAS f32x4*)(gf + 4), g2 = *(const GAS f32x4*)(gf + 8), g3 = *(const GAS f32x4*)(gf + 12);
    const int n = tper / NWAVES, t0 = rb * tper + F.wave;
#define TOK(k) (t0 + NWAVES * ((k) < n ? (k) : n - 1))
    int ee[8]; v4u urA[8], urB[8]; v4u h0, h1; float ssq;
    PEER_LOAD_IDX8(ee, 0); h0 = *(const GAS v4u*)(H1B + (size_t)TOK(0) * 1024); h1 = *(const GAS v4u*)(H1B + (size_t)TOK(0) * 1024 + 8); ssq = SUMSQ[TOK(0)];
    PEER_GATHER8(urA, UT8, ee);
    PEER_LOAD_IDX8(ee, 1);
    for (int k = 0; k < n; ++k) {
        PEER_GATHER8(urB, UT8, ee);
        PEER_LOAD_IDX8(ee, 2 * k + 2);
        const float rs = 1.0f / sqrtf(ssq * (1.f / 1024.f) + EPS);
        float xf[16];
        xf[0] = bflo(h0.x) * rs * g0.x; xf[1] = bfhi(h0.x) * rs * g0.y; xf[2] = bflo(h0.y) * rs * g0.z; xf[3] = bfhi(h0.y) * rs * g0.w;
        xf[4] = bflo(h0.z) * rs * g1.x; xf[5] = bfhi(h0.z) * rs * g1.y; xf[6] = bflo(h0.w) * rs * g1.z; xf[7] = bfhi(h0.w) * rs * g1.w;
        xf[8] = bflo(h1.x) * rs * g2.x; xf[9] = bfhi(h1.x) * rs * g2.y; xf[10] = bflo(h1.y) * rs * g2.z; xf[11] = bfhi(h1.y) * rs * g2.w;
        xf[12] = bflo(h1.z) * rs * g3.x; xf[13] = bfhi(h1.z) * rs * g3.y; xf[14] = bflo(h1.w) * rs * g3.z; xf[15] = bfhi(h1.w) * rs * g3.w;
        float am = 1e-20f;
#pragma unroll
        for (int i = 0; i < 16; ++i) am = fmaxf(am, fabsf(xf[i]));
        am = fmaxf(am, __shfl_xor(am, 1)); am = fmaxf(am, __shfl_xor(am, 2)); am = fmaxf(am, __shfl_xor(am, 4));
        const float sx = 127.0f / am, inv_sx = am * (1.0f / 127.0f);
        int xq[4];
#pragma unroll
        for (int q = 0; q < 4; ++q) { const int b0 = __float2int_rn(xf[4 * q] * sx), b1 = __float2int_rn(xf[4 * q + 1] * sx), b2 = __float2int_rn(xf[4 * q + 2] * sx), b3 = __float2int_rn(xf[4 * q + 3] * sx);
            xq[q] = (b0 & 0xff) | ((b1 & 0xff) << 8) | ((b2 & 0xff) << 16) | (b3 << 24); }
        h0 = *(const GAS v4u*)(H1B + (size_t)TOK(k + 1) * 1024); h1 = *(const GAS v4u*)(H1B + (size_t)TOK(k + 1) * 1024 + 8); ssq = SUMSQ[TOK(k + 1)];
        float pd[16];
        peer_u_half<DRY>(urA, xq, inv_sx, pd);
        PEER_GATHER8(urA, UT8, ee);
        PEER_LOAD_IDX8(ee, 2 * k + 3);
        peer_u_half<DRY>(urB, xq, inv_sx, pd + 8);
#pragma unroll
        for (int i = 0; i < 8; ++i) { const bool up = (c & 4) != 0; const float send = up ? pd[i] : pd[i + 8]; const float keep = up ? pd[i + 8] : pd[i]; pd[i] = keep + __shfl_xor(send, 4); }
#pragma unroll
        for (int i = 0; i < 4; ++i) { const bool up = (c & 2) != 0; const float send = up ? pd[i] : pd[i + 4]; const float keep = up ? pd[i + 4] : pd[i]; pd[i] = keep + __shfl_xor(send, 2); }
#pragma unroll
        for (int i = 0; i < 2; ++i) { const bool up = (c & 1) != 0; const float send = up ? pd[i] : pd[i + 2]; const float keep = up ? pd[i + 2] : pd[i]; pd[i] = keep + __shfl_xor(send, 1); }
        __hip_atomic_store(PD + (size_t)(DRY ? (TOK(k) & 63) : TOK(k)) * 64, pk2(pd[0], pd[1]), __ATOMIC_RELAXED, __HIP_MEMORY_SCOPE_AGENT);
    }
}
__device__ __forceinline__ void peer_combine_group(Frame& F, int tok0, int ntok) {
    const unsigned* IDX = (const unsigned*)(F.ws + WS_IDX); unsigned* GW = (unsigned*)(F.ws + WS_GW); const unsigned* PD = (const unsigned*)(F.ws + WS_PD);
    const float* USC = (const float*)(F.ws + WS_USC); const float* VSC = (const float*)(F.ws + WS_VSC);
    for (int i = F.tid; i < ntok * 64; i += 2 * NWAVES * 64) {
        float d0[2], d1[2]; unsigned gwv[2], ev[2];
#pragma unroll
        for (int u = 0; u < 2; ++u) { const size_t g = (size_t)tok0 * 64 + i + u * NWAVES * 64; ev[u] = IDX[g]; gwv[u] = GW[g]; float a0 = 0.f, a1 = 0.f;
#pragma unroll
            for (int xx = 0; xx < 8; ++xx) { const unsigned p = PD[(size_t)xx * T_TOK * 64 + g]; a0 += bflo(p); a1 += bfhi(p); }
            d0[u] = a0; d1[u] = a1; }
#pragma unroll
        for (int u = 0; u < 2; ++u) { const size_t g = (size_t)tok0 * 64 + i + u * NWAVES * 64; const unsigned e0 = ev[u] & 0xffffu, e1 = ev[u] >> 16;
            const float t0 = d0[u] * USC[e0], t1 = d1[u] * USC[e1];
            const float w0 = bflo(gwv[u]) * VSC[e0] * 0.5f * t0 * (1.0f + erff(t0 * 0.70710678118654752f)), w1 = bfhi(gwv[u]) * VSC[e1] * 0.5f * t1 * (1.0f + erff(t1 * 0.70710678118654752f));
            __hip_atomic_store(GW + g, pk2(w0, w1), __ATOMIC_RELAXED, __HIP_MEMORY_SCOPE_AGENT); }
    }
}
__device__ __forceinline__ void peer_group_sync(Frame& F, int rb, unsigned target) {
    asm volatile("s_waitcnt vmcnt(0)" ::: "memory");
    __syncthreads();
    if (F.tid == 0) {
        unsigned* cnt = (unsigned*)(F.ws + WS_CTL) + 1280 + 64 * rb;
        (void)__hip_atomic_fetch_add(cnt, 1u, __ATOMIC_RELAXED, __HIP_MEMORY_SCOPE_AGENT);
        unsigned sp = 0;
        while (__hip_atomic_load(cnt, __ATOMIC_RELAXED, __HIP_MEMORY_SCOPE_AGENT) < target) { __builtin_amdgcn_s_sleep(2); if (++sp > (1u << 22)) break; }
        __builtin_amdgcn_fence(__ATOMIC_ACQUIRE, "agent"); asm volatile("s_waitcnt vmcnt(0)" ::: "memory");
    }
    __syncthreads();
}
__device__ __forceinline__ void peer_v_half(const v4u (&vr)[8], const float (&ww)[8], f32x2 (&oa)[8]) {
#pragma unroll
    for (int i = 0; i < 8; ++i) { const f32x2 w2 = (f32x2){ww[i], ww[i]}; const unsigned vw[4] = {vr[i].x, vr[i].y, vr[i].z, vr[i].w};
#pragma unroll
        for (int q = 0; q < 4; ++q) { const f32x2 lo = __builtin_amdgcn_cvt_pk_f32_fp8((int)vw[q], false), hi = __builtin_amdgcn_cvt_pk_f32_fp8((int)vw[q], true);
            oa[2 * q] = __builtin_elementwise_fma(lo, w2, oa[2 * q]); oa[2 * q + 1] = __builtin_elementwise_fma(hi, w2, oa[2 * q + 1]); } }
}
__device__ __forceinline__ void peer_v_sweep(Frame& F) {
    const int lane = F.lane, eg = lane >> 3, c = lane & 7;
    const int x = blockIdx.x & 7, rb = blockIdx.x >> 3, nrb = F.G >> 3, tper = T_TOK / nrb;
    const unsigned char* VT8 = F.ws + WS_VT8 + (size_t)x * (16384 * 128) + 16 * c;
    const unsigned* IDX = (const unsigned*)(F.ws + WS_IDX); const unsigned* GW = (const unsigned*)(F.ws + WS_GW);
    float* outp = F.out + 128 * x + 16 * c + 2 * eg; const bf16* h1p = (const bf16*)(F.ws + WS_H1B) + 128 * x + 16 * c + 2 * eg;
    const int n = tper / NWAVES, t0 = rb * tper + F.wave;
    int ee[8]; float wwA[8], wwB[8]; v4u vrA[8], vrB[8];
    PEER_LOAD_IDX8(ee, 0); PEER_LOAD_W8(wwA, 0);
    PEER_GATHER8(vrA, VT8, ee);
    PEER_LOAD_IDX8(ee, 1); PEER_LOAD_W8(wwB, 1);
    for (int k = 0; k < n; ++k) {
        PEER_GATHER8(vrB, VT8, ee);
        PEER_LOAD_IDX8(ee, 2 * k + 2);
        float* op = outp + (size_t)TOK(k) * 1024;
        const unsigned hin = *(const GAS unsigned*)(h1p + (size_t)TOK(k) * 1024);
        f32x2 oa[8];
#pragma unroll
        for (int q = 0; q < 8; ++q) oa[q] = (f32x2){0.f, 0.f};
        peer_v_half(vrA, wwA, oa);
        PEER_LOAD_W8(wwA, 2 * k + 2);
        PEER_GATHER8(vrA, VT8, ee);
        PEER_LOAD_IDX8(ee, 2 * k + 3);
        peer_v_half(vrB, wwB, oa);
        PEER_LOAD_W8(wwB, 2 * k + 3);
        float pd[16];
#pragma unroll
        for (int q = 0; q < 8; ++q) { pd[2 * q] = oa[q].x; pd[2 * q + 1] = oa[q].y; }
#pragma unroll
        for (int i = 0; i < 8; ++i) { const bool up = (eg & 4) != 0; const float send = up ? pd[i] : pd[i + 8]; const float keep = up ? pd[i + 8] : pd[i]; pd[i] = keep + __shfl_xor(send, 32); }
#pragma unroll
        for (int i = 0; i < 4; ++i) { const bool up = (eg & 2) != 0; const float send = up ? pd[i] : pd[i + 4]; const float keep = up ? pd[i + 4] : pd[i]; pd[i] = keep + __shfl_xor(send, 16); }
#pragma unroll
        for (int i = 0; i < 2; ++i) { const bool up = (eg & 1) != 0; const float send = up ? pd[i] : pd[i + 2]; const float keep = up ? pd[i + 2] : pd[i]; pd[i] = keep + __shfl_xor(send, 8); }
        f32x2 o; o.x = bflo(hin) + pd[0]; o.y = bfhi(hin) + pd[1]; *(GAS f32x2*)op = o;
    }
#undef TOK
}

__device__ __forceinline__ void peer_table_row_i8(const f32x4 (&v)[4], unsigned char* dst, float* sc, int lane) {
    float am = 0.f;
#pragma unroll
    for (int j = 0; j < 4; ++j) am = fmaxf(am, fmaxf(fmaxf(fabsf(v[j].x), fabsf(v[j].y)), fmaxf(fabsf(v[j].z), fabsf(v[j].w))));
    am = fmaxf(wave_max(am), 1e-30f);
    const float s = 127.0f / am;
#pragma unroll
    for (int j = 0; j < 4; ++j) { const int b0 = __float2int_rn(v[j].x * s), b1 = __float2int_rn(v[j].y * s), b2 = __float2int_rn(v[j].z * s), b3 = __float2int_rn(v[j].w * s);
        *(GAS unsigned*)(dst + (size_t)(2 * j + (lane >> 5)) * (16384 * 128) + 4 * (lane & 31)) = (unsigned)((b0 & 0xff) | ((b1 & 0xff) << 8) | ((b2 & 0xff) << 16) | (b3 << 24)); }
    if (lane == 0) *sc = am * (1.0f / 127.0f);
}
__device__ __forceinline__ void peer_table_row_fp8(const f32x4 (&v)[4], unsigned char* dst  , float* sc, int lane) {
    float am = 0.f;
#pragma unroll
    for (int j = 0; j < 4; ++j) am = fmaxf(am, fmaxf(fmaxf(fabsf(v[j].x), fabsf(v[j].y)), fmaxf(fabsf(v[j].z), fabsf(v[j].w))));
    am = fmaxf(wave_max(am), 1e-30f);
    const float s = 224.0f / am;
#pragma unroll
    for (int j = 0; j < 4; ++j) { int p = 0; p = __builtin_amdgcn_cvt_pk_fp8_f32(v[j].x * s, v[j].y * s, p, false); p = __builtin_amdgcn_cvt_pk_fp8_f32(v[j].z * s, v[j].w * s, p, true);
        *(GAS unsigned*)(dst + (size_t)(2 * j + (lane >> 5)) * (16384 * 128) + 4 * (lane & 31)) = (unsigned)p; }
    if (lane == 0) *sc = am * (1.0f / 224.0f);
}

struct Args { const float* in[24]; float* out; unsigned char* ws; int ph_lo, ph_hi, li, pad; };
__global__ void __launch_bounds__(NWAVES * 64, 2) hybrid_fwd(Args args) {
    extern __shared__ __attribute__((aligned(16))) unsigned char lds[];
    Frame F;
    F.lds = (LAS unsigned char*)lds;
    F.MISC = (volatile LAS unsigned*)(F.lds + MISC_OFF);
    F.tid = threadIdx.x; F.lane = F.tid & 63; F.wave = __builtin_amdgcn_readfirstlane(F.tid >> 6);
    F.G = gridDim.x; F.ws = args.ws; F.out = args.out;
#pragma unroll
    for (int i = 0; i < 24; ++i) F.in[i] = args.in[i];
    for (int u = F.tid; u < (LDS_BYTES - LDSCTL_OFF) / 4; u += NWAVES * 64) ((LAS unsigned*)(F.lds + LDSCTL_OFF))[u] = 0u;
    __syncthreads();
    unsigned* ctl = (unsigned*)(F.ws + WS_CTL);
    XcdBarrier bar; bar.bar = ctl + CW_BAR; bar.x = 0; bar.st = nullptr;
    if (N_LAUNCHES != PER_PHASE) bar = xcd_barrier_post(ctl + CW_BAR, F.MISC + 8);
#define REP(k) for (int rep_ = ((PROBE_PH == (k)) ? 0 : 1); rep_ < 2; ++rep_)
#define DUMMY (rep_ == 0)
#define STAMP(k) do { if (PROBE_TS >= 0 && F.tid == 0 && blockIdx.x == PROBE_BX) { const unsigned long long t_ = __builtin_amdgcn_s_memrealtime(); F.MISC[32 + 2 * (k)] = (unsigned)t_; F.MISC[33 + 2 * (k)] = (unsigned)(t_ >> 32); } } while (0)
#define TIC() do { if (PROBE_TS >= 100 && F.tid == 0) { const unsigned long long t_ = __builtin_amdgcn_s_memrealtime(); F.MISC[28] = (unsigned)t_; F.MISC[29] = (unsigned)(t_ >> 32); } } while (0)
#define TOC(j) do { if (PROBE_TS == 100 + (j) && F.tid == 0) { const unsigned long long t_ = __builtin_amdgcn_s_memrealtime(); const unsigned long long a_ = ((unsigned long long)F.MISC[29] << 32) | F.MISC[28]; \
    unsigned long long acc_ = ((unsigned long long)F.MISC[31] << 32) | F.MISC[30]; acc_ += t_ - a_; F.MISC[30] = (unsigned)acc_; F.MISC[31] = (unsigned)(acc_ >> 32); } } while (0)
#define GRID_BAR() do { if (N_LAUNCHES != PER_PHASE) xcd_barrier(bar); } while (0)
    const int lo = args.ph_lo, hi = args.ph_hi;
#define IN(k) (lo <= (k) && (k) < hi)
#define BOTH(k) (IN(k) && IN((k) + 1))
    const int bx = blockIdx.x;

    STAMP(0);
    if (IN(0)) { REP(0) { p0_prologue(F); __syncthreads(); } if (BOTH(0)) GRID_BAR(); STAMP(1); }

    if (IN(1)) {
        pg8::Gemm g{(const bf16*)F.out, (const bf16*)(F.ws + WS_WIN), 1024, 1024, 1024}; pg8::StaticOrder S; S.init(T_TOK, 7168, F.G, bx);
        pg8::EpiProj E{(bf16*)(F.ws + WS_GATES), 512, F.in[16], 512, SPLIT_STRIDE, 12, 22, 24, F.ws + WS_GATES};
        REP(1) pg8::gemm_phase<pg8::EpiProj, pg8::StaticOrder, true, true>(F.lds, g, S, E);
        if (BOTH(1)) GRID_BAR(); STAMP(2);
    }

    if (IN(2)) {
        { pg8::Gemm g{(const bf16*)(F.ws + WS_MEMN), (const bf16*)(F.ws + WS_WKV), 1024, 1024, 1024}; pg8::FewOrder S{4, 8, bx};
          pg8::EpiProj E{(bf16*)(F.ws + WS_KVMEM), 1024, nullptr, 0, 0, 0, 0, 0, nullptr};
          TIC(); pg8::gemm_phase<pg8::EpiProj, pg8::FewOrder, false, true>(F.lds, g, S, E); TOC(3); }
        for (;;) {
            TIC();
            __syncthreads();
            if (F.tid == 0) F.MISC[16] = __hip_atomic_fetch_add(ctl + 1024, 1u, __ATOMIC_RELAXED, __HIP_MEMORY_SCOPE_AGENT);
            __syncthreads();
            const int it = __builtin_amdgcn_readfirstlane((int)F.MISC[16]);
            TOC(2);
            if (it >= 1024) break;
            TIC();
            sb_attn_item(F, it, (bf16*)(F.ws + WS_SBQ), ~(size_t)0);
            if (PROBE_TS == 100) { __syncthreads(); TOC(0); }
        }
        {
            const int bh = bx >> 5;
            __syncthreads();
            conv_weights_to_lds(F, bh & 3);
            TIC();
            const int it0 = bh * 128 + (bx & 31) * 4;
            MlstmLocalRaw lraw; mlstm_local_load(F, it0, lraw);
            for (int k = 0; k < 4; ++k) mlstm_local_item(F, it0 + k, k < 3 ? it0 + k + 1 : -1, lraw);
            if (PROBE_TS == 101) { __syncthreads(); TOC(1); }
        }
        if (BOTH(2)) GRID_BAR(); STAMP(3);
    }

    if (IN(3)) {
        scan_prepare(F);
        { TabStream TS; tab_issue(F, TS, 0); ScanStream SS; SS.st0 = 0.f; SS.st1 = 0.f; scan_issue(F, SS, 0);
          for (int it = bx; it < 512; it += F.G) mem_attn_item(F, it, (bf16*)(F.ws + WS_MEMQ), ~(size_t)0, TS, SS);
          while (TS.k < 16) tab_step(F, TS);
          while (SS.k < 16) scan_step(F, SS);
          scan_nstate(F); }
        __syncthreads(); TOC(5);
        if (BOTH(3)) GRID_BAR(); STAMP(4);
    }

    if (IN(4)) {
        { const int bh = bx >> 5;
          __syncthreads();
          conv_weights_to_lds(F, bh & 3);
          const int it0 = bh * 128 + (bx & 31) * 4;
          MlstmRaw raw; mlstm_out_load(F, it0, raw);
          for (int k = 0; k < 4; ++k) mlstm_out_item(F, it0 + k, k < 3 ? it0 + k + 1 : -1, raw, (bf16*)(F.ws + WS_MLV), ~(size_t)0); }
        if (BOTH(4)) GRID_BAR(); STAMP(5);
    }

    if (IN(5)) {
        pg8::Gemm g{(const bf16*)(F.ws + WS_SBQ), (const bf16*)(F.ws + WS_WBR), 512, 512, 512};
        pg8::GroupOrder S; S.so.init(T_TOK, 1024, F.G, bx); S.ng = 3; S.a_gstride = 16 * MiB; S.b_gstride = (size_t)1024 * 512 * 2;
        pg8::EpiBranch E{F.ws + WS_GATES, SPLIT_STRIDE, (bf16*)(F.ws + WS_MERGED)};
        REP(5) pg8::gemm_phase<pg8::EpiBranch, pg8::GroupOrder, true, true>(F.lds, g, S, E);
        if (BOTH(5)) GRID_BAR(); STAMP(6);
    }

    if (IN(6)) {
        { pg8::Gemm g{(const bf16*)(F.ws + WS_MERGED), (const bf16*)(F.ws + WS_WOUT), 1024, 1024, 1024}; pg8::StaticOrder S; S.init(T_TOK, 1024, F.G, bx);
          REP(6) { pg8::EpiOut E{F.in[0], F.out, (bf16*)(F.ws + WS_H1B), (float*)(F.ws + WS_CTL + (DUMMY ? 768 * 1024 : CTL_SUMSQ))};
          pg8::gemm_phase<pg8::EpiOut, pg8::StaticOrder, false, true>(F.lds, g, S, E); } }
        if (BOTH(6)) GRID_BAR(); STAMP(7);
    }

    if (IN(7)) {
        pg8::Gemm g{(const bf16*)(F.ws + WS_H1B), (const bf16*)(F.ws + WS_WPQ), 1024, 1024, 1024}; pg8::StaticOrder S; S.init(T_TOK, 2048, F.G, bx);
        pg8::EpiQry E{(const float*)(F.ws + WS_CTL + CTL_SUMSQ), (bf16*)(F.ws + WS_QRY), EPS};
        REP(7) pg8::gemm_phase<pg8::EpiQry, pg8::StaticOrder, true, true>(F.lds, g, S, E);
        if (BOTH(7)) GRID_BAR(); STAMP(8);
    }

    if (IN(8)) { for (int tile = bx; tile < 256; tile += F.G) peer_route_tile(F, tile); if (BOTH(8)) GRID_BAR(); STAMP(9); }
    if (IN(9)) {
        if (PROBE_PH == 9) peer_u_sweep<true>(F);
        const int x = bx & 7, rb = bx >> 3, tper = T_TOK / (F.G >> 3);
        peer_u_sweep<false>(F);
        peer_group_sync(F, rb, 8u);
        peer_combine_group(F, rb * tper + x * (tper >> 3), tper >> 3);
        peer_group_sync(F, rb, 16u);
        peer_v_sweep(F);
    }
    if (PROBE_TS >= 0) {
        __syncthreads();
        if (bx == PROBE_BX && F.tid == 0) {
            const unsigned long long tend = __builtin_amdgcn_s_memrealtime();
            const int k0 = (PROBE_TS >= 0 && PROBE_TS < 100) ? PROBE_TS : 0;
            const unsigned long long a = ((unsigned long long)F.MISC[33 + 2 * k0] << 32) | F.MISC[32 + 2 * k0];
            const unsigned long long b = (k0 + 1 < 10) ? (((unsigned long long)F.MISC[35 + 2 * k0] << 32) | F.MISC[34 + 2 * k0]) : tend;
            const unsigned long long racc = ((unsigned long long)F.MISC[31] << 32) | F.MISC[30];
            const unsigned long long until = tend + (unsigned long long)PROBE_MULT * (PROBE_TS >= 100 ? racc : (b - a));
            while (__builtin_amdgcn_s_memrealtime() < until) __builtin_amdgcn_s_sleep(32);
        }
    }
#undef IN
#undef BOTH
#undef GRID_BAR
#undef STAMP
#undef REP
#undef DUMMY
}

extern "C" void kernel_launch(void* const* d_in, const int* in_sizes, int n_in, void* d_out, int out_size, void* d_ws, size_t ws_size, hipStream_t stream) {
    static int grid = 0;
    if (grid == 0) {
        if (n_in != 24 || out_size != T_TOK * DM || ws_size < WS_END) { fprintf(stderr, "kernel_launch: unexpected problem (n_in %d, out %d, ws %zu); nothing launched\n", n_in, out_size, ws_size); grid = -1; return; }
        int dev = 0, cus = 0, per_cu = 0;
        if (hipGetDevice(&dev) != hipSuccess || hipDeviceGetAttribute(&cus, hipDeviceAttributeMultiprocessorCount, dev) != hipSuccess) { grid = -1; return; }
        if (hipFuncSetAttribute((const void*)hybrid_fwd, hipFuncAttributeMaxDynamicSharedMemorySize, LDS_BYTES) != hipSuccess) { fprintf(stderr, "kernel_launch: hipFuncSetAttribute failed\n"); grid = -1; return; }
        if (hipOccupancyMaxActiveBlocksPerMultiprocessor(&per_cu, (const void*)hybrid_fwd, NWAVES * 64, LDS_BYTES) != hipSuccess || per_cu < 1)
            fprintf(stderr, "kernel_launch: note: occupancy query reports %d workgroups per CU\n", per_cu);
        (void)hipGetLastError();
        grid = cus;
    }
    if (grid < 0) return;
    if (hipMemsetAsync((char*)d_ws + WS_CTL, 0, CTL_ZERO_BYTES, stream) != hipSuccess) { fprintf(stderr, "kernel_launch: memset failed\n"); return; }
    Args a{};
    for (int i = 0; i < 24; ++i) a.in[i] = (const float*)d_in[i];
    a.out = (float*)d_out; a.ws = (unsigned char*)d_ws;
    for (int li = 0; li < N_LAUNCHES; ++li) {
        a.ph_lo = (N_LAUNCHES == PER_PHASE) ? li : 0; a.ph_hi = (N_LAUNCHES == PER_PHASE) ? li + 1 : PER_PHASE; a.li = li;
        hipLaunchKernelGGL(hybrid_fwd, dim3(grid), dim3(NWAVES * 64), LDS_BYTES, stream, a);
        const hipError_t le = hipPeekAtLastError();
        if (le != hipSuccess) { fprintf(stderr, "kernel_launch: launch %d failed: %s\n", li, hipGetErrorName(le)); break; }
    }
}
```
